# Optimizing an MI355X kernel written in HIP

```python
import math
import jax, jax.numpy as jnp
from jax import lax
import numpy as np

D_MODEL = 1024
BATCH = 32
SEQ = 2048
DEPTH = 2
DEC_BATCH = 16
DEC_SEQ = 64
PAST_LEN = 1024

CHUNK = 64
MIX_WIDTH = D_MODEL
CONV_CH = MIX_WIDTH // 2
SSM_WIDTH = MIX_WIDTH - CONV_CH
CONV_K = 3
SSM_GROUP = 16
SSM_GROUPS = SSM_WIDTH // SSM_GROUP
SSM_STATE = 64
IN_PROJ_WIDTH = 3 * CONV_CH + SSM_WIDTH
N_MEM = 256
MEM_HEADS = 4
MEM_HEAD_DIM = D_MODEL // MEM_HEADS
D_FF = 4 * D_MODEL
EPS = 1e-6
DT_MIN = 1e-3
DT_MAX = 1e-1
A_RE_MAX = -1e-4

kernel_name = "hybrid_conv_s5_stream_step"


def _rmsnorm(x, g):
    x32 = x.astype(jnp.float32)
    inv = lax.rsqrt(jnp.mean(x32 * x32, axis=-1, keepdims=True) + EPS)
    return (x32 * inv * g.astype(jnp.float32)).astype(x.dtype)


def _short_conv(b_gate, c_gate, v, conv_state, conv_w):
    xin = c_gate * v
    s = xin.shape[1]
    xp = jnp.concatenate([conv_state.astype(xin.dtype), xin], axis=1)
    out = conv_w[0] * xp[:, 0:s]
    for k in range(1, CONV_K):
        out = out + conv_w[k] * xp[:, k:k + s]
    return b_gate * out, xp[:, -(CONV_K - 1):]


def _lin_combine(e1, e2):
    a1, b1 = e1
    a2, b2 = e2
    return (a1 * a2, a2 * b1 + b2)


def _s5(u, h0_re, h0_im, a_re, a_im, log_dt, b_re, b_im, c_re, c_im, d_skip, w_glu):
    f32 = jnp.float32
    bsz, s, _ = u.shape
    u32 = u.astype(f32).reshape(bsz, s, SSM_GROUPS, SSM_GROUP)
    lam = lax.complex(jnp.minimum(a_re.astype(f32), A_RE_MAX), a_im.astype(f32))
    dt = jnp.exp(log_dt.astype(f32))[:, None]
    a_bar = jnp.exp(lam * dt)
    b_mat = lax.complex(b_re.astype(f32), b_im.astype(f32))
    b_bar = ((a_bar - 1.0) / lam)[:, :, None] * b_mat
    bu = jnp.einsum('bsgh,gph->bsgp', u32.astype(jnp.complex64), b_bar)
    h0 = lax.complex(h0_re.astype(f32), h0_im.astype(f32))
    bu = bu.at[:, 0].add(a_bar * h0)
    a_el = jnp.broadcast_to(a_bar, (1, s) + a_bar.shape)
    _, h = lax.associative_scan(_lin_combine, (a_el, bu), axis=1)
    c_mat = lax.complex(c_re.astype(f32), c_im.astype(f32))
    y = jnp.real(jnp.einsum('bsgp,ghp->bsgh', h, c_mat)) + d_skip.astype(f32).reshape(SSM_GROUPS, SSM_GROUP) * u32
    y = jax.nn.gelu(y.reshape(bsz, s, SSM_WIDTH))
    y = y * jax.nn.sigmoid(y @ w_glu.astype(f32))
    h_last = h[:, -1]
    return (y.astype(u.dtype), jnp.real(h_last).astype(h0_re.dtype), jnp.imag(h_last).astype(h0_re.dtype))


def _mem_kv(mem, g_mem, w_k, w_v):
    b, m, _ = mem.shape
    mn = _rmsnorm(mem, g_mem)
    k = (mn @ w_k).reshape(b, m, MEM_HEADS, MEM_HEAD_DIM)
    v = (mn @ w_v).reshape(b, m, MEM_HEADS, MEM_HEAD_DIM)
    return k, v


def _mem_attend(xn, mem_k, mem_v, w_q, w_o):
    b, s, _ = xn.shape
    q = (xn @ w_q).reshape(b, s, MEM_HEADS, MEM_HEAD_DIM)
    scores = jnp.einsum('bshd,bmhd->bhsm', q, mem_k).astype(jnp.float32) / math.sqrt(MEM_HEAD_DIM)
    probs = jax.nn.softmax(scores, axis=-1).astype(xn.dtype)
    o = jnp.einsum('bhsm,bmhd->bshd', probs, mem_v).reshape(b, s, D_MODEL)
    return o @ w_o


def _layer(x, mem_k, mem_v, conv_state, h_re, h_im,
           g_mix, w_in, conv_w, a_re, a_im, log_dt, b_re, b_im, c_re, c_im, d_skip, w_glu,
           g_grp_a, g_grp_b, w_out, g_xattn, w_q, w_o, g_mlp, w_up, w_down):
    xn = _rmsnorm(x, g_mix)
    proj = xn @ w_in
    b_gate, c_gate, v, u = jnp.split(proj, [CONV_CH, 2 * CONV_CH, 3 * CONV_CH], axis=-1)
    y_a, new_conv = _short_conv(b_gate, c_gate, v, conv_state, conv_w)
    y_b, new_re, new_im = _s5(u, h_re, h_im, a_re, a_im, log_dt, b_re, b_im, c_re, c_im, d_skip, w_glu)
    y = jnp.concatenate([_rmsnorm(y_a, g_grp_a), _rmsnorm(y_b, g_grp_b)], axis=-1)
    x = x + y @ w_out
    x = x + _mem_attend(_rmsnorm(x, g_xattn), mem_k, mem_v, w_q, w_o)
    hdn = jnp.square(jax.nn.relu(_rmsnorm(x, g_mlp) @ w_up))
    x = x + hdn @ w_down
    return x, new_conv, new_re, new_im


def setup_inputs(seed: int = 0) -> dict:
    key = jax.random.key(seed)
    ks = jax.random.split(key, 40)
    f32 = jnp.float32

    def nrm(k, shape, fan_in):
        return jax.random.normal(k, shape, f32) * fan_in ** -0.5

    def gain(k, shape):
        return 1.0 + 0.02 * jax.random.normal(k, shape, f32)

    L, G, P, H = DEPTH, SSM_GROUPS, SSM_STATE, SSM_GROUP
    a_im_base = jnp.pi * jnp.arange(P, dtype=f32)
    return {
        "x_prompt": jax.random.normal(ks[0], (BATCH, SEQ, D_MODEL), f32),
        "x_sample": jax.random.normal(ks[1], (DEC_BATCH, DEC_SEQ, D_MODEL), f32),
        "mem_prompt": jax.random.normal(ks[2], (BATCH, N_MEM, D_MODEL), f32),
        "state_conv": jax.random.normal(ks[3], (L, DEC_BATCH, CONV_K - 1, CONV_CH), f32),
        "state_ssm_re": 0.5 * jax.random.normal(ks[4], (L, DEC_BATCH, G, P), f32),
        "state_ssm_im": 0.5 * jax.random.normal(ks[5], (L, DEC_BATCH, G, P), f32),
        "cache_mem_k": jax.random.normal(ks[6], (L, DEC_BATCH, N_MEM, MEM_HEADS, MEM_HEAD_DIM), f32),
        "cache_mem_v": jax.random.normal(ks[7], (L, DEC_BATCH, N_MEM, MEM_HEADS, MEM_HEAD_DIM), f32),
        "g_mix": gain(ks[8], (L, D_MODEL)),
        "w_in": nrm(ks[9], (L, D_MODEL, IN_PROJ_WIDTH), D_MODEL),
        "conv_w": nrm(ks[10], (L, CONV_K, CONV_CH), CONV_K),
        "ssm_a_re": -0.5 + 0.01 * jax.random.normal(ks[11], (L, G, P), f32),
        "ssm_a_im": a_im_base + 0.01 * jax.random.normal(ks[12], (L, G, P), f32),
        "ssm_log_dt": jax.random.uniform(ks[13], (L, G), f32, math.log(DT_MIN), math.log(DT_MAX)),
        "ssm_b_re": nrm(ks[14], (L, G, P, H), 2 * H),
        "ssm_b_im": nrm(ks[15], (L, G, P, H), 2 * H),
        "ssm_c_re": nrm(ks[16], (L, G, H, P), 2 * P),
        "ssm_c_im": nrm(ks[17], (L, G, H, P), 2 * P),
        "ssm_d": jax.random.normal(ks[18], (L, SSM_WIDTH), f32),
        "w_glu": nrm(ks[19], (L, SSM_WIDTH, SSM_WIDTH), SSM_WIDTH),
        "g_grp_a": gain(ks[20], (L, CONV_CH)),
        "g_grp_b": gain(ks[21], (L, SSM_WIDTH)),
        "w_out": nrm(ks[22], (L, MIX_WIDTH, D_MODEL), MIX_WIDTH),
        "g_xattn": gain(ks[23], (L, D_MODEL)),
        "g_mem": gain(ks[24], (L, D_MODEL)),
        "w_q": nrm(ks[25], (L, D_MODEL, D_MODEL), D_MODEL),
        "w_k": nrm(ks[26], (L, D_MODEL, D_MODEL), D_MODEL),
        "w_v": nrm(ks[27], (L, D_MODEL, D_MODEL), D_MODEL),
        "w_o": nrm(ks[28], (L, D_MODEL, D_MODEL), D_MODEL),
        "g_mlp": gain(ks[29], (L, D_MODEL)),
        "w_up": nrm(ks[30], (L, D_MODEL, D_FF), D_MODEL),
        "w_down": nrm(ks[31], (L, D_FF, D_MODEL), D_FF),
        "g_final": gain(ks[32], (D_MODEL,)),
    }


def reference(x_prompt, x_sample, mem_prompt, state_conv, state_ssm_re, state_ssm_im,
              cache_mem_k, cache_mem_v,
              g_mix, w_in, conv_w, ssm_a_re, ssm_a_im, ssm_log_dt, ssm_b_re, ssm_b_im,
              ssm_c_re, ssm_c_im, ssm_d, w_glu, g_grp_a, g_grp_b, w_out,
              g_xattn, g_mem, w_q, w_k, w_v, w_o, g_mlp, w_up, w_down, g_final):
    bp = x_prompt.shape[0]
    xp = x_prompt
    xs = x_sample
    conv_p, re_p, im_p, mk_p, mv_p = [], [], [], [], []
    conv_s, re_s, im_s = [], [], []
    zero_conv = jnp.zeros((bp, CONV_K - 1, CONV_CH), x_prompt.dtype)
    zero_h = jnp.zeros((bp, SSM_GROUPS, SSM_STATE), x_prompt.dtype)
    for l in range(DEPTH):
        lw = (g_mix[l], w_in[l], conv_w[l], ssm_a_re[l], ssm_a_im[l], ssm_log_dt[l],
              ssm_b_re[l], ssm_b_im[l], ssm_c_re[l], ssm_c_im[l], ssm_d[l], w_glu[l],
              g_grp_a[l], g_grp_b[l], w_out[l], g_xattn[l], w_q[l], w_o[l],
              g_mlp[l], w_up[l], w_down[l])
        mk, mv = _mem_kv(mem_prompt, g_mem[l], w_k[l], w_v[l])
        xp, c_new, r_new, i_new = _layer(xp, mk, mv, zero_conv, zero_h, zero_h, *lw)
        conv_p.append(c_new)
        re_p.append(r_new)
        im_p.append(i_new)
        mk_p.append(mk)
        mv_p.append(mv)
        xs, c_new, r_new, i_new = _layer(xs, cache_mem_k[l], cache_mem_v[l], state_conv[l],
                                         state_ssm_re[l], state_ssm_im[l], *lw)
        conv_s.append(c_new)
        re_s.append(r_new)
        im_s.append(i_new)
    y_prompt = _rmsnorm(xp, g_final)
    y_sample = _rmsnorm(xs, g_final)
    return (y_prompt, y_sample,
            jnp.stack(conv_p), jnp.stack(re_p), jnp.stack(im_p), jnp.stack(mk_p), jnp.stack(mv_p),
            jnp.stack(conv_s), jnp.stack(re_s), jnp.stack(im_s))
```

```cpp
#include <hip/hip_runtime.h>
#include <hip/hip_cooperative_groups.h>
#include <cstdio>
#include <cstdint>
namespace cg = cooperative_groups;

#define LAS __attribute__((address_space(3)))
typedef unsigned short bf16_t;
typedef short bf16x8 __attribute__((ext_vector_type(8)));
typedef short bf16x4 __attribute__((ext_vector_type(4)));
typedef float f32x2 __attribute__((ext_vector_type(2)));
typedef float f32x4 __attribute__((ext_vector_type(4)));
typedef float f32x16 __attribute__((ext_vector_type(16)));
typedef unsigned u32x4 __attribute__((ext_vector_type(4)));
typedef unsigned u32x2 __attribute__((ext_vector_type(2)));

constexpr int D = 1024, NB = 32, SEQ = 2048, NDB = 16, DSEQ = 64, DEPTH = 2;
constexpr int TP = NB * SEQ, TS = NDB * DSEQ, T = TP + TS;
constexpr int NMEM = 256, TM = NB * NMEM, TMS = NDB * NMEM;
constexpr int DFF = 4096, CH = 512;
constexpr float EPS = 1e-6f;
constexpr size_t O_YP = 0, O_YS = O_YP + (size_t)TP * D, O_CONVP = O_YS + (size_t)TS * D, O_REP = O_CONVP + (size_t)DEPTH * NB * 2 * CH,
                 O_IMP = O_REP + (size_t)DEPTH * NB * 32 * 64, O_MKP = O_IMP + (size_t)DEPTH * NB * 32 * 64, O_MVP = O_MKP + (size_t)DEPTH * TM * D,
                 O_CONVS = O_MVP + (size_t)DEPTH * TM * D, O_RES = O_CONVS + (size_t)DEPTH * NDB * 2 * CH, O_IMS = O_RES + (size_t)DEPTH * NDB * 32 * 64,
                 O_END = O_IMS + (size_t)DEPTH * NDB * 32 * 64;
constexpr size_t MiB = 1u << 20;
constexpr size_t WS_SS = 0;
constexpr size_t WS_W = 4 * MiB, W_LAYER = 31 * MiB;
constexpr size_t W_IN = 0, W_GLU = 4 * MiB, W_OUT = 4 * MiB + MiB / 2, W_Q = 6 * MiB + MiB / 2, W_KV = 8 * MiB + MiB / 2, W_O = 12 * MiB + MiB / 2,
                 W_UP = 14 * MiB + MiB / 2, W_DOWN = 22 * MiB + MiB / 2;
constexpr size_t WS_XB = 66 * MiB;
constexpr size_t WS_MNB = 196 * MiB;
constexpr size_t WS_KB = 212 * MiB;
constexpr size_t WS_VT = 244 * MiB;
constexpr size_t WS_KC = 276 * MiB;
constexpr size_t WS_VTC = 292 * MiB;
constexpr size_t WS_BIG = 308 * MiB;
constexpr size_t SZ_T512 = (size_t)T * 512 * 2;
constexpr size_t WS_BG = WS_BIG, WS_XIN = WS_BG + SZ_T512, WS_U = WS_XIN + SZ_T512, WS_YG = WS_U + SZ_T512, WS_YCAT = WS_YG + SZ_T512;
constexpr size_t WS_Q = WS_BG, WS_O = WS_U, WS_HDN = WS_BIG;
constexpr size_t WS_SMALL = WS_BIG + (size_t)T * DFF * 2;
constexpr size_t WS_END = WS_SMALL + 4 * MiB;
constexpr int SM_ARE = 0, SM_AIM = 4096, SM_LOGDT = 8192, SM_BRE = 8256, SM_BIM = SM_BRE + 65536, SM_CRE = SM_BIM + 65536, SM_CIM = SM_CRE + 65536, SM_SD = SM_CIM + 65536,
              SM_CONVW = SM_SD + 1024, SM_SCONV = SM_CONVW + 3072, SM_SRE = SM_SCONV + 32768, SM_SIM = SM_SRE + 65536, SM_GFIN = SM_SIM + 65536, SM_END = SM_GFIN + 1024;
static_assert(WS_YCAT + 2 * SZ_T512 <= WS_END, "ws map");

constexpr int LDS_BYTES = 256 * 528 + 1024;

__device__ __forceinline__ unsigned cvt_pk_bf16(float lo, float hi) { unsigned r; asm volatile("v_cvt_pk_bf16_f32 %0, %1, %2" : "=v"(r) : "v"(lo), "v"(hi)); return r; }
__device__ __forceinline__ float bf_lo(unsigned w) { return __uint_as_float(w << 16); }
__device__ __forceinline__ float bf_hi(unsigned w) { return __uint_as_float(w & 0xffff0000u); }
__device__ __forceinline__ float wave_sum(float v) {
#pragma unroll
    for (int o = 1; o < 64; o <<= 1) v += __shfl_xor(v, o);
    return v;
}
#define LDS_WAIT() asm volatile("s_waitcnt lgkmcnt(0)" ::: "memory")

namespace pg8 {
constexpr int BM = 256, BK = 64, HALF = 128, HTB = HALF * BK * 2, STAGE_BYTES = 8 * HTB, NXCD = 8, WGM = 8;
__host__ __device__ __forceinline__ int lds_byte(int r, int c) { const int st = (r >> 4) * 2 + (c >> 5), rr = r & 15, cc = c & 31, ob = rr * 64 + cc * 2; return st * 1024 + (ob ^ (((ob >> 9) & 1) << 5)); }
__host__ __device__ __forceinline__ void stage_rc(int b, int& R, int& C) { const int st = b / 1024, sb = b % 1024, swz = sb ^ (((sb >> 9) & 1) << 5); R = (st >> 1) * 16 + swz / 64; C = (st & 1) * 32 + (swz % 64) / 2; }
__host__ __device__ __forceinline__ int perm32(int rho) { const int n = rho >> 4, i = rho & 15; return 8 * (i >> 2) + 4 * n + (i & 3); }

struct Unit { int pm, pn; };
struct Gemm { const bf16_t* A; const bf16_t* Bt; int M, N, K; };

struct StaticOrder {
    int nM, nN, nwg, G, c;
    __device__ void init(int M, int N, int G_, int c_) { nM = M / BM; nN = N / BM; nwg = nM * nN; G = G_; c = c_; }
    __device__ bool next(int i, Unit& u) const {
        const long L = (long)i * G + c; if (L >= nwg) return false;
        int wgid = (int)L; { const int q = nwg / NXCD, r = nwg % NXCD, xcd = wgid % NXCD, off = wgid / NXCD; wgid = (xcd < r ? xcd * (q + 1) : r * (q + 1) + (xcd - r) * q) + off; }
        const int nig = WGM * nN, gid = wgid / nig, fm = gid * WGM, gsz = (nM - fm) < WGM ? (nM - fm) : WGM;
        u.pm = fm + ((wgid % nig) % gsz); u.pn = (wgid % nig) / gsz; return true;
    }
};

template <class Epi, bool SP2>
__device__ __forceinline__ void gemm_phase(LAS unsigned char* lds, const Gemm g, const StaticOrder& S, const Epi& E) {
    int tid = threadIdx.x; asm volatile("" : "+v"(tid));
    const int wid = __builtin_amdgcn_readfirstlane(tid >> 6), lane = tid & 63, wr = wid >> 2, wc = wid & 3, fr = lane & 15, fq = lane >> 4;
    const int K = g.K, nt = K / BK;
    unsigned voffA[2], voffB[2];
#pragma unroll
    for (int i = 0; i < 2; ++i) { int R, C; stage_rc(tid * 16 + i * 8192, R, C); const int Rb = Epi::PERM ? ((R & ~31) + perm32(R & 31)) : R;
        voffA[i] = (unsigned)(R * K + C) * 2u; voffB[i] = (unsigned)(Rb * K + C) * 2u; }
    const size_t kstep = (size_t)(BK * 2);
    const size_t hstep = (size_t)HALF * K * 2;
    const size_t tstep = 2 * hstep;
    const unsigned ldsw = (unsigned)wid * 1024u;
    const int aoff = lds_byte(wr * 64 + fr, fq * 8), boff = lds_byte(wc * 32 + fr, fq * 8);
#define PG8_SA(b, h) (((b) * 2 + (h)) * HTB)
#define PG8_SB(b, h) ((4 + (b) * 2 + (h)) * HTB)
#define PG8_STAGE(bufoff, gbase, voff) do { _Pragma("unroll") for (int _i = 0; _i < 2; ++_i) \
        __builtin_amdgcn_global_load_lds((const unsigned*)((const char*)(gbase) + (voff)[_i]), (LAS unsigned*)(lds + (bufoff) + ldsw + _i * 8192), 16, 0, 0); } while (0)
#define PG8_LDA(dst, b, h) do { _Pragma("unroll") for (int m = 0; m < 4; ++m) _Pragma("unroll") for (int k = 0; k < 2; ++k) dst[m][k] = *(const LAS bf16x8*)(lds + PG8_SA(b, h) + aoff + m * 2048 + k * 1024); } while (0)
#define PG8_LDB(dst, b, h) do { _Pragma("unroll") for (int n = 0; n < 2; ++n) _Pragma("unroll") for (int k = 0; k < 2; ++k) dst[n][k] = *(const LAS bf16x8*)(lds + PG8_SB(b, h) + boff + n * 2048 + k * 1024); } while (0)
#define PG8_MMA(ai, bj, At, Bt) do { __builtin_amdgcn_s_setprio(1); _Pragma("unroll") for (int m = 0; m < 4; ++m) _Pragma("unroll") for (int n = 0; n < 2; ++n) _Pragma("unroll") for (int k = 0; k < 2; ++k) \
        acc[ai][bj][m][n] = __builtin_amdgcn_mfma_f32_16x16x32_bf16(Bt[n][k], At[m][k], acc[ai][bj][m][n], 0, 0, 0); __builtin_amdgcn_s_setprio(0); } while (0)
#define PG8_WAIT_V(n) asm volatile("s_waitcnt vmcnt(" #n ")" ::: "memory")
#define PG8_WAIT_L(n) asm volatile("s_waitcnt lgkmcnt(" #n ")" ::: "memory")
#define PG8_BAR __builtin_amdgcn_s_barrier()
#define PG8_SCHED __builtin_amdgcn_sched_barrier(0)
    Unit cur, nxt; int ui = 0;
    if (!S.next(0, cur)) return;
    f32x4 acc[2][2][4][2];
#pragma unroll
    for (int a = 0; a < 2; ++a)
#pragma unroll
        for (int b = 0; b < 2; ++b)
#pragma unroll
            for (int m = 0; m < 4; ++m)
#pragma unroll
                for (int n = 0; n < 2; ++n) acc[a][b][m][n] = (f32x4){0.f, 0.f, 0.f, 0.f};
    bf16x8 At[4][2], B0[2][2], B1[2][2];
    const char* cA = (const char*)g.A + (size_t)cur.pm * tstep; const char* cB = (const char*)g.Bt + (size_t)cur.pn * tstep;
    if constexpr (SP2) {
        PG8_STAGE(PG8_SB(0, 0), cB, voffB); PG8_STAGE(PG8_SB(0, 1), cB + hstep, voffB); PG8_STAGE(PG8_SA(0, 0), cA, voffA); PG8_STAGE(PG8_SA(0, 1), cA + hstep, voffA);
        if (wr == 1) PG8_BAR;
        PG8_WAIT_V(2); PG8_BAR;
        PG8_STAGE(PG8_SB(1, 0), cB + kstep, voffB); PG8_STAGE(PG8_SA(1, 0), cA + kstep, voffA); PG8_STAGE(PG8_SB(1, 1), cB + hstep + kstep, voffB);
        PG8_WAIT_V(6); PG8_BAR;
    } else {
        PG8_STAGE(PG8_SB(0, 0), cB, voffB); PG8_STAGE(PG8_SA(0, 0), cA, voffA); PG8_STAGE(PG8_SB(0, 1), cB + hstep, voffB); PG8_STAGE(PG8_SA(0, 1), cA + hstep, voffA);
        if (wr == 1) PG8_BAR;
        PG8_WAIT_V(4); PG8_BAR;
        PG8_STAGE(PG8_SB(1, 0), cB + kstep, voffB); PG8_STAGE(PG8_SA(1, 0), cA + kstep, voffA); PG8_STAGE(PG8_SB(1, 1), cB + hstep + kstep, voffB);
        PG8_WAIT_V(6); PG8_BAR;
    }
    for (;;) {
        const bool has_next = S.next(ui + 1, nxt);
        const char* nA = has_next ? (const char*)g.A + (size_t)nxt.pm * tstep : cA; const char* nB = has_next ? (const char*)g.Bt + (size_t)nxt.pn * tstep : cB;
        for (int t = 0; t < nt; t += 2) {
            const bool last = (t == nt - 2);
            const char* a1 = cA + (size_t)(t + 1) * kstep;
            const char* a2 = last ? nA : cA + (size_t)(t + 2) * kstep; const char* b2 = last ? nB : cB + (size_t)(t + 2) * kstep;
            const char* a3 = a2 + kstep; const char* b3 = b2 + kstep;
            if constexpr (Epi::MID) { if (t == (nt >> 1)) E.mid(acc, cur, wr, fr); }
            if constexpr (SP2) {
            PG8_LDB(B0, 0, 0); PG8_LDB(B1, 0, 1); PG8_SCHED; PG8_LDA(At, 0, 0); PG8_STAGE(PG8_SA(1, 1), a1 + hstep, voffA);
            PG8_WAIT_V(8); PG8_WAIT_L(0); PG8_BAR; PG8_MMA(0, 0, At, B0); PG8_MMA(0, 1, At, B1); PG8_BAR; PG8_SCHED;
            PG8_LDA(At, 0, 1); PG8_STAGE(PG8_SB(0, 0), b2, voffB); PG8_STAGE(PG8_SB(0, 1), b2 + hstep, voffB); PG8_STAGE(PG8_SA(0, 0), a2, voffA);
            PG8_WAIT_V(8); PG8_WAIT_L(0); PG8_BAR; PG8_MMA(1, 0, At, B0); PG8_MMA(1, 1, At, B1); PG8_BAR; PG8_SCHED;
            PG8_LDB(B0, 1, 0); PG8_LDB(B1, 1, 1); PG8_SCHED; PG8_LDA(At, 1, 0); PG8_STAGE(PG8_SA(0, 1), a2 + hstep, voffA);
            PG8_WAIT_V(8); PG8_WAIT_L(0); PG8_BAR; PG8_MMA(0, 0, At, B0); PG8_MMA(0, 1, At, B1); PG8_BAR; PG8_SCHED;
            PG8_LDA(At, 1, 1); PG8_STAGE(PG8_SB(1, 0), b3, voffB); PG8_STAGE(PG8_SB(1, 1), b3 + hstep, voffB); PG8_STAGE(PG8_SA(1, 0), a3, voffA);
            PG8_WAIT_V(8); PG8_WAIT_L(0); PG8_BAR; PG8_MMA(1, 0, At, B0); PG8_MMA(1, 1, At, B1); PG8_BAR; PG8_SCHED;
            } else {
            PG8_LDB(B0, 0, 0); PG8_SCHED; PG8_LDA(At, 0, 0); PG8_STAGE(PG8_SA(1, 1), a1 + hstep, voffA);
            PG8_WAIT_L(8); PG8_BAR; PG8_WAIT_L(0); PG8_MMA(0, 0, At, B0); PG8_BAR; PG8_SCHED;
            PG8_LDB(B1, 0, 1); PG8_STAGE(PG8_SB(0, 0), b2, voffB);
            PG8_BAR; PG8_WAIT_L(0); PG8_MMA(0, 1, At, B1); PG8_BAR;
            PG8_LDA(At, 0, 1); PG8_STAGE(PG8_SA(0, 0), a2, voffA);
            PG8_BAR; PG8_WAIT_L(0); PG8_MMA(1, 0, At, B0); PG8_BAR; PG8_SCHED;
            PG8_STAGE(PG8_SB(0, 1), b2 + hstep, voffB);
            PG8_WAIT_V(6); PG8_BAR; PG8_MMA(1, 1, At, B1); PG8_BAR;
            PG8_LDB(B0, 1, 0); PG8_SCHED; PG8_LDA(At, 1, 0); PG8_STAGE(PG8_SA(0, 1), a2 + hstep, voffA);
            PG8_WAIT_L(8); PG8_BAR; PG8_WAIT_L(0); PG8_MMA(0, 0, At, B0); PG8_BAR; PG8_SCHED;
            PG8_LDB(B1, 1, 1); PG8_STAGE(PG8_SB(1, 0), b3, voffB);
            PG8_BAR; PG8_WAIT_L(0); PG8_MMA(0, 1, At, B1); PG8_BAR;
            PG8_LDA(At, 1, 1); PG8_STAGE(PG8_SA(1, 0), a3, voffA);
            PG8_BAR; PG8_WAIT_L(0); PG8_MMA(1, 0, At, B0); PG8_BAR; PG8_SCHED;
            PG8_STAGE(PG8_SB(1, 1), b3 + hstep, voffB);
            PG8_WAIT_V(6); PG8_BAR; PG8_MMA(1, 1, At, B1); PG8_BAR;
            }
        }
        if (wr == 0) PG8_BAR;
        E(acc, cur, wr, wc, fr, fq);
        if (!has_next) break;
#pragma unroll
        for (int a = 0; a < 2; ++a)
#pragma unroll
            for (int b = 0; b < 2; ++b)
#pragma unroll
                for (int m = 0; m < 4; ++m)
#pragma unroll
                    for (int n = 0; n < 2; ++n) acc[a][b][m][n] = (f32x4){0.f, 0.f, 0.f, 0.f};
        cur = nxt; cA = nA; cB = nB; ++ui;
        if (wr == 1) PG8_BAR;
    }
    PG8_WAIT_V(0);
    PG8_BAR;
#undef PG8_SA
#undef PG8_SB
#undef PG8_STAGE
#undef PG8_LDA
#undef PG8_LDB
#undef PG8_MMA
#undef PG8_WAIT_V
#undef PG8_WAIT_L
#undef PG8_BAR
#undef PG8_SCHED
}
}
using pg8::Unit;
typedef f32x4 Acc[2][2][4][2];

__device__ __forceinline__ void store8_bf16(bf16_t* p, const f32x4& a, const f32x4& b) {
    u32x4 w; w.x = cvt_pk_bf16(a[0], a[1]); w.y = cvt_pk_bf16(a[2], a[3]); w.z = cvt_pk_bf16(b[0], b[1]); w.w = cvt_pk_bf16(b[2], b[3]);
    *(u32x4*)p = w;
}
__device__ __forceinline__ void unpack8(const u32x4 w, f32x4& a, f32x4& b) {
    a = (f32x4){bf_lo(w.x), bf_hi(w.x), bf_lo(w.y), bf_hi(w.y)}; b = (f32x4){bf_lo(w.z), bf_hi(w.z), bf_lo(w.w), bf_hi(w.w)};
}

struct EpiInProj {
    static constexpr bool PERM = true, MID = false;
    bf16_t* BG; bf16_t* XIN; bf16_t* U; const float* ss; float* convp; float* convs;
    __device__ __forceinline__ void operator()(const Acc& acc, const Unit& u, int wr, int wc, int fr, int fq) const {
        const int row0 = u.pm * 256 + wr * 64 + fr, cb = wc * 32 + 8 * fq;
#pragma unroll
        for (int ai = 0; ai < 2; ++ai)
#pragma unroll
            for (int m = 0; m < 4; ++m) {
                const int r = row0 + ai * 128 + m * 16;
                const float inv = rsqrtf(ss[r] * (1.0f / D) + EPS);
                if (u.pn < 2 || u.pn >= 6) {
                    bf16_t* dst = (u.pn < 2 ? BG : U) + (size_t)r * CH + (u.pn & 1) * 256 + cb;
#pragma unroll
                    for (int bj = 0; bj < 2; ++bj) store8_bf16(dst + bj * 128, acc[ai][bj][m][0] * inv, acc[ai][bj][m][1] * inv);
                } else {
                    const int c0 = (u.pn - 2) * 128 + cb;
                    const f32x4 x0 = (acc[ai][0][m][0] * inv) * (acc[ai][1][m][0] * inv), x1 = (acc[ai][0][m][1] * inv) * (acc[ai][1][m][1] * inv);
                    store8_bf16(XIN + (size_t)r * CH + c0, x0, x1);
                    float* cd = nullptr;
                    if (r < TP) { const int t = r & (SEQ - 1); if (t >= SEQ - 2) cd = convp + ((size_t)(r >> 11) * 2 + (t - (SEQ - 2))) * CH + c0; }
                    else { const int rs = r - TP, t = rs & (DSEQ - 1); if (t >= DSEQ - 2) cd = convs + ((size_t)(rs >> 6) * 2 + (t - (DSEQ - 2))) * CH + c0; }
                    if (cd) { *(f32x4*)cd = x0; *(f32x4*)(cd + 4) = x1; }
                }
            }
    }
};
struct EpiKV {
    static constexpr bool PERM = false, MID = false;
    float* outK; float* outV; bf16_t* KB; const float* invm;
    __device__ __forceinline__ void operator()(const Acc& acc, const Unit& u, int wr, int wc, int fr, int fq) const {
        const int row0 = u.pm * 256 + wr * 64 + fr, col0 = (u.pn & 3) * 256 + wc * 32 + 4 * fq;
        float* outp = u.pn < 4 ? outK : outV;
#pragma unroll
        for (int ai = 0; ai < 2; ++ai)
#pragma unroll
            for (int m = 0; m < 4; ++m) {
                const int r = row0 + ai * 128 + m * 16; const float inv = invm[r];
#pragma unroll
                for (int bj = 0; bj < 2; ++bj)
#pragma unroll
                    for (int n = 0; n < 2; ++n) {
                        const f32x4 v = acc[ai][bj][m][n] * inv; const size_t o = (size_t)r * D + col0 + bj * 128 + n * 16;
                        *(f32x4*)(outp + o) = v;
                        if (u.pn < 4) { u32x2 w; w.x = cvt_pk_bf16(v[0], v[1]); w.y = cvt_pk_bf16(v[2], v[3]); *(u32x2*)(KB + o) = w; }
                    }
            }
    }
};
struct EpiVT {
    static constexpr bool PERM = true, MID = false;
    bf16_t* VT; const float* invm;
    __device__ __forceinline__ void operator()(const Acc& acc, const Unit& u, int wr, int wc, int fr, int fq) const {
        const int row0 = u.pm * 256 + wr * 64 + fr, col0 = u.pn * 256 + wc * 32 + 8 * fq;
        f32x4 s[2][2];
#pragma unroll
        for (int bj = 0; bj < 2; ++bj) { s[bj][0] = *(const f32x4*)(invm + col0 + bj * 128); s[bj][1] = *(const f32x4*)(invm + col0 + bj * 128 + 4); }
#pragma unroll
        for (int ai = 0; ai < 2; ++ai)
#pragma unroll
            for (int m = 0; m < 4; ++m) {
                const int r = row0 + ai * 128 + m * 16;
#pragma unroll
                for (int bj = 0; bj < 2; ++bj) store8_bf16(VT + (size_t)r * TM + col0 + bj * 128, acc[ai][bj][m][0] * s[bj][0], acc[ai][bj][m][1] * s[bj][1]);
            }
    }
};
struct EpiGLU {
    static constexpr bool PERM = true, MID = false;
    const bf16_t* YG; bf16_t* YCAT; float* ssb;
    __device__ __forceinline__ void operator()(const Acc& acc, const Unit& u, int wr, int wc, int fr, int fq) const {
        const int row0 = u.pm * 256 + wr * 64 + fr, col0 = u.pn * 256 + wc * 32 + 8 * fq;
#pragma unroll
        for (int ai = 0; ai < 2; ++ai)
#pragma unroll
            for (int m = 0; m < 4; ++m) {
                const int r = row0 + ai * 128 + m * 16; float ssum = 0.f;
#pragma unroll
                for (int bj = 0; bj < 2; ++bj) {
                    f32x4 y0, y1; unpack8(*(const u32x4*)(YG + (size_t)r * CH + col0 + bj * 128), y0, y1);
                    f32x4 z0 = acc[ai][bj][m][0], z1 = acc[ai][bj][m][1];
#pragma unroll
                    for (int e = 0; e < 4; ++e) { y0[e] = y0[e] * __builtin_amdgcn_rcpf(1.0f + __expf(-z0[e])); y1[e] = y1[e] * __builtin_amdgcn_rcpf(1.0f + __expf(-z1[e]));
                        ssum += y0[e] * y0[e] + y1[e] * y1[e]; }
                    store8_bf16(YCAT + (size_t)r * D + col0 + bj * 128, y0, y1);
                }
                ssum += __shfl_xor(ssum, 16); ssum += __shfl_xor(ssum, 32);
                if (fq == 0) atomicAdd(ssb + r, ssum);
            }
    }
};
template <bool MIDS> struct EpiRes {
    static constexpr bool PERM = true, MID = MIDS;
    bf16_t* XB; float* ssout; const float* ssb;
    __device__ __forceinline__ void mid(Acc& acc, const Unit& u, int wr, int fr) const {
        const int row0 = u.pm * 256 + wr * 64 + fr;
#pragma unroll
        for (int ai = 0; ai < 2; ++ai)
#pragma unroll
            for (int m = 0; m < 4; ++m) {
                const float s = rsqrtf(ssb[row0 + ai * 128 + m * 16] * (1.0f / CH) + EPS);
#pragma unroll
                for (int bj = 0; bj < 2; ++bj)
#pragma unroll
                    for (int n = 0; n < 2; ++n) acc[ai][bj][m][n] *= s;
            }
    }
    __device__ __forceinline__ void operator()(const Acc& acc, const Unit& u, int wr, int wc, int fr, int fq) const {
        const int row0 = u.pm * 256 + wr * 64 + fr, col0 = u.pn * 256 + wc * 32 + 8 * fq;
#pragma unroll
        for (int ai = 0; ai < 2; ++ai)
#pragma unroll
            for (int m = 0; m < 4; ++m) {
                const int r = row0 + ai * 128 + m * 16; float ssum = 0.f;
#pragma unroll
                for (int bj = 0; bj < 2; ++bj) {
                    bf16_t* p = XB + (size_t)r * D + col0 + bj * 128;
                    f32x4 x0, x1; unpack8(*(const u32x4*)p, x0, x1);
                    x0 += acc[ai][bj][m][0]; x1 += acc[ai][bj][m][1];
#pragma unroll
                    for (int e = 0; e < 4; ++e) ssum += x0[e] * x0[e] + x1[e] * x1[e];
                    store8_bf16(p, x0, x1);
                }
                ssum += __shfl_xor(ssum, 16); ssum += __shfl_xor(ssum, 32);
                if (fq == 0) atomicAdd(ssout + r, ssum);
            }
    }
};
template <int ACT> struct EpiScale {
    static constexpr bool PERM = true, MID = false;
    bf16_t* OUT; int ldc; const float* ss;
    __device__ __forceinline__ void operator()(const Acc& acc, const Unit& u, int wr, int wc, int fr, int fq) const {
        const int row0 = u.pm * 256 + wr * 64 + fr, col0 = u.pn * 256 + wc * 32 + 8 * fq;
#pragma unroll
        for (int ai = 0; ai < 2; ++ai)
#pragma unroll
            for (int m = 0; m < 4; ++m) {
                const int r = row0 + ai * 128 + m * 16; const float inv = rsqrtf(ss[r] * (1.0f / D) + EPS);
#pragma unroll
                for (int bj = 0; bj < 2; ++bj) {
                    f32x4 v0 = acc[ai][bj][m][0] * inv, v1 = acc[ai][bj][m][1] * inv;
                    if (ACT == 1) {
#pragma unroll
                        for (int e = 0; e < 4; ++e) { const float a = fmaxf(v0[e], 0.f), b = fmaxf(v1[e], 0.f); v0[e] = a * a; v1[e] = b * b; }
                    }
                    store8_bf16(OUT + (size_t)r * ldc + col0 + bj * 128, v0, v1);
                }
            }
    }
};

struct Args { const float* in[33]; float* out; unsigned char* ws; };
enum { I_XP = 0, I_XS, I_MEM, I_SCONV, I_SRE, I_SIM, I_CK, I_CV, I_GMIX, I_WIN, I_CONVW, I_ARE, I_AIM, I_LOGDT, I_BRE, I_BIM, I_CRE, I_CIM, I_SD, I_WGLU,
       I_GA, I_GB, I_WOUT, I_GX, I_GMEM, I_WQ, I_WK, I_WV, I_WO, I_GMLP, I_WUP, I_WDOWN, I_GFIN };

__device__ __forceinline__ float* ss_arr(unsigned char* ws, int idx) { return (float*)(ws + WS_SS) + (size_t)idx * T; }
__device__ __forceinline__ float* invmem_arr(unsigned char* ws) { return (float*)(ws + WS_SS) + (size_t)9 * T; }

__device__ __forceinline__ int inproj_src_col(int vc) {
    if (vc < 512 || vc >= 1536) return vc;
    const int q = (vc - 512) >> 8, r = (vc - 512) & 255;
    return r < 128 ? 512 + q * 128 + r : 1024 + q * 128 + (r - 128);
}
__device__ __forceinline__ void transpose_item(const float* W, int ldw, int srck0, int srcn0, const float* gain, float gscale, bf16_t* WT, int ldt, int dn0, int dk0, LAS float* scr, int lane) {
#pragma unroll 8
    for (int i = 0; i < 32; ++i) { const int kk = 2 * i + (lane >> 5); float v = W[(size_t)(srck0 + kk) * ldw + srcn0 + (lane & 31)];
        const float gsc = gain ? gain[kk] * gscale : gscale; scr[kk * 33 + (lane & 31)] = v * gsc; }
    LDS_WAIT();
    const int c = lane & 7;
#pragma unroll
    for (int j = 0; j < 4; ++j) { const int n = (lane >> 3) + 8 * j; const LAS float* s = scr + (8 * c) * 33 + n;
        u32x4 o; o.x = cvt_pk_bf16(s[0 * 33], s[1 * 33]); o.y = cvt_pk_bf16(s[2 * 33], s[3 * 33]); o.z = cvt_pk_bf16(s[4 * 33], s[5 * 33]); o.w = cvt_pk_bf16(s[6 * 33], s[7 * 33]);
        *(u32x4*)(WT + (size_t)(dn0 + n) * ldt + dk0 + 8 * c) = o; }
    LDS_WAIT();
}
__device__ __forceinline__ float convert_row(const float* src, bf16_t* dst, int lane) {
    const f32x4* xr = (const f32x4*)src + lane; f32x4 v[4]; float s = 0.f;
#pragma unroll
    for (int j = 0; j < 4; ++j) { v[j] = xr[64 * j]; s += (v[j][0] * v[j][0] + v[j][1] * v[j][1]) + (v[j][2] * v[j][2] + v[j][3] * v[j][3]); }
    u32x2* o = (u32x2*)dst + lane;
#pragma unroll
    for (int j = 0; j < 4; ++j) { u32x2 w; w.x = cvt_pk_bf16(v[j][0], v[j][1]); w.y = cvt_pk_bf16(v[j][2], v[j][3]); o[64 * j] = w; }
    return wave_sum(s);
}
constexpr int PI_IN = 1024, PI_GLU = 128, PI_SQ = 512, PI_UP = 2048, PI_CV = 2048;
constexpr int PI_LAYER = PI_IN + PI_GLU + 5 * PI_SQ + 2 * PI_UP + PI_CV;

__device__ __forceinline__ void prep_phase(const Args& a, LAS unsigned char* lds, int gw, int NGW, int wave, int lane) {
    unsigned char* ws = a.ws;
    LAS float* scr = (LAS float*)(lds + wave * 8704);
    for (int it = gw; it < DEPTH * PI_LAYER; it += NGW) {
        const int l = it / PI_LAYER; int r = it - l * PI_LAYER;
        unsigned char* wl = ws + WS_W + (size_t)l * W_LAYER;
        if (r < PI_IN) { const int kb = r >> 6, nb = r & 63;
            transpose_item(a.in[I_WIN] + (size_t)l * D * 2048, 2048, 64 * kb, inproj_src_col(32 * nb), a.in[I_GMIX] + l * D + 64 * kb, 1.0f, (bf16_t*)(wl + W_IN), D, 32 * nb, 64 * kb, scr, lane); continue; }
        r -= PI_IN;
        if (r < PI_GLU) { const int kb = r >> 4, nb = r & 15;
            transpose_item(a.in[I_WGLU] + (size_t)l * CH * CH, CH, 64 * kb, 32 * nb, nullptr, 1.0f, (bf16_t*)(wl + W_GLU), CH, 32 * nb, 64 * kb, scr, lane); continue; }
        r -= PI_GLU;
        if (r < PI_SQ) { const int kb = r >> 5, nb = r & 31, dk0 = 64 * kb;
            const float* gn = dk0 < 512 ? a.in[I_GB] + l * CH + dk0 : a.in[I_GA] + l * CH + dk0 - 512;
            transpose_item(a.in[I_WOUT] + (size_t)l * D * D, D, (dk0 + 512) & 1023, 32 * nb, gn, 1.0f, (bf16_t*)(wl + W_OUT), D, 32 * nb, dk0, scr, lane); continue; }
        r -= PI_SQ;
        if (r < PI_SQ) { const int kb = r >> 5, nb = r & 31;
            transpose_item(a.in[I_WQ] + (size_t)l * D * D, D, 64 * kb, 32 * nb, a.in[I_GX] + l * D + 64 * kb, 0.0625f, (bf16_t*)(wl + W_Q), D, 32 * nb, 64 * kb, scr, lane); continue; }
        r -= PI_SQ;
        if (r < PI_SQ) { const int kb = r >> 5, nb = r & 31;
            transpose_item(a.in[I_WK] + (size_t)l * D * D, D, 64 * kb, 32 * nb, a.in[I_GMEM] + l * D + 64 * kb, 1.0f, (bf16_t*)(wl + W_KV), D, 32 * nb, 64 * kb, scr, lane); continue; }
        r -= PI_SQ;
        if (r < PI_SQ) { const int kb = r >> 5, nb = r & 31;
            transpose_item(a.in[I_WV] + (size_t)l * D * D, D, 64 * kb, 32 * nb, a.in[I_GMEM] + l * D + 64 * kb, 1.0f, (bf16_t*)(wl + W_KV), D, 1024 + 32 * nb, 64 * kb, scr, lane); continue; }
        r -= PI_SQ;
        if (r < PI_SQ) { const int kb = r >> 5, nb = r & 31;
            transpose_item(a.in[I_WO] + (size_t)l * D * D, D, 64 * kb, 32 * nb, nullptr, 1.0f, (bf16_t*)(wl + W_O), D, 32 * nb, 64 * kb, scr, lane); continue; }
        r -= PI_SQ;
        if (r < PI_UP) { const int kb = r >> 7, nb = r & 127;
            transpose_item(a.in[I_WUP] + (size_t)l * D * DFF, DFF, 64 * kb, 32 * nb, a.in[I_GMLP] + l * D + 64 * kb, 1.0f, (bf16_t*)(wl + W_UP), D, 32 * nb, 64 * kb, scr, lane); continue; }
        r -= PI_UP;
        if (r < PI_UP) { const int kb = r >> 5, nb = r & 31;
            transpose_item(a.in[I_WDOWN] + (size_t)l * DFF * D, D, 64 * kb, 32 * nb, nullptr, 1.0f, (bf16_t*)(wl + W_DOWN), DFF, 32 * nb, 64 * kb, scr, lane); continue; }
        r -= PI_UP;
        { const int kb = r >> 5, nb = r & 31;
            transpose_item(a.in[I_CV] + (size_t)l * TMS * D, D, 64 * kb, 32 * nb, nullptr, 1.0f, (bf16_t*)(ws + WS_VTC) + (size_t)l * D * TMS, TMS, 32 * nb, 64 * kb, scr, lane); }
    }
    float* ss0 = ss_arr(ws, 0); float* invm = invmem_arr(ws);
    for (int m = gw; m < T + TM + 2 * TMS; m += NGW) {
        if (m < T) { const float* src = m < TP ? a.in[I_XP] + (size_t)m * D : a.in[I_XS] + (size_t)(m - TP) * D;
            const float s = convert_row(src, (bf16_t*)(ws + WS_XB) + (size_t)m * D, lane); if (lane == 0) ss0[m] = s; }
        else if (m < T + TM) { const int mm = m - T; const float s = convert_row(a.in[I_MEM] + (size_t)mm * D, (bf16_t*)(ws + WS_MNB) + (size_t)mm * D, lane);
            if (lane == 0) invm[mm] = rsqrtf(s * (1.0f / D) + EPS); }
        else { const int mm = m - T - TM; (void)convert_row(a.in[I_CK] + (size_t)mm * D, (bf16_t*)(ws + WS_KC) + (size_t)mm * D, lane); }
    }
    {
        float* sm = (float*)(ws + WS_SMALL); const int gt = gw * 64 + lane, NT = NGW * 64;
#define SMCOPY(off, idx, n) for (int i = gt; i < (n); i += NT) sm[(off) + i] = a.in[idx][i]
        SMCOPY(SM_ARE, I_ARE, 4096); SMCOPY(SM_AIM, I_AIM, 4096); SMCOPY(SM_LOGDT, I_LOGDT, 64); SMCOPY(SM_BRE, I_BRE, 65536); SMCOPY(SM_BIM, I_BIM, 65536);
        SMCOPY(SM_CRE, I_CRE, 65536); SMCOPY(SM_CIM, I_CIM, 65536); SMCOPY(SM_SD, I_SD, 1024); SMCOPY(SM_CONVW, I_CONVW, 3072); SMCOPY(SM_SCONV, I_SCONV, 32768);
        SMCOPY(SM_SRE, I_SRE, 65536); SMCOPY(SM_SIM, I_SIM, 65536); SMCOPY(SM_GFIN, I_GFIN, 1024);
#undef SMCOPY
    }
    { float* z = ss_arr(ws, 1); const size_t n = (size_t)8 * T; for (size_t i = (size_t)gw * 64 + lane; i < n; i += (size_t)NGW * 64) z[i] = 0.f; }
}

__device__ __forceinline__ float gelu_tanh(float x) {
    const float u = 0.7978845608f * (x + 0.044715f * x * x * x);
    const float e = __expf(2.0f * u);
    const float th = 1.0f - 2.0f * __builtin_amdgcn_rcpf(e + 1.0f);
    return 0.5f * x * (1.0f + th);
}
__device__ __forceinline__ void sincos_small(float x, float& s, float& c) {
    const float q = rintf(x * 0.63661977236f);
    float r = fmaf(-q, 1.57079637050628662109375f, x); r = fmaf(-q, -4.37113900018624283e-8f, r);
    const float r2 = r * r;
    const float sp = r + r * r2 * (-1.0f / 6 + r2 * (1.0f / 120 + r2 * (-1.0f / 5040 + r2 * (1.0f / 362880))));
    const float cp = 1.0f + r2 * (-0.5f + r2 * (1.0f / 24 + r2 * (-1.0f / 720 + r2 * (1.0f / 40320 + r2 * (-1.0f / 3628800)))));
    const int qi = (int)q & 3;
    s = (qi == 0) ? sp : (qi == 1) ? cp : (qi == 2) ? -sp : -cp;
    c = (qi == 0) ? cp : (qi == 1) ? -sp : (qi == 2) ? -cp : sp;
}
constexpr int BU_STRIDE = 528, H_STRIDE = 272, SCAN_LDS_WAVE = 16 * BU_STRIDE + 16 * H_STRIDE;

__device__ __forceinline__ void scan_item(unsigned char* ws, float* out, int l, int item, LAS unsigned char* wl, int lane) {
    const float* sm = (const float*)(ws + WS_SMALL);
    int b, g, row0, nblk; const bool prompt = item < NB * 32;
    if (prompt) { b = item >> 5; g = item & 31; row0 = b * SEQ; nblk = SEQ / 16; }
    else { const int i2 = item - NB * 32; b = i2 >> 5; g = i2 & 31; row0 = TP + b * DSEQ; nblk = DSEQ / 16; }
    const bf16_t* U = (const bf16_t*)(ws + WS_U); bf16_t* YG = (bf16_t*)(ws + WS_YG);
    const int lg = l * 32 + g, p = lane, t16 = lane & 15, q = lane >> 4;
    const float are = fminf(sm[SM_ARE + lg * 64 + p], -1e-4f), aim = sm[SM_AIM + lg * 64 + p];
    const float dt = expf(sm[SM_LOGDT + lg]);
    float sn, cs; sincos_small(aim * dt, sn, cs);
    const float mag = expf(are * dt), abr = mag * cs, abi = mag * sn;
    const float nr = abr - 1.0f, ni = abi, den = 1.0f / (are * are + aim * aim);
    const float c0 = (nr * are + ni * aim) * den, c1 = (ni * are - nr * aim) * den;
    bf16x8 af[8];
#pragma unroll
    for (int f = 0; f < 8; ++f) {
        const int i = 16 * f + t16, ps = i >> 1, cc = i & 1;
        const float k0 = __shfl(c0, ps), k1 = __shfl(c1, ps);
        u32x4 w = (u32x4){0u, 0u, 0u, 0u};
        if (q < 2) {
            const f32x4* br = (const f32x4*)(sm + SM_BRE + ((size_t)lg * 64 + ps) * 16 + 8 * q); const f32x4* bi = (const f32x4*)(sm + SM_BIM + ((size_t)lg * 64 + ps) * 16 + 8 * q);
            const f32x4 r0 = br[0], r1 = br[1], i0 = bi[0], i1 = bi[1];
            f32x4 v0, v1;
            if (cc == 0) { v0 = k0 * r0 - k1 * i0; v1 = k0 * r1 - k1 * i1; } else { v0 = k0 * i0 + k1 * r0; v1 = k0 * i1 + k1 * r1; }
            w.x = cvt_pk_bf16(v0[0], v0[1]); w.y = cvt_pk_bf16(v0[2], v0[3]); w.z = cvt_pk_bf16(v1[0], v1[1]); w.w = cvt_pk_bf16(v1[2], v1[3]);
        }
        af[f] = __builtin_bit_cast(bf16x8, w);
    }
    bf16x8 cf[4];
#pragma unroll
    for (int s = 0; s < 4; ++s) {
        const int p0 = 16 * s + 4 * q;
        const f32x4 cr = *(const f32x4*)(sm + SM_CRE + ((size_t)lg * 16 + t16) * 64 + p0), ci = *(const f32x4*)(sm + SM_CIM + ((size_t)lg * 16 + t16) * 64 + p0);
        u32x4 w; w.x = cvt_pk_bf16(cr[0], -ci[0]); w.y = cvt_pk_bf16(cr[1], -ci[1]); w.z = cvt_pk_bf16(cr[2], -ci[2]); w.w = cvt_pk_bf16(cr[3], -ci[3]);
        cf[s] = __builtin_bit_cast(bf16x8, w);
    }
    const f32x4 dsk = *(const f32x4*)(sm + SM_SD + l * CH + g * 16 + 4 * q);
    float hre = 0.f, him = 0.f;
    if (!prompt) { hre = sm[SM_SRE + (((size_t)l * NDB + b) * 32 + g) * 64 + p]; him = sm[SM_SIM + (((size_t)l * NDB + b) * 32 + g) * 64 + p]; }
    LAS unsigned char* BU = wl; LAS unsigned char* HB = wl + 16 * BU_STRIDE;
    const bf16_t* up = U + (size_t)(row0 + t16) * CH + g * 16;
    u32x4 ub = (u32x4){0u, 0u, 0u, 0u}; u32x2 ue;
    if (q < 2) ub = *(const u32x4*)(up + 8 * q);
    ue = *(const u32x2*)(up + 4 * q);
    for (int tb = 0; tb < nblk; ++tb) {
        const u32x4 ubc = ub; const u32x2 uec = ue;
        if (tb + 1 < nblk) { const bf16_t* un = up + (size_t)(tb + 1) * 16 * CH; if (q < 2) ub = *(const u32x4*)(un + 8 * q); ue = *(const u32x2*)(un + 4 * q); }
        const bf16x8 bfrag = __builtin_bit_cast(bf16x8, ubc);
#pragma unroll
        for (int f = 0; f < 8; ++f) {
            const f32x4 r = __builtin_amdgcn_mfma_f32_16x16x32_bf16(af[f], bfrag, (f32x4){0.f, 0.f, 0.f, 0.f}, 0, 0, 0);
            *(LAS f32x4*)(BU + t16 * BU_STRIDE + (16 * f + 4 * q) * 4) = r;
        }
        LDS_WAIT();
#pragma unroll
        for (int t = 0; t < 16; ++t) {
            const f32x2 bu = *(const LAS f32x2*)(BU + t * BU_STRIDE + p * 8);
            const float nre = fmaf(abr, hre, fmaf(-abi, him, bu[0])), nim = fmaf(abr, him, fmaf(abi, hre, bu[1]));
            hre = nre; him = nim;
            *(LAS unsigned*)(HB + t * H_STRIDE + p * 4) = cvt_pk_bf16(hre, him);
        }
        LDS_WAIT();
        f32x4 y = (f32x4){0.f, 0.f, 0.f, 0.f};
#pragma unroll
        for (int s = 0; s < 4; ++s) {
            const bf16x8 hf = *(const LAS bf16x8*)(HB + t16 * H_STRIDE + (32 * s + 8 * q) * 2);
            y = __builtin_amdgcn_mfma_f32_16x16x32_bf16(cf[s], hf, y, 0, 0, 0);
        }
        const float u0 = bf_lo(uec.x), u1 = bf_hi(uec.x), u2 = bf_lo(uec.y), u3 = bf_hi(uec.y);
        const float g0 = gelu_tanh(y[0] + dsk[0] * u0), g1 = gelu_tanh(y[1] + dsk[1] * u1), g2 = gelu_tanh(y[2] + dsk[2] * u2), g3 = gelu_tanh(y[3] + dsk[3] * u3);
        u32x2 w; w.x = cvt_pk_bf16(g0, g1); w.y = cvt_pk_bf16(g2, g3);
        *(u32x2*)(YG + (size_t)(row0 + tb * 16 + t16) * CH + g * 16 + 4 * q) = w;
        LDS_WAIT();
    }
    if (prompt) { out[O_REP + (((size_t)l * NB + b) * 32 + g) * 64 + p] = hre; out[O_IMP + (((size_t)l * NB + b) * 32 + g) * 64 + p] = him; }
    else { out[O_RES + (((size_t)l * NDB + b) * 32 + g) * 64 + p] = hre; out[O_IMS + (((size_t)l * NDB + b) * 32 + g) * 64 + p] = him; }
}
__device__ __forceinline__ void conv_run(unsigned char* ws, int l, int run, int lane) {
    const float* sm = (const float*)(ws + WS_SMALL);
    const bf16_t* XIN = (const bf16_t*)(ws + WS_XIN); const bf16_t* BG = (const bf16_t*)(ws + WS_BG); bf16_t* YCAT = (bf16_t*)(ws + WS_YCAT);
    const int row0 = run * 64, c0 = lane * 8;
    f32x4 w0a, w0b, w1a, w1b, w2a, w2b;
    { const float* cw = sm + SM_CONVW + (size_t)l * 3 * CH + c0; w0a = *(const f32x4*)cw; w0b = *(const f32x4*)(cw + 4); w1a = *(const f32x4*)(cw + CH); w1b = *(const f32x4*)(cw + CH + 4);
      w2a = *(const f32x4*)(cw + 2 * CH); w2b = *(const f32x4*)(cw + 2 * CH + 4); }
    f32x4 p2a, p2b, p1a, p1b;
    const bool seq_start = row0 < TP ? ((row0 & (SEQ - 1)) == 0) : true;
    if (!seq_start) { unpack8(*(const u32x4*)(XIN + (size_t)(row0 - 2) * CH + c0), p2a, p2b); unpack8(*(const u32x4*)(XIN + (size_t)(row0 - 1) * CH + c0), p1a, p1b); }
    else if (row0 < TP) { p2a = p2b = p1a = p1b = (f32x4){0.f, 0.f, 0.f, 0.f}; }
    else { const int b = (row0 - TP) >> 6; const float* st = sm + SM_SCONV + ((size_t)(l * NDB + b) * 2) * CH + c0;
        p2a = *(const f32x4*)st; p2b = *(const f32x4*)(st + 4); p1a = *(const f32x4*)(st + CH); p1b = *(const f32x4*)(st + CH + 4); }
    for (int tb = 0; tb < 64; tb += 8) {
        u32x4 xr[8], br[8];
#pragma unroll
        for (int j = 0; j < 8; ++j) { const size_t o = (size_t)(row0 + tb + j) * CH + c0; xr[j] = *(const u32x4*)(XIN + o); br[j] = *(const u32x4*)(BG + o); }
#pragma unroll
        for (int j = 0; j < 8; ++j) {
            f32x4 xa, xb, ba, bb; unpack8(xr[j], xa, xb); unpack8(br[j], ba, bb);
            f32x4 ya = ba * (w0a * p2a + w1a * p1a + w2a * xa), yb = bb * (w0b * p2b + w1b * p1b + w2b * xb);
            float s = 0.f;
#pragma unroll
            for (int e = 0; e < 4; ++e) s += ya[e] * ya[e] + yb[e] * yb[e];
            s = wave_sum(s);
            const float inv = rsqrtf(s * (1.0f / CH) + EPS);
            store8_bf16(YCAT + (size_t)(row0 + tb + j) * D + 512 + c0, ya * inv, yb * inv);
            p2a = p1a; p2b = p1b; p1a = xa; p1b = xb;
        }
    }
}

constexpr int KST = 528, VST = 520;
__device__ __forceinline__ void attn_phase(unsigned char* ws, int l, LAS unsigned char* lds, int G, int bid) {
    int tid = threadIdx.x; asm volatile("" : "+v"(tid));
    const int wave = __builtin_amdgcn_readfirstlane(tid >> 6);
    const bf16_t* Q = (const bf16_t*)(ws + WS_Q); bf16_t* O = (bf16_t*)(ws + WS_O);
    const int NU = NB * 4 * 8 + NDB * 4;
    for (int u = bid; u < NU; u += G) {
        int qrow0, nq, ldv; const bf16_t* Kp; const bf16_t* Vp; int h;
        if (u < NB * 32) { const int b = u >> 5; h = (u >> 3) & 3; const int qt = u & 7; qrow0 = b * SEQ + qt * 256; nq = 256;
            Kp = (const bf16_t*)(ws + WS_KB) + (size_t)l * TM * D + (size_t)(b * NMEM) * D + h * 256; Vp = (const bf16_t*)(ws + WS_VT) + (size_t)l * D * TM + (size_t)(h * 256) * TM + b * NMEM; ldv = TM; }
        else { const int i = u - NB * 32, b = i >> 2; h = i & 3; qrow0 = TP + b * DSEQ; nq = DSEQ;
            Kp = (const bf16_t*)(ws + WS_KC) + (size_t)l * TMS * D + (size_t)(b * NMEM) * D + h * 256; Vp = (const bf16_t*)(ws + WS_VTC) + (size_t)l * D * TMS + (size_t)(h * 256) * TMS + b * NMEM; ldv = TMS; }
        const bool active = wave * 32 < nq;
        __syncthreads();
        int t2 = tid; asm volatile("" : "+v"(t2));
        {
            const int c = t2 & 31, rr = t2 >> 5; const unsigned off = (unsigned)((rr * D + c * 8) * 2); const char* kb = (const char*)Kp;
            LAS unsigned char* ld0 = lds + rr * KST + c * 16;
#pragma unroll
            for (int hb = 0; hb < 4; ++hb) {
                u32x4 v[4];
#pragma unroll
                for (int i = 0; i < 4; ++i) v[i] = *(const u32x4*)(kb + (size_t)(16 * (hb * 4 + i)) * D * 2 + off);
#pragma unroll
                for (int i = 0; i < 4; ++i) *(LAS u32x4*)(ld0 + 16 * (hb * 4 + i) * KST) = v[i];
            }
        }
        bf16x8 qf[16];
        const int r32 = t2 & 31, hh = (t2 >> 5) & 1;
        const int qrow = qrow0 + wave * 32 + r32;
        if (active) {
#pragma unroll
            for (int ks = 0; ks < 16; ++ks) qf[ks] = *(const bf16x8*)(Q + (size_t)qrow * D + h * 256 + 16 * ks + 8 * hh);
        } else {
#pragma unroll
            for (int ks = 0; ks < 16; ++ks) qf[ks] = (bf16x8){0, 0, 0, 0, 0, 0, 0, 0};
        }
        __syncthreads();
        constexpr int NQ = 4, MTQ = 8 / NQ;
        bf16x8 pf[16]; float qmax[NQ], qsum[NQ];
#pragma unroll
        for (int qi = 0; qi < NQ; ++qi) { qmax[qi] = 0.f; qsum[qi] = 1.f; }
        if (active) {
#pragma unroll
            for (int qi = 0; qi < NQ; ++qi) {
                f32x16 sc[MTQ];
#pragma unroll
                for (int mq = 0; mq < MTQ; ++mq)
#pragma unroll
                    for (int e = 0; e < 16; ++e) sc[mq][e] = 0.f;
#pragma unroll
                for (int ks = 0; ks < 16; ++ks)
#pragma unroll
                    for (int mq = 0; mq < MTQ; ++mq) {
                        const bf16x8 kf = *(const LAS bf16x8*)(lds + (32 * (qi * MTQ + mq) + r32) * KST + (16 * ks + 8 * hh) * 2);
                        sc[mq] = __builtin_amdgcn_mfma_f32_32x32x16_bf16(kf, qf[ks], sc[mq], 0, 0, 0);
                    }
                float mx = -3.0e38f;
#pragma unroll
                for (int mq = 0; mq < MTQ; ++mq)
#pragma unroll
                    for (int e = 0; e < 16; ++e) mx = fmaxf(mx, sc[mq][e]);
                mx = fmaxf(mx, __shfl_xor(mx, 32));
                float sum = 0.f;
#pragma unroll
                for (int mq = 0; mq < MTQ; ++mq) {
#pragma unroll
                    for (int e = 0; e < 16; ++e) { const float pe = __builtin_amdgcn_exp2f((sc[mq][e] - mx) * 1.44269504089f); sc[mq][e] = pe; sum += pe; }
#pragma unroll
                    for (int s2 = 0; s2 < 2; ++s2) {
                        u32x4 w; w.x = cvt_pk_bf16(sc[mq][8 * s2 + 0], sc[mq][8 * s2 + 1]); w.y = cvt_pk_bf16(sc[mq][8 * s2 + 2], sc[mq][8 * s2 + 3]);
                        w.z = cvt_pk_bf16(sc[mq][8 * s2 + 4], sc[mq][8 * s2 + 5]); w.w = cvt_pk_bf16(sc[mq][8 * s2 + 6], sc[mq][8 * s2 + 7]);
                        pf[2 * (qi * MTQ + mq) + s2] = __builtin_bit_cast(bf16x8, w);
                    }
                }
                sum += __shfl_xor(sum, 32);
                qmax[qi] = mx; qsum[qi] = sum;
                __builtin_amdgcn_sched_barrier(0);
            }
        } else {
#pragma unroll
            for (int i = 0; i < 16; ++i) pf[i] = (bf16x8){0, 0, 0, 0, 0, 0, 0, 0};
        }
        float fq_[NQ]; float rinv;
        { float M = qmax[0];
#pragma unroll
          for (int qi = 1; qi < NQ; ++qi) M = fmaxf(M, qmax[qi]);
          float tot = 0.f;
#pragma unroll
          for (int qi = 0; qi < NQ; ++qi) { fq_[qi] = __builtin_amdgcn_exp2f((qmax[qi] - M) * 1.44269504089f); tot += fq_[qi] * qsum[qi]; }
          rinv = 1.0f / tot;
#pragma unroll
          for (int qi = 0; qi < NQ; ++qi) fq_[qi] *= rinv; }
        __syncthreads();
        {
            const int c = t2 & 31, rr = t2 >> 5; const unsigned off = (unsigned)((rr * ldv + c * 8) * 2); const char* vb = (const char*)Vp;
            LAS unsigned char* ld0 = lds + rr * VST + c * 16;
#pragma unroll
            for (int hb = 0; hb < 4; ++hb) {
                u32x4 v[4];
#pragma unroll
                for (int i = 0; i < 4; ++i) v[i] = *(const u32x4*)(vb + (size_t)(16 * (hb * 4 + i)) * ldv * 2 + off);
#pragma unroll
                for (int i = 0; i < 4; ++i) { LAS u32x2* d = (LAS u32x2*)(ld0 + 16 * (hb * 4 + i) * VST); d[0] = (u32x2){v[i].x, v[i].y}; d[1] = (u32x2){v[i].z, v[i].w}; }
            }
        }
        __syncthreads();
        if (active) {
#pragma unroll
            for (int dt = 0; dt < 8; ++dt) {
                f32x16 acc[NQ];
#pragma unroll
                for (int qi = 0; qi < NQ; ++qi)
#pragma unroll
                    for (int e = 0; e < 16; ++e) acc[qi][e] = 0.f;
#pragma unroll
                for (int mi = 0; mi < 16 / NQ; ++mi)
#pragma unroll
                    for (int qi = 0; qi < NQ; ++qi) {
                        const int ms = qi * (16 / NQ) + mi;
                        const LAS unsigned char* vp = lds + (32 * dt + r32) * VST + (16 * ms + 4 * hh) * 2;
                        const u32x2 lo = *(const LAS u32x2*)vp, hi = *(const LAS u32x2*)(vp + 16);
                        const u32x4 w = (u32x4){lo.x, lo.y, hi.x, hi.y};
                        acc[qi] = __builtin_amdgcn_mfma_f32_32x32x16_bf16(__builtin_bit_cast(bf16x8, w), pf[ms], acc[qi], 0, 0, 0);
                    }
#pragma unroll
                for (int g4 = 0; g4 < 4; ++g4) {
                    float o4[4];
#pragma unroll
                    for (int e = 0; e < 4; ++e) { float v = 0.f;
#pragma unroll
                        for (int qi = 0; qi < NQ; ++qi) v = fmaf(acc[qi][4 * g4 + e], fq_[qi], v);
                        o4[e] = v; }
                    u32x2 w; w.x = cvt_pk_bf16(o4[0], o4[1]); w.y = cvt_pk_bf16(o4[2], o4[3]);
                    *(u32x2*)(O + (size_t)qrow * D + h * 256 + 32 * dt + 8 * g4 + 4 * hh) = w;
                }
                __builtin_amdgcn_sched_barrier(0);
            }
        }
    }
    __syncthreads();
}

constexpr bool USE_SP2 = true;
__global__ void __launch_bounds__(512, 2) hybrid_fwd(Args a) {
    extern __shared__ __attribute__((aligned(16))) unsigned char lds_raw[];
    LAS unsigned char* lds = (LAS unsigned char*)lds_raw;
    cg::grid_group grid = cg::this_grid();
    const int tid = threadIdx.x, lane = tid & 63, wave = __builtin_amdgcn_readfirstlane(tid >> 6);
    const int G = gridDim.x, bid = blockIdx.x;
    unsigned char* ws = a.ws;
    const int NGW = G * 8;

#ifndef NO_PREP
    prep_phase(a, lds, bid * 8 + wave, NGW, wave, lane);
#endif
    grid.sync();

#define FRESH() unsigned char* wsp = ws; int ll = l; asm volatile("" : "+s"(wsp), "+s"(ll)); unsigned char* wl = wsp + WS_W + (size_t)ll * W_LAYER; (void)wl
#define SSA(k) ss_arr(wsp, 1 + 4 * ll + (k))
#pragma unroll 1
    for (int l = 0; l < DEPTH; ++l) {
        {
            FRESH();
            pg8::Gemm g{(const bf16_t*)(wsp + WS_XB), (const bf16_t*)(wl + W_IN), T, 2048, D}; pg8::StaticOrder S; S.init(T, 2048, G, bid);
            EpiInProj E{(bf16_t*)(wsp + WS_BG), (bf16_t*)(wsp + WS_XIN), (bf16_t*)(wsp + WS_U), ll == 0 ? ss_arr(wsp, 0) : ss_arr(wsp, 4), a.out + O_CONVP + (size_t)ll * NB * 2 * CH, a.out + O_CONVS + (size_t)ll * NDB * 2 * CH};
#ifndef NO_GEMM
            pg8::gemm_phase<EpiInProj, USE_SP2>(lds, g, S, E);
#endif
        }
        {
            FRESH();
            pg8::Gemm g{(const bf16_t*)(wsp + WS_MNB), (const bf16_t*)(wl + W_KV), TM, 2048, D}; pg8::StaticOrder S; S.init(TM, 2048, G, bid);
            EpiKV E{a.out + O_MKP + (size_t)ll * TM * D, a.out + O_MVP + (size_t)ll * TM * D, (bf16_t*)(wsp + WS_KB) + (size_t)ll * TM * D, invmem_arr(wsp)};
#ifndef NO_GEMM
            pg8::gemm_phase<EpiKV, USE_SP2>(lds, g, S, E);
#endif
        }
        {
            FRESH();
            pg8::Gemm g{(const bf16_t*)(wl + W_KV) + (size_t)D * D, (const bf16_t*)(wsp + WS_MNB), D, TM, D}; pg8::StaticOrder S; S.init(D, TM, G, (bid + G - (32 % G)) % G);
            EpiVT E{(bf16_t*)(wsp + WS_VT) + (size_t)ll * D * TM, invmem_arr(wsp)};
#ifndef NO_GEMM
            pg8::gemm_phase<EpiVT, USE_SP2>(lds, g, S, E);
#endif
        }
        grid.sync();
        {
            FRESH();
            int lane2 = threadIdx.x & 63; asm volatile("" : "+v"(lane2));
            const int w = wave * G + bid;
#ifndef NO_SCAN
            for (int it = w; it < NB * 32 + NDB * 32; it += NGW) scan_item(wsp, a.out, ll, it, lds + wave * SCAN_LDS_WAVE, lane2);
#endif
#ifndef NO_CONV
            for (int run = NGW - 1 - w; run < T / 64; run += NGW) conv_run(wsp, ll, run, lane2);
#endif
        }
        grid.sync();
        {
            FRESH();
            pg8::Gemm g{(const bf16_t*)(wsp + WS_YG), (const bf16_t*)(wl + W_GLU), T, CH, CH}; pg8::StaticOrder S; S.init(T, CH, G, bid);
            EpiGLU E{(const bf16_t*)(wsp + WS_YG), (bf16_t*)(wsp + WS_YCAT), SSA(0)};
#ifndef NO_GEMM
            pg8::gemm_phase<EpiGLU, USE_SP2>(lds, g, S, E);
#endif
        }
        grid.sync();
        {
            FRESH();
            pg8::Gemm g{(const bf16_t*)(wsp + WS_YCAT), (const bf16_t*)(wl + W_OUT), T, D, D}; pg8::StaticOrder S; S.init(T, D, G, bid);
            EpiRes<true> E{(bf16_t*)(wsp + WS_XB), SSA(1), SSA(0)};
#ifndef NO_GEMM
            pg8::gemm_phase<EpiRes<true>, USE_SP2>(lds, g, S, E);
#endif
        }
        grid.sync();
        {
            FRESH();
            pg8::Gemm g{(const bf16_t*)(wsp + WS_XB), (const bf16_t*)(wl + W_Q), T, D, D}; pg8::StaticOrder S; S.init(T, D, G, bid);
            EpiScale<0> E{(bf16_t*)(wsp + WS_Q), D, SSA(1)};
#ifndef NO_GEMM
            pg8::gemm_phase<EpiScale<0>, USE_SP2>(lds, g, S, E);
#endif
        }
        grid.sync();
        {
            FRESH();
#ifndef NO_ATTN
            attn_phase(wsp, ll, lds, G, bid);
#endif
        }
        grid.sync();
        {
            FRESH();
            pg8::Gemm g{(const bf16_t*)(wsp + WS_O), (const bf16_t*)(wl + W_O), T, D, D}; pg8::StaticOrder S; S.init(T, D, G, bid);
            EpiRes<false> E{(bf16_t*)(wsp + WS_XB), SSA(2), nullptr};
#ifndef NO_GEMM
            pg8::gemm_phase<EpiRes<false>, USE_SP2>(lds, g, S, E);
#endif
        }
        grid.sync();
        {
            FRESH();
            pg8::Gemm g{(const bf16_t*)(wsp + WS_XB), (const bf16_t*)(wl + W_UP), T, DFF, D}; pg8::StaticOrder S; S.init(T, DFF, G, bid);
            EpiScale<1> E{(bf16_t*)(wsp + WS_HDN), DFF, SSA(2)};
#ifndef NO_GEMM
            pg8::gemm_phase<EpiScale<1>, USE_SP2>(lds, g, S, E);
#endif
        }
        grid.sync();
        {
            FRESH();
            pg8::Gemm g{(const bf16_t*)(wsp + WS_HDN), (const bf16_t*)(wl + W_DOWN), T, D, DFF}; pg8::StaticOrder S; S.init(T, D, G, bid);
            EpiRes<false> E{(bf16_t*)(wsp + WS_XB), SSA(3), nullptr};
#ifndef NO_GEMM
            pg8::gemm_phase<EpiRes<false>, USE_SP2>(lds, g, S, E);
#endif
        }
        grid.sync();
    }
    {
        int lane = threadIdx.x & 63; asm volatile("" : "+v"(lane));
        const bf16_t* XB = (const bf16_t*)(ws + WS_XB); const float* ssf = ss_arr(ws, 1 + 4 + 3); const float* gf = (const float*)(ws + WS_SMALL) + SM_GFIN;
        f32x4 gv[4];
#pragma unroll
        for (int j = 0; j < 4; ++j) gv[j] = *(const f32x4*)(gf + 256 * j + 4 * lane);
        for (int m = bid * 8 + wave; m < T; m += NGW) {
            const float inv = rsqrtf(ssf[m] * (1.0f / D) + EPS);
            const u32x2* xr = (const u32x2*)(XB + (size_t)m * D) + lane; f32x4* o = (f32x4*)(a.out + (size_t)m * D) + lane;
#pragma unroll
            for (int j = 0; j < 4; ++j) { const u32x2 w = xr[64 * j]; o[64 * j] = (f32x4){bf_lo(w.x), bf_hi(w.x), bf_lo(w.y), bf_hi(w.y)} * inv * gv[j]; }
        }
    }
}

extern "C" void kernel_launch(void* const* d_in, const int* in_sizes, int n_in, void* d_out, int out_size, void* d_ws, size_t ws_size, hipStream_t stream) {
    static int grid = 0;
    if (grid == 0) {
        if (n_in != 33 || (size_t)out_size != O_END || ws_size < WS_END) { fprintf(stderr, "kernel_launch: unexpected sizes n_in %d out %d ws %zu (need %zu)\n", n_in, out_size, ws_size, (size_t)WS_END); grid = -1; return; }
        int dev = 0, cus = 0, per_cu = 0;
        (void)hipGetDevice(&dev); (void)hipDeviceGetAttribute(&cus, hipDeviceAttributeMultiprocessorCount, dev);
        if (hipFuncSetAttribute((const void*)hybrid_fwd, hipFuncAttributeMaxDynamicSharedMemorySize, LDS_BYTES) != hipSuccess) { fprintf(stderr, "kernel_launch: hipFuncSetAttribute failed\n"); grid = -1; return; }
        if (hipOccupancyMaxActiveBlocksPerMultiprocessor(&per_cu, (const void*)hybrid_fwd, 512, LDS_BYTES) != hipSuccess || per_cu < 1) { fprintf(stderr, "kernel_launch: occupancy query says %d\n", per_cu); per_cu = 1; }
        (void)hipGetLastError();
        grid = cus > 0 ? cus : 256;
    }
    if (grid < 0) return;
    Args a{};
    for (int i = 0; i < 33; ++i) a.in[i] = (const float*)d_in[i];
    a.out = (float*)d_out; a.ws = (unsigned char*)d_ws;
    void* args[] = {&a};
    hipError_t e = hipLaunchCooperativeKernel((const void*)hybrid_fwd, dim3(grid), dim3(512), args, LDS_BYTES, stream);
    if (e != hipSuccess) fprintf(stderr, "kernel_launch: cooperative launch failed: %s (grid %d)\n", hipGetErrorString(e), grid);
}
```

```cpp
#include <hip/hip_runtime.h>
#include <hip/hip_cooperative_groups.h>
#include <cstdio>
#include <cstdint>
namespace cg = cooperative_groups;
#define NO_SMALL 1
#ifndef REP_PREP
#define REP_PREP 1
#endif
#ifndef REP_SCAN
#define REP_SCAN 1
#endif
#ifndef REP_ATTN
#define REP_ATTN 1
#endif
#ifndef REP_UP
#define REP_UP 1
#endif

#define LAS __attribute__((address_space(3)))
#define GAS __attribute__((address_space(1)))
typedef unsigned short bf16_t;
typedef short bf16x8 __attribute__((ext_vector_type(8)));
typedef short bf16x4 __attribute__((ext_vector_type(4)));
typedef float f32x2 __attribute__((ext_vector_type(2)));
typedef float f32x4 __attribute__((ext_vector_type(4)));
typedef float f32x16 __attribute__((ext_vector_type(16)));
typedef unsigned u32x4 __attribute__((ext_vector_type(4)));
typedef unsigned u32x2 __attribute__((ext_vector_type(2)));

constexpr int D = 1024, NB = 32, SEQ = 2048, NDB = 16, DSEQ = 64, DEPTH = 2;
constexpr int TP = NB * SEQ, TS = NDB * DSEQ, T = TP + TS;
constexpr int NMEM = 256, TM = NB * NMEM, TMS = NDB * NMEM;
constexpr int DFF = 4096, CH = 512;
constexpr float EPS = 1e-6f;
constexpr size_t O_YP = 0, O_YS = O_YP + (size_t)TP * D, O_CONVP = O_YS + (size_t)TS * D, O_REP = O_CONVP + (size_t)DEPTH * NB * 2 * CH,
                 O_IMP = O_REP + (size_t)DEPTH * NB * 32 * 64, O_MKP = O_IMP + (size_t)DEPTH * NB * 32 * 64, O_MVP = O_MKP + (size_t)DEPTH * TM * D,
                 O_CONVS = O_MVP + (size_t)DEPTH * TM * D, O_RES = O_CONVS + (size_t)DEPTH * NDB * 2 * CH, O_IMS = O_RES + (size_t)DEPTH * NDB * 32 * 64,
                 O_END = O_IMS + (size_t)DEPTH * NDB * 32 * 64;
constexpr size_t MiB = 1u << 20;
constexpr size_t WS_SS = 0;
constexpr size_t WS_W = 4 * MiB, W_LAYER = 31 * MiB;
constexpr size_t W_IN = 0, W_GLU = 4 * MiB, W_OUT = 4 * MiB + MiB / 2, W_Q = 6 * MiB + MiB / 2, W_KV = 8 * MiB + MiB / 2, W_O = 12 * MiB + MiB / 2,
                 W_UP = 14 * MiB + MiB / 2, W_DOWN = 22 * MiB + MiB / 2;
constexpr size_t WS_XB = 66 * MiB;
constexpr size_t WS_MNB = 196 * MiB;
constexpr size_t WS_KB = 212 * MiB;
constexpr size_t WS_VT = 244 * MiB;
constexpr size_t WS_KC = 276 * MiB;
constexpr size_t WS_VTC = 292 * MiB;
constexpr size_t WS_BIG = 308 * MiB;
constexpr size_t SZ_T512 = (size_t)T * 512 * 2;
constexpr size_t WS_BG = WS_BIG, WS_XIN = WS_BG + SZ_T512, WS_U = WS_XIN + SZ_T512, WS_YG = WS_U + SZ_T512, WS_YCAT = WS_YG + SZ_T512;
constexpr size_t WS_Q = WS_BG, WS_O = WS_U, WS_HDN = WS_BIG;
constexpr size_t WS_SMALL = WS_BIG + (size_t)T * DFF * 2;
constexpr size_t WS_END = WS_SMALL + 4 * MiB;
constexpr int SM_ARE = 0, SM_AIM = 4096, SM_LOGDT = 8192, SM_BRE = 8256, SM_BIM = SM_BRE + 65536, SM_CRE = SM_BIM + 65536, SM_CIM = SM_CRE + 65536, SM_SD = SM_CIM + 65536,
              SM_CONVW = SM_SD + 1024, SM_SCONV = SM_CONVW + 3072, SM_SRE = SM_SCONV + 32768, SM_SIM = SM_SRE + 65536, SM_GFIN = SM_SIM + 65536, SM_END = SM_GFIN + 1024;
static_assert(WS_YCAT + 2 * SZ_T512 <= WS_END, "ws map");

constexpr int LDS_BYTES = 256 * 528 + 1024;

template <class Tp> __device__ __forceinline__ Tp* as_global(Tp* p) {
#if defined(__HIP_DEVICE_COMPILE__)
    __builtin_assume(!__builtin_amdgcn_is_shared((const __attribute__((address_space(0))) void*)p) && !__builtin_amdgcn_is_private((const __attribute__((address_space(0))) void*)p));
#endif
    return p;
}
__device__ __forceinline__ unsigned cvt_pk_bf16(float lo, float hi) { unsigned r; asm volatile("v_cvt_pk_bf16_f32 %0, %1, %2" : "=v"(r) : "v"(lo), "v"(hi)); return r; }
__device__ __forceinline__ float bf_lo(unsigned w) { return __uint_as_float(w << 16); }
__device__ __forceinline__ float bf_hi(unsigned w) { return __uint_as_float(w & 0xffff0000u); }
__device__ __forceinline__ float wave_sum(float v) {
#pragma unroll
    for (int o = 1; o < 64; o <<= 1) v += __shfl_xor(v, o);
    return v;
}
#define LDS_WAIT() asm volatile("s_waitcnt lgkmcnt(0)" ::: "memory")

namespace pg8 {
constexpr int BM = 256, BK = 64, HALF = 128, HTB = HALF * BK * 2, STAGE_BYTES = 8 * HTB, NXCD = 8, WGM = 8;
__host__ __device__ __forceinline__ int lds_byte(int r, int c) { const int st = (r >> 4) * 2 + (c >> 5), rr = r & 15, cc = c & 31, ob = rr * 64 + cc * 2; return st * 1024 + (ob ^ (((ob >> 9) & 1) << 5)); }
__host__ __device__ __forceinline__ void stage_rc(int b, int& R, int& C) { const int st = b / 1024, sb = b % 1024, swz = sb ^ (((sb >> 9) & 1) << 5); R = (st >> 1) * 16 + swz / 64; C = (st & 1) * 32 + (swz % 64) / 2; }
__host__ __device__ __forceinline__ int perm32(int rho) { const int n = rho >> 4, i = rho & 15; return 8 * (i >> 2) + 4 * n + (i & 3); }

struct Unit { int pm, pn; };
struct Gemm { const bf16_t* A; const bf16_t* Bt; int M, N, K; };

struct StaticOrder {
    int nM, nN, nwg, G, c;
    __device__ void init(int M, int N, int G_, int c_) { nM = M / BM; nN = N / BM; nwg = nM * nN; G = G_; c = c_; }
    __device__ bool next(int i, Unit& u) const {
        const long L = (long)i * G + c; if (L >= nwg) return false;
        int wgid = (int)L; { const int q = nwg / NXCD, r = nwg % NXCD, xcd = wgid % NXCD, off = wgid / NXCD; wgid = (xcd < r ? xcd * (q + 1) : r * (q + 1) + (xcd - r) * q) + off; }
        const int nig = WGM * nN, gid = wgid / nig, fm = gid * WGM, gsz = (nM - fm) < WGM ? (nM - fm) : WGM;
        u.pm = fm + ((wgid % nig) % gsz); u.pn = (wgid % nig) / gsz; return true;
    }
};

template <class Epi, bool SP2>
__device__ __forceinline__ void gemm_phase(LAS unsigned char* lds, const Gemm g, const StaticOrder& S, const Epi& E) {
    int tid = threadIdx.x; asm volatile("" : "+v"(tid));
    const int wid = __builtin_amdgcn_readfirstlane(tid >> 6), lane = tid & 63, wr = wid >> 2, wc = wid & 3, fr = lane & 15, fq = lane >> 4;
    const int K = g.K, nt = K / BK;
    unsigned voffA[2], voffB[2];
#pragma unroll
    for (int i = 0; i < 2; ++i) { int R, C; stage_rc(tid * 16 + i * 8192, R, C); const int Rb = Epi::PERM ? ((R & ~31) + perm32(R & 31)) : R;
        voffA[i] = (unsigned)(R * K + C) * 2u; voffB[i] = (unsigned)(Rb * K + C) * 2u; }
    const size_t kstep = (size_t)(BK * 2);
    const size_t hstep = (size_t)HALF * K * 2;
    const size_t tstep = 2 * hstep;
    const unsigned ldsw = (unsigned)wid * 1024u;
    const int aoff = lds_byte(wr * 64 + fr, fq * 8), boff = lds_byte(wc * 32 + fr, fq * 8);
#define PG8_SA(b, h) (((b) * 2 + (h)) * HTB)
#define PG8_SB(b, h) ((4 + (b) * 2 + (h)) * HTB)
#define PG8_STAGE(bufoff, gbase, voff) do { _Pragma("unroll") for (int _i = 0; _i < 2; ++_i) \
        __builtin_amdgcn_global_load_lds((const unsigned*)((const char*)(gbase) + (voff)[_i]), (LAS unsigned*)(lds + (bufoff) + ldsw + _i * 8192), 16, 0, 0); } while (0)
#define PG8_LDA(dst, b, h) do { _Pragma("unroll") for (int m = 0; m < 4; ++m) _Pragma("unroll") for (int k = 0; k < 2; ++k) dst[m][k] = *(const LAS bf16x8*)(lds + PG8_SA(b, h) + aoff + m * 2048 + k * 1024); } while (0)
#define PG8_LDB(dst, b, h) do { _Pragma("unroll") for (int n = 0; n < 2; ++n) _Pragma("unroll") for (int k = 0; k < 2; ++k) dst[n][k] = *(const LAS bf16x8*)(lds + PG8_SB(b, h) + boff + n * 2048 + k * 1024); } while (0)
#define PG8_MMA(ai, bj, At, Bt) do { __builtin_amdgcn_s_setprio(1); _Pragma("unroll") for (int m = 0; m < 4; ++m) _Pragma("unroll") for (int n = 0; n < 2; ++n) _Pragma("unroll") for (int k = 0; k < 2; ++k) \
        acc[ai][bj][m][n] = __builtin_amdgcn_mfma_f32_16x16x32_bf16(Bt[n][k], At[m][k], acc[ai][bj][m][n], 0, 0, 0); __builtin_amdgcn_s_setprio(0); } while (0)
#define PG8_WAIT_V(n) asm volatile("s_waitcnt vmcnt(" #n ")" ::: "memory")
#define PG8_WAIT_L(n) asm volatile("s_waitcnt lgkmcnt(" #n ")" ::: "memory")
#define PG8_BAR __builtin_amdgcn_s_barrier()
#define PG8_SCHED __builtin_amdgcn_sched_barrier(0)
    Unit cur, nxt; int ui = 0;
    if (!S.next(0, cur)) return;
    f32x4 acc[2][2][4][2];
#pragma unroll
    for (int a = 0; a < 2; ++a)
#pragma unroll
        for (int b = 0; b < 2; ++b)
#pragma unroll
            for (int m = 0; m < 4; ++m)
#pragma unroll
                for (int n = 0; n < 2; ++n) acc[a][b][m][n] = (f32x4){0.f, 0.f, 0.f, 0.f};
    bf16x8 At[4][2], B0[2][2], B1[2][2];
    const char* cA = (const char*)g.A + (size_t)cur.pm * tstep; const char* cB = (const char*)g.Bt + (size_t)cur.pn * tstep;
    if constexpr (SP2) {
        PG8_STAGE(PG8_SB(0, 0), cB, voffB); PG8_STAGE(PG8_SB(0, 1), cB + hstep, voffB); PG8_STAGE(PG8_SA(0, 0), cA, voffA); PG8_STAGE(PG8_SA(0, 1), cA + hstep, voffA);
        if (wr == 1) PG8_BAR;
        PG8_WAIT_V(2); PG8_BAR;
        PG8_STAGE(PG8_SB(1, 0), cB + kstep, voffB); PG8_STAGE(PG8_SA(1, 0), cA + kstep, voffA); PG8_STAGE(PG8_SB(1, 1), cB + hstep + kstep, voffB);
        PG8_WAIT_V(6); PG8_BAR;
    } else {
        PG8_STAGE(PG8_SB(0, 0), cB, voffB); PG8_STAGE(PG8_SA(0, 0), cA, voffA); PG8_STAGE(PG8_SB(0, 1), cB + hstep, voffB); PG8_STAGE(PG8_SA(0, 1), cA + hstep, voffA);
        if (wr == 1) PG8_BAR;
        PG8_WAIT_V(4); PG8_BAR;
        PG8_STAGE(PG8_SB(1, 0), cB + kstep, voffB); PG8_STAGE(PG8_SA(1, 0), cA + kstep, voffA); PG8_STAGE(PG8_SB(1, 1), cB + hstep + kstep, voffB);
        PG8_WAIT_V(6); PG8_BAR;
    }
    for (;;) {
        const bool has_next = S.next(ui + 1, nxt);
        const char* nA = has_next ? (const char*)g.A + (size_t)nxt.pm * tstep : cA; const char* nB = has_next ? (const char*)g.Bt + (size_t)nxt.pn * tstep : cB;
        for (int t = 0; t < nt; t += 2) {
            const bool last = (t == nt - 2);
            const char* a1 = cA + (size_t)(t + 1) * kstep;
            const char* a2 = last ? nA : cA + (size_t)(t + 2) * kstep; const char* b2 = last ? nB : cB + (size_t)(t + 2) * kstep;
            const char* a3 = a2 + kstep; const char* b3 = b2 + kstep;
            if constexpr (Epi::MID) { if (t == (nt >> 1)) E.mid(acc, cur, wr, fr); }
            if constexpr (SP2) {
            PG8_LDB(B0, 0, 0); PG8_LDB(B1, 0, 1); PG8_SCHED; PG8_LDA(At, 0, 0); PG8_STAGE(PG8_SA(1, 1), a1 + hstep, voffA);
            PG8_WAIT_V(8); PG8_WAIT_L(0); PG8_BAR; PG8_MMA(0, 0, At, B0); PG8_MMA(0, 1, At, B1); PG8_BAR; PG8_SCHED;
            PG8_LDA(At, 0, 1); PG8_STAGE(PG8_SB(0, 0), b2, voffB); PG8_STAGE(PG8_SB(0, 1), b2 + hstep, voffB); PG8_STAGE(PG8_SA(0, 0), a2, voffA);
            PG8_WAIT_V(8); PG8_WAIT_L(0); PG8_BAR; PG8_MMA(1, 0, At, B0); PG8_MMA(1, 1, At, B1); PG8_BAR; PG8_SCHED;
            PG8_LDB(B0, 1, 0); PG8_LDB(B1, 1, 1); PG8_SCHED; PG8_LDA(At, 1, 0); PG8_STAGE(PG8_SA(0, 1), a2 + hstep, voffA);
            PG8_WAIT_V(8); PG8_WAIT_L(0); PG8_BAR; PG8_MMA(0, 0, At, B0); PG8_MMA(0, 1, At, B1); PG8_BAR; PG8_SCHED;
            PG8_LDA(At, 1, 1); PG8_STAGE(PG8_SB(1, 0), b3, voffB); PG8_STAGE(PG8_SB(1, 1), b3 + hstep, voffB); PG8_STAGE(PG8_SA(1, 0), a3, voffA);
            PG8_WAIT_V(8); PG8_WAIT_L(0); PG8_BAR; PG8_MMA(1, 0, At, B0); PG8_MMA(1, 1, At, B1); PG8_BAR; PG8_SCHED;
            } else {
            PG8_LDB(B0, 0, 0); PG8_SCHED; PG8_LDA(At, 0, 0); PG8_STAGE(PG8_SA(1, 1), a1 + hstep, voffA);
            PG8_WAIT_L(8); PG8_BAR; PG8_WAIT_L(0); PG8_MMA(0, 0, At, B0); PG8_BAR; PG8_SCHED;
            PG8_LDB(B1, 0, 1); PG8_STAGE(PG8_SB(0, 0), b2, voffB);
            PG8_BAR; PG8_WAIT_L(0); PG8_MMA(0, 1, At, B1); PG8_BAR;
            PG8_LDA(At, 0, 1); PG8_STAGE(PG8_SA(0, 0), a2, voffA);
            PG8_BAR; PG8_WAIT_L(0); PG8_MMA(1, 0, At, B0); PG8_BAR; PG8_SCHED;
            PG8_STAGE(PG8_SB(0, 1), b2 + hstep, voffB);
            PG8_WAIT_V(6); PG8_BAR; PG8_MMA(1, 1, At, B1); PG8_BAR;
            PG8_LDB(B0, 1, 0); PG8_SCHED; PG8_LDA(At, 1, 0); PG8_STAGE(PG8_SA(0, 1), a2 + hstep, voffA);
            PG8_WAIT_L(8); PG8_BAR; PG8_WAIT_L(0); PG8_MMA(0, 0, At, B0); PG8_BAR; PG8_SCHED;
            PG8_LDB(B1, 1, 1); PG8_STAGE(PG8_SB(1, 0), b3, voffB);
            PG8_BAR; PG8_WAIT_L(0); PG8_MMA(0, 1, At, B1); PG8_BAR;
            PG8_LDA(At, 1, 1); PG8_STAGE(PG8_SA(1, 0), a3, voffA);
            PG8_BAR; PG8_WAIT_L(0); PG8_MMA(1, 0, At, B0); PG8_BAR; PG8_SCHED;
            PG8_STAGE(PG8_SB(1, 1), b3 + hstep, voffB);
            PG8_WAIT_V(6); PG8_BAR; PG8_MMA(1, 1, At, B1); PG8_BAR;
            }
        }
        if (wr == 0) PG8_BAR;
        E(acc, cur, wr, wc, fr, fq);
        if (!has_next) break;
#pragma unroll
        for (int a = 0; a < 2; ++a)
#pragma unroll
            for (int b = 0; b < 2; ++b)
#pragma unroll
                for (int m = 0; m < 4; ++m)
#pragma unroll
                    for (int n = 0; n < 2; ++n) acc[a][b][m][n] = (f32x4){0.f, 0.f, 0.f, 0.f};
        cur = nxt; cA = nA; cB = nB; ++ui;
        if (wr == 1) PG8_BAR;
    }
    PG8_WAIT_V(0);
    PG8_BAR;
#undef PG8_SA
#undef PG8_SB
#undef PG8_STAGE
#undef PG8_LDA
#undef PG8_LDB
#undef PG8_MMA
#undef PG8_WAIT_V
#undef PG8_WAIT_L
#undef PG8_BAR
#undef PG8_SCHED
}
}
using pg8::Unit;
typedef f32x4 Acc[2][2][4][2];

__device__ __forceinline__ void store8_bf16(bf16_t* p, const f32x4& a, const f32x4& b) {
    u32x4 w; w.x = cvt_pk_bf16(a[0], a[1]); w.y = cvt_pk_bf16(a[2], a[3]); w.z = cvt_pk_bf16(b[0], b[1]); w.w = cvt_pk_bf16(b[2], b[3]);
    *(GAS u32x4*)p = w;
}
__device__ __forceinline__ void unpack8(const u32x4 w, f32x4& a, f32x4& b) {
    a = (f32x4){bf_lo(w.x), bf_hi(w.x), bf_lo(w.y), bf_hi(w.y)}; b = (f32x4){bf_lo(w.z), bf_hi(w.z), bf_lo(w.w), bf_hi(w.w)};
}

struct EpiInProj {
    static constexpr bool PERM = true, MID = false;
    bf16_t* BG; bf16_t* XIN; bf16_t* U; const float* ss; float* convp; float* convs;
    __device__ __forceinline__ int brow(int cb, int f) const {
        const int cg = cb >> 5;
        if (cg < 16) return cb + 16 * f;
        if (cg >= 48) return 1536 + 32 * (cg - 48) + 16 * f;
        const int c = 16 * (cg - 16), q = c >> 7, r = c & 127;
        return 512 + 256 * q + 128 * f + r;
    }
    __device__ __forceinline__ void small(const f32x4 (&acc)[2][2], int r0, int cb, int fr, int fq) const {
        const int cg = cb >> 5;
#pragma unroll
        for (int m = 0; m < 2; ++m) {
            const int r = r0 + 16 * m + fr; const float inv = rsqrtf(((const GAS float*)ss)[r] * (1.0f / D) + EPS);
            if (cg < 16 || cg >= 48) {
                bf16_t* dst = (cg < 16 ? BG + (size_t)r * CH + cb : U + (size_t)r * CH + (cb - 1536)) + 4 * fq;
#pragma unroll
                for (int f = 0; f < 2; ++f) { const f32x4 v = acc[m][f] * inv; u32x2 w; w.x = cvt_pk_bf16(v[0], v[1]); w.y = cvt_pk_bf16(v[2], v[3]); *(GAS u32x2*)(dst + 16 * f) = w; }
            } else {
                const int c0 = 16 * (cg - 16) + 4 * fq;
                const f32x4 x = (acc[m][0] * inv) * (acc[m][1] * inv);
                u32x2 w; w.x = cvt_pk_bf16(x[0], x[1]); w.y = cvt_pk_bf16(x[2], x[3]); *(GAS u32x2*)(XIN + (size_t)r * CH + c0) = w;
                const int rs = r - TP, t = rs & (DSEQ - 1);
                if (t >= DSEQ - 2) *(GAS f32x4*)(convs + ((size_t)(rs >> 6) * 2 + (t - (DSEQ - 2))) * CH + c0) = x;
            }
        }
    }
    __device__ __forceinline__ void operator()(const Acc& acc, const Unit& u, int wr, int wc, int fr, int fq) const {
        const int row0 = u.pm * 256 + wr * 64 + fr, cb = wc * 32 + 8 * fq;
#pragma unroll
        for (int ai = 0; ai < 2; ++ai)
#pragma unroll
            for (int m = 0; m < 4; ++m) {
                const int r = row0 + ai * 128 + m * 16;
                const float inv = rsqrtf(((const GAS float*)ss)[r] * (1.0f / D) + EPS);
                if (u.pn < 2 || u.pn >= 6) {
                    bf16_t* dst = (u.pn < 2 ? BG : U) + (size_t)r * CH + (u.pn & 1) * 256 + cb;
#pragma unroll
                    for (int bj = 0; bj < 2; ++bj) store8_bf16(dst + bj * 128, acc[ai][bj][m][0] * inv, acc[ai][bj][m][1] * inv);
                } else {
                    const int c0 = (u.pn - 2) * 128 + cb;
                    const f32x4 x0 = (acc[ai][0][m][0] * inv) * (acc[ai][1][m][0] * inv), x1 = (acc[ai][0][m][1] * inv) * (acc[ai][1][m][1] * inv);
                    store8_bf16(XIN + (size_t)r * CH + c0, x0, x1);
                    float* cd = nullptr;
                    if (r < TP) { const int t = r & (SEQ - 1); if (t >= SEQ - 2) cd = convp + ((size_t)(r >> 11) * 2 + (t - (SEQ - 2))) * CH + c0; }
                    else { const int rs = r - TP, t = rs & (DSEQ - 1); if (t >= DSEQ - 2) cd = convs + ((size_t)(rs >> 6) * 2 + (t - (DSEQ - 2))) * CH + c0; }
                    if (cd) { *(GAS f32x4*)cd = x0; *(GAS f32x4*)(cd + 4) = x1; }
                }
            }
    }
};
struct EpiKV {
    static constexpr bool PERM = false, MID = false;
    float* outK; float* outV; bf16_t* KB; const float* invm;
    __device__ __forceinline__ void operator()(const Acc& acc, const Unit& u, int wr, int wc, int fr, int fq) const {
        const int row0 = u.pm * 256 + wr * 64 + fr, col0 = (u.pn & 3) * 256 + wc * 32 + 4 * fq;
        float* outp = u.pn < 4 ? outK : outV;
#pragma unroll
        for (int ai = 0; ai < 2; ++ai)
#pragma unroll
            for (int m = 0; m < 4; ++m) {
                const int r = row0 + ai * 128 + m * 16; const float inv = ((const GAS float*)invm)[r];
#pragma unroll
                for (int bj = 0; bj < 2; ++bj)
#pragma unroll
                    for (int n = 0; n < 2; ++n) {
                        const f32x4 v = acc[ai][bj][m][n] * inv; const size_t o = (size_t)r * D + col0 + bj * 128 + n * 16;
                        *(GAS f32x4*)(outp + o) = v;
                        if (u.pn < 4) { u32x2 w; w.x = cvt_pk_bf16(v[0], v[1]); w.y = cvt_pk_bf16(v[2], v[3]); *(GAS u32x2*)(KB + o) = w; }
                    }
            }
    }
};
struct EpiVT {
    static constexpr bool PERM = true, MID = false;
    bf16_t* VT; const float* invm;
    __device__ __forceinline__ void operator()(const Acc& acc, const Unit& u, int wr, int wc, int fr, int fq) const {
        const int row0 = u.pm * 256 + wr * 64 + fr, col0 = u.pn * 256 + wc * 32 + 8 * fq;
        f32x4 s[2][2];
#pragma unroll
        for (int bj = 0; bj < 2; ++bj) { s[bj][0] = *(const GAS f32x4*)(invm + col0 + bj * 128); s[bj][1] = *(const GAS f32x4*)(invm + col0 + bj * 128 + 4); }
#pragma unroll
        for (int ai = 0; ai < 2; ++ai)
#pragma unroll
            for (int m = 0; m < 4; ++m) {
                const int r = row0 + ai * 128 + m * 16;
#pragma unroll
                for (int bj = 0; bj < 2; ++bj) store8_bf16(VT + (size_t)r * TM + col0 + bj * 128, acc[ai][bj][m][0] * s[bj][0], acc[ai][bj][m][1] * s[bj][1]);
            }
    }
};
struct EpiGLU {
    static constexpr bool PERM = true, MID = false;
    const bf16_t* YG; bf16_t* YCAT; float* ssb;
    __device__ __forceinline__ int brow(int cb, int f) const { return cb + 16 * f; }
    __device__ __forceinline__ void small(const f32x4 (&acc)[2][2], int r0, int cb, int fr, int fq) const {
#pragma unroll
        for (int m = 0; m < 2; ++m) {
            const int r = r0 + 16 * m + fr; float ssum = 0.f;
#pragma unroll
            for (int f = 0; f < 2; ++f) {
                const int c = cb + 16 * f + 4 * fq; const u32x2 yw = *(const GAS u32x2*)(YG + (size_t)r * CH + c);
                f32x4 y = (f32x4){bf_lo(yw.x), bf_hi(yw.x), bf_lo(yw.y), bf_hi(yw.y)};
#pragma unroll
                for (int e = 0; e < 4; ++e) { y[e] = y[e] * __builtin_amdgcn_rcpf(1.0f + __expf(-acc[m][f][e])); ssum += y[e] * y[e]; }
                u32x2 w; w.x = cvt_pk_bf16(y[0], y[1]); w.y = cvt_pk_bf16(y[2], y[3]); *(GAS u32x2*)(YCAT + (size_t)r * D + c) = w;
            }
            ssum += __shfl_xor(ssum, 16); ssum += __shfl_xor(ssum, 32);
            if (fq == 0) atomicAdd(ssb + r, ssum);
        }
    }
    __device__ __forceinline__ void operator()(const Acc& acc, const Unit& u, int wr, int wc, int fr, int fq) const {
        const int row0 = u.pm * 256 + wr * 64 + fr, col0 = u.pn * 256 + wc * 32 + 8 * fq;
#pragma unroll
        for (int ai = 0; ai < 2; ++ai)
#pragma unroll
            for (int m = 0; m < 4; ++m) {
                const int r = row0 + ai * 128 + m * 16; float ssum = 0.f;
#pragma unroll
                for (int bj = 0; bj < 2; ++bj) {
                    f32x4 y0, y1; unpack8(*(const GAS u32x4*)(YG + (size_t)r * CH + col0 + bj * 128), y0, y1);
                    f32x4 z0 = acc[ai][bj][m][0], z1 = acc[ai][bj][m][1];
#pragma unroll
                    for (int e = 0; e < 4; ++e) { y0[e] = y0[e] * __builtin_amdgcn_rcpf(1.0f + __expf(-z0[e])); y1[e] = y1[e] * __builtin_amdgcn_rcpf(1.0f + __expf(-z1[e]));
                        ssum += y0[e] * y0[e] + y1[e] * y1[e]; }
                    store8_bf16(YCAT + (size_t)r * D + col0 + bj * 128, y0, y1);
                }
                ssum += __shfl_xor(ssum, 16); ssum += __shfl_xor(ssum, 32);
                if (fq == 0) atomicAdd(ssb + r, ssum);
            }
    }
};
template <bool MIDS> struct EpiRes {
    static constexpr bool PERM = true, MID = MIDS;
    bf16_t* XB; float* ssout; const float* ssb;
    __device__ __forceinline__ int brow(int cb, int f) const { return cb + 16 * f; }
    __device__ __forceinline__ void mid_small(f32x4 (&acc)[2][2], int r0, int fr) const {
#pragma unroll
        for (int m = 0; m < 2; ++m) { const float sc = rsqrtf(((const GAS float*)ssb)[r0 + 16 * m + fr] * (1.0f / CH) + EPS); acc[m][0] *= sc; acc[m][1] *= sc; }
    }
    __device__ __forceinline__ void small(const f32x4 (&acc)[2][2], int r0, int cb, int fr, int fq) const {
#pragma unroll
        for (int m = 0; m < 2; ++m) {
            const int r = r0 + 16 * m + fr; float ssum = 0.f;
#pragma unroll
            for (int f = 0; f < 2; ++f) {
                bf16_t* p = XB + (size_t)r * D + cb + 16 * f + 4 * fq; const u32x2 xw = *(const GAS u32x2*)p;
                f32x4 x = (f32x4){bf_lo(xw.x), bf_hi(xw.x), bf_lo(xw.y), bf_hi(xw.y)} + acc[m][f];
#pragma unroll
                for (int e = 0; e < 4; ++e) ssum += x[e] * x[e];
                u32x2 w; w.x = cvt_pk_bf16(x[0], x[1]); w.y = cvt_pk_bf16(x[2], x[3]); *(GAS u32x2*)p = w;
            }
            ssum += __shfl_xor(ssum, 16); ssum += __shfl_xor(ssum, 32);
            if (fq == 0) atomicAdd(ssout + r, ssum);
        }
    }
    __device__ __forceinline__ void mid(Acc& acc, const Unit& u, int wr, int fr) const {
        const int row0 = u.pm * 256 + wr * 64 + fr;
#pragma unroll
        for (int ai = 0; ai < 2; ++ai)
#pragma unroll
            for (int m = 0; m < 4; ++m) {
                const float s = rsqrtf(((const GAS float*)ssb)[row0 + ai * 128 + m * 16] * (1.0f / CH) + EPS);
#pragma unroll
                for (int bj = 0; bj < 2; ++bj)
#pragma unroll
                    for (int n = 0; n < 2; ++n) acc[ai][bj][m][n] *= s;
            }
    }
    __device__ __forceinline__ void operator()(const Acc& acc, const Unit& u, int wr, int wc, int fr, int fq) const {
        const int row0 = u.pm * 256 + wr * 64 + fr, col0 = u.pn * 256 + wc * 32 + 8 * fq;
#pragma unroll
        for (int ai = 0; ai < 2; ++ai)
#pragma unroll
            for (int m = 0; m < 4; ++m) {
                const int r = row0 + ai * 128 + m * 16; float ssum = 0.f;
#pragma unroll
                for (int bj = 0; bj < 2; ++bj) {
                    bf16_t* p = XB + (size_t)r * D + col0 + bj * 128;
                    f32x4 x0, x1; unpack8(*(const GAS u32x4*)p, x0, x1);
                    x0 += acc[ai][bj][m][0]; x1 += acc[ai][bj][m][1];
#pragma unroll
                    for (int e = 0; e < 4; ++e) ssum += x0[e] * x0[e] + x1[e] * x1[e];
                    store8_bf16(p, x0, x1);
                }
                ssum += __shfl_xor(ssum, 16); ssum += __shfl_xor(ssum, 32);
                if (fq == 0) atomicAdd(ssout + r, ssum);
            }
    }
};
template <int ACT> struct EpiScale {
    static constexpr bool PERM = true, MID = false;
    bf16_t* OUT; int ldc; const float* ss;
    __device__ __forceinline__ int brow(int cb, int f) const { return cb + 16 * f; }
    __device__ __forceinline__ void small(const f32x4 (&acc)[2][2], int r0, int cb, int fr, int fq) const {
#pragma unroll
        for (int m = 0; m < 2; ++m) {
            const int r = r0 + 16 * m + fr; const float inv = rsqrtf(((const GAS float*)ss)[r] * (1.0f / D) + EPS);
#pragma unroll
            for (int f = 0; f < 2; ++f) {
                f32x4 v = acc[m][f] * inv;
                if (ACT == 1) {
#pragma unroll
                    for (int e = 0; e < 4; ++e) { const float a = fmaxf(v[e], 0.f); v[e] = a * a; }
                }
                u32x2 w; w.x = cvt_pk_bf16(v[0], v[1]); w.y = cvt_pk_bf16(v[2], v[3]); *(GAS u32x2*)(OUT + (size_t)r * ldc + cb + 16 * f + 4 * fq) = w;
            }
        }
    }
    __device__ __forceinline__ void operator()(const Acc& acc, const Unit& u, int wr, int wc, int fr, int fq) const {
        const int row0 = u.pm * 256 + wr * 64 + fr, col0 = u.pn * 256 + wc * 32 + 8 * fq;
#pragma unroll
        for (int ai = 0; ai < 2; ++ai)
#pragma unroll
            for (int m = 0; m < 4; ++m) {
                const int r = row0 + ai * 128 + m * 16; const float inv = rsqrtf(((const GAS float*)ss)[r] * (1.0f / D) + EPS);
#pragma unroll
                for (int bj = 0; bj < 2; ++bj) {
                    f32x4 v0 = acc[ai][bj][m][0] * inv, v1 = acc[ai][bj][m][1] * inv;
                    if (ACT == 1) {
#pragma unroll
                        for (int e = 0; e < 4; ++e) { const float a = fmaxf(v0[e], 0.f), b = fmaxf(v1[e], 0.f); v0[e] = a * a; v1[e] = b * b; }
                    }
                    store8_bf16(OUT + (size_t)r * ldc + col0 + bj * 128, v0, v1);
                }
            }
    }
};

template <class Epi>
__device__ __forceinline__ void small_gemm(const bf16_t* A, const bf16_t* Bt, int N, int K, const Epi& E, int c, int stride) {
    int tid = threadIdx.x; asm volatile("" : "+v"(tid));
    const int wave = __builtin_amdgcn_readfirstlane(tid >> 6), lane = tid & 63, fr = lane & 15, fq = lane >> 4;
    const int ntn = N >> 7, ntiles = (TS / 64) * ntn;
    if (c < 0) return;
    for (int tile = c; tile < ntiles; tile += stride) {
        const int tm = tile / ntn, tn = tile - tm * ntn;
        const int r0 = TP + tm * 64 + (wave >> 2) * 32, cb = tn * 128 + (wave & 3) * 32;
        const char* pa = (const char*)A + ((size_t)(r0 + fr) * K + 8 * fq) * 2;
        const char* pb0 = (const char*)Bt + ((size_t)(E.brow(cb, 0) + fr) * K + 8 * fq) * 2;
        const char* pb1 = (const char*)Bt + ((size_t)(E.brow(cb, 1) + fr) * K + 8 * fq) * 2;
        const size_t a16 = (size_t)16 * K * 2;
        f32x4 acc[2][2];
#pragma unroll
        for (int m = 0; m < 2; ++m)
#pragma unroll
            for (int f = 0; f < 2; ++f) acc[m][f] = (f32x4){0.f, 0.f, 0.f, 0.f};
        const int ng = K >> 7;
        bf16x8 A0[4], A1[4], B0[4], B1[4], C0[4], C1[4], D0[4], D1[4];
#define SG_LOAD(a0, a1, b0, b1, g) do { _Pragma("unroll") for (int j = 0; j < 4; ++j) { const size_t ko = (size_t)((g) * 4 + j) * 64; \
            a0[j] = *(const GAS bf16x8*)(pa + ko); a1[j] = *(const GAS bf16x8*)(pa + a16 + ko); b0[j] = *(const GAS bf16x8*)(pb0 + ko); b1[j] = *(const GAS bf16x8*)(pb1 + ko); } } while (0)
#define SG_MMA(a0, a1, b0, b1) do { _Pragma("unroll") for (int j = 0; j < 4; ++j) { \
            acc[0][0] = __builtin_amdgcn_mfma_f32_16x16x32_bf16(b0[j], a0[j], acc[0][0], 0, 0, 0); acc[0][1] = __builtin_amdgcn_mfma_f32_16x16x32_bf16(b1[j], a0[j], acc[0][1], 0, 0, 0); \
            acc[1][0] = __builtin_amdgcn_mfma_f32_16x16x32_bf16(b0[j], a1[j], acc[1][0], 0, 0, 0); acc[1][1] = __builtin_amdgcn_mfma_f32_16x16x32_bf16(b1[j], a1[j], acc[1][1], 0, 0, 0); } } while (0)
        SG_LOAD(A0, A1, B0, B1, 0);
        for (int g = 0; g < ng; g += 2) {
            if constexpr (Epi::MID) { if (g == (ng >> 1)) E.mid_small(acc, r0, fr); }
            SG_LOAD(C0, C1, D0, D1, g + 1);
            SG_MMA(A0, A1, B0, B1);
            if (g + 2 < ng) SG_LOAD(A0, A1, B0, B1, g + 2);
            SG_MMA(C0, C1, D0, D1);
        }
#undef SG_LOAD
#undef SG_MMA
        E.small(acc, r0, cb, fr, fq);
    }
}

struct Args { const float* in[33]; float* out; unsigned char* ws; };
enum { I_XP = 0, I_XS, I_MEM, I_SCONV, I_SRE, I_SIM, I_CK, I_CV, I_GMIX, I_WIN, I_CONVW, I_ARE, I_AIM, I_LOGDT, I_BRE, I_BIM, I_CRE, I_CIM, I_SD, I_WGLU,
       I_GA, I_GB, I_WOUT, I_GX, I_GMEM, I_WQ, I_WK, I_WV, I_WO, I_GMLP, I_WUP, I_WDOWN, I_GFIN };

typedef const float* const __attribute__((address_space(4)))* KTab;
__device__ __forceinline__ KTab ktab() { unsigned long long p = (unsigned long long)__builtin_amdgcn_kernarg_segment_ptr(); asm volatile("" : "+s"(p)); return (KTab)p; }
__device__ __forceinline__ float* ss_arr(unsigned char* ws, int idx) { return (float*)(ws + WS_SS) + (size_t)idx * T; }
__device__ __forceinline__ float* invmem_arr(unsigned char* ws) { return (float*)(ws + WS_SS) + (size_t)9 * T; }

__device__ __forceinline__ int inproj_src_col(int vc) {
    if (vc < 512 || vc >= 1536) return vc;
    const int q = (vc - 512) >> 8, r = (vc - 512) & 255;
    return r < 128 ? 512 + q * 128 + r : 1024 + q * 128 + (r - 128);
}
__device__ __forceinline__ void transpose_item(const float* W, int ldw, int srck0, int srcn0, const float* gain, float gscale, bf16_t* WT, int ldt, int dn0, int dk0, LAS float* scr, int lane) {
#pragma unroll 8
    for (int i = 0; i < 32; ++i) { const int kk = 2 * i + (lane >> 5); float v = ((const GAS float*)W)[(size_t)(srck0 + kk) * ldw + srcn0 + (lane & 31)];
        const float gsc = gain ? ((const GAS float*)gain)[kk] * gscale : gscale; scr[kk * 33 + (lane & 31)] = v * gsc; }
    LDS_WAIT();
    const int c = lane & 7;
#pragma unroll
    for (int j = 0; j < 4; ++j) { const int n = (lane >> 3) + 8 * j; const LAS float* s = scr + (8 * c) * 33 + n;
        u32x4 o; o.x = cvt_pk_bf16(s[0 * 33], s[1 * 33]); o.y = cvt_pk_bf16(s[2 * 33], s[3 * 33]); o.z = cvt_pk_bf16(s[4 * 33], s[5 * 33]); o.w = cvt_pk_bf16(s[6 * 33], s[7 * 33]);
        *(GAS u32x4*)(WT + (size_t)(dn0 + n) * ldt + dk0 + 8 * c) = o; }
    LDS_WAIT();
}
__device__ __forceinline__ float convert_row(const float* src, bf16_t* dst, int lane) {
    const GAS f32x4* xr = (const GAS f32x4*)src + lane; f32x4 v[4]; float s = 0.f;
#pragma unroll
    for (int j = 0; j < 4; ++j) { v[j] = xr[64 * j]; s += (v[j][0] * v[j][0] + v[j][1] * v[j][1]) + (v[j][2] * v[j][2] + v[j][3] * v[j][3]); }
    GAS u32x2* o = (GAS u32x2*)dst + lane;
#pragma unroll
    for (int j = 0; j < 4; ++j) { u32x2 w; w.x = cvt_pk_bf16(v[j][0], v[j][1]); w.y = cvt_pk_bf16(v[j][2], v[j][3]); o[64 * j] = w; }
    return wave_sum(s);
}
constexpr int PI_IN = 1024, PI_GLU = 128, PI_SQ = 512, PI_UP = 2048, PI_CV = 2048;
constexpr int PI_LAYER = PI_IN + PI_GLU + 5 * PI_SQ + 2 * PI_UP + PI_CV;

__device__ __forceinline__ void prep_phase(unsigned char* ws, LAS unsigned char* lds, int gw, int NGW, int wave, int lane) {
    const KTab in = ktab();
    LAS float* scr = (LAS float*)(lds + wave * 8704);
    for (int it = gw; it < DEPTH * PI_LAYER; it += NGW) {
        const int l = it / PI_LAYER; int r = it - l * PI_LAYER;
        unsigned char* wl = ws + WS_W + (size_t)l * W_LAYER;
        if (r < PI_IN) { const int kb = r >> 6, nb = r & 63;
            transpose_item(as_global(in[I_WIN]) + (size_t)l * D * 2048, 2048, 64 * kb, inproj_src_col(32 * nb), as_global(in[I_GMIX]) + l * D + 64 * kb, 1.0f, (bf16_t*)(wl + W_IN), D, 32 * nb, 64 * kb, scr, lane); continue; }
        r -= PI_IN;
        if (r < PI_GLU) { const int kb = r >> 4, nb = r & 15;
            transpose_item(as_global(in[I_WGLU]) + (size_t)l * CH * CH, CH, 64 * kb, 32 * nb, nullptr, 1.0f, (bf16_t*)(wl + W_GLU), CH, 32 * nb, 64 * kb, scr, lane); continue; }
        r -= PI_GLU;
        if (r < PI_SQ) { const int kb = r >> 5, nb = r & 31, dk0 = 64 * kb;
            const float* gn = dk0 < 512 ? as_global(in[I_GB]) + l * CH + dk0 : as_global(in[I_GA]) + l * CH + dk0 - 512;
            transpose_item(as_global(in[I_WOUT]) + (size_t)l * D * D, D, (dk0 + 512) & 1023, 32 * nb, gn, 1.0f, (bf16_t*)(wl + W_OUT), D, 32 * nb, dk0, scr, lane); continue; }
        r -= PI_SQ;
        if (r < PI_SQ) { const int kb = r >> 5, nb = r & 31;
            transpose_item(as_global(in[I_WQ]) + (size_t)l * D * D, D, 64 * kb, 32 * nb, as_global(in[I_GX]) + l * D + 64 * kb, 0.0625f, (bf16_t*)(wl + W_Q), D, 32 * nb, 64 * kb, scr, lane); continue; }
        r -= PI_SQ;
        if (r < PI_SQ) { const int kb = r >> 5, nb = r & 31;
            transpose_item(as_global(in[I_WK]) + (size_t)l * D * D, D, 64 * kb, 32 * nb, as_global(in[I_GMEM]) + l * D + 64 * kb, 1.0f, (bf16_t*)(wl + W_KV), D, 32 * nb, 64 * kb, scr, lane); continue; }
        r -= PI_SQ;
        if (r < PI_SQ) { const int kb = r >> 5, nb = r & 31;
            transpose_item(as_global(in[I_WV]) + (size_t)l * D * D, D, 64 * kb, 32 * nb, as_global(in[I_GMEM]) + l * D + 64 * kb, 1.0f, (bf16_t*)(wl + W_KV), D, 1024 + 32 * nb, 64 * kb, scr, lane); continue; }
        r -= PI_SQ;
        if (r < PI_SQ) { const int kb = r >> 5, nb = r & 31;
            transpose_item(as_global(in[I_WO]) + (size_t)l * D * D, D, 64 * kb, 32 * nb, nullptr, 1.0f, (bf16_t*)(wl + W_O), D, 32 * nb, 64 * kb, scr, lane); continue; }
        r -= PI_SQ;
        if (r < PI_UP) { const int kb = r >> 7, nb = r & 127;
            transpose_item(as_global(in[I_WUP]) + (size_t)l * D * DFF, DFF, 64 * kb, 32 * nb, as_global(in[I_GMLP]) + l * D + 64 * kb, 1.0f, (bf16_t*)(wl + W_UP), D, 32 * nb, 64 * kb, scr, lane); continue; }
        r -= PI_UP;
        if (r < PI_UP) { const int kb = r >> 5, nb = r & 31;
            transpose_item(as_global(in[I_WDOWN]) + (size_t)l * DFF * D, D, 64 * kb, 32 * nb, nullptr, 1.0f, (bf16_t*)(wl + W_DOWN), DFF, 32 * nb, 64 * kb, scr, lane); continue; }
        r -= PI_UP;
        { const int kb = r >> 5, nb = r & 31;
            transpose_item(as_global(in[I_CV]) + (size_t)l * TMS * D, D, 64 * kb, 32 * nb, nullptr, 1.0f, (bf16_t*)(ws + WS_VTC) + (size_t)l * D * TMS, TMS, 32 * nb, 64 * kb, scr, lane); }
    }
    float* ss0 = ss_arr(ws, 0); float* invm = invmem_arr(ws);
    for (int m = gw; m < T + TM + 2 * TMS; m += NGW) {
        if (m < T) { const float* src = m < TP ? as_global(in[I_XP]) + (size_t)m * D : as_global(in[I_XS]) + (size_t)(m - TP) * D;
            const float s = convert_row(src, (bf16_t*)(ws + WS_XB) + (size_t)m * D, lane); if (lane == 0) ((GAS float*)ss0)[m] = s; }
        else if (m < T + TM) { const int mm = m - T; const float s = convert_row(as_global(in[I_MEM]) + (size_t)mm * D, (bf16_t*)(ws + WS_MNB) + (size_t)mm * D, lane);
            if (lane == 0) ((GAS float*)invm)[mm] = rsqrtf(s * (1.0f / D) + EPS); }
        else { const int mm = m - T - TM; (void)convert_row(as_global(in[I_CK]) + (size_t)mm * D, (bf16_t*)(ws + WS_KC) + (size_t)mm * D, lane); }
    }
    {
        float* sm = (float*)(ws + WS_SMALL); const int gt = gw * 64 + lane, NT = NGW * 64;
#define SMCOPY(off, idx, n) for (int i = gt; i < (n); i += NT) ((GAS float*)sm)[(off) + i] = ((const GAS float*)in[idx])[i]
        SMCOPY(SM_ARE, I_ARE, 4096); SMCOPY(SM_AIM, I_AIM, 4096); SMCOPY(SM_LOGDT, I_LOGDT, 64); SMCOPY(SM_BRE, I_BRE, 65536); SMCOPY(SM_BIM, I_BIM, 65536);
        SMCOPY(SM_CRE, I_CRE, 65536); SMCOPY(SM_CIM, I_CIM, 65536); SMCOPY(SM_SD, I_SD, 1024); SMCOPY(SM_CONVW, I_CONVW, 3072); SMCOPY(SM_SCONV, I_SCONV, 32768);
        SMCOPY(SM_SRE, I_SRE, 65536); SMCOPY(SM_SIM, I_SIM, 65536); SMCOPY(SM_GFIN, I_GFIN, 1024);
#undef SMCOPY
    }
    { float* z = ss_arr(ws, 1); const size_t n = (size_t)8 * T; for (size_t i = (size_t)gw * 64 + lane; i < n; i += (size_t)NGW * 64) ((GAS float*)z)[i] = 0.f; }
}

__device__ __forceinline__ float gelu_tanh(float x) {
    const float u = 0.7978845608f * (x + 0.044715f * x * x * x);
    const float e = __expf(2.0f * u);
    const float th = 1.0f - 2.0f * __builtin_amdgcn_rcpf(e + 1.0f);
    return 0.5f * x * (1.0f + th);
}
__device__ __forceinline__ void sincos_small(float x, float& s, float& c) {
    const float q = rintf(x * 0.63661977236f);
    float r = fmaf(-q, 1.57079637050628662109375f, x); r = fmaf(-q, -4.37113900018624283e-8f, r);
    const float r2 = r * r;
    const float sp = r + r * r2 * (-1.0f / 6 + r2 * (1.0f / 120 + r2 * (-1.0f / 5040 + r2 * (1.0f / 362880))));
    const float cp = 1.0f + r2 * (-0.5f + r2 * (1.0f / 24 + r2 * (-1.0f / 720 + r2 * (1.0f / 40320 + r2 * (-1.0f / 3628800)))));
    const int qi = (int)q & 3;
    s = (qi == 0) ? sp : (qi == 1) ? cp : (qi == 2) ? -sp : -cp;
    c = (qi == 0) ? cp : (qi == 1) ? -sp : (qi == 2) ? -cp : sp;
}
constexpr int BU_STRIDE = 528, H_STRIDE = 272, SCAN_LDS_WAVE = 16 * BU_STRIDE + 16 * H_STRIDE;

__device__ __forceinline__ void scan_item(unsigned char* ws, float* out, int l, int item, LAS unsigned char* wl, int lane_in) {
    int lane = lane_in; asm volatile("" : "+v"(lane));
    const GAS float* sm = (const GAS float*)(ws + WS_SMALL);
    int b, g, row0, nblk; const bool prompt = item < NB * 32;
    if (prompt) { b = item >> 5; g = item & 31; row0 = b * SEQ; nblk = SEQ / 16; }
    else { const int i2 = item - NB * 32; b = i2 >> 5; g = i2 & 31; row0 = TP + b * DSEQ; nblk = DSEQ / 16; }
    const bf16_t* U = (const bf16_t*)(ws + WS_U); bf16_t* YG = (bf16_t*)(ws + WS_YG);
    const int lg = l * 32 + g, p = lane, t16 = lane & 15, q = lane >> 4;
    const float are = fminf(sm[SM_ARE + lg * 64 + p], -1e-4f), aim = sm[SM_AIM + lg * 64 + p];
    const float dt = expf(sm[SM_LOGDT + lg]);
    float sn, cs; sincos_small(aim * dt, sn, cs);
    const float mag = expf(are * dt), abr = mag * cs, abi = mag * sn;
    const float nr = abr - 1.0f, ni = abi, den = 1.0f / (are * are + aim * aim);
    const float c0 = (nr * are + ni * aim) * den, c1 = (ni * are - nr * aim) * den;
    bf16x8 af[8];
#pragma unroll
    for (int f = 0; f < 8; ++f) {
        const int i = 16 * f + t16, ps = i >> 1, cc = i & 1;
        const float k0 = __shfl(c0, ps), k1 = __shfl(c1, ps);
        u32x4 w = (u32x4){0u, 0u, 0u, 0u};
        if (q < 2) {
            const GAS f32x4* br = (const GAS f32x4*)(sm + SM_BRE + ((size_t)lg * 64 + ps) * 16 + 8 * q); const GAS f32x4* bi = (const GAS f32x4*)(sm + SM_BIM + ((size_t)lg * 64 + ps) * 16 + 8 * q);
            const f32x4 r0 = br[0], r1 = br[1], i0 = bi[0], i1 = bi[1];
            f32x4 v0, v1;
            if (cc == 0) { v0 = k0 * r0 - k1 * i0; v1 = k0 * r1 - k1 * i1; } else { v0 = k0 * i0 + k1 * r0; v1 = k0 * i1 + k1 * r1; }
            w.x = cvt_pk_bf16(v0[0], v0[1]); w.y = cvt_pk_bf16(v0[2], v0[3]); w.z = cvt_pk_bf16(v1[0], v1[1]); w.w = cvt_pk_bf16(v1[2], v1[3]);
        }
        af[f] = __builtin_bit_cast(bf16x8, w);
    }
    bf16x8 cf[4];
#pragma unroll
    for (int s = 0; s < 4; ++s) {
        const int p0 = 16 * s + 4 * q;
        const f32x4 cr = *(const GAS f32x4*)(sm + SM_CRE + ((size_t)lg * 16 + t16) * 64 + p0), ci = *(const GAS f32x4*)(sm + SM_CIM + ((size_t)lg * 16 + t16) * 64 + p0);
        u32x4 w; w.x = cvt_pk_bf16(cr[0], -ci[0]); w.y = cvt_pk_bf16(cr[1], -ci[1]); w.z = cvt_pk_bf16(cr[2], -ci[2]); w.w = cvt_pk_bf16(cr[3], -ci[3]);
        cf[s] = __builtin_bit_cast(bf16x8, w);
    }
    const f32x4 dsk = *(const GAS f32x4*)(sm + SM_SD + l * CH + g * 16 + 4 * q);
    float hre = 0.f, him = 0.f;
    if (!prompt) { hre = sm[SM_SRE + (((size_t)l * NDB + b) * 32 + g) * 64 + p]; him = sm[SM_SIM + (((size_t)l * NDB + b) * 32 + g) * 64 + p]; }
    LAS unsigned char* BU = wl; LAS unsigned char* HB = wl + 16 * BU_STRIDE;
    const char* ubase = (const char*)U + (size_t)row0 * CH * 2; char* ybase = (char*)YG + (size_t)row0 * CH * 2;
    const unsigned lo8 = (unsigned)((t16 * CH + g * 16 + 8 * (q & 1)) * 2), lo4 = (unsigned)((t16 * CH + g * 16 + 4 * q) * 2);
    constexpr size_t BSTEP = (size_t)16 * CH * 2;
    constexpr int PD = 6;
    u32x4 ubuf[PD]; u32x2 ebuf[PD];
#pragma unroll
    for (int j = 0; j < PD; ++j) { ubuf[j] = (u32x4){0u, 0u, 0u, 0u}; ebuf[j] = (u32x2){0u, 0u};
        if (j < nblk) { const char* un = ubase + (size_t)j * BSTEP; if (q < 2) ubuf[j] = *(const GAS u32x4*)(un + lo8); ebuf[j] = *(const GAS u32x2*)(un + lo4); } }
    for (int tb0 = 0; tb0 < nblk; tb0 += PD) {
#pragma unroll
        for (int j = 0; j < PD; ++j) {
            const int tb = tb0 + j;
            if (tb < nblk) {
                const u32x4 ubc = ubuf[j]; const u32x2 uec = ebuf[j];
                if (tb + PD < nblk) { const char* un = ubase + (size_t)(tb + PD) * BSTEP; if (q < 2) ubuf[j] = *(const GAS u32x4*)(un + lo8); ebuf[j] = *(const GAS u32x2*)(un + lo4); }
                const bf16x8 bfrag = __builtin_bit_cast(bf16x8, ubc);
#pragma unroll
                for (int f = 0; f < 8; ++f) {
                    const f32x4 r = __builtin_amdgcn_mfma_f32_16x16x32_bf16(af[f], bfrag, (f32x4){0.f, 0.f, 0.f, 0.f}, 0, 0, 0);
                    *(LAS f32x4*)(BU + t16 * BU_STRIDE + (16 * f + 4 * q) * 4) = r;
                }
                LDS_WAIT();
                f32x2 buv[16];
#pragma unroll
                for (int t = 0; t < 16; ++t) buv[t] = *(const LAS f32x2*)(BU + t * BU_STRIDE + p * 8);
#pragma unroll
                for (int t = 0; t < 16; ++t) {
                    const float nre = fmaf(abr, hre, fmaf(-abi, him, buv[t][0])), nim = fmaf(abr, him, fmaf(abi, hre, buv[t][1]));
                    hre = nre; him = nim;
                    *(LAS unsigned*)(HB + t * H_STRIDE + p * 4) = cvt_pk_bf16(hre, him);
                }
                LDS_WAIT();
                f32x4 y = (f32x4){0.f, 0.f, 0.f, 0.f};
#pragma unroll
                for (int s2 = 0; s2 < 4; ++s2) {
                    const bf16x8 hf = *(const LAS bf16x8*)(HB + t16 * H_STRIDE + (32 * s2 + 8 * q) * 2);
                    y = __builtin_amdgcn_mfma_f32_16x16x32_bf16(cf[s2], hf, y, 0, 0, 0);
                }
                const float u0 = bf_lo(uec.x), u1 = bf_hi(uec.x), u2 = bf_lo(uec.y), u3 = bf_hi(uec.y);
                const float g0 = gelu_tanh(y[0] + dsk[0] * u0), g1 = gelu_tanh(y[1] + dsk[1] * u1), g2 = gelu_tanh(y[2] + dsk[2] * u2), g3 = gelu_tanh(y[3] + dsk[3] * u3);
                u32x2 w; w.x = cvt_pk_bf16(g0, g1); w.y = cvt_pk_bf16(g2, g3);
                *(GAS u32x2*)(ybase + (size_t)tb * BSTEP + lo4) = w;
                LDS_WAIT();
            }
        }
    }
    GAS float* outg = (GAS float*)out;
    if (prompt) { outg[O_REP + (((size_t)l * NB + b) * 32 + g) * 64 + p] = hre; outg[O_IMP + (((size_t)l * NB + b) * 32 + g) * 64 + p] = him; }
    else { outg[O_RES + (((size_t)l * NDB + b) * 32 + g) * 64 + p] = hre; outg[O_IMS + (((size_t)l * NDB + b) * 32 + g) * 64 + p] = him; }
}
__device__ __forceinline__ void conv_run(unsigned char* ws, int l, int run, int lane_in) {
    int lane = lane_in; asm volatile("" : "+v"(lane));
    const GAS float* sm = (const GAS float*)(ws + WS_SMALL);
    const bf16_t* XIN = (const bf16_t*)(ws + WS_XIN); const bf16_t* BG = (const bf16_t*)(ws + WS_BG); bf16_t* YCAT = (bf16_t*)(ws + WS_YCAT);
    const int row0 = run * 64, c0 = lane * 8;
    f32x4 w0a, w0b, w1a, w1b, w2a, w2b;
    { const GAS float* cw = sm + SM_CONVW + (size_t)l * 3 * CH + c0; w0a = *(const GAS f32x4*)cw; w0b = *(const GAS f32x4*)(cw + 4); w1a = *(const GAS f32x4*)(cw + CH); w1b = *(const GAS f32x4*)(cw + CH + 4);
      w2a = *(const GAS f32x4*)(cw + 2 * CH); w2b = *(const GAS f32x4*)(cw + 2 * CH + 4); }
    f32x4 p2a, p2b, p1a, p1b;
    const bool seq_start = row0 < TP ? ((row0 & (SEQ - 1)) == 0) : true;
    if (!seq_start) { unpack8(*(const GAS u32x4*)(XIN + (size_t)(row0 - 2) * CH + c0), p2a, p2b); unpack8(*(const GAS u32x4*)(XIN + (size_t)(row0 - 1) * CH + c0), p1a, p1b); }
    else if (row0 < TP) { p2a = p2b = p1a = p1b = (f32x4){0.f, 0.f, 0.f, 0.f}; }
    else { const int b = (row0 - TP) >> 6; const GAS float* st = sm + SM_SCONV + ((size_t)(l * NDB + b) * 2) * CH + c0;
        p2a = *(const GAS f32x4*)st; p2b = *(const GAS f32x4*)(st + 4); p1a = *(const GAS f32x4*)(st + CH); p1b = *(const GAS f32x4*)(st + CH + 4); }
    for (int tb = 0; tb < 64; tb += 8) {
        u32x4 xr[8], br[8];
#pragma unroll
        for (int j = 0; j < 8; ++j) { const size_t o = (size_t)(row0 + tb + j) * CH + c0; xr[j] = *(const GAS u32x4*)(XIN + o); br[j] = *(const GAS u32x4*)(BG + o); }
#pragma unroll
        for (int j = 0; j < 8; ++j) {
            f32x4 xa, xb, ba, bb; unpack8(xr[j], xa, xb); unpack8(br[j], ba, bb);
            f32x4 ya = ba * (w0a * p2a + w1a * p1a + w2a * xa), yb = bb * (w0b * p2b + w1b * p1b + w2b * xb);
            float s = 0.f;
#pragma unroll
            for (int e = 0; e < 4; ++e) s += ya[e] * ya[e] + yb[e] * yb[e];
            s = wave_sum(s);
            const float inv = rsqrtf(s * (1.0f / CH) + EPS);
            store8_bf16(YCAT + (size_t)(row0 + tb + j) * D + 512 + c0, ya * inv, yb * inv);
            p2a = p1a; p2b = p1b; p1a = xa; p1b = xb;
        }
    }
}

constexpr int KST = 528, VST = 520;
__device__ __forceinline__ void attn_phase(unsigned char* ws, int l, LAS unsigned char* lds, int G, int bid) {
    int tid = threadIdx.x; asm volatile("" : "+v"(tid));
    const int wave = __builtin_amdgcn_readfirstlane(tid >> 6);
    const bf16_t* Q = (const bf16_t*)(ws + WS_Q); bf16_t* O = (bf16_t*)(ws + WS_O);
    const int NU = NB * 4 * 8 + NDB * 4;
    for (int u = bid; u < NU; u += G) {
        int qrow0, nq, ldv; const bf16_t* Kp; const bf16_t* Vp; int h;
        if (u < NB * 32) { const int b = u >> 5; h = (u >> 3) & 3; const int qt = u & 7; qrow0 = b * SEQ + qt * 256; nq = 256;
            Kp = (const bf16_t*)(ws + WS_KB) + (size_t)l * TM * D + (size_t)(b * NMEM) * D + h * 256; Vp = (const bf16_t*)(ws + WS_VT) + (size_t)l * D * TM + (size_t)(h * 256) * TM + b * NMEM; ldv = TM; }
        else { const int i = u - NB * 32, b = i >> 2; h = i & 3; qrow0 = TP + b * DSEQ; nq = DSEQ;
            Kp = (const bf16_t*)(ws + WS_KC) + (size_t)l * TMS * D + (size_t)(b * NMEM) * D + h * 256; Vp = (const bf16_t*)(ws + WS_VTC) + (size_t)l * D * TMS + (size_t)(h * 256) * TMS + b * NMEM; ldv = TMS; }
        const bool active = wave * 32 < nq;
        __syncthreads();
        int t2 = tid; asm volatile("" : "+v"(t2));
        {
            const int c = t2 & 31, rr = t2 >> 5; const unsigned off = (unsigned)((rr * D + c * 8) * 2); const char* kb = (const char*)Kp;
            LAS unsigned char* ld0 = lds + rr * KST + c * 16;
#pragma unroll
            for (int hb = 0; hb < 4; ++hb) {
                u32x4 v[4];
#pragma unroll
                for (int i = 0; i < 4; ++i) v[i] = *(const GAS u32x4*)(kb + (size_t)(16 * (hb * 4 + i)) * D * 2 + off);
#pragma unroll
                for (int i = 0; i < 4; ++i) *(LAS u32x4*)(ld0 + 16 * (hb * 4 + i) * KST) = v[i];
            }
        }
        bf16x8 qf[16];
        const int r32 = t2 & 31, hh = (t2 >> 5) & 1;
        const int qrow = qrow0 + wave * 32 + r32;
        if (active) {
#pragma unroll
            for (int ks = 0; ks < 16; ++ks) qf[ks] = *(const GAS bf16x8*)(Q + (size_t)qrow * D + h * 256 + 16 * ks + 8 * hh);
        } else {
#pragma unroll
            for (int ks = 0; ks < 16; ++ks) qf[ks] = (bf16x8){0, 0, 0, 0, 0, 0, 0, 0};
        }
        __syncthreads();
        constexpr int NQ = 4, MTQ = 8 / NQ;
        bf16x8 pf[16]; float qmax[NQ], qsum[NQ];
#pragma unroll
        for (int qi = 0; qi < NQ; ++qi) { qmax[qi] = 0.f; qsum[qi] = 1.f; }
        if (active) {
#pragma unroll
            for (int qi = 0; qi < NQ; ++qi) {
                f32x16 sc[MTQ];
#pragma unroll
                for (int mq = 0; mq < MTQ; ++mq)
#pragma unroll
                    for (int e = 0; e < 16; ++e) sc[mq][e] = 0.f;
#pragma unroll
                for (int ks = 0; ks < 16; ++ks)
#pragma unroll
                    for (int mq = 0; mq < MTQ; ++mq) {
                        const bf16x8 kf = *(const LAS bf16x8*)(lds + (32 * (qi * MTQ + mq) + r32) * KST + (16 * ks + 8 * hh) * 2);
                        sc[mq] = __builtin_amdgcn_mfma_f32_32x32x16_bf16(kf, qf[ks], sc[mq], 0, 0, 0);
                    }
                float mx = -3.0e38f;
#pragma unroll
                for (int mq = 0; mq < MTQ; ++mq)
#pragma unroll
                    for (int e = 0; e < 16; ++e) mx = fmaxf(mx, sc[mq][e]);
                mx = fmaxf(mx, __shfl_xor(mx, 32));
                float sum = 0.f;
#pragma unroll
                for (int mq = 0; mq < MTQ; ++mq) {
#pragma unroll
                    for (int e = 0; e < 16; ++e) { const float pe = __builtin_amdgcn_exp2f((sc[mq][e] - mx) * 1.44269504089f); sc[mq][e] = pe; sum += pe; }
#pragma unroll
                    for (int s2 = 0; s2 < 2; ++s2) {
                        u32x4 w; w.x = cvt_pk_bf16(sc[mq][8 * s2 + 0], sc[mq][8 * s2 + 1]); w.y = cvt_pk_bf16(sc[mq][8 * s2 + 2], sc[mq][8 * s2 + 3]);
                        w.z = cvt_pk_bf16(sc[mq][8 * s2 + 4], sc[mq][8 * s2 + 5]); w.w = cvt_pk_bf16(sc[mq][8 * s2 + 6], sc[mq][8 * s2 + 7]);
                        pf[2 * (qi * MTQ + mq) + s2] = __builtin_bit_cast(bf16x8, w);
                    }
                }
                sum += __shfl_xor(sum, 32);
                qmax[qi] = mx; qsum[qi] = sum;
                __builtin_amdgcn_sched_barrier(0);
            }
        } else {
#pragma unroll
            for (int i = 0; i < 16; ++i) pf[i] = (bf16x8){0, 0, 0, 0, 0, 0, 0, 0};
        }
        float fq_[NQ]; float rinv;
        { float M = qmax[0];
#pragma unroll
          for (int qi = 1; qi < NQ; ++qi) M = fmaxf(M, qmax[qi]);
          float tot = 0.f;
#pragma unroll
          for (int qi = 0; qi < NQ; ++qi) { fq_[qi] = __builtin_amdgcn_exp2f((qmax[qi] - M) * 1.44269504089f); tot += fq_[qi] * qsum[qi]; }
          rinv = 1.0f / tot;
#pragma unroll
          for (int qi = 0; qi < NQ; ++qi) fq_[qi] *= rinv; }
        __syncthreads();
        {
            const int c = t2 & 31, rr = t2 >> 5; const unsigned off = (unsigned)((rr * ldv + c * 8) * 2); const char* vb = (const char*)Vp;
            LAS unsigned char* ld0 = lds + rr * VST + c * 16;
#pragma unroll
            for (int hb = 0; hb < 4; ++hb) {
                u32x4 v[4];
#pragma unroll
                for (int i = 0; i < 4; ++i) v[i] = *(const GAS u32x4*)(vb + (size_t)(16 * (hb * 4 + i)) * ldv * 2 + off);
#pragma unroll
                for (int i = 0; i < 4; ++i) { LAS u32x2* d = (LAS u32x2*)(ld0 + 16 * (hb * 4 + i) * VST); d[0] = (u32x2){v[i].x, v[i].y}; d[1] = (u32x2){v[i].z, v[i].w}; }
            }
        }
        __syncthreads();
        if (active) {
#pragma unroll
            for (int dt = 0; dt < 8; ++dt) {
                f32x16 acc[NQ];
#pragma unroll
                for (int qi = 0; qi < NQ; ++qi)
#pragma unroll
                    for (int e = 0; e < 16; ++e) acc[qi][e] = 0.f;
#pragma unroll
                for (int mi = 0; mi < 16 / NQ; ++mi)
#pragma unroll
                    for (int qi = 0; qi < NQ; ++qi) {
                        const int ms = qi * (16 / NQ) + mi;
                        const LAS unsigned char* vp = lds + (32 * dt + r32) * VST + (16 * ms + 4 * hh) * 2;
                        const u32x2 lo = *(const LAS u32x2*)vp, hi = *(const LAS u32x2*)(vp + 16);
                        const u32x4 w = (u32x4){lo.x, lo.y, hi.x, hi.y};
                        acc[qi] = __builtin_amdgcn_mfma_f32_32x32x16_bf16(__builtin_bit_cast(bf16x8, w), pf[ms], acc[qi], 0, 0, 0);
                    }
#pragma unroll
                for (int g4 = 0; g4 < 4; ++g4) {
                    float o4[4];
#pragma unroll
                    for (int e = 0; e < 4; ++e) { float v = 0.f;
#pragma unroll
                        for (int qi = 0; qi < NQ; ++qi) v = fmaf(acc[qi][4 * g4 + e], fq_[qi], v);
                        o4[e] = v; }
                    u32x2 w; w.x = cvt_pk_bf16(o4[0], o4[1]); w.y = cvt_pk_bf16(o4[2], o4[3]);
                    *(GAS u32x2*)(O + (size_t)qrow * D + h * 256 + 32 * dt + 8 * g4 + 4 * hh) = w;
                }
                __builtin_amdgcn_sched_barrier(0);
            }
        }
    }
    __syncthreads();
}

constexpr bool USE_SP2 = true;
__global__ void __launch_bounds__(512, 2) hybrid_fwd(Args a) {
    extern __shared__ __attribute__((aligned(16))) unsigned char lds_raw[];
    LAS unsigned char* lds = (LAS unsigned char*)lds_raw;
    cg::grid_group grid = cg::this_grid();
    const int tid = threadIdx.x, lane = tid & 63, wave = __builtin_amdgcn_readfirstlane(tid >> 6);
    const int G = gridDim.x, bid = blockIdx.x;
    unsigned char* ws = as_global(a.ws);
    const int NGW = G * 8;

#ifndef NO_PREP
    for (int rep = 0; rep < REP_PREP; ++rep) { prep_phase(ws, lds, bid * 8 + wave, NGW, wave, lane); __syncthreads(); }
#endif
    grid.sync();

#define FRESH() unsigned char* wsp = ws; int ll = l, bb = bid, gg = G; asm volatile("" : "+s"(wsp), "+s"(ll), "+s"(bb), "+s"(gg)); wsp = as_global(wsp); float* outp = as_global(a.out); (void)outp; unsigned char* wl = wsp + WS_W + (size_t)ll * W_LAYER; (void)wl
#define SSA(k) ss_arr(wsp, 1 + 4 * ll + (k))
#pragma unroll 1
    for (int l = 0; l < DEPTH; ++l) {
        {
            FRESH();
            pg8::Gemm g{(const bf16_t*)(wsp + WS_XB), (const bf16_t*)(wl + W_IN), T, 2048, D}; pg8::StaticOrder S; S.init(T, 2048, gg, bb);
            EpiInProj E{(bf16_t*)(wsp + WS_BG), (bf16_t*)(wsp + WS_XIN), (bf16_t*)(wsp + WS_U), ll == 0 ? ss_arr(wsp, 0) : ss_arr(wsp, 4), outp + O_CONVP + (size_t)ll * NB * 2 * CH, outp + O_CONVS + (size_t)ll * NDB * 2 * CH};
#ifndef NO_GEMM
            pg8::gemm_phase<EpiInProj, USE_SP2>(lds, g, S, E);
#endif
#ifndef NO_SMALL
            small_gemm(g.A, g.Bt, 2048, D, E, bb >= (gg >> 1) ? bb - (gg >> 1) : -1, gg >> 1);
#endif
        }
        {
            FRESH();
            pg8::Gemm g{(const bf16_t*)(wsp + WS_MNB), (const bf16_t*)(wl + W_KV), TM, 2048, D}; pg8::StaticOrder S; S.init(TM, 2048, gg, bb);
            EpiKV E{outp + O_MKP + (size_t)ll * TM * D, outp + O_MVP + (size_t)ll * TM * D, (bf16_t*)(wsp + WS_KB) + (size_t)ll * TM * D, invmem_arr(wsp)};
#ifndef NO_GEMM
            pg8::gemm_phase<EpiKV, USE_SP2>(lds, g, S, E);
#endif
        }
        {
            FRESH();
            pg8::Gemm g{(const bf16_t*)(wl + W_KV) + (size_t)D * D, (const bf16_t*)(wsp + WS_MNB), D, TM, D}; pg8::StaticOrder S; S.init(D, TM, gg, (bb + gg - (32 % gg)) % gg);
            EpiVT E{(bf16_t*)(wsp + WS_VT) + (size_t)ll * D * TM, invmem_arr(wsp)};
#ifndef NO_GEMM
            pg8::gemm_phase<EpiVT, USE_SP2>(lds, g, S, E);
#endif
        }
        grid.sync();
        {
            FRESH();
            int tid2 = threadIdx.x; asm volatile("" : "+v"(tid2)); const int lane2 = tid2 & 63;
            const int w = wave * gg + bb; const int NGW2 = gg * 8;
            for (int rep = 0; rep < REP_SCAN; ++rep) {
#ifndef NO_SCAN
            for (int it = w; it < NB * 32 + NDB * 32; it += NGW2) scan_item(wsp, outp, ll, it, lds + wave * SCAN_LDS_WAVE, lane2);
#endif
#ifndef NO_CONV
            for (int run = NGW2 - 1 - w; run < T / 64; run += NGW2) conv_run(wsp, ll, run, lane2);
#endif
            }
        }
        grid.sync();
        {
            FRESH();
            pg8::Gemm g{(const bf16_t*)(wsp + WS_YG), (const bf16_t*)(wl + W_GLU), T, CH, CH}; pg8::StaticOrder S; S.init(T, CH, gg, bb);
            EpiGLU E{(const bf16_t*)(wsp + WS_YG), (bf16_t*)(wsp + WS_YCAT), SSA(0)};
#ifndef NO_GEMM
            pg8::gemm_phase<EpiGLU, USE_SP2>(lds, g, S, E);
#endif
#ifndef NO_SMALL
            small_gemm(g.A, g.Bt, CH, CH, E, bb, gg);
#endif
        }
        grid.sync();
        {
            FRESH();
            pg8::Gemm g{(const bf16_t*)(wsp + WS_YCAT), (const bf16_t*)(wl + W_OUT), T, D, D}; pg8::StaticOrder S; S.init(T, D, gg, bb);
            EpiRes<true> E{(bf16_t*)(wsp + WS_XB), SSA(1), SSA(0)};
#ifndef NO_GEMM
            pg8::gemm_phase<EpiRes<true>, USE_SP2>(lds, g, S, E);
#endif
#ifndef NO_SMALL
            small_gemm(g.A, g.Bt, D, D, E, bb, gg);
#endif
        }
        grid.sync();
        {
            FRESH();
            pg8::Gemm g{(const bf16_t*)(wsp + WS_XB), (const bf16_t*)(wl + W_Q), T, D, D}; pg8::StaticOrder S; S.init(T, D, gg, bb);
            EpiScale<0> E{(bf16_t*)(wsp + WS_Q), D, SSA(1)};
#ifndef NO_GEMM
            pg8::gemm_phase<EpiScale<0>, USE_SP2>(lds, g, S, E);
#endif
#ifndef NO_SMALL
            small_gemm(g.A, g.Bt, D, D, E, bb, gg);
#endif
        }
        grid.sync();
        {
            FRESH();
#ifndef NO_ATTN
            for (int rep = 0; rep < REP_ATTN; ++rep) attn_phase(wsp, ll, lds, gg, bb);
#endif
        }
        grid.sync();
        {
            FRESH();
            pg8::Gemm g{(const bf16_t*)(wsp + WS_O), (const bf16_t*)(wl + W_O), T, D, D}; pg8::StaticOrder S; S.init(T, D, gg, bb);
            EpiRes<false> E{(bf16_t*)(wsp + WS_XB), SSA(2), nullptr};
#ifndef NO_GEMM
            pg8::gemm_phase<EpiRes<false>, USE_SP2>(lds, g, S, E);
#endif
#ifndef NO_SMALL
            small_gemm(g.A, g.Bt, D, D, E, bb, gg);
#endif
        }
        grid.sync();
        {
            FRESH();
            pg8::Gemm g{(const bf16_t*)(wsp + WS_XB), (const bf16_t*)(wl + W_UP), T, DFF, D}; pg8::StaticOrder S; S.init(T, DFF, gg, bb);
            EpiScale<1> E{(bf16_t*)(wsp + WS_HDN), DFF, SSA(2)};
#ifndef NO_GEMM
            for (int rep = 0; rep < REP_UP; ++rep) pg8::gemm_phase<EpiScale<1>, USE_SP2>(lds, g, S, E);
#endif
#ifndef NO_SMALL
            small_gemm(g.A, g.Bt, DFF, D, E, bb, gg);
#endif
        }
        grid.sync();
        {
            FRESH();
            pg8::Gemm g{(const bf16_t*)(wsp + WS_HDN), (const bf16_t*)(wl + W_DOWN), T, D, DFF}; pg8::StaticOrder S; S.init(T, D, gg, bb);
            EpiRes<false> E{(bf16_t*)(wsp + WS_XB), SSA(3), nullptr};
#ifndef NO_GEMM
            pg8::gemm_phase<EpiRes<false>, USE_SP2>(lds, g, S, E);
#endif
#ifndef NO_SMALL
            small_gemm(g.A, g.Bt, D, DFF, E, bb, gg);
#endif
        }
        grid.sync();
    }
    {
        int tid3 = threadIdx.x; asm volatile("" : "+v"(tid3)); const int lane = tid3 & 63;
        const bf16_t* XB = (const bf16_t*)(ws + WS_XB); const float* ssf = ss_arr(ws, 1 + 4 + 3); const GAS float* gf = (const GAS float*)(ws + WS_SMALL) + SM_GFIN;
        f32x4 gv[4];
#pragma unroll
        for (int j = 0; j < 4; ++j) gv[j] = *(const GAS f32x4*)(gf + 256 * j + 4 * lane);
        for (int m = bid * 8 + wave; m < T; m += NGW) {
            const float inv = rsqrtf(((const GAS float*)ssf)[m] * (1.0f / D) + EPS);
            const GAS u32x2* xr = (const GAS u32x2*)(XB + (size_t)m * D) + lane; GAS f32x4* o = (GAS f32x4*)(a.out + (size_t)m * D) + lane;
#pragma unroll
            for (int j = 0; j < 4; ++j) { const u32x2 w = xr[64 * j]; o[64 * j] = (f32x4){bf_lo(w.x), bf_hi(w.x), bf_lo(w.y), bf_hi(w.y)} * inv * gv[j]; }
        }
    }
}

extern "C" void kernel_launch(void* const* d_in, const int* in_sizes, int n_in, void* d_out, int out_size, void* d_ws, size_t ws_size, hipStream_t stream) {
    static int grid = 0;
    if (grid == 0) {
        if (n_in != 33 || (size_t)out_size != O_END || ws_size < WS_END) { fprintf(stderr, "kernel_launch: unexpected sizes n_in %d out %d ws %zu (need %zu)\n", n_in, out_size, ws_size, (size_t)WS_END); grid = -1; return; }
        int dev = 0, cus = 0, per_cu = 0;
        (void)hipGetDevice(&dev); (void)hipDeviceGetAttribute(&cus, hipDeviceAttributeMultiprocessorCount, dev);
        if (hipFuncSetAttribute((const void*)hybrid_fwd, hipFuncAttributeMaxDynamicSharedMemorySize, LDS_BYTES) != hipSuccess) { fprintf(stderr, "kernel_launch: hipFuncSetAttribute failed\n"); grid = -1; return; }
        if (hipOccupancyMaxActiveBlocksPerMultiprocessor(&per_cu, (const void*)hybrid_fwd, 512, LDS_BYTES) != hipSuccess || per_cu < 1) { fprintf(stderr, "kernel_launch: occupancy query says %d\n", per_cu); per_cu = 1; }
        (void)hipGetLastError();
        grid = cus > 0 ? cus : 256;
    }
    if (grid < 0) return;
    Args a{};
    for (int i = 0; i < 33; ++i) a.in[i] = (const float*)d_in[i];
    a.out = (float*)d_out; a.ws = (unsigned char*)d_ws;
    void* args[] = {&a};
    hipError_t e = hipLaunchCooperativeKernel((const void*)hybrid_fwd, dim3(grid), dim3(512), args, LDS_BYTES, stream);
    if (e != hipSuccess) fprintf(stderr, "kernel_launch: cooperative launch failed: %s (grid %d)\n", hipGetErrorString(e), grid);
}
```

```cpp
#include <hip/hip_runtime.h>
#include <hip/hip_cooperative_groups.h>
#include <cstdio>
#include <cstdint>
namespace cg = cooperative_groups;
#define NO_SMALL 1
#ifndef REP_PREP
#define REP_PREP 1
#endif
#ifndef REP_SCAN
#define REP_SCAN 1
#endif
#ifndef REP_ATTN
#define REP_ATTN 1
#endif
#ifndef REP_UP
#define REP_UP 1
#endif

#define LAS __attribute__((address_space(3)))
#define GAS __attribute__((address_space(1)))
typedef unsigned short bf16_t;
typedef short bf16x8 __attribute__((ext_vector_type(8)));
typedef short bf16x4 __attribute__((ext_vector_type(4)));
typedef float f32x2 __attribute__((ext_vector_type(2)));
typedef float f32x4 __attribute__((ext_vector_type(4)));
typedef float f32x16 __attribute__((ext_vector_type(16)));
typedef unsigned u32x4 __attribute__((ext_vector_type(4)));
typedef unsigned u32x2 __attribute__((ext_vector_type(2)));

constexpr int D = 1024, NB = 32, SEQ = 2048, NDB = 16, DSEQ = 64, DEPTH = 2;
constexpr int TP = NB * SEQ, TS = NDB * DSEQ, T = TP + TS;
constexpr int NMEM = 256, TM = NB * NMEM, TMS = NDB * NMEM;
constexpr int DFF = 4096, CH = 512;
constexpr float EPS = 1e-6f;
constexpr size_t O_YP = 0, O_YS = O_YP + (size_t)TP * D, O_CONVP = O_YS + (size_t)TS * D, O_REP = O_CONVP + (size_t)DEPTH * NB * 2 * CH,
                 O_IMP = O_REP + (size_t)DEPTH * NB * 32 * 64, O_MKP = O_IMP + (size_t)DEPTH * NB * 32 * 64, O_MVP = O_MKP + (size_t)DEPTH * TM * D,
                 O_CONVS = O_MVP + (size_t)DEPTH * TM * D, O_RES = O_CONVS + (size_t)DEPTH * NDB * 2 * CH, O_IMS = O_RES + (size_t)DEPTH * NDB * 32 * 64,
                 O_END = O_IMS + (size_t)DEPTH * NDB * 32 * 64;
constexpr size_t MiB = 1u << 20;
constexpr size_t WS_SS = 0;
constexpr size_t WS_W = 4 * MiB, W_LAYER = 31 * MiB;
constexpr size_t W_IN = 0, W_GLU = 4 * MiB, W_OUT = 4 * MiB + MiB / 2, W_Q = 6 * MiB + MiB / 2, W_KV = 8 * MiB + MiB / 2, W_O = 12 * MiB + MiB / 2,
                 W_UP = 14 * MiB + MiB / 2, W_DOWN = 22 * MiB + MiB / 2;
constexpr size_t WS_XB = 66 * MiB;
constexpr size_t WS_MNB = 196 * MiB;
constexpr size_t WS_KB = 212 * MiB;
constexpr size_t WS_VT = 244 * MiB;
constexpr size_t WS_KC = 276 * MiB;
constexpr size_t WS_VTC = 292 * MiB;
constexpr size_t WS_BIG = 308 * MiB;
constexpr size_t SZ_T512 = (size_t)T * 512 * 2;
constexpr size_t WS_BG = WS_BIG, WS_XIN = WS_BG + SZ_T512, WS_U = WS_XIN + SZ_T512, WS_YG = WS_U + SZ_T512, WS_YCAT = WS_YG + SZ_T512;
constexpr size_t WS_Q = WS_BG, WS_O = WS_U, WS_HDN = WS_BIG;
constexpr size_t WS_SMALL = WS_BIG + (size_t)T * DFF * 2;
constexpr size_t WS_END = WS_SMALL + 4 * MiB;
constexpr int SM_ARE = 0, SM_AIM = 4096, SM_LOGDT = 8192, SM_BRE = 8256, SM_BIM = SM_BRE + 65536, SM_CRE = SM_BIM + 65536, SM_CIM = SM_CRE + 65536, SM_SD = SM_CIM + 65536,
              SM_CONVW = SM_SD + 1024, SM_SCONV = SM_CONVW + 3072, SM_SRE = SM_SCONV + 32768, SM_SIM = SM_SRE + 65536, SM_GFIN = SM_SIM + 65536, SM_END = SM_GFIN + 1024;
static_assert(WS_YCAT + 2 * SZ_T512 <= WS_END, "ws map");

constexpr int LDS_BYTES = 256 * 528 + 1024;

template <class Tp> __device__ __forceinline__ Tp* as_global(Tp* p) {
#if defined(__HIP_DEVICE_COMPILE__)
    __builtin_assume(!__builtin_amdgcn_is_shared((const __attribute__((address_space(0))) void*)p) && !__builtin_amdgcn_is_private((const __attribute__((address_space(0))) void*)p));
#endif
    return p;
}
__device__ __forceinline__ unsigned cvt_pk_bf16(float lo, float hi) { unsigned r; asm volatile("v_cvt_pk_bf16_f32 %0, %1, %2" : "=v"(r) : "v"(lo), "v"(hi)); return r; }
__device__ __forceinline__ float bf_lo(unsigned w) { return __uint_as_float(w << 16); }
__device__ __forceinline__ float bf_hi(unsigned w) { return __uint_as_float(w & 0xffff0000u); }
__device__ __forceinline__ float wave_sum(float v) {
#pragma unroll
    for (int o = 1; o < 64; o <<= 1) v += __shfl_xor(v, o);
    return v;
}
#define LDS_WAIT() asm volatile("s_waitcnt lgkmcnt(0)" ::: "memory")

namespace pg8 {
constexpr int BM = 256, BK = 64, HALF = 128, HTB = HALF * BK * 2, STAGE_BYTES = 8 * HTB, NXCD = 8, WGM = 8;
__host__ __device__ __forceinline__ int lds_byte(int r, int c) { const int st = (r >> 4) * 2 + (c >> 5), rr = r & 15, cc = c & 31, ob = rr * 64 + cc * 2; return st * 1024 + (ob ^ (((ob >> 9) & 1) << 5)); }
__host__ __device__ __forceinline__ void stage_rc(int b, int& R, int& C) { const int st = b / 1024, sb = b % 1024, swz = sb ^ (((sb >> 9) & 1) << 5); R = (st >> 1) * 16 + swz / 64; C = (st & 1) * 32 + (swz % 64) / 2; }
__host__ __device__ __forceinline__ int perm32(int rho) { const int n = rho >> 4, i = rho & 15; return 8 * (i >> 2) + 4 * n + (i & 3); }

struct Unit { int pm, pn; };
struct Gemm { const bf16_t* A; const bf16_t* Bt; int M, N, K; };

struct StaticOrder {
    int nM, nN, nwg, G, c;
    __device__ void init(int M, int N, int G_, int c_) { nM = M / BM; nN = N / BM; nwg = nM * nN; G = G_; c = c_; }
    __device__ bool next(int i, Unit& u) const {
        const long L = (long)i * G + c; if (L >= nwg) return false;
        int wgid = (int)L; { const int q = nwg / NXCD, r = nwg % NXCD, xcd = wgid % NXCD, off = wgid / NXCD; wgid = (xcd < r ? xcd * (q + 1) : r * (q + 1) + (xcd - r) * q) + off; }
        const int nig = WGM * nN, gid = wgid / nig, fm = gid * WGM, gsz = (nM - fm) < WGM ? (nM - fm) : WGM;
        u.pm = fm + ((wgid % nig) % gsz); u.pn = (wgid % nig) / gsz; return true;
    }
};

template <class Epi, bool SP2>
__device__ __forceinline__ void gemm_phase(LAS unsigned char* lds, const Gemm g, const StaticOrder& S, const Epi& E) {
    int tid = threadIdx.x; asm volatile("" : "+v"(tid));
    const int wid = __builtin_amdgcn_readfirstlane(tid >> 6), lane = tid & 63, wr = wid >> 2, wc = wid & 3, fr = lane & 15, fq = lane >> 4;
    const int K = g.K, nt = K / BK;
    unsigned voffA[2], voffB[2];
#pragma unroll
    for (int i = 0; i < 2; ++i) { int R, C; stage_rc(tid * 16 + i * 8192, R, C); const int Rb = Epi::PERM ? ((R & ~31) + perm32(R & 31)) : R;
        voffA[i] = (unsigned)(R * K + C) * 2u; voffB[i] = (unsigned)(Rb * K + C) * 2u; }
    const size_t kstep = (size_t)(BK * 2);
    const size_t hstep = (size_t)HALF * K * 2;
    const size_t tstep = 2 * hstep;
    const unsigned ldsw = (unsigned)wid * 1024u;
    const int aoff = lds_byte(wr * 64 + fr, fq * 8), boff = lds_byte(wc * 32 + fr, fq * 8);
#define PG8_SA(b, h) (((b) * 2 + (h)) * HTB)
#define PG8_SB(b, h) ((4 + (b) * 2 + (h)) * HTB)
#define PG8_STAGE(bufoff, gbase, voff) do { _Pragma("unroll") for (int _i = 0; _i < 2; ++_i) \
        __builtin_amdgcn_global_load_lds((const unsigned*)((const char*)(gbase) + (voff)[_i]), (LAS unsigned*)(lds + (bufoff) + ldsw + _i * 8192), 16, 0, 0); } while (0)
#define PG8_LDA(dst, b, h) do { _Pragma("unroll") for (int m = 0; m < 4; ++m) _Pragma("unroll") for (int k = 0; k < 2; ++k) dst[m][k] = *(const LAS bf16x8*)(lds + PG8_SA(b, h) + aoff + m * 2048 + k * 1024); } while (0)
#define PG8_LDB(dst, b, h) do { _Pragma("unroll") for (int n = 0; n < 2; ++n) _Pragma("unroll") for (int k = 0; k < 2; ++k) dst[n][k] = *(const LAS bf16x8*)(lds + PG8_SB(b, h) + boff + n * 2048 + k * 1024); } while (0)
#define PG8_MMA(ai, bj, At, Bt) do { __builtin_amdgcn_s_setprio(1); _Pragma("unroll") for (int m = 0; m < 4; ++m) _Pragma("unroll") for (int n = 0; n < 2; ++n) _Pragma("unroll") for (int k = 0; k < 2; ++k) \
        acc[ai][bj][m][n] = __builtin_amdgcn_mfma_f32_16x16x32_bf16(Bt[n][k], At[m][k], acc[ai][bj][m][n], 0, 0, 0); __builtin_amdgcn_s_setprio(0); } while (0)
#define PG8_WAIT_V(n) asm volatile("s_waitcnt vmcnt(" #n ")" ::: "memory")
#define PG8_WAIT_L(n) asm volatile("s_waitcnt lgkmcnt(" #n ")" ::: "memory")
#define PG8_BAR __builtin_amdgcn_s_barrier()
#define PG8_SCHED __builtin_amdgcn_sched_barrier(0)
    Unit cur, nxt; int ui = 0;
    if (!S.next(0, cur)) return;
    f32x4 acc[2][2][4][2];
#pragma unroll
    for (int a = 0; a < 2; ++a)
#pragma unroll
        for (int b = 0; b < 2; ++b)
#pragma unroll
            for (int m = 0; m < 4; ++m)
#pragma unroll
                for (int n = 0; n < 2; ++n) acc[a][b][m][n] = (f32x4){0.f, 0.f, 0.f, 0.f};
    bf16x8 At[4][2], B0[2][2], B1[2][2];
    const char* cA = (const char*)g.A + (size_t)cur.pm * tstep; const char* cB = (const char*)g.Bt + (size_t)cur.pn * tstep;
    if constexpr (SP2) {
        PG8_STAGE(PG8_SB(0, 0), cB, voffB); PG8_STAGE(PG8_SB(0, 1), cB + hstep, voffB); PG8_STAGE(PG8_SA(0, 0), cA, voffA); PG8_STAGE(PG8_SA(0, 1), cA + hstep, voffA);
        if (wr == 1) PG8_BAR;
        PG8_WAIT_V(2); PG8_BAR;
        PG8_STAGE(PG8_SB(1, 0), cB + kstep, voffB); PG8_STAGE(PG8_SA(1, 0), cA + kstep, voffA); PG8_STAGE(PG8_SB(1, 1), cB + hstep + kstep, voffB);
        PG8_WAIT_V(6); PG8_BAR;
    } else {
        PG8_STAGE(PG8_SB(0, 0), cB, voffB); PG8_STAGE(PG8_SA(0, 0), cA, voffA); PG8_STAGE(PG8_SB(0, 1), cB + hstep, voffB); PG8_STAGE(PG8_SA(0, 1), cA + hstep, voffA);
        if (wr == 1) PG8_BAR;
        PG8_WAIT_V(4); PG8_BAR;
        PG8_STAGE(PG8_SB(1, 0), cB + kstep, voffB); PG8_STAGE(PG8_SA(1, 0), cA + kstep, voffA); PG8_STAGE(PG8_SB(1, 1), cB + hstep + kstep, voffB);
        PG8_WAIT_V(6); PG8_BAR;
    }
    for (;;) {
        const bool has_next = S.next(ui + 1, nxt);
        const char* nA = has_next ? (const char*)g.A + (size_t)nxt.pm * tstep : cA; const char* nB = has_next ? (const char*)g.Bt + (size_t)nxt.pn * tstep : cB;
        for (int t = 0; t < nt; t += 2) {
            const bool last = (t == nt - 2);
            const char* a1 = cA + (size_t)(t + 1) * kstep;
            const char* a2 = last ? nA : cA + (size_t)(t + 2) * kstep; const char* b2 = last ? nB : cB + (size_t)(t + 2) * kstep;
            const char* a3 = a2 + kstep; const char* b3 = b2 + kstep;
            if constexpr (Epi::MID) { if (t == (nt >> 1)) E.mid(acc, cur, wr, fr); }
            if constexpr (SP2) {
            PG8_LDB(B0, 0, 0); PG8_LDB(B1, 0, 1); PG8_SCHED; PG8_LDA(At, 0, 0); PG8_STAGE(PG8_SA(1, 1), a1 + hstep, voffA);
            PG8_WAIT_V(8); PG8_WAIT_L(0); PG8_BAR; PG8_MMA(0, 0, At, B0); PG8_MMA(0, 1, At, B1); PG8_BAR; PG8_SCHED;
            PG8_LDA(At, 0, 1); PG8_STAGE(PG8_SB(0, 0), b2, voffB); PG8_STAGE(PG8_SB(0, 1), b2 + hstep, voffB); PG8_STAGE(PG8_SA(0, 0), a2, voffA);
            PG8_WAIT_V(8); PG8_WAIT_L(0); PG8_BAR; PG8_MMA(1, 0, At, B0); PG8_MMA(1, 1, At, B1); PG8_BAR; PG8_SCHED;
            PG8_LDB(B0, 1, 0); PG8_LDB(B1, 1, 1); PG8_SCHED; PG8_LDA(At, 1, 0); PG8_STAGE(PG8_SA(0, 1), a2 + hstep, voffA);
            PG8_WAIT_V(8); PG8_WAIT_L(0); PG8_BAR; PG8_MMA(0, 0, At, B0); PG8_MMA(0, 1, At, B1); PG8_BAR; PG8_SCHED;
            PG8_LDA(At, 1, 1); PG8_STAGE(PG8_SB(1, 0), b3, voffB); PG8_STAGE(PG8_SB(1, 1), b3 + hstep, voffB); PG8_STAGE(PG8_SA(1, 0), a3, voffA);
            PG8_WAIT_V(8); PG8_WAIT_L(0); PG8_BAR; PG8_MMA(1, 0, At, B0); PG8_MMA(1, 1, At, B1); PG8_BAR; PG8_SCHED;
            } else {
            PG8_LDB(B0, 0, 0); PG8_SCHED; PG8_LDA(At, 0, 0); PG8_STAGE(PG8_SA(1, 1), a1 + hstep, voffA);
            PG8_WAIT_L(8); PG8_BAR; PG8_WAIT_L(0); PG8_MMA(0, 0, At, B0); PG8_BAR; PG8_SCHED;
            PG8_LDB(B1, 0, 1); PG8_STAGE(PG8_SB(0, 0), b2, voffB);
            PG8_BAR; PG8_WAIT_L(0); PG8_MMA(0, 1, At, B1); PG8_BAR;
            PG8_LDA(At, 0, 1); PG8_STAGE(PG8_SA(0, 0), a2, voffA);
            PG8_BAR; PG8_WAIT_L(0); PG8_MMA(1, 0, At, B0); PG8_BAR; PG8_SCHED;
            PG8_STAGE(PG8_SB(0, 1), b2 + hstep, voffB);
            PG8_WAIT_V(6); PG8_BAR; PG8_MMA(1, 1, At, B1); PG8_BAR;
            PG8_LDB(B0, 1, 0); PG8_SCHED; PG8_LDA(At, 1, 0); PG8_STAGE(PG8_SA(0, 1), a2 + hstep, voffA);
            PG8_WAIT_L(8); PG8_BAR; PG8_WAIT_L(0); PG8_MMA(0, 0, At, B0); PG8_BAR; PG8_SCHED;
            PG8_LDB(B1, 1, 1); PG8_STAGE(PG8_SB(1, 0), b3, voffB);
            PG8_BAR; PG8_WAIT_L(0); PG8_MMA(0, 1, At, B1); PG8_BAR;
            PG8_LDA(At, 1, 1); PG8_STAGE(PG8_SA(1, 0), a3, voffA);
            PG8_BAR; PG8_WAIT_L(0); PG8_MMA(1, 0, At, B0); PG8_BAR; PG8_SCHED;
            PG8_STAGE(PG8_SB(1, 1), b3 + hstep, voffB);
            PG8_WAIT_V(6); PG8_BAR; PG8_MMA(1, 1, At, B1); PG8_BAR;
            }
        }
        if (wr == 0) PG8_BAR;
        E(acc, cur, wr, wc, fr, fq);
        if (!has_next) break;
#pragma unroll
        for (int a = 0; a < 2; ++a)
#pragma unroll
            for (int b = 0; b < 2; ++b)
#pragma unroll
                for (int m = 0; m < 4; ++m)
#pragma unroll
                    for (int n = 0; n < 2; ++n) acc[a][b][m][n] = (f32x4){0.f, 0.f, 0.f, 0.f};
        cur = nxt; cA = nA; cB = nB; ++ui;
        if (wr == 1) PG8_BAR;
    }
    PG8_WAIT_V(0);
    PG8_BAR;
#undef PG8_SA
#undef PG8_SB
#undef PG8_STAGE
#undef PG8_LDA
#undef PG8_LDB
#undef PG8_MMA
#undef PG8_WAIT_V
#undef PG8_WAIT_L
#undef PG8_BAR
#undef PG8_SCHED
}
}
using pg8::Unit;
typedef f32x4 Acc[2][2][4][2];

__device__ __forceinline__ void store8_bf16(bf16_t* p, const f32x4& a, const f32x4& b) {
    u32x4 w; w.x = cvt_pk_bf16(a[0], a[1]); w.y = cvt_pk_bf16(a[2], a[3]); w.z = cvt_pk_bf16(b[0], b[1]); w.w = cvt_pk_bf16(b[2], b[3]);
    *(GAS u32x4*)p = w;
}
__device__ __forceinline__ void unpack8(const u32x4 w, f32x4& a, f32x4& b) {
    a = (f32x4){bf_lo(w.x), bf_hi(w.x), bf_lo(w.y), bf_hi(w.y)}; b = (f32x4){bf_lo(w.z), bf_hi(w.z), bf_lo(w.w), bf_hi(w.w)};
}

struct EpiInProj {
    static constexpr bool PERM = true, MID = false;
    bf16_t* BG; bf16_t* XIN; bf16_t* U; const float* ss; float* convp; float* convs;
    __device__ __forceinline__ int brow(int cb, int f) const {
        const int cg = cb >> 5;
        if (cg < 16) return cb + 16 * f;
        if (cg >= 48) return 1536 + 32 * (cg - 48) + 16 * f;
        const int c = 16 * (cg - 16), q = c >> 7, r = c & 127;
        return 512 + 256 * q + 128 * f + r;
    }
    __device__ __forceinline__ void small(const f32x4 (&acc)[2][2], int r0, int cb, int fr, int fq) const {
        const int cg = cb >> 5;
#pragma unroll
        for (int m = 0; m < 2; ++m) {
            const int r = r0 + 16 * m + fr; const float inv = rsqrtf(((const GAS float*)ss)[r] * (1.0f / D) + EPS);
            if (cg < 16 || cg >= 48) {
                bf16_t* dst = (cg < 16 ? BG + (size_t)r * CH + cb : U + (size_t)r * CH + (cb - 1536)) + 4 * fq;
#pragma unroll
                for (int f = 0; f < 2; ++f) { const f32x4 v = acc[m][f] * inv; u32x2 w; w.x = cvt_pk_bf16(v[0], v[1]); w.y = cvt_pk_bf16(v[2], v[3]); *(GAS u32x2*)(dst + 16 * f) = w; }
            } else {
                const int c0 = 16 * (cg - 16) + 4 * fq;
                const f32x4 x = (acc[m][0] * inv) * (acc[m][1] * inv);
                u32x2 w; w.x = cvt_pk_bf16(x[0], x[1]); w.y = cvt_pk_bf16(x[2], x[3]); *(GAS u32x2*)(XIN + (size_t)r * CH + c0) = w;
                const int rs = r - TP, t = rs & (DSEQ - 1);
                if (t >= DSEQ - 2) *(GAS f32x4*)(convs + ((size_t)(rs >> 6) * 2 + (t - (DSEQ - 2))) * CH + c0) = x;
            }
        }
    }
    __device__ __forceinline__ void operator()(const Acc& acc, const Unit& u, int wr, int wc, int fr, int fq) const {
        const int row0 = u.pm * 256 + wr * 64 + fr, cb = wc * 32 + 8 * fq;
#pragma unroll
        for (int ai = 0; ai < 2; ++ai)
#pragma unroll
            for (int m = 0; m < 4; ++m) {
                const int r = row0 + ai * 128 + m * 16;
                const float inv = rsqrtf(((const GAS float*)ss)[r] * (1.0f / D) + EPS);
                if (u.pn < 2 || u.pn >= 6) {
                    bf16_t* dst = (u.pn < 2 ? BG : U) + (size_t)r * CH + (u.pn & 1) * 256 + cb;
#pragma unroll
                    for (int bj = 0; bj < 2; ++bj) store8_bf16(dst + bj * 128, acc[ai][bj][m][0] * inv, acc[ai][bj][m][1] * inv);
                } else {
                    const int c0 = (u.pn - 2) * 128 + cb;
                    const f32x4 x0 = (acc[ai][0][m][0] * inv) * (acc[ai][1][m][0] * inv), x1 = (acc[ai][0][m][1] * inv) * (acc[ai][1][m][1] * inv);
                    store8_bf16(XIN + (size_t)r * CH + c0, x0, x1);
                    float* cd = nullptr;
                    if (r < TP) { const int t = r & (SEQ - 1); if (t >= SEQ - 2) cd = convp + ((size_t)(r >> 11) * 2 + (t - (SEQ - 2))) * CH + c0; }
                    else { const int rs = r - TP, t = rs & (DSEQ - 1); if (t >= DSEQ - 2) cd = convs + ((size_t)(rs >> 6) * 2 + (t - (DSEQ - 2))) * CH + c0; }
                    if (cd) { *(GAS f32x4*)cd = x0; *(GAS f32x4*)(cd + 4) = x1; }
                }
            }
    }
};
struct EpiKV {
    static constexpr bool PERM = false, MID = false;
    float* outK; float* outV; bf16_t* KB; const float* invm;
    __device__ __forceinline__ void operator()(const Acc& acc, const Unit& u, int wr, int wc, int fr, int fq) const {
        const int row0 = u.pm * 256 + wr * 64 + fr, col0 = (u.pn & 3) * 256 + wc * 32 + 4 * fq;
        float* outp = u.pn < 4 ? outK : outV;
#pragma unroll
        for (int ai = 0; ai < 2; ++ai)
#pragma unroll
            for (int m = 0; m < 4; ++m) {
                const int r = row0 + ai * 128 + m * 16; const float inv = ((const GAS float*)invm)[r];
#pragma unroll
                for (int bj = 0; bj < 2; ++bj)
#pragma unroll
                    for (int n = 0; n < 2; ++n) {
                        const f32x4 v = acc[ai][bj][m][n] * inv; const size_t o = (size_t)r * D + col0 + bj * 128 + n * 16;
                        *(GAS f32x4*)(outp + o) = v;
                        if (u.pn < 4) { u32x2 w; w.x = cvt_pk_bf16(v[0], v[1]); w.y = cvt_pk_bf16(v[2], v[3]); *(GAS u32x2*)(KB + o) = w; }
                    }
            }
    }
};
struct EpiVT {
    static constexpr bool PERM = true, MID = false;
    bf16_t* VT; const float* invm;
    __device__ __forceinline__ void operator()(const Acc& acc, const Unit& u, int wr, int wc, int fr, int fq) const {
        const int row0 = u.pm * 256 + wr * 64 + fr, col0 = u.pn * 256 + wc * 32 + 8 * fq;
        f32x4 s[2][2];
#pragma unroll
        for (int bj = 0; bj < 2; ++bj) { s[bj][0] = *(const GAS f32x4*)(invm + col0 + bj * 128); s[bj][1] = *(const GAS f32x4*)(invm + col0 + bj * 128 + 4); }
#pragma unroll
        for (int ai = 0; ai < 2; ++ai)
#pragma unroll
            for (int m = 0; m < 4; ++m) {
                const int r = row0 + ai * 128 + m * 16;
#pragma unroll
                for (int bj = 0; bj < 2; ++bj) store8_bf16(VT + (size_t)r * TM + col0 + bj * 128, acc[ai][bj][m][0] * s[bj][0], acc[ai][bj][m][1] * s[bj][1]);
            }
    }
};
struct EpiGLU {
    static constexpr bool PERM = true, MID = false;
    const bf16_t* YG; bf16_t* YCAT; float* ssb;
    __device__ __forceinline__ int brow(int cb, int f) const { return cb + 16 * f; }
    __device__ __forceinline__ void small(const f32x4 (&acc)[2][2], int r0, int cb, int fr, int fq) const {
#pragma unroll
        for (int m = 0; m < 2; ++m) {
            const int r = r0 + 16 * m + fr; float ssum = 0.f;
#pragma unroll
            for (int f = 0; f < 2; ++f) {
                const int c = cb + 16 * f + 4 * fq; const u32x2 yw = *(const GAS u32x2*)(YG + (size_t)r * CH + c);
                f32x4 y = (f32x4){bf_lo(yw.x), bf_hi(yw.x), bf_lo(yw.y), bf_hi(yw.y)};
#pragma unroll
                for (int e = 0; e < 4; ++e) { y[e] = y[e] * __builtin_amdgcn_rcpf(1.0f + __expf(-acc[m][f][e])); ssum += y[e] * y[e]; }
                u32x2 w; w.x = cvt_pk_bf16(y[0], y[1]); w.y = cvt_pk_bf16(y[2], y[3]); *(GAS u32x2*)(YCAT + (size_t)r * D + c) = w;
            }
            ssum += __shfl_xor(ssum, 16); ssum += __shfl_xor(ssum, 32);
            if (fq == 0) atomicAdd(ssb + r, ssum);
        }
    }
    __device__ __forceinline__ void operator()(const Acc& acc, const Unit& u, int wr, int wc, int fr, int fq) const {
        const int row0 = u.pm * 256 + wr * 64 + fr, col0 = u.pn * 256 + wc * 32 + 8 * fq;
#pragma unroll
        for (int ai = 0; ai < 2; ++ai)
#pragma unroll
            for (int m = 0; m < 4; ++m) {
                const int r = row0 + ai * 128 + m * 16; float ssum = 0.f;
#pragma unroll
                for (int bj = 0; bj < 2; ++bj) {
                    f32x4 y0, y1; unpack8(*(const GAS u32x4*)(YG + (size_t)r * CH + col0 + bj * 128), y0, y1);
                    f32x4 z0 = acc[ai][bj][m][0], z1 = acc[ai][bj][m][1];
#pragma unroll
                    for (int e = 0; e < 4; ++e) { y0[e] = y0[e] * __builtin_amdgcn_rcpf(1.0f + __expf(-z0[e])); y1[e] = y1[e] * __builtin_amdgcn_rcpf(1.0f + __expf(-z1[e]));
                        ssum += y0[e] * y0[e] + y1[e] * y1[e]; }
                    store8_bf16(YCAT + (size_t)r * D + col0 + bj * 128, y0, y1);
                }
                ssum += __shfl_xor(ssum, 16); ssum += __shfl_xor(ssum, 32);
                if (fq == 0) atomicAdd(ssb + r, ssum);
            }
    }
};
template <bool MIDS> struct EpiRes {
    static constexpr bool PERM = true, MID = MIDS;
    bf16_t* XB; float* ssout; const float* ssb;
    __device__ __forceinline__ int brow(int cb, int f) const { return cb + 16 * f; }
    __device__ __forceinline__ void mid_small(f32x4 (&acc)[2][2], int r0, int fr) const {
#pragma unroll
        for (int m = 0; m < 2; ++m) { const float sc = rsqrtf(((const GAS float*)ssb)[r0 + 16 * m + fr] * (1.0f / CH) + EPS); acc[m][0] *= sc; acc[m][1] *= sc; }
    }
    __device__ __forceinline__ void small(const f32x4 (&acc)[2][2], int r0, int cb, int fr, int fq) const {
#pragma unroll
        for (int m = 0; m < 2; ++m) {
            const int r = r0 + 16 * m + fr; float ssum = 0.f;
#pragma unroll
            for (int f = 0; f < 2; ++f) {
                bf16_t* p = XB + (size_t)r * D + cb + 16 * f + 4 * fq; const u32x2 xw = *(const GAS u32x2*)p;
                f32x4 x = (f32x4){bf_lo(xw.x), bf_hi(xw.x), bf_lo(xw.y), bf_hi(xw.y)} + acc[m][f];
#pragma unroll
                for (int e = 0; e < 4; ++e) ssum += x[e] * x[e];
                u32x2 w; w.x = cvt_pk_bf16(x[0], x[1]); w.y = cvt_pk_bf16(x[2], x[3]); *(GAS u32x2*)p = w;
            }
            ssum += __shfl_xor(ssum, 16); ssum += __shfl_xor(ssum, 32);
            if (fq == 0) atomicAdd(ssout + r, ssum);
        }
    }
    __device__ __forceinline__ void mid(Acc& acc, const Unit& u, int wr, int fr) const {
        const int row0 = u.pm * 256 + wr * 64 + fr;
#pragma unroll
        for (int ai = 0; ai < 2; ++ai)
#pragma unroll
            for (int m = 0; m < 4; ++m) {
                const float s = rsqrtf(((const GAS float*)ssb)[row0 + ai * 128 + m * 16] * (1.0f / CH) + EPS);
#pragma unroll
                for (int bj = 0; bj < 2; ++bj)
#pragma unroll
                    for (int n = 0; n < 2; ++n) acc[ai][bj][m][n] *= s;
            }
    }
    __device__ __forceinline__ void operator()(const Acc& acc, const Unit& u, int wr, int wc, int fr, int fq) const {
        const int row0 = u.pm * 256 + wr * 64 + fr, col0 = u.pn * 256 + wc * 32 + 8 * fq;
#pragma unroll
        for (int ai = 0; ai < 2; ++ai)
#pragma unroll
            for (int m = 0; m < 4; ++m) {
                const int r = row0 + ai * 128 + m * 16; float ssum = 0.f;
#pragma unroll
                for (int bj = 0; bj < 2; ++bj) {
                    bf16_t* p = XB + (size_t)r * D + col0 + bj * 128;
                    f32x4 x0, x1; unpack8(*(const GAS u32x4*)p, x0, x1);
                    x0 += acc[ai][bj][m][0]; x1 += acc[ai][bj][m][1];
#pragma unroll
                    for (int e = 0; e < 4; ++e) ssum += x0[e] * x0[e] + x1[e] * x1[e];
                    store8_bf16(p, x0, x1);
                }
                ssum += __shfl_xor(ssum, 16); ssum += __shfl_xor(ssum, 32);
                if (fq == 0) atomicAdd(ssout + r, ssum);
            }
    }
};
template <int ACT> struct EpiScale {
    static constexpr bool PERM = true, MID = false;
    bf16_t* OUT; int ldc; const float* ss;
    __device__ __forceinline__ int brow(int cb, int f) const { return cb + 16 * f; }
    __device__ __forceinline__ void small(const f32x4 (&acc)[2][2], int r0, int cb, int fr, int fq) const {
#pragma unroll
        for (int m = 0; m < 2; ++m) {
            const int r = r0 + 16 * m + fr; const float inv = rsqrtf(((const GAS float*)ss)[r] * (1.0f / D) + EPS);
#pragma unroll
            for (int f = 0; f < 2; ++f) {
                f32x4 v = acc[m][f] * inv;
                if (ACT == 1) {
#pragma unroll
                    for (int e = 0; e < 4; ++e) { const float a = fmaxf(v[e], 0.f); v[e] = a * a; }
                }
                u32x2 w; w.x = cvt_pk_bf16(v[0], v[1]); w.y = cvt_pk_bf16(v[2], v[3]); *(GAS u32x2*)(OUT + (size_t)r * ldc + cb + 16 * f + 4 * fq) = w;
            }
        }
    }
    __device__ __forceinline__ void operator()(const Acc& acc, const Unit& u, int wr, int wc, int fr, int fq) const {
        const int row0 = u.pm * 256 + wr * 64 + fr, col0 = u.pn * 256 + wc * 32 + 8 * fq;
#pragma unroll
        for (int ai = 0; ai < 2; ++ai)
#pragma unroll
            for (int m = 0; m < 4; ++m) {
                const int r = row0 + ai * 128 + m * 16; const float inv = rsqrtf(((const GAS float*)ss)[r] * (1.0f / D) + EPS);
#pragma unroll
                for (int bj = 0; bj < 2; ++bj) {
                    f32x4 v0 = acc[ai][bj][m][0] * inv, v1 = acc[ai][bj][m][1] * inv;
                    if (ACT == 1) {
#pragma unroll
                        for (int e = 0; e < 4; ++e) { const float a = fmaxf(v0[e], 0.f), b = fmaxf(v1[e], 0.f); v0[e] = a * a; v1[e] = b * b; }
                    }
                    store8_bf16(OUT + (size_t)r * ldc + col0 + bj * 128, v0, v1);
                }
            }
    }
};

template <class Epi>
__device__ __forceinline__ void small_gemm(const bf16_t* A, const bf16_t* Bt, int N, int K, const Epi& E, int c, int stride) {
    int tid = threadIdx.x; asm volatile("" : "+v"(tid));
    const int wave = __builtin_amdgcn_readfirstlane(tid >> 6), lane = tid & 63, fr = lane & 15, fq = lane >> 4;
    const int ntn = N >> 7, ntiles = (TS / 64) * ntn;
    if (c < 0) return;
    for (int tile = c; tile < ntiles; tile += stride) {
        const int tm = tile / ntn, tn = tile - tm * ntn;
        const int r0 = TP + tm * 64 + (wave >> 2) * 32, cb = tn * 128 + (wave & 3) * 32;
        const char* pa = (const char*)A + ((size_t)(r0 + fr) * K + 8 * fq) * 2;
        const char* pb0 = (const char*)Bt + ((size_t)(E.brow(cb, 0) + fr) * K + 8 * fq) * 2;
        const char* pb1 = (const char*)Bt + ((size_t)(E.brow(cb, 1) + fr) * K + 8 * fq) * 2;
        const size_t a16 = (size_t)16 * K * 2;
        f32x4 acc[2][2];
#pragma unroll
        for (int m = 0; m < 2; ++m)
#pragma unroll
            for (int f = 0; f < 2; ++f) acc[m][f] = (f32x4){0.f, 0.f, 0.f, 0.f};
        const int ng = K >> 7;
        bf16x8 A0[4], A1[4], B0[4], B1[4], C0[4], C1[4], D0[4], D1[4];
#define SG_LOAD(a0, a1, b0, b1, g) do { _Pragma("unroll") for (int j = 0; j < 4; ++j) { const size_t ko = (size_t)((g) * 4 + j) * 64; \
            a0[j] = *(const GAS bf16x8*)(pa + ko); a1[j] = *(const GAS bf16x8*)(pa + a16 + ko); b0[j] = *(const GAS bf16x8*)(pb0 + ko); b1[j] = *(const GAS bf16x8*)(pb1 + ko); } } while (0)
#define SG_MMA(a0, a1, b0, b1) do { _Pragma("unroll") for (int j = 0; j < 4; ++j) { \
            acc[0][0] = __builtin_amdgcn_mfma_f32_16x16x32_bf16(b0[j], a0[j], acc[0][0], 0, 0, 0); acc[0][1] = __builtin_amdgcn_mfma_f32_16x16x32_bf16(b1[j], a0[j], acc[0][1], 0, 0, 0); \
            acc[1][0] = __builtin_amdgcn_mfma_f32_16x16x32_bf16(b0[j], a1[j], acc[1][0], 0, 0, 0); acc[1][1] = __builtin_amdgcn_mfma_f32_16x16x32_bf16(b1[j], a1[j], acc[1][1], 0, 0, 0); } } while (0)
        SG_LOAD(A0, A1, B0, B1, 0);
        for (int g = 0; g < ng; g += 2) {
            if constexpr (Epi::MID) { if (g == (ng >> 1)) E.mid_small(acc, r0, fr); }
            SG_LOAD(C0, C1, D0, D1, g + 1);
            SG_MMA(A0, A1, B0, B1);
            if (g + 2 < ng) SG_LOAD(A0, A1, B0, B1, g + 2);
            SG_MMA(C0, C1, D0, D1);
        }
#undef SG_LOAD
#undef SG_MMA
        E.small(acc, r0, cb, fr, fq);
    }
}

struct Args { const float* in[33]; float* out; unsigned char* ws; };
enum { I_XP = 0, I_XS, I_MEM, I_SCONV, I_SRE, I_SIM, I_CK, I_CV, I_GMIX, I_WIN, I_CONVW, I_ARE, I_AIM, I_LOGDT, I_BRE, I_BIM, I_CRE, I_CIM, I_SD, I_WGLU,
       I_GA, I_GB, I_WOUT, I_GX, I_GMEM, I_WQ, I_WK, I_WV, I_WO, I_GMLP, I_WUP, I_WDOWN, I_GFIN };

typedef const float* const __attribute__((address_space(4)))* KTab;
__device__ __forceinline__ KTab ktab() { unsigned long long p = (unsigned long long)__builtin_amdgcn_kernarg_segment_ptr(); asm volatile("" : "+s"(p)); return (KTab)p; }
__device__ __forceinline__ float* ss_arr(unsigned char* ws, int idx) { return (float*)(ws + WS_SS) + (size_t)idx * T; }
__device__ __forceinline__ float* invmem_arr(unsigned char* ws) { return (float*)(ws + WS_SS) + (size_t)9 * T; }

__device__ __forceinline__ int inproj_src_col(int vc) {
    if (vc < 512 || vc >= 1536) return vc;
    const int q = (vc - 512) >> 8, r = (vc - 512) & 255;
    return r < 128 ? 512 + q * 128 + r : 1024 + q * 128 + (r - 128);
}
__device__ __forceinline__ void transpose_item(const float* W, int ldw, int srck0, int srcn0, const float* gain, float gscale, bf16_t* WT, int ldt, int dn0, int dk0, LAS float* scr, int lane) {
#pragma unroll 8
    for (int i = 0; i < 32; ++i) { const int kk = 2 * i + (lane >> 5); float v = ((const GAS float*)W)[(size_t)(srck0 + kk) * ldw + srcn0 + (lane & 31)];
        const float gsc = gain ? ((const GAS float*)gain)[kk] * gscale : gscale; scr[kk * 33 + (lane & 31)] = v * gsc; }
    LDS_WAIT();
    const int c = lane & 7;
#pragma unroll
    for (int j = 0; j < 4; ++j) { const int n = (lane >> 3) + 8 * j; const LAS float* s = scr + (8 * c) * 33 + n;
        u32x4 o; o.x = cvt_pk_bf16(s[0 * 33], s[1 * 33]); o.y = cvt_pk_bf16(s[2 * 33], s[3 * 33]); o.z = cvt_pk_bf16(s[4 * 33], s[5 * 33]); o.w = cvt_pk_bf16(s[6 * 33], s[7 * 33]);
        *(GAS u32x4*)(WT + (size_t)(dn0 + n) * ldt + dk0 + 8 * c) = o; }
    LDS_WAIT();
}
__device__ __forceinline__ float convert_row(const float* src, bf16_t* dst, int lane) {
    const GAS f32x4* xr = (const GAS f32x4*)src + lane; f32x4 v[4]; float s = 0.f;
#pragma unroll
    for (int j = 0; j < 4; ++j) { v[j] = xr[64 * j]; s += (v[j][0] * v[j][0] + v[j][1] * v[j][1]) + (v[j][2] * v[j][2] + v[j][3] * v[j][3]); }
    GAS u32x2* o = (GAS u32x2*)dst + lane;
#pragma unroll
    for (int j = 0; j < 4; ++j) { u32x2 w; w.x = cvt_pk_bf16(v[j][0], v[j][1]); w.y = cvt_pk_bf16(v[j][2], v[j][3]); o[64 * j] = w; }
    return wave_sum(s);
}
constexpr int PI_IN = 1024, PI_GLU = 128, PI_SQ = 512, PI_UP = 2048, PI_CV = 2048;
constexpr int PI_LAYER = PI_IN + PI_GLU + 5 * PI_SQ + 2 * PI_UP + PI_CV;

__device__ __forceinline__ void prep_phase(unsigned char* ws, LAS unsigned char* lds, int gw, int NGW, int wave, int lane) {
    const KTab in = ktab();
    LAS float* scr = (LAS float*)(lds + wave * 8704);
    for (int it = gw; it < DEPTH * PI_LAYER; it += NGW) {
        const int l = it / PI_LAYER; int r = it - l * PI_LAYER;
        unsigned char* wl = ws + WS_W + (size_t)l * W_LAYER;
        if (r < PI_IN) { const int kb = r >> 6, nb = r & 63;
            transpose_item(as_global(in[I_WIN]) + (size_t)l * D * 2048, 2048, 64 * kb, inproj_src_col(32 * nb), as_global(in[I_GMIX]) + l * D + 64 * kb, 1.0f, (bf16_t*)(wl + W_IN), D, 32 * nb, 64 * kb, scr, lane); continue; }
        r -= PI_IN;
        if (r < PI_GLU) { const int kb = r >> 4, nb = r & 15;
            transpose_item(as_global(in[I_WGLU]) + (size_t)l * CH * CH, CH, 64 * kb, 32 * nb, nullptr, 1.0f, (bf16_t*)(wl + W_GLU), CH, 32 * nb, 64 * kb, scr, lane); continue; }
        r -= PI_GLU;
        if (r < PI_SQ) { const int kb = r >> 5, nb = r & 31, dk0 = 64 * kb;
            const float* gn = dk0 < 512 ? as_global(in[I_GB]) + l * CH + dk0 : as_global(in[I_GA]) + l * CH + dk0 - 512;
            transpose_item(as_global(in[I_WOUT]) + (size_t)l * D * D, D, (dk0 + 512) & 1023, 32 * nb, gn, 1.0f, (bf16_t*)(wl + W_OUT), D, 32 * nb, dk0, scr, lane); continue; }
        r -= PI_SQ;
        if (r < PI_SQ) { const int kb = r >> 5, nb = r & 31;
            transpose_item(as_global(in[I_WQ]) + (size_t)l * D * D, D, 64 * kb, 32 * nb, as_global(in[I_GX]) + l * D + 64 * kb, 0.0625f, (bf16_t*)(wl + W_Q), D, 32 * nb, 64 * kb, scr, lane); continue; }
        r -= PI_SQ;
        if (r < PI_SQ) { const int kb = r >> 5, nb = r & 31;
            transpose_item(as_global(in[I_WK]) + (size_t)l * D * D, D, 64 * kb, 32 * nb, as_global(in[I_GMEM]) + l * D + 64 * kb, 1.0f, (bf16_t*)(wl + W_KV), D, 32 * nb, 64 * kb, scr, lane); continue; }
        r -= PI_SQ;
        if (r < PI_SQ) { const int kb = r >> 5, nb = r & 31;
            transpose_item(as_global(in[I_WV]) + (size_t)l * D * D, D, 64 * kb, 32 * nb, as_global(in[I_GMEM]) + l * D + 64 * kb, 1.0f, (bf16_t*)(wl + W_KV), D, 1024 + 32 * nb, 64 * kb, scr, lane); continue; }
        r -= PI_SQ;
        if (r < PI_SQ) { const int kb = r >> 5, nb = r & 31;
            transpose_item(as_global(in[I_WO]) + (size_t)l * D * D, D, 64 * kb, 32 * nb, nullptr, 1.0f, (bf16_t*)(wl + W_O), D, 32 * nb, 64 * kb, scr, lane); continue; }
        r -= PI_SQ;
        if (r < PI_UP) { const int kb = r >> 7, nb = r & 127;
            transpose_item(as_global(in[I_WUP]) + (size_t)l * D * DFF, DFF, 64 * kb, 32 * nb, as_global(in[I_GMLP]) + l * D + 64 * kb, 1.0f, (bf16_t*)(wl + W_UP), D, 32 * nb, 64 * kb, scr, lane); continue; }
        r -= PI_UP;
        if (r < PI_UP) { const int kb = r >> 5, nb = r & 31;
            transpose_item(as_global(in[I_WDOWN]) + (size_t)l * DFF * D, D, 64 * kb, 32 * nb, nullptr, 1.0f, (bf16_t*)(wl + W_DOWN), DFF, 32 * nb, 64 * kb, scr, lane); continue; }
        r -= PI_UP;
        { const int kb = r >> 5, nb = r & 31;
            transpose_item(as_global(in[I_CV]) + (size_t)l * TMS * D, D, 64 * kb, 32 * nb, nullptr, 1.0f, (bf16_t*)(ws + WS_VTC) + (size_t)l * D * TMS, TMS, 32 * nb, 64 * kb, scr, lane); }
    }
    float* ss0 = ss_arr(ws, 0); float* invm = invmem_arr(ws);
    for (int m0 = gw * 2; m0 < T; m0 += NGW * 2) {
        const float* src = m0 < TP ? as_global(in[I_XP]) + (size_t)m0 * D : as_global(in[I_XS]) + (size_t)(m0 - TP) * D;
        const GAS f32x4* xr = (const GAS f32x4*)src + lane; f32x4 v[8]; float s0 = 0.f, s1 = 0.f;
#pragma unroll
        for (int j = 0; j < 8; ++j) v[j] = xr[64 * j];
#pragma unroll
        for (int j = 0; j < 4; ++j) { s0 += (v[j][0] * v[j][0] + v[j][1] * v[j][1]) + (v[j][2] * v[j][2] + v[j][3] * v[j][3]);
            s1 += (v[4 + j][0] * v[4 + j][0] + v[4 + j][1] * v[4 + j][1]) + (v[4 + j][2] * v[4 + j][2] + v[4 + j][3] * v[4 + j][3]); }
        GAS u32x2* o = (GAS u32x2*)((bf16_t*)(ws + WS_XB) + (size_t)m0 * D) + lane;
#pragma unroll
        for (int j = 0; j < 8; ++j) { u32x2 w; w.x = cvt_pk_bf16(v[j][0], v[j][1]); w.y = cvt_pk_bf16(v[j][2], v[j][3]); o[64 * j] = w; }
        s0 = wave_sum(s0); s1 = wave_sum(s1);
        if (lane == 0) { ((GAS float*)ss0)[m0] = s0; ((GAS float*)ss0)[m0 + 1] = s1; }
    }
    for (int m = T + gw; m < T + TM + 2 * TMS; m += NGW) {
        if (m < T) { const float* src = m < TP ? as_global(in[I_XP]) + (size_t)m * D : as_global(in[I_XS]) + (size_t)(m - TP) * D;
            const float s = convert_row(src, (bf16_t*)(ws + WS_XB) + (size_t)m * D, lane); if (lane == 0) ((GAS float*)ss0)[m] = s; }
        else if (m < T + TM) { const int mm = m - T; const float s = convert_row(as_global(in[I_MEM]) + (size_t)mm * D, (bf16_t*)(ws + WS_MNB) + (size_t)mm * D, lane);
            if (lane == 0) ((GAS float*)invm)[mm] = rsqrtf(s * (1.0f / D) + EPS); }
        else { const int mm = m - T - TM; (void)convert_row(as_global(in[I_CK]) + (size_t)mm * D, (bf16_t*)(ws + WS_KC) + (size_t)mm * D, lane); }
    }
    {
        float* sm = (float*)(ws + WS_SMALL); const int gt = gw * 64 + lane, NT = NGW * 64;
#define SMCOPY(off, idx, n) for (int i = gt; i < (n); i += NT) ((GAS float*)sm)[(off) + i] = ((const GAS float*)in[idx])[i]
        SMCOPY(SM_ARE, I_ARE, 4096); SMCOPY(SM_AIM, I_AIM, 4096); SMCOPY(SM_LOGDT, I_LOGDT, 64); SMCOPY(SM_BRE, I_BRE, 65536); SMCOPY(SM_BIM, I_BIM, 65536);
        SMCOPY(SM_CRE, I_CRE, 65536); SMCOPY(SM_CIM, I_CIM, 65536); SMCOPY(SM_SD, I_SD, 1024); SMCOPY(SM_CONVW, I_CONVW, 3072); SMCOPY(SM_SCONV, I_SCONV, 32768);
        SMCOPY(SM_SRE, I_SRE, 65536); SMCOPY(SM_SIM, I_SIM, 65536); SMCOPY(SM_GFIN, I_GFIN, 1024);
#undef SMCOPY
    }
    { float* z = ss_arr(ws, 1); const size_t n = (size_t)8 * T; for (size_t i = (size_t)gw * 64 + lane; i < n; i += (size_t)NGW * 64) ((GAS float*)z)[i] = 0.f; }
}

__device__ __forceinline__ float gelu_tanh(float x) {
    const float u = 0.7978845608f * (x + 0.044715f * x * x * x);
    const float e = __expf(2.0f * u);
    const float th = 1.0f - 2.0f * __builtin_amdgcn_rcpf(e + 1.0f);
    return 0.5f * x * (1.0f + th);
}
__device__ __forceinline__ void sincos_small(float x, float& s, float& c) {
    const float q = rintf(x * 0.63661977236f);
    float r = fmaf(-q, 1.57079637050628662109375f, x); r = fmaf(-q, -4.37113900018624283e-8f, r);
    const float r2 = r * r;
    const float sp = r + r * r2 * (-1.0f / 6 + r2 * (1.0f / 120 + r2 * (-1.0f / 5040 + r2 * (1.0f / 362880))));
    const float cp = 1.0f + r2 * (-0.5f + r2 * (1.0f / 24 + r2 * (-1.0f / 720 + r2 * (1.0f / 40320 + r2 * (-1.0f / 3628800)))));
    const int qi = (int)q & 3;
    s = (qi == 0) ? sp : (qi == 1) ? cp : (qi == 2) ? -sp : -cp;
    c = (qi == 0) ? cp : (qi == 1) ? -sp : (qi == 2) ? -cp : sp;
}
constexpr int BU_STRIDE = 528, H_STRIDE = 272, SCAN_LDS_WAVE = 16 * BU_STRIDE + 16 * H_STRIDE;

__device__ __forceinline__ void scan_item(unsigned char* ws, float* out, int l, int item, LAS unsigned char* wl, int lane_in) {
    int lane = lane_in; asm volatile("" : "+v"(lane));
    const GAS float* sm = (const GAS float*)(ws + WS_SMALL);
    int b, g, row0, nblk; const bool prompt = item < NB * 32;
    if (prompt) { b = item >> 5; g = item & 31; row0 = b * SEQ; nblk = SEQ / 16; }
    else { const int i2 = item - NB * 32; b = i2 >> 5; g = i2 & 31; row0 = TP + b * DSEQ; nblk = DSEQ / 16; }
    const bf16_t* U = (const bf16_t*)(ws + WS_U); bf16_t* YG = (bf16_t*)(ws + WS_YG);
    const int lg = l * 32 + g, p = lane, t16 = lane & 15, q = lane >> 4;
    const float are = fminf(sm[SM_ARE + lg * 64 + p], -1e-4f), aim = sm[SM_AIM + lg * 64 + p];
    const float dt = expf(sm[SM_LOGDT + lg]);
    float sn, cs; sincos_small(aim * dt, sn, cs);
    const float mag = expf(are * dt), abr = mag * cs, abi = mag * sn;
    const float nr = abr - 1.0f, ni = abi, den = 1.0f / (are * are + aim * aim);
    const float c0 = (nr * are + ni * aim) * den, c1 = (ni * are - nr * aim) * den;
    bf16x8 af[8];
#pragma unroll
    for (int f = 0; f < 8; ++f) {
        const int i = 16 * f + t16, ps = i >> 1, cc = i & 1;
        const float k0 = __shfl(c0, ps), k1 = __shfl(c1, ps);
        u32x4 w = (u32x4){0u, 0u, 0u, 0u};
        if (q < 2) {
            const GAS f32x4* br = (const GAS f32x4*)(sm + SM_BRE + ((size_t)lg * 64 + ps) * 16 + 8 * q); const GAS f32x4* bi = (const GAS f32x4*)(sm + SM_BIM + ((size_t)lg * 64 + ps) * 16 + 8 * q);
            const f32x4 r0 = br[0], r1 = br[1], i0 = bi[0], i1 = bi[1];
            f32x4 v0, v1;
            if (cc == 0) { v0 = k0 * r0 - k1 * i0; v1 = k0 * r1 - k1 * i1; } else { v0 = k0 * i0 + k1 * r0; v1 = k0 * i1 + k1 * r1; }
            w.x = cvt_pk_bf16(v0[0], v0[1]); w.y = cvt_pk_bf16(v0[2], v0[3]); w.z = cvt_pk_bf16(v1[0], v1[1]); w.w = cvt_pk_bf16(v1[2], v1[3]);
        }
        af[f] = __builtin_bit_cast(bf16x8, w);
    }
    bf16x8 cf[4];
#pragma unroll
    for (int s = 0; s < 4; ++s) {
        const int p0 = 16 * s + 4 * q;
        const f32x4 cr = *(const GAS f32x4*)(sm + SM_CRE + ((size_t)lg * 16 + t16) * 64 + p0), ci = *(const GAS f32x4*)(sm + SM_CIM + ((size_t)lg * 16 + t16) * 64 + p0);
        u32x4 w; w.x = cvt_pk_bf16(cr[0], -ci[0]); w.y = cvt_pk_bf16(cr[1], -ci[1]); w.z = cvt_pk_bf16(cr[2], -ci[2]); w.w = cvt_pk_bf16(cr[3], -ci[3]);
        cf[s] = __builtin_bit_cast(bf16x8, w);
    }
    const f32x4 dsk = *(const GAS f32x4*)(sm + SM_SD + l * CH + g * 16 + 4 * q);
    float hre = 0.f, him = 0.f;
    if (!prompt) { hre = sm[SM_SRE + (((size_t)l * NDB + b) * 32 + g) * 64 + p]; him = sm[SM_SIM + (((size_t)l * NDB + b) * 32 + g) * 64 + p]; }
    LAS unsigned char* BU = wl; LAS unsigned char* HB = wl + 16 * BU_STRIDE;
    const char* ubase = (const char*)U + (size_t)row0 * CH * 2; char* ybase = (char*)YG + (size_t)row0 * CH * 2;
    const unsigned lo8 = (unsigned)((t16 * CH + g * 16 + 8 * (q & 1)) * 2), lo4 = (unsigned)((t16 * CH + g * 16 + 4 * q) * 2);
    constexpr size_t BSTEP = (size_t)16 * CH * 2;
    constexpr int PD = 6;
    u32x4 ubuf[PD]; u32x2 ebuf[PD];
#pragma unroll
    for (int j = 0; j < PD; ++j) { ubuf[j] = (u32x4){0u, 0u, 0u, 0u}; ebuf[j] = (u32x2){0u, 0u};
        if (j < nblk) { const char* un = ubase + (size_t)j * BSTEP; if (q < 2) ubuf[j] = *(const GAS u32x4*)(un + lo8); ebuf[j] = *(const GAS u32x2*)(un + lo4); } }
    for (int tb0 = 0; tb0 < nblk; tb0 += PD) {
#pragma unroll
        for (int j = 0; j < PD; ++j) {
            const int tb = tb0 + j;
            if (tb < nblk) {
                const u32x4 ubc = ubuf[j]; const u32x2 uec = ebuf[j];
                if (tb + PD < nblk) { const char* un = ubase + (size_t)(tb + PD) * BSTEP; if (q < 2) ubuf[j] = *(const GAS u32x4*)(un + lo8); ebuf[j] = *(const GAS u32x2*)(un + lo4); }
                const bf16x8 bfrag = __builtin_bit_cast(bf16x8, ubc);
#pragma unroll
                for (int f = 0; f < 8; ++f) {
                    const f32x4 r = __builtin_amdgcn_mfma_f32_16x16x32_bf16(af[f], bfrag, (f32x4){0.f, 0.f, 0.f, 0.f}, 0, 0, 0);
                    *(LAS f32x4*)(BU + t16 * BU_STRIDE + (16 * f + 4 * q) * 4) = r;
                }
                LDS_WAIT();
                f32x2 buv[16];
#pragma unroll
                for (int t = 0; t < 16; ++t) buv[t] = *(const LAS f32x2*)(BU + t * BU_STRIDE + p * 8);
#pragma unroll
                for (int t = 0; t < 16; ++t) {
                    const float nre = fmaf(abr, hre, fmaf(-abi, him, buv[t][0])), nim = fmaf(abr, him, fmaf(abi, hre, buv[t][1]));
                    hre = nre; him = nim;
                    *(LAS unsigned*)(HB + t * H_STRIDE + p * 4) = cvt_pk_bf16(hre, him);
                }
                LDS_WAIT();
                f32x4 y = (f32x4){0.f, 0.f, 0.f, 0.f};
#pragma unroll
                for (int s2 = 0; s2 < 4; ++s2) {
                    const bf16x8 hf = *(const LAS bf16x8*)(HB + t16 * H_STRIDE + (32 * s2 + 8 * q) * 2);
                    y = __builtin_amdgcn_mfma_f32_16x16x32_bf16(cf[s2], hf, y, 0, 0, 0);
                }
                const float u0 = bf_lo(uec.x), u1 = bf_hi(uec.x), u2 = bf_lo(uec.y), u3 = bf_hi(uec.y);
                const float g0 = gelu_tanh(y[0] + dsk[0] * u0), g1 = gelu_tanh(y[1] + dsk[1] * u1), g2 = gelu_tanh(y[2] + dsk[2] * u2), g3 = gelu_tanh(y[3] + dsk[3] * u3);
                u32x2 w; w.x = cvt_pk_bf16(g0, g1); w.y = cvt_pk_bf16(g2, g3);
                *(GAS u32x2*)(ybase + (size_t)tb * BSTEP + lo4) = w;
                LDS_WAIT();
            }
        }
    }
    GAS float* outg = (GAS float*)out;
    if (prompt) { outg[O_REP + (((size_t)l * NB + b) * 32 + g) * 64 + p] = hre; outg[O_IMP + (((size_t)l * NB + b) * 32 + g) * 64 + p] = him; }
    else { outg[O_RES + (((size_t)l * NDB + b) * 32 + g) * 64 + p] = hre; outg[O_IMS + (((size_t)l * NDB + b) * 32 + g) * 64 + p] = him; }
}
__device__ __forceinline__ void conv_run(unsigned char* ws, int l, int run, int lane_in) {
    int lane = lane_in; asm volatile("" : "+v"(lane));
    const GAS float* sm = (const GAS float*)(ws + WS_SMALL);
    const bf16_t* XIN = (const bf16_t*)(ws + WS_XIN); const bf16_t* BG = (const bf16_t*)(ws + WS_BG); bf16_t* YCAT = (bf16_t*)(ws + WS_YCAT);
    const int row0 = run * 64, c0 = lane * 8;
    f32x4 w0a, w0b, w1a, w1b, w2a, w2b;
    { const GAS float* cw = sm + SM_CONVW + (size_t)l * 3 * CH + c0; w0a = *(const GAS f32x4*)cw; w0b = *(const GAS f32x4*)(cw + 4); w1a = *(const GAS f32x4*)(cw + CH); w1b = *(const GAS f32x4*)(cw + CH + 4);
      w2a = *(const GAS f32x4*)(cw + 2 * CH); w2b = *(const GAS f32x4*)(cw + 2 * CH + 4); }
    f32x4 p2a, p2b, p1a, p1b;
    const bool seq_start = row0 < TP ? ((row0 & (SEQ - 1)) == 0) : true;
    if (!seq_start) { unpack8(*(const GAS u32x4*)(XIN + (size_t)(row0 - 2) * CH + c0), p2a, p2b); unpack8(*(const GAS u32x4*)(XIN + (size_t)(row0 - 1) * CH + c0), p1a, p1b); }
    else if (row0 < TP) { p2a = p2b = p1a = p1b = (f32x4){0.f, 0.f, 0.f, 0.f}; }
    else { const int b = (row0 - TP) >> 6; const GAS float* st = sm + SM_SCONV + ((size_t)(l * NDB + b) * 2) * CH + c0;
        p2a = *(const GAS f32x4*)st; p2b = *(const GAS f32x4*)(st + 4); p1a = *(const GAS f32x4*)(st + CH); p1b = *(const GAS f32x4*)(st + CH + 4); }
    for (int tb = 0; tb < 64; tb += 8) {
        u32x4 xr[8], br[8];
#pragma unroll
        for (int j = 0; j < 8; ++j) { const size_t o = (size_t)(row0 + tb + j) * CH + c0; xr[j] = *(const GAS u32x4*)(XIN + o); br[j] = *(const GAS u32x4*)(BG + o); }
#pragma unroll
        for (int j = 0; j < 8; ++j) {
            f32x4 xa, xb, ba, bb; unpack8(xr[j], xa, xb); unpack8(br[j], ba, bb);
            f32x4 ya = ba * (w0a * p2a + w1a * p1a + w2a * xa), yb = bb * (w0b * p2b + w1b * p1b + w2b * xb);
            float s = 0.f;
#pragma unroll
            for (int e = 0; e < 4; ++e) s += ya[e] * ya[e] + yb[e] * yb[e];
            s = wave_sum(s);
            const float inv = rsqrtf(s * (1.0f / CH) + EPS);
            store8_bf16(YCAT + (size_t)(row0 + tb + j) * D + 512 + c0, ya * inv, yb * inv);
            p2a = p1a; p2b = p1b; p1a = xa; p1b = xb;
        }
    }
}

constexpr int KST = 528, VST = 520;
__device__ __forceinline__ void attn_phase(unsigned char* ws, int l, LAS unsigned char* lds, int G, int bid) {
    int tid = threadIdx.x; asm volatile("" : "+v"(tid));
    const int wave = __builtin_amdgcn_readfirstlane(tid >> 6);
    const bf16_t* Q = (const bf16_t*)(ws + WS_Q); bf16_t* O = (bf16_t*)(ws + WS_O);
    const int NU = NB * 4 * 8 + NDB * 4;
    for (int u = bid; u < NU; u += G) {
        int qrow0, nq, ldv; const bf16_t* Kp; const bf16_t* Vp; int h;
        if (u < NB * 32) { const int b = u >> 5; h = (u >> 3) & 3; const int qt = u & 7; qrow0 = b * SEQ + qt * 256; nq = 256;
            Kp = (const bf16_t*)(ws + WS_KB) + (size_t)l * TM * D + (size_t)(b * NMEM) * D + h * 256; Vp = (const bf16_t*)(ws + WS_VT) + (size_t)l * D * TM + (size_t)(h * 256) * TM + b * NMEM; ldv = TM; }
        else { const int i = u - NB * 32, b = i >> 2; h = i & 3; qrow0 = TP + b * DSEQ; nq = DSEQ;
            Kp = (const bf16_t*)(ws + WS_KC) + (size_t)l * TMS * D + (size_t)(b * NMEM) * D + h * 256; Vp = (const bf16_t*)(ws + WS_VTC) + (size_t)l * D * TMS + (size_t)(h * 256) * TMS + b * NMEM; ldv = TMS; }
        const bool active = wave * 32 < nq;
        __syncthreads();
        int t2 = tid; asm volatile("" : "+v"(t2));
        {
            const int c = t2 & 31, rr = t2 >> 5; const unsigned off = (unsigned)((rr * D + c * 8) * 2); const char* kb = (const char*)Kp;
            LAS unsigned char* ld0 = lds + rr * KST + c * 16;
#pragma unroll
            for (int hb = 0; hb < 4; ++hb) {
                u32x4 v[4];
#pragma unroll
                for (int i = 0; i < 4; ++i) v[i] = *(const GAS u32x4*)(kb + (size_t)(16 * (hb * 4 + i)) * D * 2 + off);
#pragma unroll
                for (int i = 0; i < 4; ++i) *(LAS u32x4*)(ld0 + 16 * (hb * 4 + i) * KST) = v[i];
            }
        }
        bf16x8 qf[16];
        const int r32 = t2 & 31, hh = (t2 >> 5) & 1;
        const int qrow = qrow0 + wave * 32 + r32;
        if (active) {
#pragma unroll
            for (int ks = 0; ks < 16; ++ks) qf[ks] = *(const GAS bf16x8*)(Q + (size_t)qrow * D + h * 256 + 16 * ks + 8 * hh);
        } else {
#pragma unroll
            for (int ks = 0; ks < 16; ++ks) qf[ks] = (bf16x8){0, 0, 0, 0, 0, 0, 0, 0};
        }
        __syncthreads();
        constexpr int NQ = 4, MTQ = 8 / NQ;
        bf16x8 pf[16]; float qmax[NQ], qsum[NQ];
#pragma unroll
        for (int qi = 0; qi < NQ; ++qi) { qmax[qi] = 0.f; qsum[qi] = 1.f; }
        if (active) {
#pragma unroll
            for (int qi = 0; qi < NQ; ++qi) {
                f32x16 sc[MTQ];
#pragma unroll
                for (int mq = 0; mq < MTQ; ++mq)
#pragma unroll
                    for (int e = 0; e < 16; ++e) sc[mq][e] = 0.f;
#pragma unroll
                for (int ks = 0; ks < 16; ++ks)
#pragma unroll
                    for (int mq = 0; mq < MTQ; ++mq) {
                        const bf16x8 kf = *(const LAS bf16x8*)(lds + (32 * (qi * MTQ + mq) + r32) * KST + (16 * ks + 8 * hh) * 2);
                        sc[mq] = __builtin_amdgcn_mfma_f32_32x32x16_bf16(kf, qf[ks], sc[mq], 0, 0, 0);
                    }
                float mx = -3.0e38f;
#pragma unroll
                for (int mq = 0; mq < MTQ; ++mq)
#pragma unroll
                    for (int e = 0; e < 16; ++e) mx = fmaxf(mx, sc[mq][e]);
                mx = fmaxf(mx, __shfl_xor(mx, 32));
                float sum = 0.f;
#pragma unroll
                for (int mq = 0; mq < MTQ; ++mq) {
#pragma unroll
                    for (int e = 0; e < 16; ++e) { const float pe = __builtin_amdgcn_exp2f((sc[mq][e] - mx) * 1.44269504089f); sc[mq][e] = pe; sum += pe; }
#pragma unroll
                    for (int s2 = 0; s2 < 2; ++s2) {
                        u32x4 w; w.x = cvt_pk_bf16(sc[mq][8 * s2 + 0], sc[mq][8 * s2 + 1]); w.y = cvt_pk_bf16(sc[mq][8 * s2 + 2], sc[mq][8 * s2 + 3]);
                        w.z = cvt_pk_bf16(sc[mq][8 * s2 + 4], sc[mq][8 * s2 + 5]); w.w = cvt_pk_bf16(sc[mq][8 * s2 + 6], sc[mq][8 * s2 + 7]);
                        pf[2 * (qi * MTQ + mq) + s2] = __builtin_bit_cast(bf16x8, w);
                    }
                }
                sum += __shfl_xor(sum, 32);
                qmax[qi] = mx; qsum[qi] = sum;
                __builtin_amdgcn_sched_barrier(0);
            }
        } else {
#pragma unroll
            for (int i = 0; i < 16; ++i) pf[i] = (bf16x8){0, 0, 0, 0, 0, 0, 0, 0};
        }
        float fq_[NQ]; float rinv;
        { float M = qmax[0];
#pragma unroll
          for (int qi = 1; qi < NQ; ++qi) M = fmaxf(M, qmax[qi]);
          float tot = 0.f;
#pragma unroll
          for (int qi = 0; qi < NQ; ++qi) { fq_[qi] = __builtin_amdgcn_exp2f((qmax[qi] - M) * 1.44269504089f); tot += fq_[qi] * qsum[qi]; }
          rinv = 1.0f / tot;
#pragma unroll
          for (int qi = 0; qi < NQ; ++qi) fq_[qi] *= rinv; }
        __syncthreads();
        {
            const int c = t2 & 31, rr = t2 >> 5; const unsigned off = (unsigned)((rr * ldv + c * 8) * 2); const char* vb = (const char*)Vp;
            LAS unsigned char* ld0 = lds + rr * VST + c * 16;
#pragma unroll
            for (int hb = 0; hb < 4; ++hb) {
                u32x4 v[4];
#pragma unroll
                for (int i = 0; i < 4; ++i) v[i] = *(const GAS u32x4*)(vb + (size_t)(16 * (hb * 4 + i)) * ldv * 2 + off);
#pragma unroll
                for (int i = 0; i < 4; ++i) { LAS u32x2* d = (LAS u32x2*)(ld0 + 16 * (hb * 4 + i) * VST); d[0] = (u32x2){v[i].x, v[i].y}; d[1] = (u32x2){v[i].z, v[i].w}; }
            }
        }
        __syncthreads();
        if (active) {
#pragma unroll
            for (int dt = 0; dt < 8; ++dt) {
                f32x16 acc[NQ];
#pragma unroll
                for (int qi = 0; qi < NQ; ++qi)
#pragma unroll
                    for (int e = 0; e < 16; ++e) acc[qi][e] = 0.f;
#pragma unroll
                for (int mi = 0; mi < 16 / NQ; ++mi)
#pragma unroll
                    for (int qi = 0; qi < NQ; ++qi) {
                        const int ms = qi * (16 / NQ) + mi;
                        const LAS unsigned char* vp = lds + (32 * dt + r32) * VST + (16 * ms + 4 * hh) * 2;
                        const u32x2 lo = *(const LAS u32x2*)vp, hi = *(const LAS u32x2*)(vp + 16);
                        const u32x4 w = (u32x4){lo.x, lo.y, hi.x, hi.y};
                        acc[qi] = __builtin_amdgcn_mfma_f32_32x32x16_bf16(__builtin_bit_cast(bf16x8, w), pf[ms], acc[qi], 0, 0, 0);
                    }
#pragma unroll
                for (int g4 = 0; g4 < 4; ++g4) {
                    float o4[4];
#pragma unroll
                    for (int e = 0; e < 4; ++e) { float v = 0.f;
#pragma unroll
                        for (int qi = 0; qi < NQ; ++qi) v = fmaf(acc[qi][4 * g4 + e], fq_[qi], v);
                        o4[e] = v; }
                    u32x2 w; w.x = cvt_pk_bf16(o4[0], o4[1]); w.y = cvt_pk_bf16(o4[2], o4[3]);
                    *(GAS u32x2*)(O + (size_t)qrow * D + h * 256 + 32 * dt + 8 * g4 + 4 * hh) = w;
                }
                __builtin_amdgcn_sched_barrier(0);
            }
        }
    }
    __syncthreads();
}

constexpr bool USE_SP2 = true;
__global__ void __launch_bounds__(512, 2) hybrid_fwd(Args a) {
    extern __shared__ __attribute__((aligned(16))) unsigned char lds_raw[];
    LAS unsigned char* lds = (LAS unsigned char*)lds_raw;
    cg::grid_group grid = cg::this_grid();
    const int tid = threadIdx.x, lane = tid & 63, wave = __builtin_amdgcn_readfirstlane(tid >> 6);
    const int G = gridDim.x, bid = blockIdx.x;
    unsigned char* ws = as_global(a.ws);
    const int NGW = G * 8;

#ifndef NO_PREP
    for (int rep = 0; rep < REP_PREP; ++rep) { prep_phase(ws, lds, bid * 8 + wave, NGW, wave, lane); __syncthreads(); }
#endif
    grid.sync();

#define FRESH() unsigned char* wsp = ws; int ll = l, bb = bid, gg = G; asm volatile("" : "+s"(wsp), "+s"(ll), "+s"(bb), "+s"(gg)); wsp = as_global(wsp); float* outp = as_global(a.out); (void)outp; unsigned char* wl = wsp + WS_W + (size_t)ll * W_LAYER; (void)wl
#define SSA(k) ss_arr(wsp, 1 + 4 * ll + (k))
#pragma unroll 1
    for (int l = 0; l < DEPTH; ++l) {
        {
            FRESH();
            pg8::Gemm g{(const bf16_t*)(wsp + WS_XB), (const bf16_t*)(wl + W_IN), T, 2048, D}; pg8::StaticOrder S; S.init(T, 2048, gg, bb);
            EpiInProj E{(bf16_t*)(wsp + WS_BG), (bf16_t*)(wsp + WS_XIN), (bf16_t*)(wsp + WS_U), ll == 0 ? ss_arr(wsp, 0) : ss_arr(wsp, 4), outp + O_CONVP + (size_t)ll * NB * 2 * CH, outp + O_CONVS + (size_t)ll * NDB * 2 * CH};
#ifndef NO_GEMM
            pg8::gemm_phase<EpiInProj, USE_SP2>(lds, g, S, E);
#endif
#ifndef NO_SMALL
            small_gemm(g.A, g.Bt, 2048, D, E, bb >= (gg >> 1) ? bb - (gg >> 1) : -1, gg >> 1);
#endif
        }
        {
            FRESH();
            pg8::Gemm g{(const bf16_t*)(wsp + WS_MNB), (const bf16_t*)(wl + W_KV), TM, 2048, D}; pg8::StaticOrder S; S.init(TM, 2048, gg, bb);
            EpiKV E{outp + O_MKP + (size_t)ll * TM * D, outp + O_MVP + (size_t)ll * TM * D, (bf16_t*)(wsp + WS_KB) + (size_t)ll * TM * D, invmem_arr(wsp)};
#ifndef NO_GEMM
            pg8::gemm_phase<EpiKV, USE_SP2>(lds, g, S, E);
#endif
        }
        {
            FRESH();
            pg8::Gemm g{(const bf16_t*)(wl + W_KV) + (size_t)D * D, (const bf16_t*)(wsp + WS_MNB), D, TM, D}; pg8::StaticOrder S; S.init(D, TM, gg, (bb + gg - (32 % gg)) % gg);
            EpiVT E{(bf16_t*)(wsp + WS_VT) + (size_t)ll * D * TM, invmem_arr(wsp)};
#ifndef NO_GEMM
            pg8::gemm_phase<EpiVT, USE_SP2>(lds, g, S, E);
#endif
        }
        grid.sync();
        {
            FRESH();
            int tid2 = threadIdx.x; asm volatile("" : "+v"(tid2)); const int lane2 = tid2 & 63;
            const int w = wave * gg + bb; const int NGW2 = gg * 8;
            for (int rep = 0; rep < REP_SCAN; ++rep) {
#ifndef NO_SCAN
            for (int it = w; it < NB * 32 + NDB * 32; it += NGW2) scan_item(wsp, outp, ll, it, lds + wave * SCAN_LDS_WAVE, lane2);
#endif
#ifndef NO_CONV
            for (int run = NGW2 - 1 - w; run < T / 64; run += NGW2) conv_run(wsp, ll, run, lane2);
#endif
            }
        }
        grid.sync();
        {
            FRESH();
            pg8::Gemm g{(const bf16_t*)(wsp + WS_YG), (const bf16_t*)(wl + W_GLU), T, CH, CH}; pg8::StaticOrder S; S.init(T, CH, gg, bb);
            EpiGLU E{(const bf16_t*)(wsp + WS_YG), (bf16_t*)(wsp + WS_YCAT), SSA(0)};
#ifndef NO_GEMM
            pg8::gemm_phase<EpiGLU, USE_SP2>(lds, g, S, E);
#endif
#ifndef NO_SMALL
            small_gemm(g.A, g.Bt, CH, CH, E, bb, gg);
#endif
        }
        grid.sync();
        {
            FRESH();
            pg8::Gemm g{(const bf16_t*)(wsp + WS_YCAT), (const bf16_t*)(wl + W_OUT), T, D, D}; pg8::StaticOrder S; S.init(T, D, gg, bb);
            EpiRes<true> E{(bf16_t*)(wsp + WS_XB), SSA(1), SSA(0)};
#ifndef NO_GEMM
            pg8::gemm_phase<EpiRes<true>, USE_SP2>(lds, g, S, E);
#endif
#ifndef NO_SMALL
            small_gemm(g.A, g.Bt, D, D, E, bb, gg);
#endif
        }
        grid.sync();
        {
            FRESH();
            pg8::Gemm g{(const bf16_t*)(wsp + WS_XB), (const bf16_t*)(wl + W_Q), T, D, D}; pg8::StaticOrder S; S.init(T, D, gg, bb);
            EpiScale<0> E{(bf16_t*)(wsp + WS_Q), D, SSA(1)};
#ifndef NO_GEMM
            pg8::gemm_phase<EpiScale<0>, USE_SP2>(lds, g, S, E);
#endif
#ifndef NO_SMALL
            small_gemm(g.A, g.Bt, D, D, E, bb, gg);
#endif
        }
        grid.sync();
        {
            FRESH();
#ifndef NO_ATTN
            for (int rep = 0; rep < REP_ATTN; ++rep) attn_phase(wsp, ll, lds, gg, bb);
#endif
        }
        grid.sync();
        {
            FRESH();
            pg8::Gemm g{(const bf16_t*)(wsp + WS_O), (const bf16_t*)(wl + W_O), T, D, D}; pg8::StaticOrder S; S.init(T, D, gg, bb);
            EpiRes<false> E{(bf16_t*)(wsp + WS_XB), SSA(2), nullptr};
#ifndef NO_GEMM
            pg8::gemm_phase<EpiRes<false>, USE_SP2>(lds, g, S, E);
#endif
#ifndef NO_SMALL
            small_gemm(g.A, g.Bt, D, D, E, bb, gg);
#endif
        }
        grid.sync();
        {
            FRESH();
            pg8::Gemm g{(const bf16_t*)(wsp + WS_XB), (const bf16_t*)(wl + W_UP), T, DFF, D}; pg8::StaticOrder S; S.init(T, DFF, gg, bb);
            EpiScale<1> E{(bf16_t*)(wsp + WS_HDN), DFF, SSA(2)};
#ifndef NO_GEMM
            for (int rep = 0; rep < REP_UP; ++rep) pg8::gemm_phase<EpiScale<1>, USE_SP2>(lds, g, S, E);
#endif
#ifndef NO_SMALL
            small_gemm(g.A, g.Bt, DFF, D, E, bb, gg);
#endif
        }
        grid.sync();
        {
            FRESH();
            pg8::Gemm g{(const bf16_t*)(wsp + WS_HDN), (const bf16_t*)(wl + W_DOWN), T, D, DFF}; pg8::StaticOrder S; S.init(T, D, gg, bb);
            EpiRes<false> E{(bf16_t*)(wsp + WS_XB), SSA(3), nullptr};
#ifndef NO_GEMM
            pg8::gemm_phase<EpiRes<false>, USE_SP2>(lds, g, S, E);
#endif
#ifndef NO_SMALL
            small_gemm(g.A, g.Bt, D, DFF, E, bb, gg);
#endif
        }
        grid.sync();
    }
    {
        int tid3 = threadIdx.x; asm volatile("" : "+v"(tid3)); const int lane = tid3 & 63;
        const bf16_t* XB = (const bf16_t*)(ws + WS_XB); const float* ssf = ss_arr(ws, 1 + 4 + 3); const GAS float* gf = (const GAS float*)(ws + WS_SMALL) + SM_GFIN;
        f32x4 gv[4];
#pragma unroll
        for (int j = 0; j < 4; ++j) gv[j] = *(const GAS f32x4*)(gf + 256 * j + 4 * lane);
        for (int m0 = (bid * 8 + wave) * 4; m0 < T; m0 += NGW * 4) {
            u32x2 wv[4][4]; float inv[4];
#pragma unroll
            for (int r = 0; r < 4; ++r) { const GAS u32x2* xr = (const GAS u32x2*)(XB + (size_t)(m0 + r) * D) + lane;
#pragma unroll
                for (int j = 0; j < 4; ++j) wv[r][j] = xr[64 * j];
                inv[r] = rsqrtf(((const GAS float*)ssf)[m0 + r] * (1.0f / D) + EPS); }
#pragma unroll
            for (int r = 0; r < 4; ++r) { GAS f32x4* o = (GAS f32x4*)(a.out + (size_t)(m0 + r) * D) + lane;
#pragma unroll
                for (int j = 0; j < 4; ++j) { const u32x2 w = wv[r][j]; o[64 * j] = (f32x4){bf_lo(w.x), bf_hi(w.x), bf_lo(w.y), bf_hi(w.y)} * inv[r] * gv[j]; } }
        }
    }
}

extern "C" void kernel_launch(void* const* d_in, const int* in_sizes, int n_in, void* d_out, int out_size, void* d_ws, size_t ws_size, hipStream_t stream) {
    static int grid = 0;
    if (grid == 0) {
        if (n_in != 33 || (size_t)out_size != O_END || ws_size < WS_END) { fprintf(stderr, "kernel_launch: unexpected sizes n_in %d out %d ws %zu (need %zu)\n", n_in, out_size, ws_size, (size_t)WS_END); grid = -1; return; }
        int dev = 0, cus = 0, per_cu = 0;
        (void)hipGetDevice(&dev); (void)hipDeviceGetAttribute(&cus, hipDeviceAttributeMultiprocessorCount, dev);
        if (hipFuncSetAttribute((const void*)hybrid_fwd, hipFuncAttributeMaxDynamicSharedMemorySize, LDS_BYTES) != hipSuccess) { fprintf(stderr, "kernel_launch: hipFuncSetAttribute failed\n"); grid = -1; return; }
        if (hipOccupancyMaxActiveBlocksPerMultiprocessor(&per_cu, (const void*)hybrid_fwd, 512, LDS_BYTES) != hipSuccess || per_cu < 1) { fprintf(stderr, "kernel_launch: occupancy query says %d\n", per_cu); per_cu = 1; }
        (void)hipGetLastError();
        grid = cus > 0 ? cus : 256;
    }
    if (grid < 0) return;
    Args a{};
    for (int i = 0; i < 33; ++i) a.in[i] = (const float*)d_in[i];
    a.out = (float*)d_out; a.ws = (unsigned char*)d_ws;
    void* args[] = {&a};
    hipError_t e = hipLaunchCooperativeKernel((const void*)hybrid_fwd, dim3(grid), dim3(512), args, LDS_BYTES, stream);
    if (e != hipSuccess) fprintf(stderr, "kernel_launch: cooperative launch failed: %s (grid %d)\n", hipGetErrorString(e), grid);
}
```

```cpp
#include <hip/hip_runtime.h>
#include <hip/hip_cooperative_groups.h>
#include <cstdio>
#include <cstdint>
namespace cg = cooperative_groups;
#define NO_SMALL 1
#ifndef REP_PREP
#define REP_PREP 1
#endif
#ifndef REP_SCAN
#define REP_SCAN 1
#endif
#ifndef REP_ATTN
#define REP_ATTN 1
#endif
#ifndef REP_UP
#define REP_UP 1
#endif

#define LAS __attribute__((address_space(3)))
#define GAS __attribute__((address_space(1)))
typedef unsigned short bf16_t;
typedef short bf16x8 __attribute__((ext_vector_type(8)));
typedef short bf16x4 __attribute__((ext_vector_type(4)));
typedef float f32x2 __attribute__((ext_vector_type(2)));
typedef float f32x4 __attribute__((ext_vector_type(4)));
typedef float f32x16 __attribute__((ext_vector_type(16)));
typedef unsigned u32x4 __attribute__((ext_vector_type(4)));
typedef unsigned u32x2 __attribute__((ext_vector_type(2)));

constexpr int D = 1024, NB = 32, SEQ = 2048, NDB = 16, DSEQ = 64, DEPTH = 2;
constexpr int TP = NB * SEQ, TS = NDB * DSEQ, T = TP + TS;
constexpr int NMEM = 256, TM = NB * NMEM, TMS = NDB * NMEM;
constexpr int DFF = 4096, CH = 512;
constexpr float EPS = 1e-6f;
constexpr size_t O_YP = 0, O_YS = O_YP + (size_t)TP * D, O_CONVP = O_YS + (size_t)TS * D, O_REP = O_CONVP + (size_t)DEPTH * NB * 2 * CH,
                 O_IMP = O_REP + (size_t)DEPTH * NB * 32 * 64, O_MKP = O_IMP + (size_t)DEPTH * NB * 32 * 64, O_MVP = O_MKP + (size_t)DEPTH * TM * D,
                 O_CONVS = O_MVP + (size_t)DEPTH * TM * D, O_RES = O_CONVS + (size_t)DEPTH * NDB * 2 * CH, O_IMS = O_RES + (size_t)DEPTH * NDB * 32 * 64,
                 O_END = O_IMS + (size_t)DEPTH * NDB * 32 * 64;
constexpr size_t MiB = 1u << 20;
constexpr size_t WS_SS = 0;
constexpr size_t WS_W = 4 * MiB, W_LAYER = 31 * MiB;
constexpr size_t W_IN = 0, W_GLU = 4 * MiB, W_OUT = 4 * MiB + MiB / 2, W_Q = 6 * MiB + MiB / 2, W_KV = 8 * MiB + MiB / 2, W_O = 12 * MiB + MiB / 2,
                 W_UP = 14 * MiB + MiB / 2, W_DOWN = 22 * MiB + MiB / 2;
constexpr size_t WS_XB = 66 * MiB;
constexpr size_t WS_MNB = 196 * MiB;
constexpr size_t WS_KB = 212 * MiB;
constexpr size_t WS_VT = 244 * MiB;
constexpr size_t WS_KC = 276 * MiB;
constexpr size_t WS_VTC = 292 * MiB;
constexpr size_t WS_BIG = 308 * MiB;
constexpr size_t SZ_T512 = (size_t)T * 512 * 2;
constexpr size_t WS_BG = WS_BIG, WS_XIN = WS_BG + SZ_T512, WS_U = WS_XIN + SZ_T512, WS_YG = WS_U + SZ_T512, WS_YCAT = WS_YG + SZ_T512;
constexpr size_t WS_Q = WS_BG, WS_O = WS_U, WS_HDN = WS_BIG;
constexpr size_t WS_SMALL = WS_BIG + (size_t)T * DFF * 2;
constexpr size_t WS_SCR = WS_SMALL + 4 * MiB;
constexpr size_t WS_END = WS_SCR + 16 * MiB;
constexpr int SM_ARE = 0, SM_AIM = 4096, SM_LOGDT = 8192, SM_BRE = 8256, SM_BIM = SM_BRE + 65536, SM_CRE = SM_BIM + 65536, SM_CIM = SM_CRE + 65536, SM_SD = SM_CIM + 65536,
              SM_CONVW = SM_SD + 1024, SM_SCONV = SM_CONVW + 3072, SM_SRE = SM_SCONV + 32768, SM_SIM = SM_SRE + 65536, SM_GFIN = SM_SIM + 65536, SM_END = SM_GFIN + 1024;
static_assert(WS_YCAT + 2 * SZ_T512 <= WS_END, "ws map");

constexpr int LDS_BYTES = 256 * 528 + 1024;

template <class Tp> __device__ __forceinline__ Tp* as_global(Tp* p) {
#if defined(__HIP_DEVICE_COMPILE__)
    __builtin_assume(!__builtin_amdgcn_is_shared((const __attribute__((address_space(0))) void*)p) && !__builtin_amdgcn_is_private((const __attribute__((address_space(0))) void*)p));
#endif
    return p;
}
__device__ __forceinline__ unsigned cvt_pk_bf16(float lo, float hi) { unsigned r; asm volatile("v_cvt_pk_bf16_f32 %0, %1, %2" : "=v"(r) : "v"(lo), "v"(hi)); return r; }
__device__ __forceinline__ float bf_lo(unsigned w) { return __uint_as_float(w << 16); }
__device__ __forceinline__ float bf_hi(unsigned w) { return __uint_as_float(w & 0xffff0000u); }
__device__ __forceinline__ float wave_sum(float v) {
#pragma unroll
    for (int o = 1; o < 64; o <<= 1) v += __shfl_xor(v, o);
    return v;
}
#define LDS_WAIT() asm volatile("s_waitcnt lgkmcnt(0)" ::: "memory")

namespace pg8 {
constexpr int BM = 256, BK = 64, HALF = 128, HTB = HALF * BK * 2, STAGE_BYTES = 8 * HTB, NXCD = 8, WGM = 8;
__host__ __device__ __forceinline__ int lds_byte(int r, int c) { const int st = (r >> 4) * 2 + (c >> 5), rr = r & 15, cc = c & 31, ob = rr * 64 + cc * 2; return st * 1024 + (ob ^ (((ob >> 9) & 1) << 5)); }
__host__ __device__ __forceinline__ void stage_rc(int b, int& R, int& C) { const int st = b / 1024, sb = b % 1024, swz = sb ^ (((sb >> 9) & 1) << 5); R = (st >> 1) * 16 + swz / 64; C = (st & 1) * 32 + (swz % 64) / 2; }
__host__ __device__ __forceinline__ int perm32(int rho) { const int n = rho >> 4, i = rho & 15; return 8 * (i >> 2) + 4 * n + (i & 3); }

struct Unit { int pm, pn, ko; };
struct Gemm { const bf16_t* A; const bf16_t* Bt; int M, N, K, lda, ldb; };

struct StaticOrder {
    int nM, nN, nwg, G, c;
    __device__ void init(int M, int N, int G_, int c_) { nM = M / BM; nN = N / BM; nwg = nM * nN; G = G_; c = c_; }
    __device__ bool next(int i, Unit& u) const {
        const long L = (long)i * G + c; if (L >= nwg) return false;
        int wgid = (int)L; { const int q = nwg / NXCD, r = nwg % NXCD, xcd = wgid % NXCD, off = wgid / NXCD; wgid = (xcd < r ? xcd * (q + 1) : r * (q + 1) + (xcd - r) * q) + off; }
        const int nig = WGM * nN, gid = wgid / nig, fm = gid * WGM, gsz = (nM - fm) < WGM ? (nM - fm) : WGM;
        u.pm = fm + ((wgid % nig) % gsz); u.pn = (wgid % nig) / gsz; u.ko = 0; return true;
    }
};
struct KSplitOrder {
    int nN, nS, nwg, G, c, kslice_bytes;
    __device__ void init(int M, int N, int nS_, int kslice, int G_, int c_) { nN = N / BM; nS = nS_; nwg = (M / BM) * nN * nS; G = G_; c = c_; kslice_bytes = kslice * 2; }
    __device__ bool next(int i, Unit& u) const {
        const long L = (long)i * G + c; if (L >= nwg) return false;
        const int l = (int)L, sidx = l % nS, t = l / nS; u.pn = t % nN; u.pm = t / nN; u.ko = sidx * kslice_bytes; return true;
    }
};

template <class Epi, bool SP2, class Sched>
__device__ __forceinline__ void gemm_phase(LAS unsigned char* lds, const Gemm g, const Sched& S, const Epi& E) {
    int tid = threadIdx.x; asm volatile("" : "+v"(tid));
    const int wid = __builtin_amdgcn_readfirstlane(tid >> 6), lane = tid & 63, wr = wid >> 2, wc = wid & 3, fr = lane & 15, fq = lane >> 4;
    const int K = g.K, nt = K / BK;
    unsigned voffA[2], voffB[2];
#pragma unroll
    for (int i = 0; i < 2; ++i) { int R, C; stage_rc(tid * 16 + i * 8192, R, C); const int Rb = Epi::PERM ? ((R & ~31) + perm32(R & 31)) : R;
        voffA[i] = (unsigned)(R * g.lda + C) * 2u; voffB[i] = (unsigned)(Rb * g.ldb + C) * 2u; }
    const size_t kstep = (size_t)(BK * 2);
    const size_t hstep = (size_t)HALF * g.lda * 2, hstepB = (size_t)HALF * g.ldb * 2;
    const size_t tstep = 2 * hstep, tstepB = 2 * hstepB;
    const unsigned ldsw = (unsigned)wid * 1024u;
    const int aoff = lds_byte(wr * 64 + fr, fq * 8), boff = lds_byte(wc * 32 + fr, fq * 8);
#define PG8_SA(b, h) (((b) * 2 + (h)) * HTB)
#define PG8_SB(b, h) ((4 + (b) * 2 + (h)) * HTB)
#define PG8_STAGE(bufoff, gbase, voff) do { _Pragma("unroll") for (int _i = 0; _i < 2; ++_i) \
        __builtin_amdgcn_global_load_lds((const unsigned*)((const char*)(gbase) + (voff)[_i]), (LAS unsigned*)(lds + (bufoff) + ldsw + _i * 8192), 16, 0, 0); } while (0)
#define PG8_LDA(dst, b, h) do { _Pragma("unroll") for (int m = 0; m < 4; ++m) _Pragma("unroll") for (int k = 0; k < 2; ++k) dst[m][k] = *(const LAS bf16x8*)(lds + PG8_SA(b, h) + aoff + m * 2048 + k * 1024); } while (0)
#define PG8_LDB(dst, b, h) do { _Pragma("unroll") for (int n = 0; n < 2; ++n) _Pragma("unroll") for (int k = 0; k < 2; ++k) dst[n][k] = *(const LAS bf16x8*)(lds + PG8_SB(b, h) + boff + n * 2048 + k * 1024); } while (0)
#define PG8_MMA(ai, bj, At, Bt) do { __builtin_amdgcn_s_setprio(1); _Pragma("unroll") for (int m = 0; m < 4; ++m) _Pragma("unroll") for (int n = 0; n < 2; ++n) _Pragma("unroll") for (int k = 0; k < 2; ++k) \
        acc[ai][bj][m][n] = __builtin_amdgcn_mfma_f32_16x16x32_bf16(Bt[n][k], At[m][k], acc[ai][bj][m][n], 0, 0, 0); __builtin_amdgcn_s_setprio(0); } while (0)
#define PG8_WAIT_V(n) asm volatile("s_waitcnt vmcnt(" #n ")" ::: "memory")
#define PG8_WAIT_L(n) asm volatile("s_waitcnt lgkmcnt(" #n ")" ::: "memory")
#define PG8_BAR __builtin_amdgcn_s_barrier()
#define PG8_SCHED __builtin_amdgcn_sched_barrier(0)
    Unit cur, nxt; int ui = 0;
    if (!S.next(0, cur)) return;
    f32x4 acc[2][2][4][2];
#pragma unroll
    for (int a = 0; a < 2; ++a)
#pragma unroll
        for (int b = 0; b < 2; ++b)
#pragma unroll
            for (int m = 0; m < 4; ++m)
#pragma unroll
                for (int n = 0; n < 2; ++n) acc[a][b][m][n] = (f32x4){0.f, 0.f, 0.f, 0.f};
    bf16x8 At[4][2], B0[2][2], B1[2][2];
    const char* cA = (const char*)g.A + (size_t)cur.pm * tstep + cur.ko; const char* cB = (const char*)g.Bt + (size_t)cur.pn * tstepB + cur.ko;
    if constexpr (SP2) {
        PG8_STAGE(PG8_SB(0, 0), cB, voffB); PG8_STAGE(PG8_SB(0, 1), cB + hstepB, voffB); PG8_STAGE(PG8_SA(0, 0), cA, voffA); PG8_STAGE(PG8_SA(0, 1), cA + hstep, voffA);
        if (wr == 1) PG8_BAR;
        PG8_WAIT_V(2); PG8_BAR;
        PG8_STAGE(PG8_SB(1, 0), cB + kstep, voffB); PG8_STAGE(PG8_SA(1, 0), cA + kstep, voffA); PG8_STAGE(PG8_SB(1, 1), cB + hstepB + kstep, voffB);
        PG8_WAIT_V(6); PG8_BAR;
    } else {
        PG8_STAGE(PG8_SB(0, 0), cB, voffB); PG8_STAGE(PG8_SA(0, 0), cA, voffA); PG8_STAGE(PG8_SB(0, 1), cB + hstepB, voffB); PG8_STAGE(PG8_SA(0, 1), cA + hstep, voffA);
        if (wr == 1) PG8_BAR;
        PG8_WAIT_V(4); PG8_BAR;
        PG8_STAGE(PG8_SB(1, 0), cB + kstep, voffB); PG8_STAGE(PG8_SA(1, 0), cA + kstep, voffA); PG8_STAGE(PG8_SB(1, 1), cB + hstepB + kstep, voffB);
        PG8_WAIT_V(6); PG8_BAR;
    }
    for (;;) {
        const bool has_next = S.next(ui + 1, nxt);
        const char* nA = has_next ? (const char*)g.A + (size_t)nxt.pm * tstep + nxt.ko : cA; const char* nB = has_next ? (const char*)g.Bt + (size_t)nxt.pn * tstepB + nxt.ko : cB;
        for (int t = 0; t < nt; t += 2) {
            const bool last = (t == nt - 2);
            const char* a1 = cA + (size_t)(t + 1) * kstep;
            const char* a2 = last ? nA : cA + (size_t)(t + 2) * kstep; const char* b2 = last ? nB : cB + (size_t)(t + 2) * kstep;
            const char* a3 = a2 + kstep; const char* b3 = b2 + kstep;
            if constexpr (Epi::MID) { if (t == (nt >> 1)) E.mid(acc, cur, wr, fr); }
            if constexpr (SP2) {
            PG8_LDB(B0, 0, 0); PG8_LDB(B1, 0, 1); PG8_SCHED; PG8_LDA(At, 0, 0); PG8_STAGE(PG8_SA(1, 1), a1 + hstep, voffA);
            PG8_WAIT_V(8); PG8_WAIT_L(0); PG8_BAR; PG8_MMA(0, 0, At, B0); PG8_MMA(0, 1, At, B1); PG8_BAR; PG8_SCHED;
            PG8_LDA(At, 0, 1); PG8_STAGE(PG8_SB(0, 0), b2, voffB); PG8_STAGE(PG8_SB(0, 1), b2 + hstepB, voffB); PG8_STAGE(PG8_SA(0, 0), a2, voffA);
            PG8_WAIT_V(8); PG8_WAIT_L(0); PG8_BAR; PG8_MMA(1, 0, At, B0); PG8_MMA(1, 1, At, B1); PG8_BAR; PG8_SCHED;
            PG8_LDB(B0, 1, 0); PG8_LDB(B1, 1, 1); PG8_SCHED; PG8_LDA(At, 1, 0); PG8_STAGE(PG8_SA(0, 1), a2 + hstep, voffA);
            PG8_WAIT_V(8); PG8_WAIT_L(0); PG8_BAR; PG8_MMA(0, 0, At, B0); PG8_MMA(0, 1, At, B1); PG8_BAR; PG8_SCHED;
            PG8_LDA(At, 1, 1); PG8_STAGE(PG8_SB(1, 0), b3, voffB); PG8_STAGE(PG8_SB(1, 1), b3 + hstepB, voffB); PG8_STAGE(PG8_SA(1, 0), a3, voffA);
            PG8_WAIT_V(8); PG8_WAIT_L(0); PG8_BAR; PG8_MMA(1, 0, At, B0); PG8_MMA(1, 1, At, B1); PG8_BAR; PG8_SCHED;
            } else {
            PG8_LDB(B0, 0, 0); PG8_SCHED; PG8_LDA(At, 0, 0); PG8_STAGE(PG8_SA(1, 1), a1 + hstep, voffA);
            PG8_WAIT_L(8); PG8_BAR; PG8_WAIT_L(0); PG8_MMA(0, 0, At, B0); PG8_BAR; PG8_SCHED;
            PG8_LDB(B1, 0, 1); PG8_STAGE(PG8_SB(0, 0), b2, voffB);
            PG8_BAR; PG8_WAIT_L(0); PG8_MMA(0, 1, At, B1); PG8_BAR;
            PG8_LDA(At, 0, 1); PG8_STAGE(PG8_SA(0, 0), a2, voffA);
            PG8_BAR; PG8_WAIT_L(0); PG8_MMA(1, 0, At, B0); PG8_BAR; PG8_SCHED;
            PG8_STAGE(PG8_SB(0, 1), b2 + hstepB, voffB);
            PG8_WAIT_V(6); PG8_BAR; PG8_MMA(1, 1, At, B1); PG8_BAR;
            PG8_LDB(B0, 1, 0); PG8_SCHED; PG8_LDA(At, 1, 0); PG8_STAGE(PG8_SA(0, 1), a2 + hstep, voffA);
            PG8_WAIT_L(8); PG8_BAR; PG8_WAIT_L(0); PG8_MMA(0, 0, At, B0); PG8_BAR; PG8_SCHED;
            PG8_LDB(B1, 1, 1); PG8_STAGE(PG8_SB(1, 0), b3, voffB);
            PG8_BAR; PG8_WAIT_L(0); PG8_MMA(0, 1, At, B1); PG8_BAR;
            PG8_LDA(At, 1, 1); PG8_STAGE(PG8_SA(1, 0), a3, voffA);
            PG8_BAR; PG8_WAIT_L(0); PG8_MMA(1, 0, At, B0); PG8_BAR; PG8_SCHED;
            PG8_STAGE(PG8_SB(1, 1), b3 + hstepB, voffB);
            PG8_WAIT_V(6); PG8_BAR; PG8_MMA(1, 1, At, B1); PG8_BAR;
            }
        }
        if (wr == 0) PG8_BAR;
        E(acc, cur, wr, wc, fr, fq);
        if (!has_next) break;
#pragma unroll
        for (int a = 0; a < 2; ++a)
#pragma unroll
            for (int b = 0; b < 2; ++b)
#pragma unroll
                for (int m = 0; m < 4; ++m)
#pragma unroll
                    for (int n = 0; n < 2; ++n) acc[a][b][m][n] = (f32x4){0.f, 0.f, 0.f, 0.f};
        cur = nxt; cA = nA; cB = nB; ++ui;
        if (wr == 1) PG8_BAR;
    }
    PG8_WAIT_V(0);
    PG8_BAR;
#undef PG8_SA
#undef PG8_SB
#undef PG8_STAGE
#undef PG8_LDA
#undef PG8_LDB
#undef PG8_MMA
#undef PG8_WAIT_V
#undef PG8_WAIT_L
#undef PG8_BAR
#undef PG8_SCHED
}
}
using pg8::Unit;
typedef f32x4 Acc[2][2][4][2];

__device__ __forceinline__ void store8_bf16(bf16_t* p, const f32x4& a, const f32x4& b) {
    u32x4 w; w.x = cvt_pk_bf16(a[0], a[1]); w.y = cvt_pk_bf16(a[2], a[3]); w.z = cvt_pk_bf16(b[0], b[1]); w.w = cvt_pk_bf16(b[2], b[3]);
    *(GAS u32x4*)p = w;
}
__device__ __forceinline__ void unpack8(const u32x4 w, f32x4& a, f32x4& b) {
    a = (f32x4){bf_lo(w.x), bf_hi(w.x), bf_lo(w.y), bf_hi(w.y)}; b = (f32x4){bf_lo(w.z), bf_hi(w.z), bf_lo(w.w), bf_hi(w.w)};
}

struct EpiInProj {
    static constexpr bool PERM = true, MID = false;
    bf16_t* BG; bf16_t* XIN; bf16_t* U; const float* ss; float* convp; float* convs;
    __device__ __forceinline__ int brow(int cb, int f) const {
        const int cg = cb >> 5;
        if (cg < 16) return cb + 16 * f;
        if (cg >= 48) return 1536 + 32 * (cg - 48) + 16 * f;
        const int c = 16 * (cg - 16), q = c >> 7, r = c & 127;
        return 512 + 256 * q + 128 * f + r;
    }
    __device__ __forceinline__ void small(const f32x4 (&acc)[2][2], int r0, int cb, int fr, int fq) const {
        const int cg = cb >> 5;
#pragma unroll
        for (int m = 0; m < 2; ++m) {
            const int r = r0 + 16 * m + fr; const float inv = rsqrtf(((const GAS float*)ss)[r] * (1.0f / D) + EPS);
            if (cg < 16 || cg >= 48) {
                bf16_t* dst = (cg < 16 ? BG + (size_t)r * CH + cb : U + (size_t)r * CH + (cb - 1536)) + 4 * fq;
#pragma unroll
                for (int f = 0; f < 2; ++f) { const f32x4 v = acc[m][f] * inv; u32x2 w; w.x = cvt_pk_bf16(v[0], v[1]); w.y = cvt_pk_bf16(v[2], v[3]); *(GAS u32x2*)(dst + 16 * f) = w; }
            } else {
                const int c0 = 16 * (cg - 16) + 4 * fq;
                const f32x4 x = (acc[m][0] * inv) * (acc[m][1] * inv);
                u32x2 w; w.x = cvt_pk_bf16(x[0], x[1]); w.y = cvt_pk_bf16(x[2], x[3]); *(GAS u32x2*)(XIN + (size_t)r * CH + c0) = w;
                const int rs = r - TP, t = rs & (DSEQ - 1);
                if (t >= DSEQ - 2) *(GAS f32x4*)(convs + ((size_t)(rs >> 6) * 2 + (t - (DSEQ - 2))) * CH + c0) = x;
            }
        }
    }
    __device__ __forceinline__ void operator()(const Acc& acc, const Unit& u, int wr, int wc, int fr, int fq) const {
        const int row0 = u.pm * 256 + wr * 64 + fr, cb = wc * 32 + 8 * fq;
#pragma unroll
        for (int ai = 0; ai < 2; ++ai)
#pragma unroll
            for (int m = 0; m < 4; ++m) {
                const int r = row0 + ai * 128 + m * 16;
                const float inv = rsqrtf(((const GAS float*)ss)[r] * (1.0f / D) + EPS);
                if (u.pn < 2 || u.pn >= 6) {
                    bf16_t* dst = (u.pn < 2 ? BG : U) + (size_t)r * CH + (u.pn & 1) * 256 + cb;
#pragma unroll
                    for (int bj = 0; bj < 2; ++bj) store8_bf16(dst + bj * 128, acc[ai][bj][m][0] * inv, acc[ai][bj][m][1] * inv);
                } else {
                    const int c0 = (u.pn - 2) * 128 + cb;
                    const f32x4 x0 = (acc[ai][0][m][0] * inv) * (acc[ai][1][m][0] * inv), x1 = (acc[ai][0][m][1] * inv) * (acc[ai][1][m][1] * inv);
                    store8_bf16(XIN + (size_t)r * CH + c0, x0, x1);
                    float* cd = nullptr;
                    if (r < TP) { const int t = r & (SEQ - 1); if (t >= SEQ - 2) cd = convp + ((size_t)(r >> 11) * 2 + (t - (SEQ - 2))) * CH + c0; }
                    else { const int rs = r - TP, t = rs & (DSEQ - 1); if (t >= DSEQ - 2) cd = convs + ((size_t)(rs >> 6) * 2 + (t - (DSEQ - 2))) * CH + c0; }
                    if (cd) { *(GAS f32x4*)cd = x0; *(GAS f32x4*)(cd + 4) = x1; }
                }
            }
    }
};
struct EpiKV {
    static constexpr bool PERM = false, MID = false;
    float* outK; float* outV; bf16_t* KB; const float* invm;
    __device__ __forceinline__ void operator()(const Acc& acc, const Unit& u, int wr, int wc, int fr, int fq) const {
        const int row0 = u.pm * 256 + wr * 64 + fr, col0 = (u.pn & 3) * 256 + wc * 32 + 4 * fq;
        float* outp = u.pn < 4 ? outK : outV;
#pragma unroll
        for (int ai = 0; ai < 2; ++ai)
#pragma unroll
            for (int m = 0; m < 4; ++m) {
                const int r = row0 + ai * 128 + m * 16; const float inv = ((const GAS float*)invm)[r];
#pragma unroll
                for (int bj = 0; bj < 2; ++bj)
#pragma unroll
                    for (int n = 0; n < 2; ++n) {
                        const f32x4 v = acc[ai][bj][m][n] * inv; const size_t o = (size_t)r * D + col0 + bj * 128 + n * 16;
                        *(GAS f32x4*)(outp + o) = v;
                        if (u.pn < 4) { u32x2 w; w.x = cvt_pk_bf16(v[0], v[1]); w.y = cvt_pk_bf16(v[2], v[3]); *(GAS u32x2*)(KB + o) = w; }
                    }
            }
    }
};
struct EpiVT {
    static constexpr bool PERM = true, MID = false;
    bf16_t* VT; const float* invm;
    __device__ __forceinline__ void operator()(const Acc& acc, const Unit& u, int wr, int wc, int fr, int fq) const {
        const int row0 = u.pm * 256 + wr * 64 + fr, col0 = u.pn * 256 + wc * 32 + 8 * fq;
        f32x4 s[2][2];
#pragma unroll
        for (int bj = 0; bj < 2; ++bj) { s[bj][0] = *(const GAS f32x4*)(invm + col0 + bj * 128); s[bj][1] = *(const GAS f32x4*)(invm + col0 + bj * 128 + 4); }
#pragma unroll
        for (int ai = 0; ai < 2; ++ai)
#pragma unroll
            for (int m = 0; m < 4; ++m) {
                const int r = row0 + ai * 128 + m * 16;
#pragma unroll
                for (int bj = 0; bj < 2; ++bj) store8_bf16(VT + (size_t)r * TM + col0 + bj * 128, acc[ai][bj][m][0] * s[bj][0], acc[ai][bj][m][1] * s[bj][1]);
            }
    }
};
struct EpiGLU {
    static constexpr bool PERM = true, MID = false;
    const bf16_t* YG; bf16_t* YCAT; float* ssb;
    __device__ __forceinline__ int brow(int cb, int f) const { return cb + 16 * f; }
    __device__ __forceinline__ void small(const f32x4 (&acc)[2][2], int r0, int cb, int fr, int fq) const {
#pragma unroll
        for (int m = 0; m < 2; ++m) {
            const int r = r0 + 16 * m + fr; float ssum = 0.f;
#pragma unroll
            for (int f = 0; f < 2; ++f) {
                const int c = cb + 16 * f + 4 * fq; const u32x2 yw = *(const GAS u32x2*)(YG + (size_t)r * CH + c);
                f32x4 y = (f32x4){bf_lo(yw.x), bf_hi(yw.x), bf_lo(yw.y), bf_hi(yw.y)};
#pragma unroll
                for (int e = 0; e < 4; ++e) { y[e] = y[e] * __builtin_amdgcn_rcpf(1.0f + __expf(-acc[m][f][e])); ssum += y[e] * y[e]; }
                u32x2 w; w.x = cvt_pk_bf16(y[0], y[1]); w.y = cvt_pk_bf16(y[2], y[3]); *(GAS u32x2*)(YCAT + (size_t)r * D + c) = w;
            }
            ssum += __shfl_xor(ssum, 16); ssum += __shfl_xor(ssum, 32);
            if (fq == 0) atomicAdd(ssb + r, ssum);
        }
    }
    __device__ __forceinline__ void operator()(const Acc& acc, const Unit& u, int wr, int wc, int fr, int fq) const {
        const int row0 = u.pm * 256 + wr * 64 + fr, col0 = u.pn * 256 + wc * 32 + 8 * fq;
#pragma unroll
        for (int ai = 0; ai < 2; ++ai)
#pragma unroll
            for (int m = 0; m < 4; ++m) {
                const int r = row0 + ai * 128 + m * 16; float ssum = 0.f;
#pragma unroll
                for (int bj = 0; bj < 2; ++bj) {
                    f32x4 y0, y1; unpack8(*(const GAS u32x4*)(YG + (size_t)r * CH + col0 + bj * 128), y0, y1);
                    f32x4 z0 = acc[ai][bj][m][0], z1 = acc[ai][bj][m][1];
#pragma unroll
                    for (int e = 0; e < 4; ++e) { y0[e] = y0[e] * __builtin_amdgcn_rcpf(1.0f + __expf(-z0[e])); y1[e] = y1[e] * __builtin_amdgcn_rcpf(1.0f + __expf(-z1[e]));
                        ssum += y0[e] * y0[e] + y1[e] * y1[e]; }
                    store8_bf16(YCAT + (size_t)r * D + col0 + bj * 128, y0, y1);
                }
                ssum += __shfl_xor(ssum, 16); ssum += __shfl_xor(ssum, 32);
                if (fq == 0) atomicAdd(ssb + r, ssum);
            }
    }
};
template <bool MIDS> struct EpiRes {
    static constexpr bool PERM = true, MID = MIDS;
    bf16_t* XB; float* ssout; const float* ssb;
    __device__ __forceinline__ int brow(int cb, int f) const { return cb + 16 * f; }
    __device__ __forceinline__ void mid_small(f32x4 (&acc)[2][2], int r0, int fr) const {
#pragma unroll
        for (int m = 0; m < 2; ++m) { const float sc = rsqrtf(((const GAS float*)ssb)[r0 + 16 * m + fr] * (1.0f / CH) + EPS); acc[m][0] *= sc; acc[m][1] *= sc; }
    }
    __device__ __forceinline__ void small(const f32x4 (&acc)[2][2], int r0, int cb, int fr, int fq) const {
#pragma unroll
        for (int m = 0; m < 2; ++m) {
            const int r = r0 + 16 * m + fr; float ssum = 0.f;
#pragma unroll
            for (int f = 0; f < 2; ++f) {
                bf16_t* p = XB + (size_t)r * D + cb + 16 * f + 4 * fq; const u32x2 xw = *(const GAS u32x2*)p;
                f32x4 x = (f32x4){bf_lo(xw.x), bf_hi(xw.x), bf_lo(xw.y), bf_hi(xw.y)} + acc[m][f];
#pragma unroll
                for (int e = 0; e < 4; ++e) ssum += x[e] * x[e];
                u32x2 w; w.x = cvt_pk_bf16(x[0], x[1]); w.y = cvt_pk_bf16(x[2], x[3]); *(GAS u32x2*)p = w;
            }
            ssum += __shfl_xor(ssum, 16); ssum += __shfl_xor(ssum, 32);
            if (fq == 0) atomicAdd(ssout + r, ssum);
        }
    }
    __device__ __forceinline__ void mid(Acc& acc, const Unit& u, int wr, int fr) const {
        const int row0 = u.pm * 256 + wr * 64 + fr;
#pragma unroll
        for (int ai = 0; ai < 2; ++ai)
#pragma unroll
            for (int m = 0; m < 4; ++m) {
                const float s = rsqrtf(((const GAS float*)ssb)[row0 + ai * 128 + m * 16] * (1.0f / CH) + EPS);
#pragma unroll
                for (int bj = 0; bj < 2; ++bj)
#pragma unroll
                    for (int n = 0; n < 2; ++n) acc[ai][bj][m][n] *= s;
            }
    }
    __device__ __forceinline__ void operator()(const Acc& acc, const Unit& u, int wr, int wc, int fr, int fq) const {
        const int row0 = u.pm * 256 + wr * 64 + fr, col0 = u.pn * 256 + wc * 32 + 8 * fq;
#pragma unroll
        for (int ai = 0; ai < 2; ++ai)
#pragma unroll
            for (int m = 0; m < 4; ++m) {
                const int r = row0 + ai * 128 + m * 16; float ssum = 0.f;
#pragma unroll
                for (int bj = 0; bj < 2; ++bj) {
                    bf16_t* p = XB + (size_t)r * D + col0 + bj * 128;
                    f32x4 x0, x1; unpack8(*(const GAS u32x4*)p, x0, x1);
                    x0 += acc[ai][bj][m][0]; x1 += acc[ai][bj][m][1];
#pragma unroll
                    for (int e = 0; e < 4; ++e) ssum += x0[e] * x0[e] + x1[e] * x1[e];
                    store8_bf16(p, x0, x1);
                }
                ssum += __shfl_xor(ssum, 16); ssum += __shfl_xor(ssum, 32);
                if (fq == 0) atomicAdd(ssout + r, ssum);
            }
    }
};
template <int ACT> struct EpiScale {
    static constexpr bool PERM = true, MID = false;
    bf16_t* OUT; int ldc; const float* ss;
    __device__ __forceinline__ int brow(int cb, int f) const { return cb + 16 * f; }
    __device__ __forceinline__ void small(const f32x4 (&acc)[2][2], int r0, int cb, int fr, int fq) const {
#pragma unroll
        for (int m = 0; m < 2; ++m) {
            const int r = r0 + 16 * m + fr; const float inv = rsqrtf(((const GAS float*)ss)[r] * (1.0f / D) + EPS);
#pragma unroll
            for (int f = 0; f < 2; ++f) {
                f32x4 v = acc[m][f] * inv;
                if (ACT == 1) {
#pragma unroll
                    for (int e = 0; e < 4; ++e) { const float a = fmaxf(v[e], 0.f); v[e] = a * a; }
                }
                u32x2 w; w.x = cvt_pk_bf16(v[0], v[1]); w.y = cvt_pk_bf16(v[2], v[3]); *(GAS u32x2*)(OUT + (size_t)r * ldc + cb + 16 * f + 4 * fq) = w;
            }
        }
    }
    __device__ __forceinline__ void operator()(const Acc& acc, const Unit& u, int wr, int wc, int fr, int fq) const {
        const int row0 = u.pm * 256 + wr * 64 + fr, col0 = u.pn * 256 + wc * 32 + 8 * fq;
#pragma unroll
        for (int ai = 0; ai < 2; ++ai)
#pragma unroll
            for (int m = 0; m < 4; ++m) {
                const int r = row0 + ai * 128 + m * 16; const float inv = rsqrtf(((const GAS float*)ss)[r] * (1.0f / D) + EPS);
#pragma unroll
                for (int bj = 0; bj < 2; ++bj) {
                    f32x4 v0 = acc[ai][bj][m][0] * inv, v1 = acc[ai][bj][m][1] * inv;
                    if (ACT == 1) {
#pragma unroll
                        for (int e = 0; e < 4; ++e) { const float a = fmaxf(v0[e], 0.f), b = fmaxf(v1[e], 0.f); v0[e] = a * a; v1[e] = b * b; }
                    }
                    store8_bf16(OUT + (size_t)r * ldc + col0 + bj * 128, v0, v1);
                }
            }
    }
};

template <class Epi>
__device__ __forceinline__ void small_gemm(const bf16_t* A, const bf16_t* Bt, int N, int K, const Epi& E, int c, int stride) {
    int tid = threadIdx.x; asm volatile("" : "+v"(tid));
    const int wave = __builtin_amdgcn_readfirstlane(tid >> 6), lane = tid & 63, fr = lane & 15, fq = lane >> 4;
    const int ntn = N >> 7, ntiles = (TS / 64) * ntn;
    if (c < 0) return;
    for (int tile = c; tile < ntiles; tile += stride) {
        const int tm = tile / ntn, tn = tile - tm * ntn;
        const int r0 = TP + tm * 64 + (wave >> 2) * 32, cb = tn * 128 + (wave & 3) * 32;
        const char* pa = (const char*)A + ((size_t)(r0 + fr) * K + 8 * fq) * 2;
        const char* pb0 = (const char*)Bt + ((size_t)(E.brow(cb, 0) + fr) * K + 8 * fq) * 2;
        const char* pb1 = (const char*)Bt + ((size_t)(E.brow(cb, 1) + fr) * K + 8 * fq) * 2;
        const size_t a16 = (size_t)16 * K * 2;
        f32x4 acc[2][2];
#pragma unroll
        for (int m = 0; m < 2; ++m)
#pragma unroll
            for (int f = 0; f < 2; ++f) acc[m][f] = (f32x4){0.f, 0.f, 0.f, 0.f};
        const int ng = K >> 7;
        bf16x8 A0[4], A1[4], B0[4], B1[4], C0[4], C1[4], D0[4], D1[4];
#define SG_LOAD(a0, a1, b0, b1, g) do { _Pragma("unroll") for (int j = 0; j < 4; ++j) { const size_t ko = (size_t)((g) * 4 + j) * 64; \
            a0[j] = *(const GAS bf16x8*)(pa + ko); a1[j] = *(const GAS bf16x8*)(pa + a16 + ko); b0[j] = *(const GAS bf16x8*)(pb0 + ko); b1[j] = *(const GAS bf16x8*)(pb1 + ko); } } while (0)
#define SG_MMA(a0, a1, b0, b1) do { _Pragma("unroll") for (int j = 0; j < 4; ++j) { \
            acc[0][0] = __builtin_amdgcn_mfma_f32_16x16x32_bf16(b0[j], a0[j], acc[0][0], 0, 0, 0); acc[0][1] = __builtin_amdgcn_mfma_f32_16x16x32_bf16(b1[j], a0[j], acc[0][1], 0, 0, 0); \
            acc[1][0] = __builtin_amdgcn_mfma_f32_16x16x32_bf16(b0[j], a1[j], acc[1][0], 0, 0, 0); acc[1][1] = __builtin_amdgcn_mfma_f32_16x16x32_bf16(b1[j], a1[j], acc[1][1], 0, 0, 0); } } while (0)
        SG_LOAD(A0, A1, B0, B1, 0);
        for (int g = 0; g < ng; g += 2) {
            if constexpr (Epi::MID) { if (g == (ng >> 1)) E.mid_small(acc, r0, fr); }
            SG_LOAD(C0, C1, D0, D1, g + 1);
            SG_MMA(A0, A1, B0, B1);
            if (g + 2 < ng) SG_LOAD(A0, A1, B0, B1, g + 2);
            SG_MMA(C0, C1, D0, D1);
        }
#undef SG_LOAD
#undef SG_MMA
        E.small(acc, r0, cb, fr, fq);
    }
}

struct EpiAtomic {
    static constexpr bool PERM = false, MID = false;
    float* SCR;
    __device__ __forceinline__ void operator()(const Acc& acc, const Unit& u, int wr, int wc, int fr, int fq) const {
        const int row0 = u.pm * 256 + wr * 64 + fr, col0 = u.pn * 256 + wc * 32 + 4 * fq;
        float* slab = SCR + (size_t)(u.ko >> 11) * TS * D;
#pragma unroll
        for (int ai = 0; ai < 2; ++ai)
#pragma unroll
            for (int m = 0; m < 4; ++m) {
                float* rp = slab + (size_t)(row0 + ai * 128 + m * 16) * D + col0;
#pragma unroll
                for (int bj = 0; bj < 2; ++bj)
#pragma unroll
                    for (int n = 0; n < 2; ++n) *(GAS f32x4*)(rp + bj * 128 + n * 16) = acc[ai][bj][m][n];
            }
    }
};
struct Args { const float* in[33]; float* out; unsigned char* ws; };
enum { I_XP = 0, I_XS, I_MEM, I_SCONV, I_SRE, I_SIM, I_CK, I_CV, I_GMIX, I_WIN, I_CONVW, I_ARE, I_AIM, I_LOGDT, I_BRE, I_BIM, I_CRE, I_CIM, I_SD, I_WGLU,
       I_GA, I_GB, I_WOUT, I_GX, I_GMEM, I_WQ, I_WK, I_WV, I_WO, I_GMLP, I_WUP, I_WDOWN, I_GFIN };

typedef const float* const __attribute__((address_space(4)))* KTab;
__device__ __forceinline__ KTab ktab() { unsigned long long p = (unsigned long long)__builtin_amdgcn_kernarg_segment_ptr(); asm volatile("" : "+s"(p)); return (KTab)p; }
__device__ __forceinline__ float* ss_arr(unsigned char* ws, int idx) { return (float*)(ws + WS_SS) + (size_t)idx * T; }
__device__ __forceinline__ float* invmem_arr(unsigned char* ws) { return (float*)(ws + WS_SS) + (size_t)9 * T; }

__device__ __forceinline__ int inproj_src_col(int vc) {
    if (vc < 512 || vc >= 1536) return vc;
    const int q = (vc - 512) >> 8, r = (vc - 512) & 255;
    return r < 128 ? 512 + q * 128 + r : 1024 + q * 128 + (r - 128);
}
__device__ __forceinline__ void transpose_item(const float* W, int ldw, int srck0, int srcn0, const float* gain, float gscale, bf16_t* WT, int ldt, int dn0, int dk0, LAS float* scr, int lane) {
#pragma unroll 8
    for (int i = 0; i < 32; ++i) { const int kk = 2 * i + (lane >> 5); float v = ((const GAS float*)W)[(size_t)(srck0 + kk) * ldw + srcn0 + (lane & 31)];
        const float gsc = gain ? ((const GAS float*)gain)[kk] * gscale : gscale; scr[kk * 33 + (lane & 31)] = v * gsc; }
    LDS_WAIT();
    const int c = lane & 7;
#pragma unroll
    for (int j = 0; j < 4; ++j) { const int n = (lane >> 3) + 8 * j; const LAS float* s = scr + (8 * c) * 33 + n;
        u32x4 o; o.x = cvt_pk_bf16(s[0 * 33], s[1 * 33]); o.y = cvt_pk_bf16(s[2 * 33], s[3 * 33]); o.z = cvt_pk_bf16(s[4 * 33], s[5 * 33]); o.w = cvt_pk_bf16(s[6 * 33], s[7 * 33]);
        *(GAS u32x4*)(WT + (size_t)(dn0 + n) * ldt + dk0 + 8 * c) = o; }
    LDS_WAIT();
}
__device__ __forceinline__ float convert_row(const float* src, bf16_t* dst, int lane) {
    const GAS f32x4* xr = (const GAS f32x4*)src + lane; f32x4 v[4]; float s = 0.f;
#pragma unroll
    for (int j = 0; j < 4; ++j) { v[j] = xr[64 * j]; s += (v[j][0] * v[j][0] + v[j][1] * v[j][1]) + (v[j][2] * v[j][2] + v[j][3] * v[j][3]); }
    GAS u32x2* o = (GAS u32x2*)dst + lane;
#pragma unroll
    for (int j = 0; j < 4; ++j) { u32x2 w; w.x = cvt_pk_bf16(v[j][0], v[j][1]); w.y = cvt_pk_bf16(v[j][2], v[j][3]); o[64 * j] = w; }
    return wave_sum(s);
}
constexpr int PI_IN = 1024, PI_GLU = 128, PI_SQ = 512, PI_UP = 2048, PI_CV = 2048;
constexpr int PI_LAYER = PI_IN + PI_GLU + 5 * PI_SQ + 2 * PI_UP + PI_CV;

__device__ __forceinline__ void prep_phase(unsigned char* ws, LAS unsigned char* lds, int gw, int NGW, int wave, int lane) {
    const KTab in = ktab();
    LAS float* scr = (LAS float*)(lds + wave * 8704);
    for (int it = gw; it < DEPTH * PI_LAYER; it += NGW) {
        const int l = it / PI_LAYER; int r = it - l * PI_LAYER;
        unsigned char* wl = ws + WS_W + (size_t)l * W_LAYER;
        if (r < PI_IN) { const int kb = r >> 6, nb = r & 63;
            transpose_item(as_global(in[I_WIN]) + (size_t)l * D * 2048, 2048, 64 * kb, inproj_src_col(32 * nb), as_global(in[I_GMIX]) + l * D + 64 * kb, 1.0f, (bf16_t*)(wl + W_IN), D, 32 * nb, 64 * kb, scr, lane); continue; }
        r -= PI_IN;
        if (r < PI_GLU) { const int kb = r >> 4, nb = r & 15;
            transpose_item(as_global(in[I_WGLU]) + (size_t)l * CH * CH, CH, 64 * kb, 32 * nb, nullptr, 1.0f, (bf16_t*)(wl + W_GLU), CH, 32 * nb, 64 * kb, scr, lane); continue; }
        r -= PI_GLU;
        if (r < PI_SQ) { const int kb = r >> 5, nb = r & 31, dk0 = 64 * kb;
            const float* gn = dk0 < 512 ? as_global(in[I_GB]) + l * CH + dk0 : as_global(in[I_GA]) + l * CH + dk0 - 512;
            transpose_item(as_global(in[I_WOUT]) + (size_t)l * D * D, D, (dk0 + 512) & 1023, 32 * nb, gn, 1.0f, (bf16_t*)(wl + W_OUT), D, 32 * nb, dk0, scr, lane); continue; }
        r -= PI_SQ;
        if (r < PI_SQ) { const int kb = r >> 5, nb = r & 31;
            transpose_item(as_global(in[I_WQ]) + (size_t)l * D * D, D, 64 * kb, 32 * nb, as_global(in[I_GX]) + l * D + 64 * kb, 0.0625f, (bf16_t*)(wl + W_Q), D, 32 * nb, 64 * kb, scr, lane); continue; }
        r -= PI_SQ;
        if (r < PI_SQ) { const int kb = r >> 5, nb = r & 31;
            transpose_item(as_global(in[I_WK]) + (size_t)l * D * D, D, 64 * kb, 32 * nb, as_global(in[I_GMEM]) + l * D + 64 * kb, 1.0f, (bf16_t*)(wl + W_KV), D, 32 * nb, 64 * kb, scr, lane); continue; }
        r -= PI_SQ;
        if (r < PI_SQ) { const int kb = r >> 5, nb = r & 31;
            transpose_item(as_global(in[I_WV]) + (size_t)l * D * D, D, 64 * kb, 32 * nb, as_global(in[I_GMEM]) + l * D + 64 * kb, 1.0f, (bf16_t*)(wl + W_KV), D, 1024 + 32 * nb, 64 * kb, scr, lane); continue; }
        r -= PI_SQ;
        if (r < PI_SQ) { const int kb = r >> 5, nb = r & 31;
            transpose_item(as_global(in[I_WO]) + (size_t)l * D * D, D, 64 * kb, 32 * nb, nullptr, 1.0f, (bf16_t*)(wl + W_O), D, 32 * nb, 64 * kb, scr, lane); continue; }
        r -= PI_SQ;
        if (r < PI_UP) { const int kb = r >> 7, nb = r & 127;
            transpose_item(as_global(in[I_WUP]) + (size_t)l * D * DFF, DFF, 64 * kb, 32 * nb, as_global(in[I_GMLP]) + l * D + 64 * kb, 1.0f, (bf16_t*)(wl + W_UP), D, 32 * nb, 64 * kb, scr, lane); continue; }
        r -= PI_UP;
        if (r < PI_UP) { const int kb = r >> 5, nb = r & 31;
            transpose_item(as_global(in[I_WDOWN]) + (size_t)l * DFF * D, D, 64 * kb, 32 * nb, nullptr, 1.0f, (bf16_t*)(wl + W_DOWN), DFF, 32 * nb, 64 * kb, scr, lane); continue; }
        r -= PI_UP;
        { const int kb = r >> 5, nb = r & 31;
            transpose_item(as_global(in[I_CV]) + (size_t)l * TMS * D, D, 64 * kb, 32 * nb, nullptr, 1.0f, (bf16_t*)(ws + WS_VTC) + (size_t)l * D * TMS, TMS, 32 * nb, 64 * kb, scr, lane); }
    }
    float* ss0 = ss_arr(ws, 0); float* invm = invmem_arr(ws);
    for (int m0 = gw * 2; m0 < T; m0 += NGW * 2) {
        const float* src = m0 < TP ? as_global(in[I_XP]) + (size_t)m0 * D : as_global(in[I_XS]) + (size_t)(m0 - TP) * D;
        const GAS f32x4* xr = (const GAS f32x4*)src + lane; f32x4 v[8]; float s0 = 0.f, s1 = 0.f;
#pragma unroll
        for (int j = 0; j < 8; ++j) v[j] = xr[64 * j];
#pragma unroll
        for (int j = 0; j < 4; ++j) { s0 += (v[j][0] * v[j][0] + v[j][1] * v[j][1]) + (v[j][2] * v[j][2] + v[j][3] * v[j][3]);
            s1 += (v[4 + j][0] * v[4 + j][0] + v[4 + j][1] * v[4 + j][1]) + (v[4 + j][2] * v[4 + j][2] + v[4 + j][3] * v[4 + j][3]); }
        GAS u32x2* o = (GAS u32x2*)((bf16_t*)(ws + WS_XB) + (size_t)m0 * D) + lane;
#pragma unroll
        for (int j = 0; j < 8; ++j) { u32x2 w; w.x = cvt_pk_bf16(v[j][0], v[j][1]); w.y = cvt_pk_bf16(v[j][2], v[j][3]); o[64 * j] = w; }
        s0 = wave_sum(s0); s1 = wave_sum(s1);
        if (lane == 0) { ((GAS float*)ss0)[m0] = s0; ((GAS float*)ss0)[m0 + 1] = s1; }
    }
    for (int m = T + gw; m < T + TM + 2 * TMS; m += NGW) {
        if (m < T) { const float* src = m < TP ? as_global(in[I_XP]) + (size_t)m * D : as_global(in[I_XS]) + (size_t)(m - TP) * D;
            const float s = convert_row(src, (bf16_t*)(ws + WS_XB) + (size_t)m * D, lane); if (lane == 0) ((GAS float*)ss0)[m] = s; }
        else if (m < T + TM) { const int mm = m - T; const float s = convert_row(as_global(in[I_MEM]) + (size_t)mm * D, (bf16_t*)(ws + WS_MNB) + (size_t)mm * D, lane);
            if (lane == 0) ((GAS float*)invm)[mm] = rsqrtf(s * (1.0f / D) + EPS); }
        else { const int mm = m - T - TM; (void)convert_row(as_global(in[I_CK]) + (size_t)mm * D, (bf16_t*)(ws + WS_KC) + (size_t)mm * D, lane); }
    }
    {
        float* sm = (float*)(ws + WS_SMALL); const int gt = gw * 64 + lane, NT = NGW * 64;
#define SMCOPY(off, idx, n) for (int i = gt; i < (n); i += NT) ((GAS float*)sm)[(off) + i] = ((const GAS float*)in[idx])[i]
        SMCOPY(SM_ARE, I_ARE, 4096); SMCOPY(SM_AIM, I_AIM, 4096); SMCOPY(SM_LOGDT, I_LOGDT, 64); SMCOPY(SM_BRE, I_BRE, 65536); SMCOPY(SM_BIM, I_BIM, 65536);
        SMCOPY(SM_CRE, I_CRE, 65536); SMCOPY(SM_CIM, I_CIM, 65536); SMCOPY(SM_SD, I_SD, 1024); SMCOPY(SM_CONVW, I_CONVW, 3072); SMCOPY(SM_SCONV, I_SCONV, 32768);
        SMCOPY(SM_SRE, I_SRE, 65536); SMCOPY(SM_SIM, I_SIM, 65536); SMCOPY(SM_GFIN, I_GFIN, 1024);
#undef SMCOPY
    }
    { float* z = ss_arr(ws, 1); const size_t n = (size_t)8 * T; for (size_t i = (size_t)gw * 64 + lane; i < n; i += (size_t)NGW * 64) ((GAS float*)z)[i] = 0.f; }
}

__device__ __forceinline__ float gelu_tanh(float x) {
    const float u = 0.7978845608f * (x + 0.044715f * x * x * x);
    const float e = __expf(2.0f * u);
    const float th = 1.0f - 2.0f * __builtin_amdgcn_rcpf(e + 1.0f);
    return 0.5f * x * (1.0f + th);
}
__device__ __forceinline__ void sincos_small(float x, float& s, float& c) {
    const float q = rintf(x * 0.63661977236f);
    float r = fmaf(-q, 1.57079637050628662109375f, x); r = fmaf(-q, -4.37113900018624283e-8f, r);
    const float r2 = r * r;
    const float sp = r + r * r2 * (-1.0f / 6 + r2 * (1.0f / 120 + r2 * (-1.0f / 5040 + r2 * (1.0f / 362880))));
    const float cp = 1.0f + r2 * (-0.5f + r2 * (1.0f / 24 + r2 * (-1.0f / 720 + r2 * (1.0f / 40320 + r2 * (-1.0f / 3628800)))));
    const int qi = (int)q & 3;
    s = (qi == 0) ? sp : (qi == 1) ? cp : (qi == 2) ? -sp : -cp;
    c = (qi == 0) ? cp : (qi == 1) ? -sp : (qi == 2) ? -cp : sp;
}
constexpr int BU_STRIDE = 528, H_STRIDE = 272, SCAN_LDS_WAVE = 16 * BU_STRIDE + 16 * H_STRIDE;

__device__ __forceinline__ void scan_item(unsigned char* ws, float* out, int l, int item, LAS unsigned char* wl, int lane_in) {
    int lane = lane_in; asm volatile("" : "+v"(lane));
    const GAS float* sm = (const GAS float*)(ws + WS_SMALL);
    int b, g, row0, nblk; const bool prompt = item < NB * 32;
    if (prompt) { b = item >> 5; g = item & 31; row0 = b * SEQ; nblk = SEQ / 16; }
    else { const int i2 = item - NB * 32; b = i2 >> 5; g = i2 & 31; row0 = TP + b * DSEQ; nblk = DSEQ / 16; }
    const bf16_t* U = (const bf16_t*)(ws + WS_U); bf16_t* YG = (bf16_t*)(ws + WS_YG);
    const int lg = l * 32 + g, p = lane, t16 = lane & 15, q = lane >> 4;
    const float are = fminf(sm[SM_ARE + lg * 64 + p], -1e-4f), aim = sm[SM_AIM + lg * 64 + p];
    const float dt = expf(sm[SM_LOGDT + lg]);
    float sn, cs; sincos_small(aim * dt, sn, cs);
    const float mag = expf(are * dt), abr = mag * cs, abi = mag * sn;
    const float nr = abr - 1.0f, ni = abi, den = 1.0f / (are * are + aim * aim);
    const float c0 = (nr * are + ni * aim) * den, c1 = (ni * are - nr * aim) * den;
    bf16x8 af[8];
#pragma unroll
    for (int f = 0; f < 8; ++f) {
        const int i = 16 * f + t16, ps = i >> 1, cc = i & 1;
        const float k0 = __shfl(c0, ps), k1 = __shfl(c1, ps);
        u32x4 w = (u32x4){0u, 0u, 0u, 0u};
        if (q < 2) {
            const GAS f32x4* br = (const GAS f32x4*)(sm + SM_BRE + ((size_t)lg * 64 + ps) * 16 + 8 * q); const GAS f32x4* bi = (const GAS f32x4*)(sm + SM_BIM + ((size_t)lg * 64 + ps) * 16 + 8 * q);
            const f32x4 r0 = br[0], r1 = br[1], i0 = bi[0], i1 = bi[1];
            f32x4 v0, v1;
            if (cc == 0) { v0 = k0 * r0 - k1 * i0; v1 = k0 * r1 - k1 * i1; } else { v0 = k0 * i0 + k1 * r0; v1 = k0 * i1 + k1 * r1; }
            w.x = cvt_pk_bf16(v0[0], v0[1]); w.y = cvt_pk_bf16(v0[2], v0[3]); w.z = cvt_pk_bf16(v1[0], v1[1]); w.w = cvt_pk_bf16(v1[2], v1[3]);
        }
        af[f] = __builtin_bit_cast(bf16x8, w);
    }
    bf16x8 cf[4];
#pragma unroll
    for (int s = 0; s < 4; ++s) {
        const int p0 = 16 * s + 4 * q;
        const f32x4 cr = *(const GAS f32x4*)(sm + SM_CRE + ((size_t)lg * 16 + t16) * 64 + p0), ci = *(const GAS f32x4*)(sm + SM_CIM + ((size_t)lg * 16 + t16) * 64 + p0);
        u32x4 w; w.x = cvt_pk_bf16(cr[0], -ci[0]); w.y = cvt_pk_bf16(cr[1], -ci[1]); w.z = cvt_pk_bf16(cr[2], -ci[2]); w.w = cvt_pk_bf16(cr[3], -ci[3]);
        cf[s] = __builtin_bit_cast(bf16x8, w);
    }
    const f32x4 dsk = *(const GAS f32x4*)(sm + SM_SD + l * CH + g * 16 + 4 * q);
    float hre = 0.f, him = 0.f;
    if (!prompt) { hre = sm[SM_SRE + (((size_t)l * NDB + b) * 32 + g) * 64 + p]; him = sm[SM_SIM + (((size_t)l * NDB + b) * 32 + g) * 64 + p]; }
    LAS unsigned char* BU = wl; LAS unsigned char* HB = wl + 16 * BU_STRIDE;
    const char* ubase = (const char*)U + (size_t)row0 * CH * 2; char* ybase = (char*)YG + (size_t)row0 * CH * 2;
    const unsigned lo8 = (unsigned)((t16 * CH + g * 16 + 8 * (q & 1)) * 2), lo4 = (unsigned)((t16 * CH + g * 16 + 4 * q) * 2);
    constexpr size_t BSTEP = (size_t)16 * CH * 2;
    constexpr int PD = 6;
    u32x4 ubuf[PD]; u32x2 ebuf[PD];
#pragma unroll
    for (int j = 0; j < PD; ++j) { ubuf[j] = (u32x4){0u, 0u, 0u, 0u}; ebuf[j] = (u32x2){0u, 0u};
        if (j < nblk) { const char* un = ubase + (size_t)j * BSTEP; if (q < 2) ubuf[j] = *(const GAS u32x4*)(un + lo8); ebuf[j] = *(const GAS u32x2*)(un + lo4); } }
    for (int tb0 = 0; tb0 < nblk; tb0 += PD) {
#pragma unroll
        for (int j = 0; j < PD; ++j) {
            const int tb = tb0 + j;
            if (tb < nblk) {
                const u32x4 ubc = ubuf[j]; const u32x2 uec = ebuf[j];
                if (tb + PD < nblk) { const char* un = ubase + (size_t)(tb + PD) * BSTEP; if (q < 2) ubuf[j] = *(const GAS u32x4*)(un + lo8); ebuf[j] = *(const GAS u32x2*)(un + lo4); }
                const bf16x8 bfrag = __builtin_bit_cast(bf16x8, ubc);
#pragma unroll
                for (int f = 0; f < 8; ++f) {
                    const f32x4 r = __builtin_amdgcn_mfma_f32_16x16x32_bf16(af[f], bfrag, (f32x4){0.f, 0.f, 0.f, 0.f}, 0, 0, 0);
                    *(LAS f32x4*)(BU + t16 * BU_STRIDE + (16 * f + 4 * q) * 4) = r;
                }
                LDS_WAIT();
                f32x2 buv[16];
#pragma unroll
                for (int t = 0; t < 16; ++t) buv[t] = *(const LAS f32x2*)(BU + t * BU_STRIDE + p * 8);
#pragma unroll
                for (int t = 0; t < 16; ++t) {
                    const float nre = fmaf(abr, hre, fmaf(-abi, him, buv[t][0])), nim = fmaf(abr, him, fmaf(abi, hre, buv[t][1]));
                    hre = nre; him = nim;
                    *(LAS unsigned*)(HB + t * H_STRIDE + p * 4) = cvt_pk_bf16(hre, him);
                }
                LDS_WAIT();
                f32x4 y = (f32x4){0.f, 0.f, 0.f, 0.f};
#pragma unroll
                for (int s2 = 0; s2 < 4; ++s2) {
                    const bf16x8 hf = *(const LAS bf16x8*)(HB + t16 * H_STRIDE + (32 * s2 + 8 * q) * 2);
                    y = __builtin_amdgcn_mfma_f32_16x16x32_bf16(cf[s2], hf, y, 0, 0, 0);
                }
                const float u0 = bf_lo(uec.x), u1 = bf_hi(uec.x), u2 = bf_lo(uec.y), u3 = bf_hi(uec.y);
                const float g0 = gelu_tanh(y[0] + dsk[0] * u0), g1 = gelu_tanh(y[1] + dsk[1] * u1), g2 = gelu_tanh(y[2] + dsk[2] * u2), g3 = gelu_tanh(y[3] + dsk[3] * u3);
                u32x2 w; w.x = cvt_pk_bf16(g0, g1); w.y = cvt_pk_bf16(g2, g3);
                *(GAS u32x2*)(ybase + (size_t)tb * BSTEP + lo4) = w;
                LDS_WAIT();
            }
        }
    }
    GAS float* outg = (GAS float*)out;
    if (prompt) { outg[O_REP + (((size_t)l * NB + b) * 32 + g) * 64 + p] = hre; outg[O_IMP + (((size_t)l * NB + b) * 32 + g) * 64 + p] = him; }
    else { outg[O_RES + (((size_t)l * NDB + b) * 32 + g) * 64 + p] = hre; outg[O_IMS + (((size_t)l * NDB + b) * 32 + g) * 64 + p] = him; }
}
__device__ __forceinline__ void conv_run(unsigned char* ws, int l, int run, int lane_in) {
    int lane = lane_in; asm volatile("" : "+v"(lane));
    const GAS float* sm = (const GAS float*)(ws + WS_SMALL);
    const bf16_t* XIN = (const bf16_t*)(ws + WS_XIN); const bf16_t* BG = (const bf16_t*)(ws + WS_BG); bf16_t* YCAT = (bf16_t*)(ws + WS_YCAT);
    const int row0 = run * 64, c0 = lane * 8;
    f32x4 w0a, w0b, w1a, w1b, w2a, w2b;
    { const GAS float* cw = sm + SM_CONVW + (size_t)l * 3 * CH + c0; w0a = *(const GAS f32x4*)cw; w0b = *(const GAS f32x4*)(cw + 4); w1a = *(const GAS f32x4*)(cw + CH); w1b = *(const GAS f32x4*)(cw + CH + 4);
      w2a = *(const GAS f32x4*)(cw + 2 * CH); w2b = *(const GAS f32x4*)(cw + 2 * CH + 4); }
    f32x4 p2a, p2b, p1a, p1b;
    const bool seq_start = row0 < TP ? ((row0 & (SEQ - 1)) == 0) : true;
    if (!seq_start) { unpack8(*(const GAS u32x4*)(XIN + (size_t)(row0 - 2) * CH + c0), p2a, p2b); unpack8(*(const GAS u32x4*)(XIN + (size_t)(row0 - 1) * CH + c0), p1a, p1b); }
    else if (row0 < TP) { p2a = p2b = p1a = p1b = (f32x4){0.f, 0.f, 0.f, 0.f}; }
    else { const int b = (row0 - TP) >> 6; const GAS float* st = sm + SM_SCONV + ((size_t)(l * NDB + b) * 2) * CH + c0;
        p2a = *(const GAS f32x4*)st; p2b = *(const GAS f32x4*)(st + 4); p1a = *(const GAS f32x4*)(st + CH); p1b = *(const GAS f32x4*)(st + CH + 4); }
    for (int tb = 0; tb < 64; tb += 8) {
        u32x4 xr[8], br[8];
#pragma unroll
        for (int j = 0; j < 8; ++j) { const size_t o = (size_t)(row0 + tb + j) * CH + c0; xr[j] = *(const GAS u32x4*)(XIN + o); br[j] = *(const GAS u32x4*)(BG + o); }
#pragma unroll
        for (int j = 0; j < 8; ++j) {
            f32x4 xa, xb, ba, bb; unpack8(xr[j], xa, xb); unpack8(br[j], ba, bb);
            f32x4 ya = ba * (w0a * p2a + w1a * p1a + w2a * xa), yb = bb * (w0b * p2b + w1b * p1b + w2b * xb);
            float s = 0.f;
#pragma unroll
            for (int e = 0; e < 4; ++e) s += ya[e] * ya[e] + yb[e] * yb[e];
            s = wave_sum(s);
            const float inv = rsqrtf(s * (1.0f / CH) + EPS);
            store8_bf16(YCAT + (size_t)(row0 + tb + j) * D + 512 + c0, ya * inv, yb * inv);
            p2a = p1a; p2b = p1b; p1a = xa; p1b = xb;
        }
    }
}

constexpr int KST = 528, VST = 520;
__device__ __forceinline__ void attn_phase(unsigned char* ws, int l, LAS unsigned char* lds, int G, int bid) {
    int tid = threadIdx.x; asm volatile("" : "+v"(tid));
    const int wave = __builtin_amdgcn_readfirstlane(tid >> 6);
    const bf16_t* Q = (const bf16_t*)(ws + WS_Q); bf16_t* O = (bf16_t*)(ws + WS_O);
    const int NU = NB * 4 * 8 + NDB * 4;
    for (int u = bid; u < NU; u += G) {
        int qrow0, nq, ldv; const bf16_t* Kp; const bf16_t* Vp; int h;
        if (u < NB * 32) { const int b = u >> 5; h = (u >> 3) & 3; const int qt = u & 7; qrow0 = b * SEQ + qt * 256; nq = 256;
            Kp = (const bf16_t*)(ws + WS_KB) + (size_t)l * TM * D + (size_t)(b * NMEM) * D + h * 256; Vp = (const bf16_t*)(ws + WS_VT) + (size_t)l * D * TM + (size_t)(h * 256) * TM + b * NMEM; ldv = TM; }
        else { const int i = u - NB * 32, b = i >> 2; h = i & 3; qrow0 = TP + b * DSEQ; nq = DSEQ;
            Kp = (const bf16_t*)(ws + WS_KC) + (size_t)l * TMS * D + (size_t)(b * NMEM) * D + h * 256; Vp = (const bf16_t*)(ws + WS_VTC) + (size_t)l * D * TMS + (size_t)(h * 256) * TMS + b * NMEM; ldv = TMS; }
        const bool active = wave * 32 < nq;
        __syncthreads();
        int t2 = tid; asm volatile("" : "+v"(t2));
        {
            const int c = t2 & 31, rr = t2 >> 5; const unsigned off = (unsigned)((rr * D + c * 8) * 2); const char* kb = (const char*)Kp;
            LAS unsigned char* ld0 = lds + rr * KST + c * 16;
#pragma unroll
            for (int hb = 0; hb < 4; ++hb) {
                u32x4 v[4];
#pragma unroll
                for (int i = 0; i < 4; ++i) v[i] = *(const GAS u32x4*)(kb + (size_t)(16 * (hb * 4 + i)) * D * 2 + off);
#pragma unroll
                for (int i = 0; i < 4; ++i) *(LAS u32x4*)(ld0 + 16 * (hb * 4 + i) * KST) = v[i];
            }
        }
        bf16x8 qf[16];
        const int r32 = t2 & 31, hh = (t2 >> 5) & 1;
        const int qrow = qrow0 + wave * 32 + r32;
        if (active) {
#pragma unroll
            for (int ks = 0; ks < 16; ++ks) qf[ks] = *(const GAS bf16x8*)(Q + (size_t)qrow * D + h * 256 + 16 * ks + 8 * hh);
        } else {
#pragma unroll
            for (int ks = 0; ks < 16; ++ks) qf[ks] = (bf16x8){0, 0, 0, 0, 0, 0, 0, 0};
        }
        __syncthreads();
        constexpr int NQ = 4, MTQ = 8 / NQ;
        bf16x8 pf[16]; float qmax[NQ], qsum[NQ];
#pragma unroll
        for (int qi = 0; qi < NQ; ++qi) { qmax[qi] = 0.f; qsum[qi] = 1.f; }
        if (active) {
#pragma unroll
            for (int qi = 0; qi < NQ; ++qi) {
                f32x16 sc[MTQ];
#pragma unroll
                for (int mq = 0; mq < MTQ; ++mq)
#pragma unroll
                    for (int e = 0; e < 16; ++e) sc[mq][e] = 0.f;
#pragma unroll
                for (int ks = 0; ks < 16; ++ks)
#pragma unroll
                    for (int mq = 0; mq < MTQ; ++mq) {
                        const bf16x8 kf = *(const LAS bf16x8*)(lds + (32 * (qi * MTQ + mq) + r32) * KST + (16 * ks + 8 * hh) * 2);
                        sc[mq] = __builtin_amdgcn_mfma_f32_32x32x16_bf16(kf, qf[ks], sc[mq], 0, 0, 0);
                    }
                float mx = -3.0e38f;
#pragma unroll
                for (int mq = 0; mq < MTQ; ++mq)
#pragma unroll
                    for (int e = 0; e < 16; ++e) mx = fmaxf(mx, sc[mq][e]);
                mx = fmaxf(mx, __shfl_xor(mx, 32));
                float sum = 0.f;
#pragma unroll
                for (int mq = 0; mq < MTQ; ++mq) {
#pragma unroll
                    for (int e = 0; e < 16; ++e) { const float pe = __builtin_amdgcn_exp2f((sc[mq][e] - mx) * 1.44269504089f); sc[mq][e] = pe; sum += pe; }
#pragma unroll
                    for (int s2 = 0; s2 < 2; ++s2) {
                        u32x4 w; w.x = cvt_pk_bf16(sc[mq][8 * s2 + 0], sc[mq][8 * s2 + 1]); w.y = cvt_pk_bf16(sc[mq][8 * s2 + 2], sc[mq][8 * s2 + 3]);
                        w.z = cvt_pk_bf16(sc[mq][8 * s2 + 4], sc[mq][8 * s2 + 5]); w.w = cvt_pk_bf16(sc[mq][8 * s2 + 6], sc[mq][8 * s2 + 7]);
                        pf[2 * (qi * MTQ + mq) + s2] = __builtin_bit_cast(bf16x8, w);
                    }
                }
                sum += __shfl_xor(sum, 32);
                qmax[qi] = mx; qsum[qi] = sum;
                __builtin_amdgcn_sched_barrier(0);
            }
        } else {
#pragma unroll
            for (int i = 0; i < 16; ++i) pf[i] = (bf16x8){0, 0, 0, 0, 0, 0, 0, 0};
        }
        float fq_[NQ]; float rinv;
        { float M = qmax[0];
#pragma unroll
          for (int qi = 1; qi < NQ; ++qi) M = fmaxf(M, qmax[qi]);
          float tot = 0.f;
#pragma unroll
          for (int qi = 0; qi < NQ; ++qi) { fq_[qi] = __builtin_amdgcn_exp2f((qmax[qi] - M) * 1.44269504089f); tot += fq_[qi] * qsum[qi]; }
          rinv = 1.0f / tot;
#pragma unroll
          for (int qi = 0; qi < NQ; ++qi) fq_[qi] *= rinv; }
        __syncthreads();
        {
            const int c = t2 & 31, rr = t2 >> 5; const unsigned off = (unsigned)((rr * ldv + c * 8) * 2); const char* vb = (const char*)Vp;
            LAS unsigned char* ld0 = lds + rr * VST + c * 16;
#pragma unroll
            for (int hb = 0; hb < 4; ++hb) {
                u32x4 v[4];
#pragma unroll
                for (int i = 0; i < 4; ++i) v[i] = *(const GAS u32x4*)(vb + (size_t)(16 * (hb * 4 + i)) * ldv * 2 + off);
#pragma unroll
                for (int i = 0; i < 4; ++i) { LAS u32x2* d = (LAS u32x2*)(ld0 + 16 * (hb * 4 + i) * VST); d[0] = (u32x2){v[i].x, v[i].y}; d[1] = (u32x2){v[i].z, v[i].w}; }
            }
        }
        __syncthreads();
        if (active) {
#pragma unroll
            for (int dt = 0; dt < 8; ++dt) {
                f32x16 acc[NQ];
#pragma unroll
                for (int qi = 0; qi < NQ; ++qi)
#pragma unroll
                    for (int e = 0; e < 16; ++e) acc[qi][e] = 0.f;
#pragma unroll
                for (int mi = 0; mi < 16 / NQ; ++mi)
#pragma unroll
                    for (int qi = 0; qi < NQ; ++qi) {
                        const int ms = qi * (16 / NQ) + mi;
                        const LAS unsigned char* vp = lds + (32 * dt + r32) * VST + (16 * ms + 4 * hh) * 2;
                        const u32x2 lo = *(const LAS u32x2*)vp, hi = *(const LAS u32x2*)(vp + 16);
                        const u32x4 w = (u32x4){lo.x, lo.y, hi.x, hi.y};
                        acc[qi] = __builtin_amdgcn_mfma_f32_32x32x16_bf16(__builtin_bit_cast(bf16x8, w), pf[ms], acc[qi], 0, 0, 0);
                    }
#pragma unroll
                for (int g4 = 0; g4 < 4; ++g4) {
                    float o4[4];
#pragma unroll
                    for (int e = 0; e < 4; ++e) { float v = 0.f;
#pragma unroll
                        for (int qi = 0; qi < NQ; ++qi) v = fmaf(acc[qi][4 * g4 + e], fq_[qi], v);
                        o4[e] = v; }
                    u32x2 w; w.x = cvt_pk_bf16(o4[0], o4[1]); w.y = cvt_pk_bf16(o4[2], o4[3]);
                    *(GAS u32x2*)(O + (size_t)qrow * D + h * 256 + 32 * dt + 8 * g4 + 4 * hh) = w;
                }
                __builtin_amdgcn_sched_barrier(0);
            }
        }
    }
    __syncthreads();
}

constexpr bool USE_SP2 = true;
__global__ void __launch_bounds__(512, 2) hybrid_fwd(Args a) {
    extern __shared__ __attribute__((aligned(16))) unsigned char lds_raw[];
    LAS unsigned char* lds = (LAS unsigned char*)lds_raw;
    cg::grid_group grid = cg::this_grid();
    const int tid = threadIdx.x, lane = tid & 63, wave = __builtin_amdgcn_readfirstlane(tid >> 6);
    const int G = gridDim.x, bid = blockIdx.x;
    unsigned char* ws = as_global(a.ws);
    const int NGW = G * 8;

#ifndef NO_PREP
    for (int rep = 0; rep < REP_PREP; ++rep) { prep_phase(ws, lds, bid * 8 + wave, NGW, wave, lane); __syncthreads(); }
#endif
    grid.sync();

#define FRESH() unsigned char* wsp = ws; int ll = l, bb = bid, gg = G; asm volatile("" : "+s"(wsp), "+s"(ll), "+s"(bb), "+s"(gg)); wsp = as_global(wsp); float* outp = as_global(a.out); (void)outp; unsigned char* wl = wsp + WS_W + (size_t)ll * W_LAYER; (void)wl
#define SSA(k) ss_arr(wsp, 1 + 4 * ll + (k))
#pragma unroll 1
    for (int l = 0; l < DEPTH; ++l) {
        {
            FRESH();
            pg8::Gemm g{(const bf16_t*)(wsp + WS_XB), (const bf16_t*)(wl + W_IN), T, 2048, D, D, D}; pg8::StaticOrder S; S.init(T, 2048, gg, bb);
            EpiInProj E{(bf16_t*)(wsp + WS_BG), (bf16_t*)(wsp + WS_XIN), (bf16_t*)(wsp + WS_U), ll == 0 ? ss_arr(wsp, 0) : ss_arr(wsp, 4), outp + O_CONVP + (size_t)ll * NB * 2 * CH, outp + O_CONVS + (size_t)ll * NDB * 2 * CH};
#ifndef NO_GEMM
            pg8::gemm_phase<EpiInProj, USE_SP2, pg8::StaticOrder>(lds, g, S, E);
#endif
#ifndef NO_SMALL
            small_gemm(g.A, g.Bt, 2048, D, E, bb >= (gg >> 1) ? bb - (gg >> 1) : -1, gg >> 1);
#endif
        }
        {
            FRESH();
            pg8::Gemm g{(const bf16_t*)(wsp + WS_MNB), (const bf16_t*)(wl + W_KV), TM, 2048, D, D, D}; pg8::StaticOrder S; S.init(TM, 2048, gg, bb);
            EpiKV E{outp + O_MKP + (size_t)ll * TM * D, outp + O_MVP + (size_t)ll * TM * D, (bf16_t*)(wsp + WS_KB) + (size_t)ll * TM * D, invmem_arr(wsp)};
#ifndef NO_GEMM
            pg8::gemm_phase<EpiKV, USE_SP2, pg8::StaticOrder>(lds, g, S, E);
#endif
        }
        {
            FRESH();
            pg8::Gemm g{(const bf16_t*)(wl + W_KV) + (size_t)D * D, (const bf16_t*)(wsp + WS_MNB), D, TM, D, D, D}; pg8::StaticOrder S; S.init(D, TM, gg, (bb + gg - (32 % gg)) % gg);
            EpiVT E{(bf16_t*)(wsp + WS_VT) + (size_t)ll * D * TM, invmem_arr(wsp)};
#ifndef NO_GEMM
            pg8::gemm_phase<EpiVT, USE_SP2, pg8::StaticOrder>(lds, g, S, E);
#endif
        }
        grid.sync();
        {
            FRESH();
            int tid2 = threadIdx.x; asm volatile("" : "+v"(tid2)); const int lane2 = tid2 & 63;
            const int w = wave * gg + bb; const int NGW2 = gg * 8;
            for (int rep = 0; rep < REP_SCAN; ++rep) {
#ifndef NO_SCAN
            for (int it = w; it < NB * 32 + NDB * 32; it += NGW2) scan_item(wsp, outp, ll, it, lds + wave * SCAN_LDS_WAVE, lane2);
#endif
#ifndef NO_CONV
            for (int run = NGW2 - 1 - w; run < T / 64; run += NGW2) conv_run(wsp, ll, run, lane2);
#endif
            }
        }
        grid.sync();
        {
            FRESH();
            pg8::Gemm g{(const bf16_t*)(wsp + WS_YG), (const bf16_t*)(wl + W_GLU), T, CH, CH, CH, CH}; pg8::StaticOrder S; S.init(T, CH, gg, bb);
            EpiGLU E{(const bf16_t*)(wsp + WS_YG), (bf16_t*)(wsp + WS_YCAT), SSA(0)};
#ifndef NO_GEMM
            pg8::gemm_phase<EpiGLU, USE_SP2, pg8::StaticOrder>(lds, g, S, E);
#endif
#ifndef NO_SMALL
            small_gemm(g.A, g.Bt, CH, CH, E, bb, gg);
#endif
        }
        grid.sync();
        {
            FRESH();
            pg8::Gemm g{(const bf16_t*)(wsp + WS_YCAT), (const bf16_t*)(wl + W_OUT), T, D, D, D, D}; pg8::StaticOrder S; S.init(T, D, gg, bb);
            EpiRes<true> E{(bf16_t*)(wsp + WS_XB), SSA(1), SSA(0)};
#ifndef NO_GEMM
            pg8::gemm_phase<EpiRes<true>, USE_SP2, pg8::StaticOrder>(lds, g, S, E);
#endif
#ifndef NO_SMALL
            small_gemm(g.A, g.Bt, D, D, E, bb, gg);
#endif
        }
        grid.sync();
        {
            FRESH();
            pg8::Gemm g{(const bf16_t*)(wsp + WS_XB), (const bf16_t*)(wl + W_Q), T, D, D, D, D}; pg8::StaticOrder S; S.init(T, D, gg, bb);
            EpiScale<0> E{(bf16_t*)(wsp + WS_Q), D, SSA(1)};
#ifndef NO_GEMM
            pg8::gemm_phase<EpiScale<0>, USE_SP2, pg8::StaticOrder>(lds, g, S, E);
#endif
#ifndef NO_SMALL
            small_gemm(g.A, g.Bt, D, D, E, bb, gg);
#endif
        }
        grid.sync();
        {
            FRESH();
#ifndef NO_ATTN
            for (int rep = 0; rep < REP_ATTN; ++rep) attn_phase(wsp, ll, lds, gg, bb);
#endif
        }
        grid.sync();
        {
            FRESH();
            pg8::Gemm g{(const bf16_t*)(wsp + WS_O), (const bf16_t*)(wl + W_O), T, D, D, D, D}; pg8::StaticOrder S; S.init(T, D, gg, bb);
            EpiRes<false> E{(bf16_t*)(wsp + WS_XB), SSA(2), nullptr};
#ifndef NO_GEMM
            pg8::gemm_phase<EpiRes<false>, USE_SP2, pg8::StaticOrder>(lds, g, S, E);
#endif
#ifndef NO_SMALL
            small_gemm(g.A, g.Bt, D, D, E, bb, gg);
#endif
        }
        grid.sync();
        {
            FRESH();
            pg8::Gemm g{(const bf16_t*)(wsp + WS_XB), (const bf16_t*)(wl + W_UP), T, DFF, D, D, D}; pg8::StaticOrder S; S.init(T, DFF, gg, bb);
            EpiScale<1> E{(bf16_t*)(wsp + WS_HDN), DFF, SSA(2)};
#ifndef NO_GEMM
            for (int rep = 0; rep < REP_UP; ++rep) pg8::gemm_phase<EpiScale<1>, USE_SP2, pg8::StaticOrder>(lds, g, S, E);
#endif
#ifndef NO_SMALL
            small_gemm(g.A, g.Bt, DFF, D, E, bb, gg);
#endif
        }
        grid.sync();
        {
            FRESH();
            pg8::Gemm g{(const bf16_t*)(wsp + WS_HDN), (const bf16_t*)(wl + W_DOWN), TP, D, DFF, DFF, DFF}; pg8::StaticOrder S; S.init(TP, D, gg, bb);
            EpiRes<false> E{(bf16_t*)(wsp + WS_XB), SSA(3), nullptr};
#if !defined(NO_GEMM)
            pg8::gemm_phase<EpiRes<false>, USE_SP2, pg8::StaticOrder>(lds, g, S, E);
#endif
        }
        {
            FRESH();
            pg8::Gemm g{(const bf16_t*)(wsp + WS_HDN) + (size_t)TP * DFF, (const bf16_t*)(wl + W_DOWN), TS, D, D, DFF, DFF}; pg8::KSplitOrder S; S.init(TS, D, 4, D, gg, bb);
            EpiAtomic E{(float*)(wsp + WS_SCR)};
#if !defined(NO_GEMM)
            pg8::gemm_phase<EpiAtomic, USE_SP2, pg8::KSplitOrder>(lds, g, S, E);
#endif
        }
        grid.sync();
        {
            FRESH();
            int tid4 = threadIdx.x; asm volatile("" : "+v"(tid4)); const int lane4 = tid4 & 63;
            GAS float* scr = (GAS float*)(wsp + WS_SCR); GAS float* ss3 = (GAS float*)SSA(3);
            for (int r = bb * 8 + wave; r < TS; r += gg * 8) {
                GAS f32x4* sp = (GAS f32x4*)(scr + (size_t)r * D) + lane4; GAS u32x2* xp = (GAS u32x2*)((bf16_t*)(wsp + WS_XB) + (size_t)(TP + r) * D) + lane4;
                float ssum = 0.f;
#pragma unroll
                for (int j = 0; j < 4; ++j) { const f32x4 d = (sp[64 * j] + sp[64 * j + (size_t)TS * D / 4]) + (sp[64 * j + 2 * ((size_t)TS * D / 4)] + sp[64 * j + 3 * ((size_t)TS * D / 4)]); const u32x2 w = xp[64 * j];
                    const f32x4 x = (f32x4){bf_lo(w.x), bf_hi(w.x), bf_lo(w.y), bf_hi(w.y)} + d;
                    ssum += (x[0] * x[0] + x[1] * x[1]) + (x[2] * x[2] + x[3] * x[3]);
                    u32x2 o; o.x = cvt_pk_bf16(x[0], x[1]); o.y = cvt_pk_bf16(x[2], x[3]); xp[64 * j] = o; }
                ssum = wave_sum(ssum);
                if (lane4 == 0) ss3[TP + r] = ssum;
            }
        }
        grid.sync();
    }
    {
        int tid3 = threadIdx.x; asm volatile("" : "+v"(tid3)); const int lane = tid3 & 63;
        const bf16_t* XB = (const bf16_t*)(ws + WS_XB); const float* ssf = ss_arr(ws, 1 + 4 + 3); const GAS float* gf = (const GAS float*)(ws + WS_SMALL) + SM_GFIN;
        f32x4 gv[4];
#pragma unroll
        for (int j = 0; j < 4; ++j) gv[j] = *(const GAS f32x4*)(gf + 256 * j + 4 * lane);
        for (int m0 = (bid * 8 + wave) * 4; m0 < T; m0 += NGW * 4) {
            u32x2 wv[4][4]; float inv[4];
#pragma unroll
            for (int r = 0; r < 4; ++r) { const GAS u32x2* xr = (const GAS u32x2*)(XB + (size_t)(m0 + r) * D) + lane;
#pragma unroll
                for (int j = 0; j < 4; ++j) wv[r][j] = xr[64 * j];
                inv[r] = rsqrtf(((const GAS float*)ssf)[m0 + r] * (1.0f / D) + EPS); }
#pragma unroll
            for (int r = 0; r < 4; ++r) { GAS f32x4* o = (GAS f32x4*)(a.out + (size_t)(m0 + r) * D) + lane;
#pragma unroll
                for (int j = 0; j < 4; ++j) { const u32x2 w = wv[r][j]; o[64 * j] = (f32x4){bf_lo(w.x), bf_hi(w.x), bf_lo(w.y), bf_hi(w.y)} * inv[r] * gv[j]; } }
        }
    }
}

extern "C" void kernel_launch(void* const* d_in, const int* in_sizes, int n_in, void* d_out, int out_size, void* d_ws, size_t ws_size, hipStream_t stream) {
    static int grid = 0;
    if (grid == 0) {
        if (n_in != 33 || (size_t)out_size != O_END || ws_size < WS_END) { fprintf(stderr, "kernel_launch: unexpected sizes n_in %d out %d ws %zu (need %zu)\n", n_in, out_size, ws_size, (size_t)WS_END); grid = -1; return; }
        int dev = 0, cus = 0, per_cu = 0;
        (void)hipGetDevice(&dev); (void)hipDeviceGetAttribute(&cus, hipDeviceAttributeMultiprocessorCount, dev);
        if (hipFuncSetAttribute((const void*)hybrid_fwd, hipFuncAttributeMaxDynamicSharedMemorySize, LDS_BYTES) != hipSuccess) { fprintf(stderr, "kernel_launch: hipFuncSetAttribute failed\n"); grid = -1; return; }
        if (hipOccupancyMaxActiveBlocksPerMultiprocessor(&per_cu, (const void*)hybrid_fwd, 512, LDS_BYTES) != hipSuccess || per_cu < 1) { fprintf(stderr, "kernel_launch: occupancy query says %d\n", per_cu); per_cu = 1; }
        (void)hipGetLastError();
        grid = cus > 0 ? cus : 256;
    }
    if (grid < 0) return;
    Args a{};
    for (int i = 0; i < 33; ++i) a.in[i] = (const float*)d_in[i];
    a.out = (float*)d_out; a.ws = (unsigned char*)d_ws;
    void* args[] = {&a};
    hipError_t e = hipLaunchCooperativeKernel((const void*)hybrid_fwd, dim3(grid), dim3(512), args, LDS_BYTES, stream);
    if (e != hipSuccess) fprintf(stderr, "kernel_launch: cooperative launch failed: %s (grid %d)\n", hipGetErrorString(e), grid);
}
```

```cpp
#include <hip/hip_runtime.h>
#include <hip/hip_cooperative_groups.h>
#include <cstdio>
#include <cstdint>
namespace cg = cooperative_groups;
#define NO_SMALL 1
#ifndef REP_PREP
#define REP_PREP 1
#endif
#ifndef REP_SCAN
#define REP_SCAN 1
#endif
#ifndef REP_ATTN
#define REP_ATTN 1
#endif
#ifndef REP_UP
#define REP_UP 1
#endif

#define LAS __attribute__((address_space(3)))
#define GAS __attribute__((address_space(1)))
typedef unsigned short bf16_t;
typedef short bf16x8 __attribute__((ext_vector_type(8)));
typedef short bf16x4 __attribute__((ext_vector_type(4)));
typedef float f32x2 __attribute__((ext_vector_type(2)));
typedef float f32x4 __attribute__((ext_vector_type(4)));
typedef float f32x16 __attribute__((ext_vector_type(16)));
typedef unsigned u32x4 __attribute__((ext_vector_type(4)));
typedef unsigned u32x2 __attribute__((ext_vector_type(2)));

constexpr int D = 1024, NB = 32, SEQ = 2048, NDB = 16, DSEQ = 64, DEPTH = 2;
constexpr int TP = NB * SEQ, TS = NDB * DSEQ, T = TP + TS;
constexpr int NMEM = 256, TM = NB * NMEM, TMS = NDB * NMEM;
constexpr int DFF = 4096, CH = 512;
constexpr float EPS = 1e-6f;
constexpr size_t O_YP = 0, O_YS = O_YP + (size_t)TP * D, O_CONVP = O_YS + (size_t)TS * D, O_REP = O_CONVP + (size_t)DEPTH * NB * 2 * CH,
                 O_IMP = O_REP + (size_t)DEPTH * NB * 32 * 64, O_MKP = O_IMP + (size_t)DEPTH * NB * 32 * 64, O_MVP = O_MKP + (size_t)DEPTH * TM * D,
                 O_CONVS = O_MVP + (size_t)DEPTH * TM * D, O_RES = O_CONVS + (size_t)DEPTH * NDB * 2 * CH, O_IMS = O_RES + (size_t)DEPTH * NDB * 32 * 64,
                 O_END = O_IMS + (size_t)DEPTH * NDB * 32 * 64;
constexpr size_t MiB = 1u << 20;
constexpr size_t WS_SS = 0;
constexpr size_t WS_BAR = 3 * MiB + MiB / 2, BAR_BYTES = 16384;
constexpr size_t WS_W = 4 * MiB, W_LAYER = 31 * MiB;
constexpr size_t W_IN = 0, W_GLU = 4 * MiB, W_OUT = 4 * MiB + MiB / 2, W_Q = 6 * MiB + MiB / 2, W_KV = 8 * MiB + MiB / 2, W_O = 12 * MiB + MiB / 2,
                 W_UP = 14 * MiB + MiB / 2, W_DOWN = 22 * MiB + MiB / 2;
constexpr size_t WS_XB = 66 * MiB;
constexpr size_t WS_MNB = 196 * MiB;
constexpr size_t WS_KB = 212 * MiB;
constexpr size_t WS_VT = 244 * MiB;
constexpr size_t WS_KC = 276 * MiB;
constexpr size_t WS_VTC = 292 * MiB;
constexpr size_t WS_BIG = 308 * MiB;
constexpr size_t SZ_T512 = (size_t)T * 512 * 2;
constexpr size_t WS_BG = WS_BIG, WS_XIN = WS_BG + SZ_T512, WS_U = WS_XIN + SZ_T512, WS_YG = WS_U + SZ_T512, WS_YCAT = WS_YG + SZ_T512;
constexpr size_t WS_Q = WS_BG, WS_O = WS_U, WS_HDN = WS_BIG;
constexpr size_t WS_SMALL = WS_BIG + (size_t)T * DFF * 2;
constexpr size_t WS_SCR = WS_SMALL + 4 * MiB;
constexpr size_t WS_END = WS_SCR + 16 * MiB;
constexpr int SM_ARE = 0, SM_AIM = 4096, SM_LOGDT = 8192, SM_BRE = 8256, SM_BIM = SM_BRE + 65536, SM_CRE = SM_BIM + 65536, SM_CIM = SM_CRE + 65536, SM_SD = SM_CIM + 65536,
              SM_CONVW = SM_SD + 1024, SM_SCONV = SM_CONVW + 3072, SM_SRE = SM_SCONV + 32768, SM_SIM = SM_SRE + 65536, SM_GFIN = SM_SIM + 65536, SM_END = SM_GFIN + 1024;
static_assert(WS_YCAT + 2 * SZ_T512 <= WS_END, "ws map");

constexpr int LDS_BYTES = 256 * 528 + 1024;

template <class Tp> __device__ __forceinline__ Tp* as_global(Tp* p) {
#if defined(__HIP_DEVICE_COMPILE__)
    __builtin_assume(!__builtin_amdgcn_is_shared((const __attribute__((address_space(0))) void*)p) && !__builtin_amdgcn_is_private((const __attribute__((address_space(0))) void*)p));
#endif
    return p;
}
__device__ __forceinline__ unsigned cvt_pk_bf16(float lo, float hi) { unsigned r; asm volatile("v_cvt_pk_bf16_f32 %0, %1, %2" : "=v"(r) : "v"(lo), "v"(hi)); return r; }
__device__ __forceinline__ float bf_lo(unsigned w) { return __uint_as_float(w << 16); }
__device__ __forceinline__ float bf_hi(unsigned w) { return __uint_as_float(w & 0xffff0000u); }
__device__ __forceinline__ float wave_sum(float v) {
#pragma unroll
    for (int o = 1; o < 64; o <<= 1) v += __shfl_xor(v, o);
    return v;
}
#define LDS_WAIT() asm volatile("s_waitcnt lgkmcnt(0)" ::: "memory")

namespace pg8 {
constexpr int BM = 256, BK = 64, HALF = 128, HTB = HALF * BK * 2, STAGE_BYTES = 8 * HTB, NXCD = 8, WGM = 8;
__host__ __device__ __forceinline__ int lds_byte(int r, int c) { const int st = (r >> 4) * 2 + (c >> 5), rr = r & 15, cc = c & 31, ob = rr * 64 + cc * 2; return st * 1024 + (ob ^ (((ob >> 9) & 1) << 5)); }
__host__ __device__ __forceinline__ void stage_rc(int b, int& R, int& C) { const int st = b / 1024, sb = b % 1024, swz = sb ^ (((sb >> 9) & 1) << 5); R = (st >> 1) * 16 + swz / 64; C = (st & 1) * 32 + (swz % 64) / 2; }
__host__ __device__ __forceinline__ int perm32(int rho) { const int n = rho >> 4, i = rho & 15; return 8 * (i >> 2) + 4 * n + (i & 3); }

struct Unit { int pm, pn, ko; };
struct Gemm { const bf16_t* A; const bf16_t* Bt; int M, N, K, lda, ldb; };

struct StaticOrder {
    int nM, nN, nwg, G, c;
    __device__ void init(int M, int N, int G_, int c_) { nM = M / BM; nN = N / BM; nwg = nM * nN; G = G_; c = c_; }
    __device__ bool next(int i, Unit& u) const {
        const long L = (long)i * G + c; if (L >= nwg) return false;
        int wgid = (int)L; { const int q = nwg / NXCD, r = nwg % NXCD, xcd = wgid % NXCD, off = wgid / NXCD; wgid = (xcd < r ? xcd * (q + 1) : r * (q + 1) + (xcd - r) * q) + off; }
        const int nig = WGM * nN, gid = wgid / nig, fm = gid * WGM, gsz = (nM - fm) < WGM ? (nM - fm) : WGM;
        u.pm = fm + ((wgid % nig) % gsz); u.pn = (wgid % nig) / gsz; u.ko = 0; return true;
    }
};
struct KSplitOrder {
    int nN, nS, nwg, G, c, kslice_bytes;
    __device__ void init(int M, int N, int nS_, int kslice, int G_, int c_) { nN = N / BM; nS = nS_; nwg = (M / BM) * nN * nS; G = G_; c = c_; kslice_bytes = kslice * 2; }
    __device__ bool next(int i, Unit& u) const {
        const long L = (long)i * G + c; if (L >= nwg) return false;
        const int l = (int)L, sidx = l % nS, t = l / nS; u.pn = t % nN; u.pm = t / nN; u.ko = sidx * kslice_bytes; return true;
    }
};

template <class Epi, bool SP2, class Sched>
__device__ __forceinline__ void gemm_phase(LAS unsigned char* lds, const Gemm g, const Sched& S, const Epi& E) {
    int tid = threadIdx.x; asm volatile("" : "+v"(tid));
    const int wid = __builtin_amdgcn_readfirstlane(tid >> 6), lane = tid & 63, wr = wid >> 2, wc = wid & 3, fr = lane & 15, fq = lane >> 4;
    const int K = g.K, nt = K / BK;
    unsigned voffA[2], voffB[2];
#pragma unroll
    for (int i = 0; i < 2; ++i) { int R, C; stage_rc(tid * 16 + i * 8192, R, C); const int Rb = Epi::PERM ? ((R & ~31) + perm32(R & 31)) : R;
        voffA[i] = (unsigned)(R * g.lda + C) * 2u; voffB[i] = (unsigned)(Rb * g.ldb + C) * 2u; }
    const size_t kstep = (size_t)(BK * 2);
    const size_t hstep = (size_t)HALF * g.lda * 2, hstepB = (size_t)HALF * g.ldb * 2;
    const size_t tstep = 2 * hstep, tstepB = 2 * hstepB;
    const unsigned ldsw = (unsigned)wid * 1024u;
    const int aoff = lds_byte(wr * 64 + fr, fq * 8), boff = lds_byte(wc * 32 + fr, fq * 8);
#define PG8_SA(b, h) (((b) * 2 + (h)) * HTB)
#define PG8_SB(b, h) ((4 + (b) * 2 + (h)) * HTB)
#define PG8_STAGE(bufoff, gbase, voff) do { _Pragma("unroll") for (int _i = 0; _i < 2; ++_i) \
        __builtin_amdgcn_global_load_lds((const unsigned*)((const char*)(gbase) + (voff)[_i]), (LAS unsigned*)(lds + (bufoff) + ldsw + _i * 8192), 16, 0, 0); } while (0)
#define PG8_LDA(dst, b, h) do { _Pragma("unroll") for (int m = 0; m < 4; ++m) _Pragma("unroll") for (int k = 0; k < 2; ++k) dst[m][k] = *(const LAS bf16x8*)(lds + PG8_SA(b, h) + aoff + m * 2048 + k * 1024); } while (0)
#define PG8_LDB(dst, b, h) do { _Pragma("unroll") for (int n = 0; n < 2; ++n) _Pragma("unroll") for (int k = 0; k < 2; ++k) dst[n][k] = *(const LAS bf16x8*)(lds + PG8_SB(b, h) + boff + n * 2048 + k * 1024); } while (0)
#define PG8_MMA(ai, bj, At, Bt) do { __builtin_amdgcn_s_setprio(1); _Pragma("unroll") for (int m = 0; m < 4; ++m) _Pragma("unroll") for (int n = 0; n < 2; ++n) _Pragma("unroll") for (int k = 0; k < 2; ++k) \
        acc[ai][bj][m][n] = __builtin_amdgcn_mfma_f32_16x16x32_bf16(Bt[n][k], At[m][k], acc[ai][bj][m][n], 0, 0, 0); __builtin_amdgcn_s_setprio(0); } while (0)
#define PG8_WAIT_V(n) asm volatile("s_waitcnt vmcnt(" #n ")" ::: "memory")
#define PG8_WAIT_L(n) asm volatile("s_waitcnt lgkmcnt(" #n ")" ::: "memory")
#define PG8_BAR __builtin_amdgcn_s_barrier()
#define PG8_SCHED __builtin_amdgcn_sched_barrier(0)
    Unit cur, nxt; int ui = 0;
    if (!S.next(0, cur)) return;
    f32x4 acc[2][2][4][2];
#pragma unroll
    for (int a = 0; a < 2; ++a)
#pragma unroll
        for (int b = 0; b < 2; ++b)
#pragma unroll
            for (int m = 0; m < 4; ++m)
#pragma unroll
                for (int n = 0; n < 2; ++n) acc[a][b][m][n] = (f32x4){0.f, 0.f, 0.f, 0.f};
    bf16x8 At[4][2], B0[2][2], B1[2][2];
    const char* cA = (const char*)g.A + (size_t)cur.pm * tstep + cur.ko; const char* cB = (const char*)g.Bt + (size_t)cur.pn * tstepB + cur.ko;
    if constexpr (SP2) {
        PG8_STAGE(PG8_SB(0, 0), cB, voffB); PG8_STAGE(PG8_SB(0, 1), cB + hstepB, voffB); PG8_STAGE(PG8_SA(0, 0), cA, voffA); PG8_STAGE(PG8_SA(0, 1), cA + hstep, voffA);
        if (wr == 1) PG8_BAR;
        PG8_WAIT_V(2); PG8_BAR;
        PG8_STAGE(PG8_SB(1, 0), cB + kstep, voffB); PG8_STAGE(PG8_SA(1, 0), cA + kstep, voffA); PG8_STAGE(PG8_SB(1, 1), cB + hstepB + kstep, voffB);
        PG8_WAIT_V(6); PG8_BAR;
    } else {
        PG8_STAGE(PG8_SB(0, 0), cB, voffB); PG8_STAGE(PG8_SA(0, 0), cA, voffA); PG8_STAGE(PG8_SB(0, 1), cB + hstepB, voffB); PG8_STAGE(PG8_SA(0, 1), cA + hstep, voffA);
        if (wr == 1) PG8_BAR;
        PG8_WAIT_V(4); PG8_BAR;
        PG8_STAGE(PG8_SB(1, 0), cB + kstep, voffB); PG8_STAGE(PG8_SA(1, 0), cA + kstep, voffA); PG8_STAGE(PG8_SB(1, 1), cB + hstepB + kstep, voffB);
        PG8_WAIT_V(6); PG8_BAR;
    }
    for (;;) {
        const bool has_next = S.next(ui + 1, nxt);
        const char* nA = has_next ? (const char*)g.A + (size_t)nxt.pm * tstep + nxt.ko : cA; const char* nB = has_next ? (const char*)g.Bt + (size_t)nxt.pn * tstepB + nxt.ko : cB;
        for (int t = 0; t < nt; t += 2) {
            const bool last = (t == nt - 2);
            const char* a1 = cA + (size_t)(t + 1) * kstep;
            const char* a2 = last ? nA : cA + (size_t)(t + 2) * kstep; const char* b2 = last ? nB : cB + (size_t)(t + 2) * kstep;
            const char* a3 = a2 + kstep; const char* b3 = b2 + kstep;
            if constexpr (Epi::MID) { if (t == (nt >> 1)) E.mid(acc, cur, wr, fr); }
            if constexpr (SP2) {
            PG8_LDB(B0, 0, 0); PG8_LDB(B1, 0, 1); PG8_SCHED; PG8_LDA(At, 0, 0); PG8_STAGE(PG8_SA(1, 1), a1 + hstep, voffA);
            PG8_WAIT_V(8); PG8_WAIT_L(0); PG8_BAR; PG8_MMA(0, 0, At, B0); PG8_MMA(0, 1, At, B1); PG8_BAR; PG8_SCHED;
            PG8_LDA(At, 0, 1); PG8_STAGE(PG8_SB(0, 0), b2, voffB); PG8_STAGE(PG8_SB(0, 1), b2 + hstepB, voffB); PG8_STAGE(PG8_SA(0, 0), a2, voffA);
            PG8_WAIT_V(8); PG8_WAIT_L(0); PG8_BAR; PG8_MMA(1, 0, At, B0); PG8_MMA(1, 1, At, B1); PG8_BAR; PG8_SCHED;
            PG8_LDB(B0, 1, 0); PG8_LDB(B1, 1, 1); PG8_SCHED; PG8_LDA(At, 1, 0); PG8_STAGE(PG8_SA(0, 1), a2 + hstep, voffA);
            PG8_WAIT_V(8); PG8_WAIT_L(0); PG8_BAR; PG8_MMA(0, 0, At, B0); PG8_MMA(0, 1, At, B1); PG8_BAR; PG8_SCHED;
            PG8_LDA(At, 1, 1); PG8_STAGE(PG8_SB(1, 0), b3, voffB); PG8_STAGE(PG8_SB(1, 1), b3 + hstepB, voffB); PG8_STAGE(PG8_SA(1, 0), a3, voffA);
            PG8_WAIT_V(8); PG8_WAIT_L(0); PG8_BAR; PG8_MMA(1, 0, At, B0); PG8_MMA(1, 1, At, B1); PG8_BAR; PG8_SCHED;
            } else {
            PG8_LDB(B0, 0, 0); PG8_SCHED; PG8_LDA(At, 0, 0); PG8_STAGE(PG8_SA(1, 1), a1 + hstep, voffA);
            PG8_WAIT_L(8); PG8_BAR; PG8_WAIT_L(0); PG8_MMA(0, 0, At, B0); PG8_BAR; PG8_SCHED;
            PG8_LDB(B1, 0, 1); PG8_STAGE(PG8_SB(0, 0), b2, voffB);
            PG8_BAR; PG8_WAIT_L(0); PG8_MMA(0, 1, At, B1); PG8_BAR;
            PG8_LDA(At, 0, 1); PG8_STAGE(PG8_SA(0, 0), a2, voffA);
            PG8_BAR; PG8_WAIT_L(0); PG8_MMA(1, 0, At, B0); PG8_BAR; PG8_SCHED;
            PG8_STAGE(PG8_SB(0, 1), b2 + hstepB, voffB);
            PG8_WAIT_V(6); PG8_BAR; PG8_MMA(1, 1, At, B1); PG8_BAR;
            PG8_LDB(B0, 1, 0); PG8_SCHED; PG8_LDA(At, 1, 0); PG8_STAGE(PG8_SA(0, 1), a2 + hstep, voffA);
            PG8_WAIT_L(8); PG8_BAR; PG8_WAIT_L(0); PG8_MMA(0, 0, At, B0); PG8_BAR; PG8_SCHED;
            PG8_LDB(B1, 1, 1); PG8_STAGE(PG8_SB(1, 0), b3, voffB);
            PG8_BAR; PG8_WAIT_L(0); PG8_MMA(0, 1, At, B1); PG8_BAR;
            PG8_LDA(At, 1, 1); PG8_STAGE(PG8_SA(1, 0), a3, voffA);
            PG8_BAR; PG8_WAIT_L(0); PG8_MMA(1, 0, At, B0); PG8_BAR; PG8_SCHED;
            PG8_STAGE(PG8_SB(1, 1), b3 + hstepB, voffB);
            PG8_WAIT_V(6); PG8_BAR; PG8_MMA(1, 1, At, B1); PG8_BAR;
            }
        }
        if (wr == 0) PG8_BAR;
        E(acc, cur, wr, wc, fr, fq);
        if (!has_next) break;
#pragma unroll
        for (int a = 0; a < 2; ++a)
#pragma unroll
            for (int b = 0; b < 2; ++b)
#pragma unroll
                for (int m = 0; m < 4; ++m)
#pragma unroll
                    for (int n = 0; n < 2; ++n) acc[a][b][m][n] = (f32x4){0.f, 0.f, 0.f, 0.f};
        cur = nxt; cA = nA; cB = nB; ++ui;
        if (wr == 1) PG8_BAR;
    }
    PG8_WAIT_V(0);
    PG8_BAR;
#undef PG8_SA
#undef PG8_SB
#undef PG8_STAGE
#undef PG8_LDA
#undef PG8_LDB
#undef PG8_MMA
#undef PG8_WAIT_V
#undef PG8_WAIT_L
#undef PG8_BAR
#undef PG8_SCHED
}
}
using pg8::Unit;
typedef f32x4 Acc[2][2][4][2];

__device__ __forceinline__ void store8_bf16(bf16_t* p, const f32x4& a, const f32x4& b) {
    u32x4 w; w.x = cvt_pk_bf16(a[0], a[1]); w.y = cvt_pk_bf16(a[2], a[3]); w.z = cvt_pk_bf16(b[0], b[1]); w.w = cvt_pk_bf16(b[2], b[3]);
    *(GAS u32x4*)p = w;
}
__device__ __forceinline__ void unpack8(const u32x4 w, f32x4& a, f32x4& b) {
    a = (f32x4){bf_lo(w.x), bf_hi(w.x), bf_lo(w.y), bf_hi(w.y)}; b = (f32x4){bf_lo(w.z), bf_hi(w.z), bf_lo(w.w), bf_hi(w.w)};
}

struct EpiInProj {
    static constexpr bool PERM = true, MID = false;
    bf16_t* BG; bf16_t* XIN; bf16_t* U; const float* ss; float* convp; float* convs;
    __device__ __forceinline__ int brow(int cb, int f) const {
        const int cg = cb >> 5;
        if (cg < 16) return cb + 16 * f;
        if (cg >= 48) return 1536 + 32 * (cg - 48) + 16 * f;
        const int c = 16 * (cg - 16), q = c >> 7, r = c & 127;
        return 512 + 256 * q + 128 * f + r;
    }
    __device__ __forceinline__ void small(const f32x4 (&acc)[2][2], int r0, int cb, int fr, int fq) const {
        const int cg = cb >> 5;
#pragma unroll
        for (int m = 0; m < 2; ++m) {
            const int r = r0 + 16 * m + fr; const float inv = rsqrtf(((const GAS float*)ss)[r] * (1.0f / D) + EPS);
            if (cg < 16 || cg >= 48) {
                bf16_t* dst = (cg < 16 ? BG + (size_t)r * CH + cb : U + (size_t)r * CH + (cb - 1536)) + 4 * fq;
#pragma unroll
                for (int f = 0; f < 2; ++f) { const f32x4 v = acc[m][f] * inv; u32x2 w; w.x = cvt_pk_bf16(v[0], v[1]); w.y = cvt_pk_bf16(v[2], v[3]); *(GAS u32x2*)(dst + 16 * f) = w; }
            } else {
                const int c0 = 16 * (cg - 16) + 4 * fq;
                const f32x4 x = (acc[m][0] * inv) * (acc[m][1] * inv);
                u32x2 w; w.x = cvt_pk_bf16(x[0], x[1]); w.y = cvt_pk_bf16(x[2], x[3]); *(GAS u32x2*)(XIN + (size_t)r * CH + c0) = w;
                const int rs = r - TP, t = rs & (DSEQ - 1);
                if (t >= DSEQ - 2) *(GAS f32x4*)(convs + ((size_t)(rs >> 6) * 2 + (t - (DSEQ - 2))) * CH + c0) = x;
            }
        }
    }
    __device__ __forceinline__ void operator()(const Acc& acc, const Unit& u, int wr, int wc, int fr, int fq) const {
        const int row0 = u.pm * 256 + wr * 64 + fr, cb = wc * 32 + 8 * fq;
#pragma unroll
        for (int ai = 0; ai < 2; ++ai)
#pragma unroll
            for (int m = 0; m < 4; ++m) {
                const int r = row0 + ai * 128 + m * 16;
                const float inv = rsqrtf(((const GAS float*)ss)[r] * (1.0f / D) + EPS);
                if (u.pn < 2 || u.pn >= 6) {
                    bf16_t* dst = (u.pn < 2 ? BG : U) + (size_t)r * CH + (u.pn & 1) * 256 + cb;
#pragma unroll
                    for (int bj = 0; bj < 2; ++bj) store8_bf16(dst + bj * 128, acc[ai][bj][m][0] * inv, acc[ai][bj][m][1] * inv);
                } else {
                    const int c0 = (u.pn - 2) * 128 + cb;
                    const f32x4 x0 = (acc[ai][0][m][0] * inv) * (acc[ai][1][m][0] * inv), x1 = (acc[ai][0][m][1] * inv) * (acc[ai][1][m][1] * inv);
                    store8_bf16(XIN + (size_t)r * CH + c0, x0, x1);
                    float* cd = nullptr;
                    if (r < TP) { const int t = r & (SEQ - 1); if (t >= SEQ - 2) cd = convp + ((size_t)(r >> 11) * 2 + (t - (SEQ - 2))) * CH + c0; }
                    else { const int rs = r - TP, t = rs & (DSEQ - 1); if (t >= DSEQ - 2) cd = convs + ((size_t)(rs >> 6) * 2 + (t - (DSEQ - 2))) * CH + c0; }
                    if (cd) { *(GAS f32x4*)cd = x0; *(GAS f32x4*)(cd + 4) = x1; }
                }
            }
    }
};
struct EpiKV {
    static constexpr bool PERM = false, MID = false;
    float* outK; float* outV; bf16_t* KB; const float* invm;
    __device__ __forceinline__ void operator()(const Acc& acc, const Unit& u, int wr, int wc, int fr, int fq) const {
        const int row0 = u.pm * 256 + wr * 64 + fr, col0 = (u.pn & 3) * 256 + wc * 32 + 4 * fq;
        float* outp = u.pn < 4 ? outK : outV;
#pragma unroll
        for (int ai = 0; ai < 2; ++ai)
#pragma unroll
            for (int m = 0; m < 4; ++m) {
                const int r = row0 + ai * 128 + m * 16; const float inv = ((const GAS float*)invm)[r];
#pragma unroll
                for (int bj = 0; bj < 2; ++bj)
#pragma unroll
                    for (int n = 0; n < 2; ++n) {
                        const f32x4 v = acc[ai][bj][m][n] * inv; const size_t o = (size_t)r * D + col0 + bj * 128 + n * 16;
                        *(GAS f32x4*)(outp + o) = v;
                        if (u.pn < 4) { u32x2 w; w.x = cvt_pk_bf16(v[0], v[1]); w.y = cvt_pk_bf16(v[2], v[3]); *(GAS u32x2*)(KB + o) = w; }
                    }
            }
    }
};
struct EpiVT {
    static constexpr bool PERM = true, MID = false;
    bf16_t* VT; const float* invm;
    __device__ __forceinline__ void operator()(const Acc& acc, const Unit& u, int wr, int wc, int fr, int fq) const {
        const int row0 = u.pm * 256 + wr * 64 + fr, col0 = u.pn * 256 + wc * 32 + 8 * fq;
        f32x4 s[2][2];
#pragma unroll
        for (int bj = 0; bj < 2; ++bj) { s[bj][0] = *(const GAS f32x4*)(invm + col0 + bj * 128); s[bj][1] = *(const GAS f32x4*)(invm + col0 + bj * 128 + 4); }
#pragma unroll
        for (int ai = 0; ai < 2; ++ai)
#pragma unroll
            for (int m = 0; m < 4; ++m) {
                const int r = row0 + ai * 128 + m * 16;
#pragma unroll
                for (int bj = 0; bj < 2; ++bj) store8_bf16(VT + (size_t)r * TM + col0 + bj * 128, acc[ai][bj][m][0] * s[bj][0], acc[ai][bj][m][1] * s[bj][1]);
            }
    }
};
struct EpiGLU {
    static constexpr bool PERM = true, MID = false;
    const bf16_t* YG; bf16_t* YCAT; float* ssb;
    __device__ __forceinline__ int brow(int cb, int f) const { return cb + 16 * f; }
    __device__ __forceinline__ void small(const f32x4 (&acc)[2][2], int r0, int cb, int fr, int fq) const {
#pragma unroll
        for (int m = 0; m < 2; ++m) {
            const int r = r0 + 16 * m + fr; float ssum = 0.f;
#pragma unroll
            for (int f = 0; f < 2; ++f) {
                const int c = cb + 16 * f + 4 * fq; const u32x2 yw = *(const GAS u32x2*)(YG + (size_t)r * CH + c);
                f32x4 y = (f32x4){bf_lo(yw.x), bf_hi(yw.x), bf_lo(yw.y), bf_hi(yw.y)};
#pragma unroll
                for (int e = 0; e < 4; ++e) { y[e] = y[e] * __builtin_amdgcn_rcpf(1.0f + __expf(-acc[m][f][e])); ssum += y[e] * y[e]; }
                u32x2 w; w.x = cvt_pk_bf16(y[0], y[1]); w.y = cvt_pk_bf16(y[2], y[3]); *(GAS u32x2*)(YCAT + (size_t)r * D + c) = w;
            }
            ssum += __shfl_xor(ssum, 16); ssum += __shfl_xor(ssum, 32);
            if (fq == 0) atomicAdd(ssb + r, ssum);
        }
    }
    __device__ __forceinline__ void operator()(const Acc& acc, const Unit& u, int wr, int wc, int fr, int fq) const {
        const int row0 = u.pm * 256 + wr * 64 + fr, col0 = u.pn * 256 + wc * 32 + 8 * fq;
#pragma unroll
        for (int ai = 0; ai < 2; ++ai)
#pragma unroll
            for (int m = 0; m < 4; ++m) {
                const int r = row0 + ai * 128 + m * 16; float ssum = 0.f;
#pragma unroll
                for (int bj = 0; bj < 2; ++bj) {
                    f32x4 y0, y1; unpack8(*(const GAS u32x4*)(YG + (size_t)r * CH + col0 + bj * 128), y0, y1);
                    f32x4 z0 = acc[ai][bj][m][0], z1 = acc[ai][bj][m][1];
#pragma unroll
                    for (int e = 0; e < 4; ++e) { y0[e] = y0[e] * __builtin_amdgcn_rcpf(1.0f + __expf(-z0[e])); y1[e] = y1[e] * __builtin_amdgcn_rcpf(1.0f + __expf(-z1[e]));
                        ssum += y0[e] * y0[e] + y1[e] * y1[e]; }
                    store8_bf16(YCAT + (size_t)r * D + col0 + bj * 128, y0, y1);
                }
                ssum += __shfl_xor(ssum, 16); ssum += __shfl_xor(ssum, 32);
                if (fq == 0) atomicAdd(ssb + r, ssum);
            }
    }
};
template <bool MIDS> struct EpiRes {
    static constexpr bool PERM = true, MID = MIDS;
    bf16_t* XB; float* ssout; const float* ssb;
    __device__ __forceinline__ int brow(int cb, int f) const { return cb + 16 * f; }
    __device__ __forceinline__ void mid_small(f32x4 (&acc)[2][2], int r0, int fr) const {
#pragma unroll
        for (int m = 0; m < 2; ++m) { const float sc = rsqrtf(((const GAS float*)ssb)[r0 + 16 * m + fr] * (1.0f / CH) + EPS); acc[m][0] *= sc; acc[m][1] *= sc; }
    }
    __device__ __forceinline__ void small(const f32x4 (&acc)[2][2], int r0, int cb, int fr, int fq) const {
#pragma unroll
        for (int m = 0; m < 2; ++m) {
            const int r = r0 + 16 * m + fr; float ssum = 0.f;
#pragma unroll
            for (int f = 0; f < 2; ++f) {
                bf16_t* p = XB + (size_t)r * D + cb + 16 * f + 4 * fq; const u32x2 xw = *(const GAS u32x2*)p;
                f32x4 x = (f32x4){bf_lo(xw.x), bf_hi(xw.x), bf_lo(xw.y), bf_hi(xw.y)} + acc[m][f];
#pragma unroll
                for (int e = 0; e < 4; ++e) ssum += x[e] * x[e];
                u32x2 w; w.x = cvt_pk_bf16(x[0], x[1]); w.y = cvt_pk_bf16(x[2], x[3]); *(GAS u32x2*)p = w;
            }
            ssum += __shfl_xor(ssum, 16); ssum += __shfl_xor(ssum, 32);
            if (fq == 0) atomicAdd(ssout + r, ssum);
        }
    }
    __device__ __forceinline__ void mid(Acc& acc, const Unit& u, int wr, int fr) const {
        const int row0 = u.pm * 256 + wr * 64 + fr;
#pragma unroll
        for (int ai = 0; ai < 2; ++ai)
#pragma unroll
            for (int m = 0; m < 4; ++m) {
                const float s = rsqrtf(((const GAS float*)ssb)[row0 + ai * 128 + m * 16] * (1.0f / CH) + EPS);
#pragma unroll
                for (int bj = 0; bj < 2; ++bj)
#pragma unroll
                    for (int n = 0; n < 2; ++n) acc[ai][bj][m][n] *= s;
            }
    }
    __device__ __forceinline__ void operator()(const Acc& acc, const Unit& u, int wr, int wc, int fr, int fq) const {
        const int row0 = u.pm * 256 + wr * 64 + fr, col0 = u.pn * 256 + wc * 32 + 8 * fq;
#pragma unroll
        for (int ai = 0; ai < 2; ++ai)
#pragma unroll
            for (int m = 0; m < 4; ++m) {
                const int r = row0 + ai * 128 + m * 16; float ssum = 0.f;
#pragma unroll
                for (int bj = 0; bj < 2; ++bj) {
                    bf16_t* p = XB + (size_t)r * D + col0 + bj * 128;
                    f32x4 x0, x1; unpack8(*(const GAS u32x4*)p, x0, x1);
                    x0 += acc[ai][bj][m][0]; x1 += acc[ai][bj][m][1];
#pragma unroll
                    for (int e = 0; e < 4; ++e) ssum += x0[e] * x0[e] + x1[e] * x1[e];
                    store8_bf16(p, x0, x1);
                }
                ssum += __shfl_xor(ssum, 16); ssum += __shfl_xor(ssum, 32);
                if (fq == 0) atomicAdd(ssout + r, ssum);
            }
    }
};
template <int ACT> struct EpiScale {
    static constexpr bool PERM = true, MID = false;
    bf16_t* OUT; int ldc; const float* ss;
    __device__ __forceinline__ int brow(int cb, int f) const { return cb + 16 * f; }
    __device__ __forceinline__ void small(const f32x4 (&acc)[2][2], int r0, int cb, int fr, int fq) const {
#pragma unroll
        for (int m = 0; m < 2; ++m) {
            const int r = r0 + 16 * m + fr; const float inv = rsqrtf(((const GAS float*)ss)[r] * (1.0f / D) + EPS);
#pragma unroll
            for (int f = 0; f < 2; ++f) {
                f32x4 v = acc[m][f] * inv;
                if (ACT == 1) {
#pragma unroll
                    for (int e = 0; e < 4; ++e) { const float a = fmaxf(v[e], 0.f); v[e] = a * a; }
                }
                u32x2 w; w.x = cvt_pk_bf16(v[0], v[1]); w.y = cvt_pk_bf16(v[2], v[3]); *(GAS u32x2*)(OUT + (size_t)r * ldc + cb + 16 * f + 4 * fq) = w;
            }
        }
    }
    __device__ __forceinline__ void operator()(const Acc& acc, const Unit& u, int wr, int wc, int fr, int fq) const {
        const int row0 = u.pm * 256 + wr * 64 + fr, col0 = u.pn * 256 + wc * 32 + 8 * fq;
#pragma unroll
        for (int ai = 0; ai < 2; ++ai)
#pragma unroll
            for (int m = 0; m < 4; ++m) {
                const int r = row0 + ai * 128 + m * 16; const float inv = rsqrtf(((const GAS float*)ss)[r] * (1.0f / D) + EPS);
#pragma unroll
                for (int bj = 0; bj < 2; ++bj) {
                    f32x4 v0 = acc[ai][bj][m][0] * inv, v1 = acc[ai][bj][m][1] * inv;
                    if (ACT == 1) {
#pragma unroll
                        for (int e = 0; e < 4; ++e) { const float a = fmaxf(v0[e], 0.f), b = fmaxf(v1[e], 0.f); v0[e] = a * a; v1[e] = b * b; }
                    }
                    store8_bf16(OUT + (size_t)r * ldc + col0 + bj * 128, v0, v1);
                }
            }
    }
};

template <class Epi>
__device__ __forceinline__ void small_gemm(const bf16_t* A, const bf16_t* Bt, int N, int K, const Epi& E, int c, int stride) {
    int tid = threadIdx.x; asm volatile("" : "+v"(tid));
    const int wave = __builtin_amdgcn_readfirstlane(tid >> 6), lane = tid & 63, fr = lane & 15, fq = lane >> 4;
    const int ntn = N >> 7, ntiles = (TS / 64) * ntn;
    if (c < 0) return;
    for (int tile = c; tile < ntiles; tile += stride) {
        const int tm = tile / ntn, tn = tile - tm * ntn;
        const int r0 = TP + tm * 64 + (wave >> 2) * 32, cb = tn * 128 + (wave & 3) * 32;
        const char* pa = (const char*)A + ((size_t)(r0 + fr) * K + 8 * fq) * 2;
        const char* pb0 = (const char*)Bt + ((size_t)(E.brow(cb, 0) + fr) * K + 8 * fq) * 2;
        const char* pb1 = (const char*)Bt + ((size_t)(E.brow(cb, 1) + fr) * K + 8 * fq) * 2;
        const size_t a16 = (size_t)16 * K * 2;
        f32x4 acc[2][2];
#pragma unroll
        for (int m = 0; m < 2; ++m)
#pragma unroll
            for (int f = 0; f < 2; ++f) acc[m][f] = (f32x4){0.f, 0.f, 0.f, 0.f};
        const int ng = K >> 7;
        bf16x8 A0[4], A1[4], B0[4], B1[4], C0[4], C1[4], D0[4], D1[4];
#define SG_LOAD(a0, a1, b0, b1, g) do { _Pragma("unroll") for (int j = 0; j < 4; ++j) { const size_t ko = (size_t)((g) * 4 + j) * 64; \
            a0[j] = *(const GAS bf16x8*)(pa + ko); a1[j] = *(const GAS bf16x8*)(pa + a16 + ko); b0[j] = *(const GAS bf16x8*)(pb0 + ko); b1[j] = *(const GAS bf16x8*)(pb1 + ko); } } while (0)
#define SG_MMA(a0, a1, b0, b1) do { _Pragma("unroll") for (int j = 0; j < 4; ++j) { \
            acc[0][0] = __builtin_amdgcn_mfma_f32_16x16x32_bf16(b0[j], a0[j], acc[0][0], 0, 0, 0); acc[0][1] = __builtin_amdgcn_mfma_f32_16x16x32_bf16(b1[j], a0[j], acc[0][1], 0, 0, 0); \
            acc[1][0] = __builtin_amdgcn_mfma_f32_16x16x32_bf16(b0[j], a1[j], acc[1][0], 0, 0, 0); acc[1][1] = __builtin_amdgcn_mfma_f32_16x16x32_bf16(b1[j], a1[j], acc[1][1], 0, 0, 0); } } while (0)
        SG_LOAD(A0, A1, B0, B1, 0);
        for (int g = 0; g < ng; g += 2) {
            if constexpr (Epi::MID) { if (g == (ng >> 1)) E.mid_small(acc, r0, fr); }
            SG_LOAD(C0, C1, D0, D1, g + 1);
            SG_MMA(A0, A1, B0, B1);
            if (g + 2 < ng) SG_LOAD(A0, A1, B0, B1, g + 2);
            SG_MMA(C0, C1, D0, D1);
        }
#undef SG_LOAD
#undef SG_MMA
        E.small(acc, r0, cb, fr, fq);
    }
}

struct EpiAtomic {
    static constexpr bool PERM = false, MID = false;
    float* SCR;
    __device__ __forceinline__ void operator()(const Acc& acc, const Unit& u, int wr, int wc, int fr, int fq) const {
        const int row0 = u.pm * 256 + wr * 64 + fr, col0 = u.pn * 256 + wc * 32 + 4 * fq;
        float* slab = SCR + (size_t)(u.ko >> 11) * TS * D;
#pragma unroll
        for (int ai = 0; ai < 2; ++ai)
#pragma unroll
            for (int m = 0; m < 4; ++m) {
                float* rp = slab + (size_t)(row0 + ai * 128 + m * 16) * D + col0;
#pragma unroll
                for (int bj = 0; bj < 2; ++bj)
#pragma unroll
                    for (int n = 0; n < 2; ++n) *(GAS f32x4*)(rp + bj * 128 + n * 16) = acc[ai][bj][m][n];
            }
    }
};
struct Args { const float* in[33]; float* out; unsigned char* ws; };
enum { I_XP = 0, I_XS, I_MEM, I_SCONV, I_SRE, I_SIM, I_CK, I_CV, I_GMIX, I_WIN, I_CONVW, I_ARE, I_AIM, I_LOGDT, I_BRE, I_BIM, I_CRE, I_CIM, I_SD, I_WGLU,
       I_GA, I_GB, I_WOUT, I_GX, I_GMEM, I_WQ, I_WK, I_WV, I_WO, I_GMLP, I_WUP, I_WDOWN, I_GFIN };

typedef const float* const __attribute__((address_space(4)))* KTab;
__device__ __forceinline__ KTab ktab() { unsigned long long p = (unsigned long long)__builtin_amdgcn_kernarg_segment_ptr(); asm volatile("" : "+s"(p)); return (KTab)p; }
__device__ __forceinline__ float* ss_arr(unsigned char* ws, int idx) { return (float*)(ws + WS_SS) + (size_t)idx * T; }
__device__ __forceinline__ float* invmem_arr(unsigned char* ws) { return (float*)(ws + WS_SS) + (size_t)9 * T; }

__device__ __forceinline__ int inproj_src_col(int vc) {
    if (vc < 512 || vc >= 1536) return vc;
    const int q = (vc - 512) >> 8, r = (vc - 512) & 255;
    return r < 128 ? 512 + q * 128 + r : 1024 + q * 128 + (r - 128);
}
__device__ __forceinline__ void transpose_item(const float* W, int ldw, int srck0, int srcn0, const float* gain, float gscale, bf16_t* WT, int ldt, int dn0, int dk0, LAS float* scr, int lane) {
#pragma unroll 8
    for (int i = 0; i < 32; ++i) { const int kk = 2 * i + (lane >> 5); float v = ((const GAS float*)W)[(size_t)(srck0 + kk) * ldw + srcn0 + (lane & 31)];
        const float gsc = gain ? ((const GAS float*)gain)[kk] * gscale : gscale; scr[kk * 33 + (lane & 31)] = v * gsc; }
    LDS_WAIT();
    const int c = lane & 7;
#pragma unroll
    for (int j = 0; j < 4; ++j) { const int n = (lane >> 3) + 8 * j; const LAS float* s = scr + (8 * c) * 33 + n;
        u32x4 o; o.x = cvt_pk_bf16(s[0 * 33], s[1 * 33]); o.y = cvt_pk_bf16(s[2 * 33], s[3 * 33]); o.z = cvt_pk_bf16(s[4 * 33], s[5 * 33]); o.w = cvt_pk_bf16(s[6 * 33], s[7 * 33]);
        *(GAS u32x4*)(WT + (size_t)(dn0 + n) * ldt + dk0 + 8 * c) = o; }
    LDS_WAIT();
}
__device__ __forceinline__ float convert_row(const float* src, bf16_t* dst, int lane) {
    const GAS f32x4* xr = (const GAS f32x4*)src + lane; f32x4 v[4]; float s = 0.f;
#pragma unroll
    for (int j = 0; j < 4; ++j) { v[j] = xr[64 * j]; s += (v[j][0] * v[j][0] + v[j][1] * v[j][1]) + (v[j][2] * v[j][2] + v[j][3] * v[j][3]); }
    GAS u32x2* o = (GAS u32x2*)dst + lane;
#pragma unroll
    for (int j = 0; j < 4; ++j) { u32x2 w; w.x = cvt_pk_bf16(v[j][0], v[j][1]); w.y = cvt_pk_bf16(v[j][2], v[j][3]); o[64 * j] = w; }
    return wave_sum(s);
}
constexpr int PI_IN = 1024, PI_GLU = 128, PI_SQ = 512, PI_UP = 2048, PI_CV = 2048;
constexpr int PI_LAYER = PI_IN + PI_GLU + 5 * PI_SQ + 2 * PI_UP + PI_CV;

__device__ __forceinline__ void prep_phase(unsigned char* ws, LAS unsigned char* lds, int gw, int NGW, int wave, int lane) {
    const KTab in = ktab();
    LAS float* scr = (LAS float*)(lds + wave * 8704);
    for (int it = gw; it < DEPTH * PI_LAYER; it += NGW) {
        const int l = it / PI_LAYER; int r = it - l * PI_LAYER;
        unsigned char* wl = ws + WS_W + (size_t)l * W_LAYER;
        if (r < PI_IN) { const int kb = r >> 6, nb = r & 63;
            transpose_item(as_global(in[I_WIN]) + (size_t)l * D * 2048, 2048, 64 * kb, inproj_src_col(32 * nb), as_global(in[I_GMIX]) + l * D + 64 * kb, 1.0f, (bf16_t*)(wl + W_IN), D, 32 * nb, 64 * kb, scr, lane); continue; }
        r -= PI_IN;
        if (r < PI_GLU) { const int kb = r >> 4, nb = r & 15;
            transpose_item(as_global(in[I_WGLU]) + (size_t)l * CH * CH, CH, 64 * kb, 32 * nb, nullptr, 1.0f, (bf16_t*)(wl + W_GLU), CH, 32 * nb, 64 * kb, scr, lane); continue; }
        r -= PI_GLU;
        if (r < PI_SQ) { const int kb = r >> 5, nb = r & 31, dk0 = 64 * kb;
            const float* gn = dk0 < 512 ? as_global(in[I_GB]) + l * CH + dk0 : as_global(in[I_GA]) + l * CH + dk0 - 512;
            transpose_item(as_global(in[I_WOUT]) + (size_t)l * D * D, D, (dk0 + 512) & 1023, 32 * nb, gn, 1.0f, (bf16_t*)(wl + W_OUT), D, 32 * nb, dk0, scr, lane); continue; }
        r -= PI_SQ;
        if (r < PI_SQ) { const int kb = r >> 5, nb = r & 31;
            transpose_item(as_global(in[I_WQ]) + (size_t)l * D * D, D, 64 * kb, 32 * nb, as_global(in[I_GX]) + l * D + 64 * kb, 0.0625f, (bf16_t*)(wl + W_Q), D, 32 * nb, 64 * kb, scr, lane); continue; }
        r -= PI_SQ;
        if (r < PI_SQ) { const int kb = r >> 5, nb = r & 31;
            transpose_item(as_global(in[I_WK]) + (size_t)l * D * D, D, 64 * kb, 32 * nb, as_global(in[I_GMEM]) + l * D + 64 * kb, 1.0f, (bf16_t*)(wl + W_KV), D, 32 * nb, 64 * kb, scr, lane); continue; }
        r -= PI_SQ;
        if (r < PI_SQ) { const int kb = r >> 5, nb = r & 31;
            transpose_item(as_global(in[I_WV]) + (size_t)l * D * D, D, 64 * kb, 32 * nb, as_global(in[I_GMEM]) + l * D + 64 * kb, 1.0f, (bf16_t*)(wl + W_KV), D, 1024 + 32 * nb, 64 * kb, scr, lane); continue; }
        r -= PI_SQ;
        if (r < PI_SQ) { const int kb = r >> 5, nb = r & 31;
            transpose_item(as_global(in[I_WO]) + (size_t)l * D * D, D, 64 * kb, 32 * nb, nullptr, 1.0f, (bf16_t*)(wl + W_O), D, 32 * nb, 64 * kb, scr, lane); continue; }
        r -= PI_SQ;
        if (r < PI_UP) { const int kb = r >> 7, nb = r & 127;
            transpose_item(as_global(in[I_WUP]) + (size_t)l * D * DFF, DFF, 64 * kb, 32 * nb, as_global(in[I_GMLP]) + l * D + 64 * kb, 1.0f, (bf16_t*)(wl + W_UP), D, 32 * nb, 64 * kb, scr, lane); continue; }
        r -= PI_UP;
        if (r < PI_UP) { const int kb = r >> 5, nb = r & 31;
            transpose_item(as_global(in[I_WDOWN]) + (size_t)l * DFF * D, D, 64 * kb, 32 * nb, nullptr, 1.0f, (bf16_t*)(wl + W_DOWN), DFF, 32 * nb, 64 * kb, scr, lane); continue; }
        r -= PI_UP;
        { const int kb = r >> 5, nb = r & 31;
            transpose_item(as_global(in[I_CV]) + (size_t)l * TMS * D, D, 64 * kb, 32 * nb, nullptr, 1.0f, (bf16_t*)(ws + WS_VTC) + (size_t)l * D * TMS, TMS, 32 * nb, 64 * kb, scr, lane); }
    }
    float* ss0 = ss_arr(ws, 0); float* invm = invmem_arr(ws);
    for (int m0 = gw * 2; m0 < T; m0 += NGW * 2) {
        const float* src = m0 < TP ? as_global(in[I_XP]) + (size_t)m0 * D : as_global(in[I_XS]) + (size_t)(m0 - TP) * D;
        const GAS f32x4* xr = (const GAS f32x4*)src + lane; f32x4 v[8]; float s0 = 0.f, s1 = 0.f;
#pragma unroll
        for (int j = 0; j < 8; ++j) v[j] = xr[64 * j];
#pragma unroll
        for (int j = 0; j < 4; ++j) { s0 += (v[j][0] * v[j][0] + v[j][1] * v[j][1]) + (v[j][2] * v[j][2] + v[j][3] * v[j][3]);
            s1 += (v[4 + j][0] * v[4 + j][0] + v[4 + j][1] * v[4 + j][1]) + (v[4 + j][2] * v[4 + j][2] + v[4 + j][3] * v[4 + j][3]); }
        GAS u32x2* o = (GAS u32x2*)((bf16_t*)(ws + WS_XB) + (size_t)m0 * D) + lane;
#pragma unroll
        for (int j = 0; j < 8; ++j) { u32x2 w; w.x = cvt_pk_bf16(v[j][0], v[j][1]); w.y = cvt_pk_bf16(v[j][2], v[j][3]); o[64 * j] = w; }
        s0 = wave_sum(s0); s1 = wave_sum(s1);
        if (lane == 0) { ((GAS float*)ss0)[m0] = s0; ((GAS float*)ss0)[m0 + 1] = s1; }
    }
    for (int m = T + gw; m < T + TM + 2 * TMS; m += NGW) {
        if (m < T) { const float* src = m < TP ? as_global(in[I_XP]) + (size_t)m * D : as_global(in[I_XS]) + (size_t)(m - TP) * D;
            const float s = convert_row(src, (bf16_t*)(ws + WS_XB) + (size_t)m * D, lane); if (lane == 0) ((GAS float*)ss0)[m] = s; }
        else if (m < T + TM) { const int mm = m - T; const float s = convert_row(as_global(in[I_MEM]) + (size_t)mm * D, (bf16_t*)(ws + WS_MNB) + (size_t)mm * D, lane);
            if (lane == 0) ((GAS float*)invm)[mm] = rsqrtf(s * (1.0f / D) + EPS); }
        else { const int mm = m - T - TM; (void)convert_row(as_global(in[I_CK]) + (size_t)mm * D, (bf16_t*)(ws + WS_KC) + (size_t)mm * D, lane); }
    }
    {
        float* sm = (float*)(ws + WS_SMALL); const int gt = gw * 64 + lane, NT = NGW * 64;
#define SMCOPY(off, idx, n) for (int i = gt; i < (n); i += NT) ((GAS float*)sm)[(off) + i] = ((const GAS float*)in[idx])[i]
        SMCOPY(SM_ARE, I_ARE, 4096); SMCOPY(SM_AIM, I_AIM, 4096); SMCOPY(SM_LOGDT, I_LOGDT, 64); SMCOPY(SM_BRE, I_BRE, 65536); SMCOPY(SM_BIM, I_BIM, 65536);
        SMCOPY(SM_CRE, I_CRE, 65536); SMCOPY(SM_CIM, I_CIM, 65536); SMCOPY(SM_SD, I_SD, 1024); SMCOPY(SM_CONVW, I_CONVW, 3072); SMCOPY(SM_SCONV, I_SCONV, 32768);
        SMCOPY(SM_SRE, I_SRE, 65536); SMCOPY(SM_SIM, I_SIM, 65536); SMCOPY(SM_GFIN, I_GFIN, 1024);
#undef SMCOPY
    }
    { float* z = ss_arr(ws, 1); const size_t n = (size_t)8 * T; for (size_t i = (size_t)gw * 64 + lane; i < n; i += (size_t)NGW * 64) ((GAS float*)z)[i] = 0.f; }
}

__device__ __forceinline__ float gelu_tanh(float x) {
    const float u = 0.7978845608f * (x + 0.044715f * x * x * x);
    const float e = __expf(2.0f * u);
    const float th = 1.0f - 2.0f * __builtin_amdgcn_rcpf(e + 1.0f);
    return 0.5f * x * (1.0f + th);
}
__device__ __forceinline__ void sincos_small(float x, float& s, float& c) {
    const float q = rintf(x * 0.63661977236f);
    float r = fmaf(-q, 1.57079637050628662109375f, x); r = fmaf(-q, -4.37113900018624283e-8f, r);
    const float r2 = r * r;
    const float sp = r + r * r2 * (-1.0f / 6 + r2 * (1.0f / 120 + r2 * (-1.0f / 5040 + r2 * (1.0f / 362880))));
    const float cp = 1.0f + r2 * (-0.5f + r2 * (1.0f / 24 + r2 * (-1.0f / 720 + r2 * (1.0f / 40320 + r2 * (-1.0f / 3628800)))));
    const int qi = (int)q & 3;
    s = (qi == 0) ? sp : (qi == 1) ? cp : (qi == 2) ? -sp : -cp;
    c = (qi == 0) ? cp : (qi == 1) ? -sp : (qi == 2) ? -cp : sp;
}
constexpr int BU_STRIDE = 528, H_STRIDE = 272, SCAN_LDS_WAVE = 16 * BU_STRIDE + 16 * H_STRIDE;

__device__ __forceinline__ void scan_item(unsigned char* ws, float* out, int l, int item, LAS unsigned char* wl, int lane_in) {
    int lane = lane_in; asm volatile("" : "+v"(lane));
    const GAS float* sm = (const GAS float*)(ws + WS_SMALL);
    int b, g, row0, nblk; const bool prompt = item < NB * 32;
    if (prompt) { b = item >> 5; g = item & 31; row0 = b * SEQ; nblk = SEQ / 16; }
    else { const int i2 = item - NB * 32; b = i2 >> 5; g = i2 & 31; row0 = TP + b * DSEQ; nblk = DSEQ / 16; }
    const bf16_t* U = (const bf16_t*)(ws + WS_U); bf16_t* YG = (bf16_t*)(ws + WS_YG);
    const int lg = l * 32 + g, p = lane, t16 = lane & 15, q = lane >> 4;
    const float are = fminf(sm[SM_ARE + lg * 64 + p], -1e-4f), aim = sm[SM_AIM + lg * 64 + p];
    const float dt = expf(sm[SM_LOGDT + lg]);
    float sn, cs; sincos_small(aim * dt, sn, cs);
    const float mag = expf(are * dt), abr = mag * cs, abi = mag * sn;
    const float nr = abr - 1.0f, ni = abi, den = 1.0f / (are * are + aim * aim);
    const float c0 = (nr * are + ni * aim) * den, c1 = (ni * are - nr * aim) * den;
    bf16x8 af[8];
#pragma unroll
    for (int f = 0; f < 8; ++f) {
        const int i = 16 * f + t16, ps = i >> 1, cc = i & 1;
        const float k0 = __shfl(c0, ps), k1 = __shfl(c1, ps);
        u32x4 w = (u32x4){0u, 0u, 0u, 0u};
        if (q < 2) {
            const GAS f32x4* br = (const GAS f32x4*)(sm + SM_BRE + ((size_t)lg * 64 + ps) * 16 + 8 * q); const GAS f32x4* bi = (const GAS f32x4*)(sm + SM_BIM + ((size_t)lg * 64 + ps) * 16 + 8 * q);
            const f32x4 r0 = br[0], r1 = br[1], i0 = bi[0], i1 = bi[1];
            f32x4 v0, v1;
            if (cc == 0) { v0 = k0 * r0 - k1 * i0; v1 = k0 * r1 - k1 * i1; } else { v0 = k0 * i0 + k1 * r0; v1 = k0 * i1 + k1 * r1; }
            w.x = cvt_pk_bf16(v0[0], v0[1]); w.y = cvt_pk_bf16(v0[2], v0[3]); w.z = cvt_pk_bf16(v1[0], v1[1]); w.w = cvt_pk_bf16(v1[2], v1[3]);
        }
        af[f] = __builtin_bit_cast(bf16x8, w);
    }
    bf16x8 cf[4];
#pragma unroll
    for (int s = 0; s < 4; ++s) {
        const int p0 = 16 * s + 4 * q;
        const f32x4 cr = *(const GAS f32x4*)(sm + SM_CRE + ((size_t)lg * 16 + t16) * 64 + p0), ci = *(const GAS f32x4*)(sm + SM_CIM + ((size_t)lg * 16 + t16) * 64 + p0);
        u32x4 w; w.x = cvt_pk_bf16(cr[0], -ci[0]); w.y = cvt_pk_bf16(cr[1], -ci[1]); w.z = cvt_pk_bf16(cr[2], -ci[2]); w.w = cvt_pk_bf16(cr[3], -ci[3]);
        cf[s] = __builtin_bit_cast(bf16x8, w);
    }
    const f32x4 dsk = *(const GAS f32x4*)(sm + SM_SD + l * CH + g * 16 + 4 * q);
    float hre = 0.f, him = 0.f;
    if (!prompt) { hre = sm[SM_SRE + (((size_t)l * NDB + b) * 32 + g) * 64 + p]; him = sm[SM_SIM + (((size_t)l * NDB + b) * 32 + g) * 64 + p]; }
    LAS unsigned char* BU = wl; LAS unsigned char* HB = wl + 16 * BU_STRIDE;
    const char* ubase = (const char*)U + (size_t)row0 * CH * 2; char* ybase = (char*)YG + (size_t)row0 * CH * 2;
    const unsigned lo8 = (unsigned)((t16 * CH + g * 16 + 8 * (q & 1)) * 2), lo4 = (unsigned)((t16 * CH + g * 16 + 4 * q) * 2);
    constexpr size_t BSTEP = (size_t)16 * CH * 2;
    constexpr int PD = 6;
    u32x4 ubuf[PD]; u32x2 ebuf[PD];
#pragma unroll
    for (int j = 0; j < PD; ++j) { ubuf[j] = (u32x4){0u, 0u, 0u, 0u}; ebuf[j] = (u32x2){0u, 0u};
        if (j < nblk) { const char* un = ubase + (size_t)j * BSTEP; if (q < 2) ubuf[j] = *(const GAS u32x4*)(un + lo8); ebuf[j] = *(const GAS u32x2*)(un + lo4); } }
    for (int tb0 = 0; tb0 < nblk; tb0 += PD) {
#pragma unroll
        for (int j = 0; j < PD; ++j) {
            const int tb = tb0 + j;
            if (tb < nblk) {
                const u32x4 ubc = ubuf[j]; const u32x2 uec = ebuf[j];
                if (tb + PD < nblk) { const char* un = ubase + (size_t)(tb + PD) * BSTEP; if (q < 2) ubuf[j] = *(const GAS u32x4*)(un + lo8); ebuf[j] = *(const GAS u32x2*)(un + lo4); }
                const bf16x8 bfrag = __builtin_bit_cast(bf16x8, ubc);
#pragma unroll
                for (int f = 0; f < 8; ++f) {
                    const f32x4 r = __builtin_amdgcn_mfma_f32_16x16x32_bf16(af[f], bfrag, (f32x4){0.f, 0.f, 0.f, 0.f}, 0, 0, 0);
                    *(LAS f32x4*)(BU + t16 * BU_STRIDE + (16 * f + 4 * q) * 4) = r;
                }
                LDS_WAIT();
                f32x2 buv[16];
#pragma unroll
                for (int t = 0; t < 16; ++t) buv[t] = *(const LAS f32x2*)(BU + t * BU_STRIDE + p * 8);
#pragma unroll
                for (int t = 0; t < 16; ++t) {
                    const float nre = fmaf(abr, hre, fmaf(-abi, him, buv[t][0])), nim = fmaf(abr, him, fmaf(abi, hre, buv[t][1]));
                    hre = nre; him = nim;
                    *(LAS unsigned*)(HB + t * H_STRIDE + p * 4) = cvt_pk_bf16(hre, him);
                }
                LDS_WAIT();
                f32x4 y = (f32x4){0.f, 0.f, 0.f, 0.f};
#pragma unroll
                for (int s2 = 0; s2 < 4; ++s2) {
                    const bf16x8 hf = *(const LAS bf16x8*)(HB + t16 * H_STRIDE + (32 * s2 + 8 * q) * 2);
                    y = __builtin_amdgcn_mfma_f32_16x16x32_bf16(cf[s2], hf, y, 0, 0, 0);
                }
                const float u0 = bf_lo(uec.x), u1 = bf_hi(uec.x), u2 = bf_lo(uec.y), u3 = bf_hi(uec.y);
                const float g0 = gelu_tanh(y[0] + dsk[0] * u0), g1 = gelu_tanh(y[1] + dsk[1] * u1), g2 = gelu_tanh(y[2] + dsk[2] * u2), g3 = gelu_tanh(y[3] + dsk[3] * u3);
                u32x2 w; w.x = cvt_pk_bf16(g0, g1); w.y = cvt_pk_bf16(g2, g3);
                *(GAS u32x2*)(ybase + (size_t)tb * BSTEP + lo4) = w;
                LDS_WAIT();
            }
        }
    }
    GAS float* outg = (GAS float*)out;
    if (prompt) { outg[O_REP + (((size_t)l * NB + b) * 32 + g) * 64 + p] = hre; outg[O_IMP + (((size_t)l * NB + b) * 32 + g) * 64 + p] = him; }
    else { outg[O_RES + (((size_t)l * NDB + b) * 32 + g) * 64 + p] = hre; outg[O_IMS + (((size_t)l * NDB + b) * 32 + g) * 64 + p] = him; }
}
__device__ __forceinline__ void conv_run(unsigned char* ws, int l, int run, int lane_in) {
    int lane = lane_in; asm volatile("" : "+v"(lane));
    const GAS float* sm = (const GAS float*)(ws + WS_SMALL);
    const bf16_t* XIN = (const bf16_t*)(ws + WS_XIN); const bf16_t* BG = (const bf16_t*)(ws + WS_BG); bf16_t* YCAT = (bf16_t*)(ws + WS_YCAT);
    const int row0 = run * 64, c0 = lane * 8;
    f32x4 w0a, w0b, w1a, w1b, w2a, w2b;
    { const GAS float* cw = sm + SM_CONVW + (size_t)l * 3 * CH + c0; w0a = *(const GAS f32x4*)cw; w0b = *(const GAS f32x4*)(cw + 4); w1a = *(const GAS f32x4*)(cw + CH); w1b = *(const GAS f32x4*)(cw + CH + 4);
      w2a = *(const GAS f32x4*)(cw + 2 * CH); w2b = *(const GAS f32x4*)(cw + 2 * CH + 4); }
    f32x4 p2a, p2b, p1a, p1b;
    const bool seq_start = row0 < TP ? ((row0 & (SEQ - 1)) == 0) : true;
    if (!seq_start) { unpack8(*(const GAS u32x4*)(XIN + (size_t)(row0 - 2) * CH + c0), p2a, p2b); unpack8(*(const GAS u32x4*)(XIN + (size_t)(row0 - 1) * CH + c0), p1a, p1b); }
    else if (row0 < TP) { p2a = p2b = p1a = p1b = (f32x4){0.f, 0.f, 0.f, 0.f}; }
    else { const int b = (row0 - TP) >> 6; const GAS float* st = sm + SM_SCONV + ((size_t)(l * NDB + b) * 2) * CH + c0;
        p2a = *(const GAS f32x4*)st; p2b = *(const GAS f32x4*)(st + 4); p1a = *(const GAS f32x4*)(st + CH); p1b = *(const GAS f32x4*)(st + CH + 4); }
    for (int tb = 0; tb < 64; tb += 8) {
        u32x4 xr[8], br[8];
#pragma unroll
        for (int j = 0; j < 8; ++j) { const size_t o = (size_t)(row0 + tb + j) * CH + c0; xr[j] = *(const GAS u32x4*)(XIN + o); br[j] = *(const GAS u32x4*)(BG + o); }
#pragma unroll
        for (int j = 0; j < 8; ++j) {
            f32x4 xa, xb, ba, bb; unpack8(xr[j], xa, xb); unpack8(br[j], ba, bb);
            f32x4 ya = ba * (w0a * p2a + w1a * p1a + w2a * xa), yb = bb * (w0b * p2b + w1b * p1b + w2b * xb);
            float s = 0.f;
#pragma unroll
            for (int e = 0; e < 4; ++e) s += ya[e] * ya[e] + yb[e] * yb[e];
            s = wave_sum(s);
            const float inv = rsqrtf(s * (1.0f / CH) + EPS);
            store8_bf16(YCAT + (size_t)(row0 + tb + j) * D + 512 + c0, ya * inv, yb * inv);
            p2a = p1a; p2b = p1b; p1a = xa; p1b = xb;
        }
    }
}

constexpr int KST = 528, VST = 520;
__device__ __forceinline__ void attn_phase(unsigned char* ws, int l, LAS unsigned char* lds, int G, int bid) {
    int tid = threadIdx.x; asm volatile("" : "+v"(tid));
    const int wave = __builtin_amdgcn_readfirstlane(tid >> 6);
    const bf16_t* Q = (const bf16_t*)(ws + WS_Q); bf16_t* O = (bf16_t*)(ws + WS_O);
    const int NU = NB * 4 * 8 + NDB * 4;
    for (int u = bid; u < NU; u += G) {
        int qrow0, nq, ldv; const bf16_t* Kp; const bf16_t* Vp; int h;
        if (u < NB * 32) { const int b = u >> 5; h = (u >> 3) & 3; const int qt = u & 7; qrow0 = b * SEQ + qt * 256; nq = 256;
            Kp = (const bf16_t*)(ws + WS_KB) + (size_t)l * TM * D + (size_t)(b * NMEM) * D + h * 256; Vp = (const bf16_t*)(ws + WS_VT) + (size_t)l * D * TM + (size_t)(h * 256) * TM + b * NMEM; ldv = TM; }
        else { const int i = u - NB * 32, b = i >> 2; h = i & 3; qrow0 = TP + b * DSEQ; nq = DSEQ;
            Kp = (const bf16_t*)(ws + WS_KC) + (size_t)l * TMS * D + (size_t)(b * NMEM) * D + h * 256; Vp = (const bf16_t*)(ws + WS_VTC) + (size_t)l * D * TMS + (size_t)(h * 256) * TMS + b * NMEM; ldv = TMS; }
        const bool active = wave * 32 < nq;
        __syncthreads();
        int t2 = tid; asm volatile("" : "+v"(t2));
        {
            const int c = t2 & 31, rr = t2 >> 5; const unsigned off = (unsigned)((rr * D + c * 8) * 2); const char* kb = (const char*)Kp;
            LAS unsigned char* ld0 = lds + rr * KST + c * 16;
#pragma unroll
            for (int hb = 0; hb < 4; ++hb) {
                u32x4 v[4];
#pragma unroll
                for (int i = 0; i < 4; ++i) v[i] = *(const GAS u32x4*)(kb + (size_t)(16 * (hb * 4 + i)) * D * 2 + off);
#pragma unroll
                for (int i = 0; i < 4; ++i) *(LAS u32x4*)(ld0 + 16 * (hb * 4 + i) * KST) = v[i];
            }
        }
        bf16x8 qf[16];
        const int r32 = t2 & 31, hh = (t2 >> 5) & 1;
        const int qrow = qrow0 + wave * 32 + r32;
        if (active) {
#pragma unroll
            for (int ks = 0; ks < 16; ++ks) qf[ks] = *(const GAS bf16x8*)(Q + (size_t)qrow * D + h * 256 + 16 * ks + 8 * hh);
        } else {
#pragma unroll
            for (int ks = 0; ks < 16; ++ks) qf[ks] = (bf16x8){0, 0, 0, 0, 0, 0, 0, 0};
        }
        __syncthreads();
        constexpr int NQ = 4, MTQ = 8 / NQ;
        bf16x8 pf[16]; float qmax[NQ], qsum[NQ];
#pragma unroll
        for (int qi = 0; qi < NQ; ++qi) { qmax[qi] = 0.f; qsum[qi] = 1.f; }
        if (active) {
#pragma unroll
            for (int qi = 0; qi < NQ; ++qi) {
                f32x16 sc[MTQ];
#pragma unroll
                for (int mq = 0; mq < MTQ; ++mq)
#pragma unroll
                    for (int e = 0; e < 16; ++e) sc[mq][e] = 0.f;
#pragma unroll
                for (int ks = 0; ks < 16; ++ks)
#pragma unroll
                    for (int mq = 0; mq < MTQ; ++mq) {
                        const bf16x8 kf = *(const LAS bf16x8*)(lds + (32 * (qi * MTQ + mq) + r32) * KST + (16 * ks + 8 * hh) * 2);
                        sc[mq] = __builtin_amdgcn_mfma_f32_32x32x16_bf16(kf, qf[ks], sc[mq], 0, 0, 0);
                    }
                float mx = -3.0e38f;
#pragma unroll
                for (int mq = 0; mq < MTQ; ++mq)
#pragma unroll
                    for (int e = 0; e < 16; ++e) mx = fmaxf(mx, sc[mq][e]);
                mx = fmaxf(mx, __shfl_xor(mx, 32));
                float sum = 0.f;
#pragma unroll
                for (int mq = 0; mq < MTQ; ++mq) {
#pragma unroll
                    for (int e = 0; e < 16; ++e) { const float pe = __builtin_amdgcn_exp2f((sc[mq][e] - mx) * 1.44269504089f); sc[mq][e] = pe; sum += pe; }
#pragma unroll
                    for (int s2 = 0; s2 < 2; ++s2) {
                        u32x4 w; w.x = cvt_pk_bf16(sc[mq][8 * s2 + 0], sc[mq][8 * s2 + 1]); w.y = cvt_pk_bf16(sc[mq][8 * s2 + 2], sc[mq][8 * s2 + 3]);
                        w.z = cvt_pk_bf16(sc[mq][8 * s2 + 4], sc[mq][8 * s2 + 5]); w.w = cvt_pk_bf16(sc[mq][8 * s2 + 6], sc[mq][8 * s2 + 7]);
                        pf[2 * (qi * MTQ + mq) + s2] = __builtin_bit_cast(bf16x8, w);
                    }
                }
                sum += __shfl_xor(sum, 32);
                qmax[qi] = mx; qsum[qi] = sum;
                __builtin_amdgcn_sched_barrier(0);
            }
        } else {
#pragma unroll
            for (int i = 0; i < 16; ++i) pf[i] = (bf16x8){0, 0, 0, 0, 0, 0, 0, 0};
        }
        float fq_[NQ]; float rinv;
        { float M = qmax[0];
#pragma unroll
          for (int qi = 1; qi < NQ; ++qi) M = fmaxf(M, qmax[qi]);
          float tot = 0.f;
#pragma unroll
          for (int qi = 0; qi < NQ; ++qi) { fq_[qi] = __builtin_amdgcn_exp2f((qmax[qi] - M) * 1.44269504089f); tot += fq_[qi] * qsum[qi]; }
          rinv = 1.0f / tot;
#pragma unroll
          for (int qi = 0; qi < NQ; ++qi) fq_[qi] *= rinv; }
        __syncthreads();
        {
            const int c = t2 & 31, rr = t2 >> 5; const unsigned off = (unsigned)((rr * ldv + c * 8) * 2); const char* vb = (const char*)Vp;
            LAS unsigned char* ld0 = lds + rr * VST + c * 16;
#pragma unroll
            for (int hb = 0; hb < 4; ++hb) {
                u32x4 v[4];
#pragma unroll
                for (int i = 0; i < 4; ++i) v[i] = *(const GAS u32x4*)(vb + (size_t)(16 * (hb * 4 + i)) * ldv * 2 + off);
#pragma unroll
                for (int i = 0; i < 4; ++i) { LAS u32x2* d = (LAS u32x2*)(ld0 + 16 * (hb * 4 + i) * VST); d[0] = (u32x2){v[i].x, v[i].y}; d[1] = (u32x2){v[i].z, v[i].w}; }
            }
        }
        __syncthreads();
        if (active) {
#pragma unroll
            for (int dt = 0; dt < 8; ++dt) {
                f32x16 acc[NQ];
#pragma unroll
                for (int qi = 0; qi < NQ; ++qi)
#pragma unroll
                    for (int e = 0; e < 16; ++e) acc[qi][e] = 0.f;
#pragma unroll
                for (int mi = 0; mi < 16 / NQ; ++mi)
#pragma unroll
                    for (int qi = 0; qi < NQ; ++qi) {
                        const int ms = qi * (16 / NQ) + mi;
                        const LAS unsigned char* vp = lds + (32 * dt + r32) * VST + (16 * ms + 4 * hh) * 2;
                        const u32x2 lo = *(const LAS u32x2*)vp, hi = *(const LAS u32x2*)(vp + 16);
                        const u32x4 w = (u32x4){lo.x, lo.y, hi.x, hi.y};
                        acc[qi] = __builtin_amdgcn_mfma_f32_32x32x16_bf16(__builtin_bit_cast(bf16x8, w), pf[ms], acc[qi], 0, 0, 0);
                    }
#pragma unroll
                for (int g4 = 0; g4 < 4; ++g4) {
                    float o4[4];
#pragma unroll
                    for (int e = 0; e < 4; ++e) { float v = 0.f;
#pragma unroll
                        for (int qi = 0; qi < NQ; ++qi) v = fmaf(acc[qi][4 * g4 + e], fq_[qi], v);
                        o4[e] = v; }
                    u32x2 w; w.x = cvt_pk_bf16(o4[0], o4[1]); w.y = cvt_pk_bf16(o4[2], o4[3]);
                    *(GAS u32x2*)(O + (size_t)qrow * D + h * 256 + 32 * dt + 8 * g4 + 4 * hh) = w;
                }
                __builtin_amdgcn_sched_barrier(0);
            }
        }
    }
    __syncthreads();
}

#define XB_TMO      128
#define XB_XCNT(j)  (256  + 64 * (j))
#define XB_XSUB(j)  (1280 + 64 * (j))
#define XB_XGEN(j)  (2304 + 64 * (j))
#define XB_TOP      3328
#define XB_TOPGEN   3392
#define XCD_BAR_WORDS 3456
#define XB_SPIN_CAP (1u << 18)

__device__ __forceinline__ unsigned xb_ld(unsigned* p)              { return __hip_atomic_load(p, __ATOMIC_RELAXED, __HIP_MEMORY_SCOPE_AGENT); }
__device__ __forceinline__ unsigned xb_add(unsigned* p, unsigned v) { return __hip_atomic_fetch_add(p, v, __ATOMIC_RELAXED, __HIP_MEMORY_SCOPE_AGENT); }
__device__ __forceinline__ unsigned xb_xcc_id() { return (unsigned)__builtin_amdgcn_s_getreg((3 << 11) | 20) & 0xFu; }
#define XB_SPIN(cond, bar) do { unsigned _sp = 0; while (cond) { __builtin_amdgcn_s_sleep(1); \
    if ((++_sp & 255u) == 0u) { if (xb_ld(&(bar)[XB_TMO])) break; if (_sp > XB_SPIN_CAP) { atomicAdd(&(bar)[XB_TMO], 1u); break; } } } } while (0)

struct XcdBarrier {
    unsigned* bar; unsigned x;
    volatile LAS unsigned* st;
};

__device__ __forceinline__ XcdBarrier xcd_barrier_post(unsigned* bar, volatile LAS unsigned* st) {
    XcdBarrier b; b.bar = bar; b.x = xb_xcc_id(); b.st = st;
    if (threadIdx.x == 0) (void)xb_add(&bar[XB_XCNT(b.x)], 1u);
    return b;
}
__device__ __forceinline__ void xcd_barrier_complete(unsigned* bar, unsigned x, unsigned& nloc, unsigned& nx) {
    const unsigned G = gridDim.x * gridDim.y * gridDim.z;
    unsigned sum, cnt, mine, sp = 0u;
    for (;;) {
        sum = 0u; cnt = 0u; mine = 0u;
#pragma unroll
        for (unsigned j = 0; j < 16; ++j) { const unsigned c = xb_ld(&bar[XB_XCNT(j)]); sum += c; cnt += (c > 0u) ? 1u : 0u; mine = (j == x) ? c : mine; }
        if (sum == G) break;
        __builtin_amdgcn_s_sleep(1);
        if ((++sp & 255u) == 0u) { if (xb_ld(&bar[XB_TMO])) break; if (sp > XB_SPIN_CAP) { atomicAdd(&bar[XB_TMO], 1u); break; } }
    }
    nloc = mine > 0u ? mine : 1u; nx = cnt > 0u ? cnt : 1u;
}

__device__ __forceinline__ void xcd_barrier(const XcdBarrier& b) {
    asm volatile("s_waitcnt vmcnt(0)" ::: "memory");
    __syncthreads();
    if (threadIdx.x == 0) {
        unsigned* bar = b.bar;
        __builtin_amdgcn_s_waitcnt(0);
        unsigned nloc = b.st[0], nx = b.st[1];
        if (nloc == 0u) { xcd_barrier_complete(bar, b.x, nloc, nx); b.st[0] = nloc; b.st[1] = nx; }
        const unsigned old = xb_add(&bar[XB_XSUB(b.x)], 1u);
        const unsigned gen = old / nloc;
        if (old + 1u == (gen + 1u) * nloc) {
            __builtin_amdgcn_fence(__ATOMIC_RELEASE, "agent");
            asm volatile("s_waitcnt vmcnt(0)" ::: "memory");
            const unsigned og = xb_add(&bar[XB_TOP], 1u);
            const unsigned tg = og / nx;
            if (og + 1u == (tg + 1u) * nx) xb_add(&bar[XB_TOPGEN], 1u);
            else XB_SPIN(xb_ld(&bar[XB_TOPGEN]) == tg, bar);
            __builtin_amdgcn_fence(__ATOMIC_ACQUIRE, "agent");
            xb_add(&bar[XB_XGEN(b.x)], 1u);
            asm volatile("s_waitcnt vmcnt(0)" ::: "memory");
        } else {
            XB_SPIN(xb_ld(&bar[XB_XGEN(b.x)]) == gen, bar);
            __builtin_amdgcn_fence(__ATOMIC_ACQUIRE, "agent");
            asm volatile("s_waitcnt vmcnt(0)" ::: "memory");
        }
    }
    __syncthreads();
}

constexpr bool USE_SP2 = true;
__global__ void __launch_bounds__(512, 2) hybrid_fwd(Args a) {
    extern __shared__ __attribute__((aligned(16))) unsigned char lds_raw[];
    LAS unsigned char* lds = (LAS unsigned char*)lds_raw;
    cg::grid_group grid = cg::this_grid();
    volatile LAS unsigned* bst = (volatile LAS unsigned*)(lds + LDS_BYTES - 64);
    if (threadIdx.x < 16) bst[threadIdx.x] = 0u;
    __syncthreads();
    const XcdBarrier xbar = xcd_barrier_post((unsigned*)(a.ws + WS_BAR), bst);
    const int tid = threadIdx.x, lane = tid & 63, wave = __builtin_amdgcn_readfirstlane(tid >> 6);
    const int G = gridDim.x, bid = blockIdx.x;
    unsigned char* ws = as_global(a.ws);
    const int NGW = G * 8;

#ifndef NO_PREP
    for (int rep = 0; rep < REP_PREP; ++rep) { prep_phase(ws, lds, bid * 8 + wave, NGW, wave, lane); __syncthreads(); }
#endif
    grid.sync();

#define FRESH() unsigned char* wsp = ws; int ll = l, bb = bid, gg = G; asm volatile("" : "+s"(wsp), "+s"(ll), "+s"(bb), "+s"(gg)); wsp = as_global(wsp); float* outp = as_global(a.out); (void)outp; unsigned char* wl = wsp + WS_W + (size_t)ll * W_LAYER; (void)wl
#define SSA(k) ss_arr(wsp, 1 + 4 * ll + (k))
#pragma unroll 1
    for (int l = 0; l < DEPTH; ++l) {
        {
            FRESH();
            pg8::Gemm g{(const bf16_t*)(wsp + WS_XB), (const bf16_t*)(wl + W_IN), T, 2048, D, D, D}; pg8::StaticOrder S; S.init(T, 2048, gg, bb);
            EpiInProj E{(bf16_t*)(wsp + WS_BG), (bf16_t*)(wsp + WS_XIN), (bf16_t*)(wsp + WS_U), ll == 0 ? ss_arr(wsp, 0) : ss_arr(wsp, 4), outp + O_CONVP + (size_t)ll * NB * 2 * CH, outp + O_CONVS + (size_t)ll * NDB * 2 * CH};
#ifndef NO_GEMM
            pg8::gemm_phase<EpiInProj, USE_SP2, pg8::StaticOrder>(lds, g, S, E);
#endif
#ifndef NO_SMALL
            small_gemm(g.A, g.Bt, 2048, D, E, bb >= (gg >> 1) ? bb - (gg >> 1) : -1, gg >> 1);
#endif
        }
        {
            FRESH();
            pg8::Gemm g{(const bf16_t*)(wsp + WS_MNB), (const bf16_t*)(wl + W_KV), TM, 2048, D, D, D}; pg8::StaticOrder S; S.init(TM, 2048, gg, bb);
            EpiKV E{outp + O_MKP + (size_t)ll * TM * D, outp + O_MVP + (size_t)ll * TM * D, (bf16_t*)(wsp + WS_KB) + (size_t)ll * TM * D, invmem_arr(wsp)};
#ifndef NO_GEMM
            pg8::gemm_phase<EpiKV, USE_SP2, pg8::StaticOrder>(lds, g, S, E);
#endif
        }
        {
            FRESH();
            pg8::Gemm g{(const bf16_t*)(wl + W_KV) + (size_t)D * D, (const bf16_t*)(wsp + WS_MNB), D, TM, D, D, D}; pg8::StaticOrder S; S.init(D, TM, gg, (bb + gg - (32 % gg)) % gg);
            EpiVT E{(bf16_t*)(wsp + WS_VT) + (size_t)ll * D * TM, invmem_arr(wsp)};
#ifndef NO_GEMM
            pg8::gemm_phase<EpiVT, USE_SP2, pg8::StaticOrder>(lds, g, S, E);
#endif
        }
        xcd_barrier(xbar);
        {
            FRESH();
            int tid2 = threadIdx.x; asm volatile("" : "+v"(tid2)); const int lane2 = tid2 & 63;
            const int w = wave * gg + bb; const int NGW2 = gg * 8;
            for (int rep = 0; rep < REP_SCAN; ++rep) {
#ifndef NO_SCAN
            for (int it = w; it < NB * 32 + NDB * 32; it += NGW2) scan_item(wsp, outp, ll, it, lds + wave * SCAN_LDS_WAVE, lane2);
#endif
#ifndef NO_CONV
            for (int run = NGW2 - 1 - w; run < T / 64; run += NGW2) conv_run(wsp, ll, run, lane2);
#endif
            }
        }
        xcd_barrier(xbar);
        {
            FRESH();
            pg8::Gemm g{(const bf16_t*)(wsp + WS_YG), (const bf16_t*)(wl + W_GLU), T, CH, CH, CH, CH}; pg8::StaticOrder S; S.init(T, CH, gg, bb);
            EpiGLU E{(const bf16_t*)(wsp + WS_YG), (bf16_t*)(wsp + WS_YCAT), SSA(0)};
#ifndef NO_GEMM
            pg8::gemm_phase<EpiGLU, USE_SP2, pg8::StaticOrder>(lds, g, S, E);
#endif
#ifndef NO_SMALL
            small_gemm(g.A, g.Bt, CH, CH, E, bb, gg);
#endif
        }
        xcd_barrier(xbar);
        {
            FRESH();
            pg8::Gemm g{(const bf16_t*)(wsp + WS_YCAT), (const bf16_t*)(wl + W_OUT), T, D, D, D, D}; pg8::StaticOrder S; S.init(T, D, gg, bb);
            EpiRes<true> E{(bf16_t*)(wsp + WS_XB), SSA(1), SSA(0)};
#ifndef NO_GEMM
            pg8::gemm_phase<EpiRes<true>, USE_SP2, pg8::StaticOrder>(lds, g, S, E);
#endif
#ifndef NO_SMALL
            small_gemm(g.A, g.Bt, D, D, E, bb, gg);
#endif
        }
        xcd_barrier(xbar);
        {
            FRESH();
            pg8::Gemm g{(const bf16_t*)(wsp + WS_XB), (const bf16_t*)(wl + W_Q), T, D, D, D, D}; pg8::StaticOrder S; S.init(T, D, gg, bb);
            EpiScale<0> E{(bf16_t*)(wsp + WS_Q), D, SSA(1)};
#ifndef NO_GEMM
            pg8::gemm_phase<EpiScale<0>, USE_SP2, pg8::StaticOrder>(lds, g, S, E);
#endif
#ifndef NO_SMALL
            small_gemm(g.A, g.Bt, D, D, E, bb, gg);
#endif
        }
        xcd_barrier(xbar);
        {
            FRESH();
#ifndef NO_ATTN
            for (int rep = 0; rep < REP_ATTN; ++rep) attn_phase(wsp, ll, lds, gg, bb);
#endif
        }
        xcd_barrier(xbar);
        {
            FRESH();
            pg8::Gemm g{(const bf16_t*)(wsp + WS_O), (const bf16_t*)(wl + W_O), T, D, D, D, D}; pg8::StaticOrder S; S.init(T, D, gg, bb);
            EpiRes<false> E{(bf16_t*)(wsp + WS_XB), SSA(2), nullptr};
#ifndef NO_GEMM
            pg8::gemm_phase<EpiRes<false>, USE_SP2, pg8::StaticOrder>(lds, g, S, E);
#endif
#ifndef NO_SMALL
            small_gemm(g.A, g.Bt, D, D, E, bb, gg);
#endif
        }
        xcd_barrier(xbar);
        {
            FRESH();
            pg8::Gemm g{(const bf16_t*)(wsp + WS_XB), (const bf16_t*)(wl + W_UP), T, DFF, D, D, D}; pg8::StaticOrder S; S.init(T, DFF, gg, bb);
            EpiScale<1> E{(bf16_t*)(wsp + WS_HDN), DFF, SSA(2)};
#ifndef NO_GEMM
            for (int rep = 0; rep < REP_UP; ++rep) pg8::gemm_phase<EpiScale<1>, USE_SP2, pg8::StaticOrder>(lds, g, S, E);
#endif
#ifndef NO_SMALL
            small_gemm(g.A, g.Bt, DFF, D, E, bb, gg);
#endif
        }
        xcd_barrier(xbar);
        {
            FRESH();
            pg8::Gemm g{(const bf16_t*)(wsp + WS_HDN), (const bf16_t*)(wl + W_DOWN), TP, D, DFF, DFF, DFF}; pg8::StaticOrder S; S.init(TP, D, gg, bb);
            EpiRes<false> E{(bf16_t*)(wsp + WS_XB), SSA(3), nullptr};
#if !defined(NO_GEMM)
            pg8::gemm_phase<EpiRes<false>, USE_SP2, pg8::StaticOrder>(lds, g, S, E);
#endif
        }
        {
            FRESH();
            pg8::Gemm g{(const bf16_t*)(wsp + WS_HDN) + (size_t)TP * DFF, (const bf16_t*)(wl + W_DOWN), TS, D, D, DFF, DFF}; pg8::KSplitOrder S; S.init(TS, D, 4, D, gg, bb);
            EpiAtomic E{(float*)(wsp + WS_SCR)};
#if !defined(NO_GEMM)
            pg8::gemm_phase<EpiAtomic, USE_SP2, pg8::KSplitOrder>(lds, g, S, E);
#endif
        }
        xcd_barrier(xbar);
        {
            FRESH();
            int tid4 = threadIdx.x; asm volatile("" : "+v"(tid4)); const int lane4 = tid4 & 63;
            GAS float* scr = (GAS float*)(wsp + WS_SCR); GAS float* ss3 = (GAS float*)SSA(3);
            for (int r = bb * 8 + wave; r < TS; r += gg * 8) {
                GAS f32x4* sp = (GAS f32x4*)(scr + (size_t)r * D) + lane4; GAS u32x2* xp = (GAS u32x2*)((bf16_t*)(wsp + WS_XB) + (size_t)(TP + r) * D) + lane4;
                float ssum = 0.f;
#pragma unroll
                for (int j = 0; j < 4; ++j) { const f32x4 d = (sp[64 * j] + sp[64 * j + (size_t)TS * D / 4]) + (sp[64 * j + 2 * ((size_t)TS * D / 4)] + sp[64 * j + 3 * ((size_t)TS * D / 4)]); const u32x2 w = xp[64 * j];
                    const f32x4 x = (f32x4){bf_lo(w.x), bf_hi(w.x), bf_lo(w.y), bf_hi(w.y)} + d;
                    ssum += (x[0] * x[0] + x[1] * x[1]) + (x[2] * x[2] + x[3] * x[3]);
                    u32x2 o; o.x = cvt_pk_bf16(x[0], x[1]); o.y = cvt_pk_bf16(x[2], x[3]); xp[64 * j] = o; }
                ssum = wave_sum(ssum);
                if (lane4 == 0) ss3[TP + r] = ssum;
            }
        }
        xcd_barrier(xbar);
    }
    {
        int tid3 = threadIdx.x; asm volatile("" : "+v"(tid3)); const int lane = tid3 & 63;
        const bf16_t* XB = (const bf16_t*)(ws + WS_XB); const float* ssf = ss_arr(ws, 1 + 4 + 3); const GAS float* gf = (const GAS float*)(ws + WS_SMALL) + SM_GFIN;
        f32x4 gv[4];
#pragma unroll
        for (int j = 0; j < 4; ++j) gv[j] = *(const GAS f32x4*)(gf + 256 * j + 4 * lane);
        for (int m0 = (bid * 8 + wave) * 4; m0 < T; m0 += NGW * 4) {
            u32x2 wv[4][4]; float inv[4];
#pragma unroll
            for (int r = 0; r < 4; ++r) { const GAS u32x2* xr = (const GAS u32x2*)(XB + (size_t)(m0 + r) * D) + lane;
#pragma unroll
                for (int j = 0; j < 4; ++j) wv[r][j] = xr[64 * j];
                inv[r] = rsqrtf(((const GAS float*)ssf)[m0 + r] * (1.0f / D) + EPS); }
#pragma unroll
            for (int r = 0; r < 4; ++r) { GAS f32x4* o = (GAS f32x4*)(a.out + (size_t)(m0 + r) * D) + lane;
#pragma unroll
                for (int j = 0; j < 4; ++j) { const u32x2 w = wv[r][j]; o[64 * j] = (f32x4){bf_lo(w.x), bf_hi(w.x), bf_lo(w.y), bf_hi(w.y)} * inv[r] * gv[j]; } }
        }
    }
}

extern "C" void kernel_launch(void* const* d_in, const int* in_sizes, int n_in, void* d_out, int out_size, void* d_ws, size_t ws_size, hipStream_t stream) {
    static int grid = 0;
    if (grid == 0) {
        if (n_in != 33 || (size_t)out_size != O_END || ws_size < WS_END) { fprintf(stderr, "kernel_launch: unexpected sizes n_in %d out %d ws %zu (need %zu)\n", n_in, out_size, ws_size, (size_t)WS_END); grid = -1; return; }
        int dev = 0, cus = 0, per_cu = 0;
        (void)hipGetDevice(&dev); (void)hipDeviceGetAttribute(&cus, hipDeviceAttributeMultiprocessorCount, dev);
        if (hipFuncSetAttribute((const void*)hybrid_fwd, hipFuncAttributeMaxDynamicSharedMemorySize, LDS_BYTES) != hipSuccess) { fprintf(stderr, "kernel_launch: hipFuncSetAttribute failed\n"); grid = -1; return; }
        if (hipOccupancyMaxActiveBlocksPerMultiprocessor(&per_cu, (const void*)hybrid_fwd, 512, LDS_BYTES) != hipSuccess || per_cu < 1) { fprintf(stderr, "kernel_launch: occupancy query says %d\n", per_cu); per_cu = 1; }
        (void)hipGetLastError();
        grid = cus > 0 ? cus : 256;
    }
    if (grid < 0) return;
    if (hipMemsetAsync((char*)d_ws + WS_BAR, 0, BAR_BYTES, stream) != hipSuccess) { fprintf(stderr, "kernel_launch: hipMemsetAsync failed\n"); return; }
    Args a{};
    for (int i = 0; i < 33; ++i) a.in[i] = (const float*)d_in[i];
    a.out = (float*)d_out; a.ws = (unsigned char*)d_ws;
    void* args[] = {&a};
    hipError_t e = hipLaunchCooperativeKernel((const void*)hybrid_fwd, dim3(grid), dim3(512), args, LDS_BYTES, stream);
    if (e != hipSuccess) fprintf(stderr, "kernel_launch: cooperative launch failed: %s (grid %d)\n", hipGetErrorString(e), grid);
}
```

```cpp
#include <hip/hip_runtime.h>
#include <hip/hip_cooperative_groups.h>
#include <cstdio>
#include <cstdint>
namespace cg = cooperative_groups;
#define NO_SMALL 1
#ifndef REP_PREP
#define REP_PREP 1
#endif
#ifndef REP_SCAN
#define REP_SCAN 1
#endif
#ifndef REP_ATTN
#define REP_ATTN 1
#endif
#ifndef REP_UP
#define REP_UP 1
#endif

#define LAS __attribute__((address_space(3)))
#define GAS __attribute__((address_space(1)))
typedef unsigned short bf16_t;
typedef short bf16x8 __attribute__((ext_vector_type(8)));
typedef short bf16x4 __attribute__((ext_vector_type(4)));
typedef float f32x2 __attribute__((ext_vector_type(2)));
typedef float f32x4 __attribute__((ext_vector_type(4)));
typedef float f32x16 __attribute__((ext_vector_type(16)));
typedef unsigned u32x4 __attribute__((ext_vector_type(4)));
typedef unsigned u32x2 __attribute__((ext_vector_type(2)));

constexpr int D = 1024, NB = 32, SEQ = 2048, NDB = 16, DSEQ = 64, DEPTH = 2;
constexpr int TP = NB * SEQ, TS = NDB * DSEQ, T = TP + TS;
constexpr int NMEM = 256, TM = NB * NMEM, TMS = NDB * NMEM;
constexpr int DFF = 4096, CH = 512;
constexpr float EPS = 1e-6f;
constexpr size_t O_YP = 0, O_YS = O_YP + (size_t)TP * D, O_CONVP = O_YS + (size_t)TS * D, O_REP = O_CONVP + (size_t)DEPTH * NB * 2 * CH,
                 O_IMP = O_REP + (size_t)DEPTH * NB * 32 * 64, O_MKP = O_IMP + (size_t)DEPTH * NB * 32 * 64, O_MVP = O_MKP + (size_t)DEPTH * TM * D,
                 O_CONVS = O_MVP + (size_t)DEPTH * TM * D, O_RES = O_CONVS + (size_t)DEPTH * NDB * 2 * CH, O_IMS = O_RES + (size_t)DEPTH * NDB * 32 * 64,
                 O_END = O_IMS + (size_t)DEPTH * NDB * 32 * 64;
constexpr size_t MiB = 1u << 20;
constexpr size_t WS_SS = 0;
constexpr size_t WS_BAR = 3 * MiB + MiB / 2, BAR_BYTES = 16384;
constexpr size_t WS_W = 4 * MiB, W_LAYER = 31 * MiB;
constexpr size_t W_IN = 0, W_GLU = 4 * MiB, W_OUT = 4 * MiB + MiB / 2, W_Q = 6 * MiB + MiB / 2, W_KV = 8 * MiB + MiB / 2, W_O = 12 * MiB + MiB / 2,
                 W_UP = 14 * MiB + MiB / 2, W_DOWN = 22 * MiB + MiB / 2;
constexpr size_t WS_XB = 66 * MiB;
constexpr size_t WS_MNB = 196 * MiB;
constexpr size_t WS_KB = 212 * MiB;
constexpr size_t WS_VT = 244 * MiB;
constexpr size_t WS_KC = 276 * MiB;
constexpr size_t WS_VTC = 292 * MiB;
constexpr size_t WS_BIG = 308 * MiB;
constexpr size_t SZ_T512 = (size_t)T * 512 * 2;
constexpr size_t WS_BG = WS_BIG, WS_XIN = WS_BG + SZ_T512, WS_U = WS_XIN + SZ_T512, WS_YG = WS_U + SZ_T512, WS_YCAT = WS_YG + SZ_T512;
constexpr size_t WS_Q = WS_BG, WS_O = WS_U, WS_HDN = WS_BIG;
constexpr size_t WS_SMALL = WS_BIG + (size_t)T * DFF * 2;
constexpr size_t WS_SCR = WS_SMALL + 4 * MiB;
constexpr size_t WS_END = WS_SCR + 16 * MiB;
constexpr int SM_ARE = 0, SM_AIM = 4096, SM_LOGDT = 8192, SM_BRE = 8256, SM_BIM = SM_BRE + 65536, SM_CRE = SM_BIM + 65536, SM_CIM = SM_CRE + 65536, SM_SD = SM_CIM + 65536,
              SM_CONVW = SM_SD + 1024, SM_SCONV = SM_CONVW + 3072, SM_SRE = SM_SCONV + 32768, SM_SIM = SM_SRE + 65536, SM_GFIN = SM_SIM + 65536, SM_END = SM_GFIN + 1024;
static_assert(WS_YCAT + 2 * SZ_T512 <= WS_END, "ws map");

constexpr int LDS_BYTES = 256 * 528 + 1024;

template <class Tp> __device__ __forceinline__ Tp* as_global(Tp* p) {
#if defined(__HIP_DEVICE_COMPILE__)
    __builtin_assume(!__builtin_amdgcn_is_shared((const __attribute__((address_space(0))) void*)p) && !__builtin_amdgcn_is_private((const __attribute__((address_space(0))) void*)p));
#endif
    return p;
}
__device__ __forceinline__ unsigned cvt_pk_bf16(float lo, float hi) { unsigned r; asm volatile("v_cvt_pk_bf16_f32 %0, %1, %2" : "=v"(r) : "v"(lo), "v"(hi)); return r; }
__device__ __forceinline__ float bf_lo(unsigned w) { return __uint_as_float(w << 16); }
__device__ __forceinline__ float bf_hi(unsigned w) { return __uint_as_float(w & 0xffff0000u); }
__device__ __forceinline__ float wave_sum(float v) {
#pragma unroll
    for (int o = 1; o < 64; o <<= 1) v += __shfl_xor(v, o);
    return v;
}
#define LDS_WAIT() asm volatile("s_waitcnt lgkmcnt(0)" ::: "memory")

namespace pg8 {
constexpr int BM = 256, BK = 64, HALF = 128, HTB = HALF * BK * 2, STAGE_BYTES = 8 * HTB, NXCD = 8, WGM = 8;
__host__ __device__ __forceinline__ int lds_byte(int r, int c) { const int st = (r >> 4) * 2 + (c >> 5), rr = r & 15, cc = c & 31, ob = rr * 64 + cc * 2; return st * 1024 + (ob ^ (((ob >> 9) & 1) << 5)); }
__host__ __device__ __forceinline__ void stage_rc(int b, int& R, int& C) { const int st = b / 1024, sb = b % 1024, swz = sb ^ (((sb >> 9) & 1) << 5); R = (st >> 1) * 16 + swz / 64; C = (st & 1) * 32 + (swz % 64) / 2; }
__host__ __device__ __forceinline__ int perm32(int rho) { const int n = rho >> 4, i = rho & 15; return 8 * (i >> 2) + 4 * n + (i & 3); }

struct Unit { int pm, pn, ko; };
struct Gemm { const bf16_t* A; const bf16_t* Bt; int M, N, K, lda, ldb; };

struct StaticOrder {
    int nM, nN, nwg, G, c;
    __device__ void init(int M, int N, int G_, int c_) { nM = M / BM; nN = N / BM; nwg = nM * nN; G = G_; c = c_; }
    __device__ bool next(int i, Unit& u) const {
        const long L = (long)i * G + c; if (L >= nwg) return false;
        int wgid = (int)L; { const int q = nwg / NXCD, r = nwg % NXCD, xcd = wgid % NXCD, off = wgid / NXCD; wgid = (xcd < r ? xcd * (q + 1) : r * (q + 1) + (xcd - r) * q) + off; }
        const int nig = WGM * nN, gid = wgid / nig, fm = gid * WGM, gsz = (nM - fm) < WGM ? (nM - fm) : WGM;
        u.pm = fm + ((wgid % nig) % gsz); u.pn = (wgid % nig) / gsz; u.ko = 0; return true;
    }
};
struct KSplitOrder {
    int nN, nS, nwg, G, c, kslice_bytes;
    __device__ void init(int M, int N, int nS_, int kslice, int G_, int c_) { nN = N / BM; nS = nS_; nwg = (M / BM) * nN * nS; G = G_; c = c_; kslice_bytes = kslice * 2; }
    __device__ bool next(int i, Unit& u) const {
        const long L = (long)i * G + c; if (L >= nwg) return false;
        const int l = (int)L, sidx = l % nS, t = l / nS; u.pn = t % nN; u.pm = t / nN; u.ko = sidx * kslice_bytes; return true;
    }
};

template <class Epi, bool SP2, class Sched>
__device__ __forceinline__ void gemm_phase(LAS unsigned char* lds, const Gemm g, const Sched& S, const Epi& E) {
    int tid = threadIdx.x; asm volatile("" : "+v"(tid));
    const int wid = __builtin_amdgcn_readfirstlane(tid >> 6), lane = tid & 63, wr = wid >> 2, wc = wid & 3, fr = lane & 15, fq = lane >> 4;
    const int K = g.K, nt = K / BK;
    unsigned voffA[2], voffB[2];
#pragma unroll
    for (int i = 0; i < 2; ++i) { int R, C; stage_rc(tid * 16 + i * 8192, R, C); const int Rb = Epi::PERM ? ((R & ~31) + perm32(R & 31)) : R;
        voffA[i] = (unsigned)(R * g.lda + C) * 2u; voffB[i] = (unsigned)(Rb * g.ldb + C) * 2u; }
    const size_t kstep = (size_t)(BK * 2);
    const size_t hstep = (size_t)HALF * g.lda * 2, hstepB = (size_t)HALF * g.ldb * 2;
    const size_t tstep = 2 * hstep, tstepB = 2 * hstepB;
    const unsigned ldsw = (unsigned)wid * 1024u;
    const int aoff = lds_byte(wr * 64 + fr, fq * 8), boff = lds_byte(wc * 32 + fr, fq * 8);
#define PG8_SA(b, h) (((b) * 2 + (h)) * HTB)
#define PG8_SB(b, h) ((4 + (b) * 2 + (h)) * HTB)
#define PG8_STAGE(bufoff, gbase, voff) do { _Pragma("unroll") for (int _i = 0; _i < 2; ++_i) \
        __builtin_amdgcn_global_load_lds((const unsigned*)((const char*)(gbase) + (voff)[_i]), (LAS unsigned*)(lds + (bufoff) + ldsw + _i * 8192), 16, 0, 0); } while (0)
#define PG8_LDA(dst, b, h) do { _Pragma("unroll") for (int m = 0; m < 4; ++m) _Pragma("unroll") for (int k = 0; k < 2; ++k) dst[m][k] = *(const LAS bf16x8*)(lds + PG8_SA(b, h) + aoff + m * 2048 + k * 1024); } while (0)
#define PG8_LDB(dst, b, h) do { _Pragma("unroll") for (int n = 0; n < 2; ++n) _Pragma("unroll") for (int k = 0; k < 2; ++k) dst[n][k] = *(const LAS bf16x8*)(lds + PG8_SB(b, h) + boff + n * 2048 + k * 1024); } while (0)
#define PG8_MMA(ai, bj, At, Bt) do { __builtin_amdgcn_s_setprio(1); _Pragma("unroll") for (int m = 0; m < 4; ++m) _Pragma("unroll") for (int n = 0; n < 2; ++n) _Pragma("unroll") for (int k = 0; k < 2; ++k) \
        acc[ai][bj][m][n] = __builtin_amdgcn_mfma_f32_16x16x32_bf16(Bt[n][k], At[m][k], acc[ai][bj][m][n], 0, 0, 0); __builtin_amdgcn_s_setprio(0); } while (0)
#define PG8_WAIT_V(n) asm volatile("s_waitcnt vmcnt(" #n ")" ::: "memory")
#define PG8_WAIT_L(n) asm volatile("s_waitcnt lgkmcnt(" #n ")" ::: "memory")
#define PG8_BAR __builtin_amdgcn_s_barrier()
#define PG8_SCHED __builtin_amdgcn_sched_barrier(0)
    Unit cur, nxt; int ui = 0;
    if (!S.next(0, cur)) return;
    f32x4 acc[2][2][4][2];
#pragma unroll
    for (int a = 0; a < 2; ++a)
#pragma unroll
        for (int b = 0; b < 2; ++b)
#pragma unroll
            for (int m = 0; m < 4; ++m)
#pragma unroll
                for (int n = 0; n < 2; ++n) acc[a][b][m][n] = (f32x4){0.f, 0.f, 0.f, 0.f};
    bf16x8 At[4][2], B0[2][2], B1[2][2];
    const char* cA = (const char*)g.A + (size_t)cur.pm * tstep + cur.ko; const char* cB = (const char*)g.Bt + (size_t)cur.pn * tstepB + cur.ko;
    if constexpr (SP2) {
        PG8_STAGE(PG8_SB(0, 0), cB, voffB); PG8_STAGE(PG8_SB(0, 1), cB + hstepB, voffB); PG8_STAGE(PG8_SA(0, 0), cA, voffA); PG8_STAGE(PG8_SA(0, 1), cA + hstep, voffA);
        if (wr == 1) PG8_BAR;
        PG8_WAIT_V(2); PG8_BAR;
        PG8_STAGE(PG8_SB(1, 0), cB + kstep, voffB); PG8_STAGE(PG8_SA(1, 0), cA + kstep, voffA); PG8_STAGE(PG8_SB(1, 1), cB + hstepB + kstep, voffB);
        PG8_WAIT_V(6); PG8_BAR;
    } else {
        PG8_STAGE(PG8_SB(0, 0), cB, voffB); PG8_STAGE(PG8_SA(0, 0), cA, voffA); PG8_STAGE(PG8_SB(0, 1), cB + hstepB, voffB); PG8_STAGE(PG8_SA(0, 1), cA + hstep, voffA);
        if (wr == 1) PG8_BAR;
        PG8_WAIT_V(4); PG8_BAR;
        PG8_STAGE(PG8_SB(1, 0), cB + kstep, voffB); PG8_STAGE(PG8_SA(1, 0), cA + kstep, voffA); PG8_STAGE(PG8_SB(1, 1), cB + hstepB + kstep, voffB);
        PG8_WAIT_V(6); PG8_BAR;
    }
    for (;;) {
        const bool has_next = S.next(ui + 1, nxt);
        const char* nA = has_next ? (const char*)g.A + (size_t)nxt.pm * tstep + nxt.ko : cA; const char* nB = has_next ? (const char*)g.Bt + (size_t)nxt.pn * tstepB + nxt.ko : cB;
        for (int t = 0; t < nt; t += 2) {
            const bool last = (t == nt - 2);
            const char* a1 = cA + (size_t)(t + 1) * kstep;
            const char* a2 = last ? nA : cA + (size_t)(t + 2) * kstep; const char* b2 = last ? nB : cB + (size_t)(t + 2) * kstep;
            const char* a3 = a2 + kstep; const char* b3 = b2 + kstep;
            if constexpr (Epi::MID) { if (t == (nt >> 1)) E.mid(acc, cur, wr, fr); }
            if constexpr (SP2) {
            PG8_LDB(B0, 0, 0); PG8_LDB(B1, 0, 1); PG8_SCHED; PG8_LDA(At, 0, 0); PG8_STAGE(PG8_SA(1, 1), a1 + hstep, voffA);
            PG8_WAIT_V(8); PG8_WAIT_L(0); PG8_BAR; PG8_MMA(0, 0, At, B0); PG8_MMA(0, 1, At, B1); PG8_BAR; PG8_SCHED;
            PG8_LDA(At, 0, 1); PG8_STAGE(PG8_SB(0, 0), b2, voffB); PG8_STAGE(PG8_SB(0, 1), b2 + hstepB, voffB); PG8_STAGE(PG8_SA(0, 0), a2, voffA);
            PG8_WAIT_V(8); PG8_WAIT_L(0); PG8_BAR; PG8_MMA(1, 0, At, B0); PG8_MMA(1, 1, At, B1); PG8_BAR; PG8_SCHED;
            PG8_LDB(B0, 1, 0); PG8_LDB(B1, 1, 1); PG8_SCHED; PG8_LDA(At, 1, 0); PG8_STAGE(PG8_SA(0, 1), a2 + hstep, voffA);
            PG8_WAIT_V(8); PG8_WAIT_L(0); PG8_BAR; PG8_MMA(0, 0, At, B0); PG8_MMA(0, 1, At, B1); PG8_BAR; PG8_SCHED;
            PG8_LDA(At, 1, 1); PG8_STAGE(PG8_SB(1, 0), b3, voffB); PG8_STAGE(PG8_SB(1, 1), b3 + hstepB, voffB); PG8_STAGE(PG8_SA(1, 0), a3, voffA);
            PG8_WAIT_V(8); PG8_WAIT_L(0); PG8_BAR; PG8_MMA(1, 0, At, B0); PG8_MMA(1, 1, At, B1); PG8_BAR; PG8_SCHED;
            } else {
            PG8_LDB(B0, 0, 0); PG8_SCHED; PG8_LDA(At, 0, 0); PG8_STAGE(PG8_SA(1, 1), a1 + hstep, voffA);
            PG8_WAIT_L(8); PG8_BAR; PG8_WAIT_L(0); PG8_MMA(0, 0, At, B0); PG8_BAR; PG8_SCHED;
            PG8_LDB(B1, 0, 1); PG8_STAGE(PG8_SB(0, 0), b2, voffB);
            PG8_BAR; PG8_WAIT_L(0); PG8_MMA(0, 1, At, B1); PG8_BAR;
            PG8_LDA(At, 0, 1); PG8_STAGE(PG8_SA(0, 0), a2, voffA);
            PG8_BAR; PG8_WAIT_L(0); PG8_MMA(1, 0, At, B0); PG8_BAR; PG8_SCHED;
            PG8_STAGE(PG8_SB(0, 1), b2 + hstepB, voffB);
            PG8_WAIT_V(6); PG8_BAR; PG8_MMA(1, 1, At, B1); PG8_BAR;
            PG8_LDB(B0, 1, 0); PG8_SCHED; PG8_LDA(At, 1, 0); PG8_STAGE(PG8_SA(0, 1), a2 + hstep, voffA);
            PG8_WAIT_L(8); PG8_BAR; PG8_WAIT_L(0); PG8_MMA(0, 0, At, B0); PG8_BAR; PG8_SCHED;
            PG8_LDB(B1, 1, 1); PG8_STAGE(PG8_SB(1, 0), b3, voffB);
            PG8_BAR; PG8_WAIT_L(0); PG8_MMA(0, 1, At, B1); PG8_BAR;
            PG8_LDA(At, 1, 1); PG8_STAGE(PG8_SA(1, 0), a3, voffA);
            PG8_BAR; PG8_WAIT_L(0); PG8_MMA(1, 0, At, B0); PG8_BAR; PG8_SCHED;
            PG8_STAGE(PG8_SB(1, 1), b3 + hstepB, voffB);
            PG8_WAIT_V(6); PG8_BAR; PG8_MMA(1, 1, At, B1); PG8_BAR;
            }
        }
        if (wr == 0) PG8_BAR;
        E(acc, cur, wr, wc, fr, fq);
        if (!has_next) break;
#pragma unroll
        for (int a = 0; a < 2; ++a)
#pragma unroll
            for (int b = 0; b < 2; ++b)
#pragma unroll
                for (int m = 0; m < 4; ++m)
#pragma unroll
                    for (int n = 0; n < 2; ++n) acc[a][b][m][n] = (f32x4){0.f, 0.f, 0.f, 0.f};
        cur = nxt; cA = nA; cB = nB; ++ui;
        if (wr == 1) PG8_BAR;
    }
    PG8_WAIT_V(0);
    PG8_BAR;
#undef PG8_SA
#undef PG8_SB
#undef PG8_STAGE
#undef PG8_LDA
#undef PG8_LDB
#undef PG8_MMA
#undef PG8_WAIT_V
#undef PG8_WAIT_L
#undef PG8_BAR
#undef PG8_SCHED
}
}
using pg8::Unit;
typedef f32x4 Acc[2][2][4][2];

__device__ __forceinline__ void store8_bf16(bf16_t* p, const f32x4& a, const f32x4& b) {
    u32x4 w; w.x = cvt_pk_bf16(a[0], a[1]); w.y = cvt_pk_bf16(a[2], a[3]); w.z = cvt_pk_bf16(b[0], b[1]); w.w = cvt_pk_bf16(b[2], b[3]);
    *(GAS u32x4*)p = w;
}
__device__ __forceinline__ void unpack8(const u32x4 w, f32x4& a, f32x4& b) {
    a = (f32x4){bf_lo(w.x), bf_hi(w.x), bf_lo(w.y), bf_hi(w.y)}; b = (f32x4){bf_lo(w.z), bf_hi(w.z), bf_lo(w.w), bf_hi(w.w)};
}

struct EpiInProj {
    static constexpr bool PERM = true, MID = false;
    bf16_t* BG; bf16_t* XIN; bf16_t* U; const float* ss; float* convp; float* convs;
    __device__ __forceinline__ int brow(int cb, int f) const {
        const int cg = cb >> 5;
        if (cg < 16) return cb + 16 * f;
        if (cg >= 48) return 1536 + 32 * (cg - 48) + 16 * f;
        const int c = 16 * (cg - 16), q = c >> 7, r = c & 127;
        return 512 + 256 * q + 128 * f + r;
    }
    __device__ __forceinline__ void small(const f32x4 (&acc)[2][2], int r0, int cb, int fr, int fq) const {
        const int cg = cb >> 5;
#pragma unroll
        for (int m = 0; m < 2; ++m) {
            const int r = r0 + 16 * m + fr; const float inv = rsqrtf(((const GAS float*)ss)[r] * (1.0f / D) + EPS);
            if (cg < 16 || cg >= 48) {
                bf16_t* dst = (cg < 16 ? BG + (size_t)r * CH + cb : U + (size_t)r * CH + (cb - 1536)) + 4 * fq;
#pragma unroll
                for (int f = 0; f < 2; ++f) { const f32x4 v = acc[m][f] * inv; u32x2 w; w.x = cvt_pk_bf16(v[0], v[1]); w.y = cvt_pk_bf16(v[2], v[3]); *(GAS u32x2*)(dst + 16 * f) = w; }
            } else {
                const int c0 = 16 * (cg - 16) + 4 * fq;
                const f32x4 x = (acc[m][0] * inv) * (acc[m][1] * inv);
                u32x2 w; w.x = cvt_pk_bf16(x[0], x[1]); w.y = cvt_pk_bf16(x[2], x[3]); *(GAS u32x2*)(XIN + (size_t)r * CH + c0) = w;
                const int rs = r - TP, t = rs & (DSEQ - 1);
                if (t >= DSEQ - 2) *(GAS f32x4*)(convs + ((size_t)(rs >> 6) * 2 + (t - (DSEQ - 2))) * CH + c0) = x;
            }
        }
    }
    __device__ __forceinline__ void operator()(const Acc& acc, const Unit& u, int wr, int wc, int fr, int fq) const {
        const int row0 = u.pm * 256 + wr * 64 + fr, cb = wc * 32 + 8 * fq;
#pragma unroll
        for (int ai = 0; ai < 2; ++ai)
#pragma unroll
            for (int m = 0; m < 4; ++m) {
                const int r = row0 + ai * 128 + m * 16;
                const float inv = rsqrtf(((const GAS float*)ss)[r] * (1.0f / D) + EPS);
                if (u.pn < 2 || u.pn >= 6) {
                    bf16_t* dst = (u.pn < 2 ? BG : U) + (size_t)r * CH + (u.pn & 1) * 256 + cb;
#pragma unroll
                    for (int bj = 0; bj < 2; ++bj) store8_bf16(dst + bj * 128, acc[ai][bj][m][0] * inv, acc[ai][bj][m][1] * inv);
                } else {
                    const int c0 = (u.pn - 2) * 128 + cb;
                    const f32x4 x0 = (acc[ai][0][m][0] * inv) * (acc[ai][1][m][0] * inv), x1 = (acc[ai][0][m][1] * inv) * (acc[ai][1][m][1] * inv);
                    store8_bf16(XIN + (size_t)r * CH + c0, x0, x1);
                    float* cd = nullptr;
                    if (r < TP) { const int t = r & (SEQ - 1); if (t >= SEQ - 2) cd = convp + ((size_t)(r >> 11) * 2 + (t - (SEQ - 2))) * CH + c0; }
                    else { const int rs = r - TP, t = rs & (DSEQ - 1); if (t >= DSEQ - 2) cd = convs + ((size_t)(rs >> 6) * 2 + (t - (DSEQ - 2))) * CH + c0; }
                    if (cd) { *(GAS f32x4*)cd = x0; *(GAS f32x4*)(cd + 4) = x1; }
                }
            }
    }
};
template <bool VPART> struct EpiKV {
    static constexpr bool PERM = false, MID = false;
    float* outK; float* outV; bf16_t* KB; const float* invm;
    __device__ __forceinline__ void operator()(const Acc& acc, const Unit& u, int wr, int wc, int fr, int fq) const {
        const int row0 = u.pm * 256 + wr * 64 + fr, col0 = (u.pn & 3) * 256 + wc * 32 + 4 * fq;
        float* outp = VPART ? outV : outK;
#pragma unroll
        for (int ai = 0; ai < 2; ++ai)
#pragma unroll
            for (int m = 0; m < 4; ++m) {
                const int r = row0 + ai * 128 + m * 16; const float inv = ((const GAS float*)invm)[r];
#pragma unroll
                for (int bj = 0; bj < 2; ++bj)
#pragma unroll
                    for (int n = 0; n < 2; ++n) {
                        const f32x4 v = acc[ai][bj][m][n] * inv; const size_t o = (size_t)r * D + col0 + bj * 128 + n * 16;
                        *(GAS f32x4*)(outp + o) = v;
                        if (!VPART) { u32x2 w; w.x = cvt_pk_bf16(v[0], v[1]); w.y = cvt_pk_bf16(v[2], v[3]); *(GAS u32x2*)(KB + o) = w; }
                    }
            }
    }
};
struct EpiVT {
    static constexpr bool PERM = true, MID = false;
    bf16_t* VT; const float* invm;
    __device__ __forceinline__ void operator()(const Acc& acc, const Unit& u, int wr, int wc, int fr, int fq) const {
        const int row0 = u.pm * 256 + wr * 64 + fr, col0 = u.pn * 256 + wc * 32 + 8 * fq;
        f32x4 s[2][2];
#pragma unroll
        for (int bj = 0; bj < 2; ++bj) { s[bj][0] = *(const GAS f32x4*)(invm + col0 + bj * 128); s[bj][1] = *(const GAS f32x4*)(invm + col0 + bj * 128 + 4); }
#pragma unroll
        for (int ai = 0; ai < 2; ++ai)
#pragma unroll
            for (int m = 0; m < 4; ++m) {
                const int r = row0 + ai * 128 + m * 16;
#pragma unroll
                for (int bj = 0; bj < 2; ++bj) store8_bf16(VT + (size_t)r * TM + col0 + bj * 128, acc[ai][bj][m][0] * s[bj][0], acc[ai][bj][m][1] * s[bj][1]);
            }
    }
};
struct EpiGLU {
    static constexpr bool PERM = true, MID = false;
    const bf16_t* YG; bf16_t* YCAT; float* ssb;
    __device__ __forceinline__ int brow(int cb, int f) const { return cb + 16 * f; }
    __device__ __forceinline__ void small(const f32x4 (&acc)[2][2], int r0, int cb, int fr, int fq) const {
#pragma unroll
        for (int m = 0; m < 2; ++m) {
            const int r = r0 + 16 * m + fr; float ssum = 0.f;
#pragma unroll
            for (int f = 0; f < 2; ++f) {
                const int c = cb + 16 * f + 4 * fq; const u32x2 yw = *(const GAS u32x2*)(YG + (size_t)r * CH + c);
                f32x4 y = (f32x4){bf_lo(yw.x), bf_hi(yw.x), bf_lo(yw.y), bf_hi(yw.y)};
#pragma unroll
                for (int e = 0; e < 4; ++e) { y[e] = y[e] * __builtin_amdgcn_rcpf(1.0f + __expf(-acc[m][f][e])); ssum += y[e] * y[e]; }
                u32x2 w; w.x = cvt_pk_bf16(y[0], y[1]); w.y = cvt_pk_bf16(y[2], y[3]); *(GAS u32x2*)(YCAT + (size_t)r * D + c) = w;
            }
            ssum += __shfl_xor(ssum, 16); ssum += __shfl_xor(ssum, 32);
            if (fq == 0) atomicAdd(ssb + r, ssum);
        }
    }
    __device__ __forceinline__ void operator()(const Acc& acc, const Unit& u, int wr, int wc, int fr, int fq) const {
        const int row0 = u.pm * 256 + wr * 64 + fr, col0 = u.pn * 256 + wc * 32 + 8 * fq;
#pragma unroll
        for (int ai = 0; ai < 2; ++ai)
#pragma unroll
            for (int m = 0; m < 4; ++m) {
                const int r = row0 + ai * 128 + m * 16; float ssum = 0.f;
#pragma unroll
                for (int bj = 0; bj < 2; ++bj) {
                    f32x4 y0, y1; unpack8(*(const GAS u32x4*)(YG + (size_t)r * CH + col0 + bj * 128), y0, y1);
                    f32x4 z0 = acc[ai][bj][m][0], z1 = acc[ai][bj][m][1];
#pragma unroll
                    for (int e = 0; e < 4; ++e) { y0[e] = y0[e] * __builtin_amdgcn_rcpf(1.0f + __expf(-z0[e])); y1[e] = y1[e] * __builtin_amdgcn_rcpf(1.0f + __expf(-z1[e]));
                        ssum += y0[e] * y0[e] + y1[e] * y1[e]; }
                    store8_bf16(YCAT + (size_t)r * D + col0 + bj * 128, y0, y1);
                }
                ssum += __shfl_xor(ssum, 16); ssum += __shfl_xor(ssum, 32);
                if (fq == 0) atomicAdd(ssb + r, ssum);
            }
    }
};
template <bool MIDS> struct EpiRes {
    static constexpr bool PERM = true, MID = MIDS;
    bf16_t* XB; float* ssout; const float* ssb;
    __device__ __forceinline__ int brow(int cb, int f) const { return cb + 16 * f; }
    __device__ __forceinline__ void mid_small(f32x4 (&acc)[2][2], int r0, int fr) const {
#pragma unroll
        for (int m = 0; m < 2; ++m) { const float sc = rsqrtf(((const GAS float*)ssb)[r0 + 16 * m + fr] * (1.0f / CH) + EPS); acc[m][0] *= sc; acc[m][1] *= sc; }
    }
    __device__ __forceinline__ void small(const f32x4 (&acc)[2][2], int r0, int cb, int fr, int fq) const {
#pragma unroll
        for (int m = 0; m < 2; ++m) {
            const int r = r0 + 16 * m + fr; float ssum = 0.f;
#pragma unroll
            for (int f = 0; f < 2; ++f) {
                bf16_t* p = XB + (size_t)r * D + cb + 16 * f + 4 * fq; const u32x2 xw = *(const GAS u32x2*)p;
                f32x4 x = (f32x4){bf_lo(xw.x), bf_hi(xw.x), bf_lo(xw.y), bf_hi(xw.y)} + acc[m][f];
#pragma unroll
                for (int e = 0; e < 4; ++e) ssum += x[e] * x[e];
                u32x2 w; w.x = cvt_pk_bf16(x[0], x[1]); w.y = cvt_pk_bf16(x[2], x[3]); *(GAS u32x2*)p = w;
            }
            ssum += __shfl_xor(ssum, 16); ssum += __shfl_xor(ssum, 32);
            if (fq == 0) atomicAdd(ssout + r, ssum);
        }
    }
    __device__ __forceinline__ void mid(Acc& acc, const Unit& u, int wr, int fr) const {
        const int row0 = u.pm * 256 + wr * 64 + fr;
#pragma unroll
        for (int ai = 0; ai < 2; ++ai)
#pragma unroll
            for (int m = 0; m < 4; ++m) {
                const float s = rsqrtf(((const GAS float*)ssb)[row0 + ai * 128 + m * 16] * (1.0f / CH) + EPS);
#pragma unroll
                for (int bj = 0; bj < 2; ++bj)
#pragma unroll
                    for (int n = 0; n < 2; ++n) acc[ai][bj][m][n] *= s;
            }
    }
    __device__ __forceinline__ void operator()(const Acc& acc, const Unit& u, int wr, int wc, int fr, int fq) const {
        const int row0 = u.pm * 256 + wr * 64 + fr, col0 = u.pn * 256 + wc * 32 + 8 * fq;
#pragma unroll
        for (int ai = 0; ai < 2; ++ai)
#pragma unroll
            for (int m = 0; m < 4; ++m) {
                const int r = row0 + ai * 128 + m * 16; float ssum = 0.f;
#pragma unroll
                for (int bj = 0; bj < 2; ++bj) {
                    bf16_t* p = XB + (size_t)r * D + col0 + bj * 128;
                    f32x4 x0, x1; unpack8(*(const GAS u32x4*)p, x0, x1);
                    x0 += acc[ai][bj][m][0]; x1 += acc[ai][bj][m][1];
#pragma unroll
                    for (int e = 0; e < 4; ++e) ssum += x0[e] * x0[e] + x1[e] * x1[e];
                    store8_bf16(p, x0, x1);
                }
                ssum += __shfl_xor(ssum, 16); ssum += __shfl_xor(ssum, 32);
                if (fq == 0) atomicAdd(ssout + r, ssum);
            }
    }
};
template <int ACT> struct EpiScale {
    static constexpr bool PERM = true, MID = false;
    bf16_t* OUT; int ldc; const float* ss;
    __device__ __forceinline__ int brow(int cb, int f) const { return cb + 16 * f; }
    __device__ __forceinline__ void small(const f32x4 (&acc)[2][2], int r0, int cb, int fr, int fq) const {
#pragma unroll
        for (int m = 0; m < 2; ++m) {
            const int r = r0 + 16 * m + fr; const float inv = rsqrtf(((const GAS float*)ss)[r] * (1.0f / D) + EPS);
#pragma unroll
            for (int f = 0; f < 2; ++f) {
                f32x4 v = acc[m][f] * inv;
                if (ACT == 1) {
#pragma unroll
                    for (int e = 0; e < 4; ++e) { const float a = fmaxf(v[e], 0.f); v[e] = a * a; }
                }
                u32x2 w; w.x = cvt_pk_bf16(v[0], v[1]); w.y = cvt_pk_bf16(v[2], v[3]); *(GAS u32x2*)(OUT + (size_t)r * ldc + cb + 16 * f + 4 * fq) = w;
            }
        }
    }
    __device__ __forceinline__ void operator()(const Acc& acc, const Unit& u, int wr, int wc, int fr, int fq) const {
        const int row0 = u.pm * 256 + wr * 64 + fr, col0 = u.pn * 256 + wc * 32 + 8 * fq;
#pragma unroll
        for (int ai = 0; ai < 2; ++ai)
#pragma unroll
            for (int m = 0; m < 4; ++m) {
                const int r = row0 + ai * 128 + m * 16; const float inv = rsqrtf(((const GAS float*)ss)[r] * (1.0f / D) + EPS);
#pragma unroll
                for (int bj = 0; bj < 2; ++bj) {
                    f32x4 v0 = acc[ai][bj][m][0] * inv, v1 = acc[ai][bj][m][1] * inv;
                    if (ACT == 1) {
#pragma unroll
                        for (int e = 0; e < 4; ++e) { const float a = fmaxf(v0[e], 0.f), b = fmaxf(v1[e], 0.f); v0[e] = a * a; v1[e] = b * b; }
                    }
                    store8_bf16(OUT + (size_t)r * ldc + col0 + bj * 128, v0, v1);
                }
            }
    }
};

template <class Epi>
__device__ __forceinline__ void small_gemm(const bf16_t* A, const bf16_t* Bt, int N, int K, const Epi& E, int c, int stride) {
    int tid = threadIdx.x; asm volatile("" : "+v"(tid));
    const int wave = __builtin_amdgcn_readfirstlane(tid >> 6), lane = tid & 63, fr = lane & 15, fq = lane >> 4;
    const int ntn = N >> 7, ntiles = (TS / 64) * ntn;
    if (c < 0) return;
    for (int tile = c; tile < ntiles; tile += stride) {
        const int tm = tile / ntn, tn = tile - tm * ntn;
        const int r0 = TP + tm * 64 + (wave >> 2) * 32, cb = tn * 128 + (wave & 3) * 32;
        const char* pa = (const char*)A + ((size_t)(r0 + fr) * K + 8 * fq) * 2;
        const char* pb0 = (const char*)Bt + ((size_t)(E.brow(cb, 0) + fr) * K + 8 * fq) * 2;
        const char* pb1 = (const char*)Bt + ((size_t)(E.brow(cb, 1) + fr) * K + 8 * fq) * 2;
        const size_t a16 = (size_t)16 * K * 2;
        f32x4 acc[2][2];
#pragma unroll
        for (int m = 0; m < 2; ++m)
#pragma unroll
            for (int f = 0; f < 2; ++f) acc[m][f] = (f32x4){0.f, 0.f, 0.f, 0.f};
        const int ng = K >> 7;
        bf16x8 A0[4], A1[4], B0[4], B1[4], C0[4], C1[4], D0[4], D1[4];
#define SG_LOAD(a0, a1, b0, b1, g) do { _Pragma("unroll") for (int j = 0; j < 4; ++j) { const size_t ko = (size_t)((g) * 4 + j) * 64; \
            a0[j] = *(const GAS bf16x8*)(pa + ko); a1[j] = *(const GAS bf16x8*)(pa + a16 + ko); b0[j] = *(const GAS bf16x8*)(pb0 + ko); b1[j] = *(const GAS bf16x8*)(pb1 + ko); } } while (0)
#define SG_MMA(a0, a1, b0, b1) do { _Pragma("unroll") for (int j = 0; j < 4; ++j) { \
            acc[0][0] = __builtin_amdgcn_mfma_f32_16x16x32_bf16(b0[j], a0[j], acc[0][0], 0, 0, 0); acc[0][1] = __builtin_amdgcn_mfma_f32_16x16x32_bf16(b1[j], a0[j], acc[0][1], 0, 0, 0); \
            acc[1][0] = __builtin_amdgcn_mfma_f32_16x16x32_bf16(b0[j], a1[j], acc[1][0], 0, 0, 0); acc[1][1] = __builtin_amdgcn_mfma_f32_16x16x32_bf16(b1[j], a1[j], acc[1][1], 0, 0, 0); } } while (0)
        SG_LOAD(A0, A1, B0, B1, 0);
        for (int g = 0; g < ng; g += 2) {
            if constexpr (Epi::MID) { if (g == (ng >> 1)) E.mid_small(acc, r0, fr); }
            SG_LOAD(C0, C1, D0, D1, g + 1);
            SG_MMA(A0, A1, B0, B1);
            if (g + 2 < ng) SG_LOAD(A0, A1, B0, B1, g + 2);
            SG_MMA(C0, C1, D0, D1);
        }
#undef SG_LOAD
#undef SG_MMA
        E.small(acc, r0, cb, fr, fq);
    }
}

struct EpiAtomic {
    static constexpr bool PERM = false, MID = false;
    float* SCR;
    __device__ __forceinline__ void operator()(const Acc& acc, const Unit& u, int wr, int wc, int fr, int fq) const {
        const int row0 = u.pm * 256 + wr * 64 + fr, col0 = u.pn * 256 + wc * 32 + 4 * fq;
        float* slab = SCR + (size_t)(u.ko >> 11) * TS * D;
#pragma unroll
        for (int ai = 0; ai < 2; ++ai)
#pragma unroll
            for (int m = 0; m < 4; ++m) {
                float* rp = slab + (size_t)(row0 + ai * 128 + m * 16) * D + col0;
#pragma unroll
                for (int bj = 0; bj < 2; ++bj)
#pragma unroll
                    for (int n = 0; n < 2; ++n) *(GAS f32x4*)(rp + bj * 128 + n * 16) = acc[ai][bj][m][n];
            }
    }
};
struct Args { const float* in[33]; float* out; unsigned char* ws; };
enum { I_XP = 0, I_XS, I_MEM, I_SCONV, I_SRE, I_SIM, I_CK, I_CV, I_GMIX, I_WIN, I_CONVW, I_ARE, I_AIM, I_LOGDT, I_BRE, I_BIM, I_CRE, I_CIM, I_SD, I_WGLU,
       I_GA, I_GB, I_WOUT, I_GX, I_GMEM, I_WQ, I_WK, I_WV, I_WO, I_GMLP, I_WUP, I_WDOWN, I_GFIN };

typedef const float* const __attribute__((address_space(4)))* KTab;
__device__ __forceinline__ KTab ktab() { unsigned long long p = (unsigned long long)__builtin_amdgcn_kernarg_segment_ptr(); asm volatile("" : "+s"(p)); return (KTab)p; }
__device__ __forceinline__ float* ss_arr(unsigned char* ws, int idx) { return (float*)(ws + WS_SS) + (size_t)idx * T; }
__device__ __forceinline__ float* invmem_arr(unsigned char* ws) { return (float*)(ws + WS_SS) + (size_t)9 * T; }

__device__ __forceinline__ int inproj_src_col(int vc) {
    if (vc < 512 || vc >= 1536) return vc;
    const int q = (vc - 512) >> 8, r = (vc - 512) & 255;
    return r < 128 ? 512 + q * 128 + r : 1024 + q * 128 + (r - 128);
}
__device__ __forceinline__ void transpose_item(const float* W, int ldw, int srck0, int srcn0, const float* gain, float gscale, bf16_t* WT, int ldt, int dn0, int dk0, LAS float* scr, int lane) {
#pragma unroll 8
    for (int i = 0; i < 32; ++i) { const int kk = 2 * i + (lane >> 5); float v = ((const GAS float*)W)[(size_t)(srck0 + kk) * ldw + srcn0 + (lane & 31)];
        const float gsc = gain ? ((const GAS float*)gain)[kk] * gscale : gscale; scr[kk * 33 + (lane & 31)] = v * gsc; }
    LDS_WAIT();
    const int c = lane & 7;
#pragma unroll
    for (int j = 0; j < 4; ++j) { const int n = (lane >> 3) + 8 * j; const LAS float* s = scr + (8 * c) * 33 + n;
        u32x4 o; o.x = cvt_pk_bf16(s[0 * 33], s[1 * 33]); o.y = cvt_pk_bf16(s[2 * 33], s[3 * 33]); o.z = cvt_pk_bf16(s[4 * 33], s[5 * 33]); o.w = cvt_pk_bf16(s[6 * 33], s[7 * 33]);
        *(GAS u32x4*)(WT + (size_t)(dn0 + n) * ldt + dk0 + 8 * c) = o; }
    LDS_WAIT();
}
__device__ __forceinline__ float convert_row(const float* src, bf16_t* dst, int lane) {
    const GAS f32x4* xr = (const GAS f32x4*)src + lane; f32x4 v[4]; float s = 0.f;
#pragma unroll
    for (int j = 0; j < 4; ++j) { v[j] = xr[64 * j]; s += (v[j][0] * v[j][0] + v[j][1] * v[j][1]) + (v[j][2] * v[j][2] + v[j][3] * v[j][3]); }
    GAS u32x2* o = (GAS u32x2*)dst + lane;
#pragma unroll
    for (int j = 0; j < 4; ++j) { u32x2 w; w.x = cvt_pk_bf16(v[j][0], v[j][1]); w.y = cvt_pk_bf16(v[j][2], v[j][3]); o[64 * j] = w; }
    return wave_sum(s);
}
constexpr int PI_IN = 1024, PI_GLU = 128, PI_SQ = 512, PI_UP = 2048, PI_CV = 2048;
constexpr int PI_LAYER = PI_IN + PI_GLU + 5 * PI_SQ + 2 * PI_UP + PI_CV;

__device__ __forceinline__ void prep_phase(unsigned char* ws, LAS unsigned char* lds, int gw, int NGW, int wave, int lane) {
    const KTab in = ktab();
    LAS float* scr = (LAS float*)(lds + wave * 8704);
    for (int it = gw; it < DEPTH * PI_LAYER; it += NGW) {
        const int l = it / PI_LAYER; int r = it - l * PI_LAYER;
        unsigned char* wl = ws + WS_W + (size_t)l * W_LAYER;
        if (r < PI_IN) { const int kb = r >> 6, nb = r & 63;
            transpose_item(as_global(in[I_WIN]) + (size_t)l * D * 2048, 2048, 64 * kb, inproj_src_col(32 * nb), as_global(in[I_GMIX]) + l * D + 64 * kb, 1.0f, (bf16_t*)(wl + W_IN), D, 32 * nb, 64 * kb, scr, lane); continue; }
        r -= PI_IN;
        if (r < PI_GLU) { const int kb = r >> 4, nb = r & 15;
            transpose_item(as_global(in[I_WGLU]) + (size_t)l * CH * CH, CH, 64 * kb, 32 * nb, nullptr, 1.0f, (bf16_t*)(wl + W_GLU), CH, 32 * nb, 64 * kb, scr, lane); continue; }
        r -= PI_GLU;
        if (r < PI_SQ) { const int kb = r >> 5, nb = r & 31, dk0 = 64 * kb;
            const float* gn = dk0 < 512 ? as_global(in[I_GB]) + l * CH + dk0 : as_global(in[I_GA]) + l * CH + dk0 - 512;
            transpose_item(as_global(in[I_WOUT]) + (size_t)l * D * D, D, (dk0 + 512) & 1023, 32 * nb, gn, 1.0f, (bf16_t*)(wl + W_OUT), D, 32 * nb, dk0, scr, lane); continue; }
        r -= PI_SQ;
        if (r < PI_SQ) { const int kb = r >> 5, nb = r & 31;
            transpose_item(as_global(in[I_WQ]) + (size_t)l * D * D, D, 64 * kb, 32 * nb, as_global(in[I_GX]) + l * D + 64 * kb, 0.0625f, (bf16_t*)(wl + W_Q), D, 32 * nb, 64 * kb, scr, lane); continue; }
        r -= PI_SQ;
        if (r < PI_SQ) { const int kb = r >> 5, nb = r & 31;
            transpose_item(as_global(in[I_WK]) + (size_t)l * D * D, D, 64 * kb, 32 * nb, as_global(in[I_GMEM]) + l * D + 64 * kb, 1.0f, (bf16_t*)(wl + W_KV), D, 32 * nb, 64 * kb, scr, lane); continue; }
        r -= PI_SQ;
        if (r < PI_SQ) { const int kb = r >> 5, nb = r & 31;
            transpose_item(as_global(in[I_WV]) + (size_t)l * D * D, D, 64 * kb, 32 * nb, as_global(in[I_GMEM]) + l * D + 64 * kb, 1.0f, (bf16_t*)(wl + W_KV), D, 1024 + 32 * nb, 64 * kb, scr, lane); continue; }
        r -= PI_SQ;
        if (r < PI_SQ) { const int kb = r >> 5, nb = r & 31;
            transpose_item(as_global(in[I_WO]) + (size_t)l * D * D, D, 64 * kb, 32 * nb, nullptr, 1.0f, (bf16_t*)(wl + W_O), D, 32 * nb, 64 * kb, scr, lane); continue; }
        r -= PI_SQ;
        if (r < PI_UP) { const int kb = r >> 7, nb = r & 127;
            transpose_item(as_global(in[I_WUP]) + (size_t)l * D * DFF, DFF, 64 * kb, 32 * nb, as_global(in[I_GMLP]) + l * D + 64 * kb, 1.0f, (bf16_t*)(wl + W_UP), D, 32 * nb, 64 * kb, scr, lane); continue; }
        r -= PI_UP;
        if (r < PI_UP) { const int kb = r >> 5, nb = r & 31;
            transpose_item(as_global(in[I_WDOWN]) + (size_t)l * DFF * D, D, 64 * kb, 32 * nb, nullptr, 1.0f, (bf16_t*)(wl + W_DOWN), DFF, 32 * nb, 64 * kb, scr, lane); continue; }
        r -= PI_UP;
        { const int kb = r >> 5, nb = r & 31;
            transpose_item(as_global(in[I_CV]) + (size_t)l * TMS * D, D, 64 * kb, 32 * nb, nullptr, 1.0f, (bf16_t*)(ws + WS_VTC) + (size_t)l * D * TMS, TMS, 32 * nb, 64 * kb, scr, lane); }
    }
    float* ss0 = ss_arr(ws, 0); float* invm = invmem_arr(ws);
    for (int m0 = gw * 2; m0 < T; m0 += NGW * 2) {
        const float* src = m0 < TP ? as_global(in[I_XP]) + (size_t)m0 * D : as_global(in[I_XS]) + (size_t)(m0 - TP) * D;
        const GAS f32x4* xr = (const GAS f32x4*)src + lane; f32x4 v[8]; float s0 = 0.f, s1 = 0.f;
#pragma unroll
        for (int j = 0; j < 8; ++j) v[j] = xr[64 * j];
#pragma unroll
        for (int j = 0; j < 4; ++j) { s0 += (v[j][0] * v[j][0] + v[j][1] * v[j][1]) + (v[j][2] * v[j][2] + v[j][3] * v[j][3]);
            s1 += (v[4 + j][0] * v[4 + j][0] + v[4 + j][1] * v[4 + j][1]) + (v[4 + j][2] * v[4 + j][2] + v[4 + j][3] * v[4 + j][3]); }
        GAS u32x2* o = (GAS u32x2*)((bf16_t*)(ws + WS_XB) + (size_t)m0 * D) + lane;
#pragma unroll
        for (int j = 0; j < 8; ++j) { u32x2 w; w.x = cvt_pk_bf16(v[j][0], v[j][1]); w.y = cvt_pk_bf16(v[j][2], v[j][3]); o[64 * j] = w; }
        s0 = wave_sum(s0); s1 = wave_sum(s1);
        if (lane == 0) { ((GAS float*)ss0)[m0] = s0; ((GAS float*)ss0)[m0 + 1] = s1; }
    }
    for (int m = T + gw; m < T + TM + 2 * TMS; m += NGW) {
        if (m < T) { const float* src = m < TP ? as_global(in[I_XP]) + (size_t)m * D : as_global(in[I_XS]) + (size_t)(m - TP) * D;
            const float s = convert_row(src, (bf16_t*)(ws + WS_XB) + (size_t)m * D, lane); if (lane == 0) ((GAS float*)ss0)[m] = s; }
        else if (m < T + TM) { const int mm = m - T; const float s = convert_row(as_global(in[I_MEM]) + (size_t)mm * D, (bf16_t*)(ws + WS_MNB) + (size_t)mm * D, lane);
            if (lane == 0) ((GAS float*)invm)[mm] = rsqrtf(s * (1.0f / D) + EPS); }
        else { const int mm = m - T - TM; (void)convert_row(as_global(in[I_CK]) + (size_t)mm * D, (bf16_t*)(ws + WS_KC) + (size_t)mm * D, lane); }
    }
    {
        float* sm = (float*)(ws + WS_SMALL); const int gt = gw * 64 + lane, NT = NGW * 64;
#define SMCOPY(off, idx, n) for (int i = gt; i < (n); i += NT) ((GAS float*)sm)[(off) + i] = ((const GAS float*)in[idx])[i]
        SMCOPY(SM_ARE, I_ARE, 4096); SMCOPY(SM_AIM, I_AIM, 4096); SMCOPY(SM_LOGDT, I_LOGDT, 64); SMCOPY(SM_BRE, I_BRE, 65536); SMCOPY(SM_BIM, I_BIM, 65536);
        SMCOPY(SM_CRE, I_CRE, 65536); SMCOPY(SM_CIM, I_CIM, 65536); SMCOPY(SM_SD, I_SD, 1024); SMCOPY(SM_CONVW, I_CONVW, 3072); SMCOPY(SM_SCONV, I_SCONV, 32768);
        SMCOPY(SM_SRE, I_SRE, 65536); SMCOPY(SM_SIM, I_SIM, 65536); SMCOPY(SM_GFIN, I_GFIN, 1024);
#undef SMCOPY
    }
    { float* z = ss_arr(ws, 1); const size_t n = (size_t)8 * T; for (size_t i = (size_t)gw * 64 + lane; i < n; i += (size_t)NGW * 64) ((GAS float*)z)[i] = 0.f; }
}

__device__ __forceinline__ float gelu_tanh(float x) {
    const float u = 0.7978845608f * (x + 0.044715f * x * x * x);
    const float e = __expf(2.0f * u);
    const float th = 1.0f - 2.0f * __builtin_amdgcn_rcpf(e + 1.0f);
    return 0.5f * x * (1.0f + th);
}
__device__ __forceinline__ void sincos_small(float x, float& s, float& c) {
    const float q = rintf(x * 0.63661977236f);
    float r = fmaf(-q, 1.57079637050628662109375f, x); r = fmaf(-q, -4.37113900018624283e-8f, r);
    const float r2 = r * r;
    const float sp = r + r * r2 * (-1.0f / 6 + r2 * (1.0f / 120 + r2 * (-1.0f / 5040 + r2 * (1.0f / 362880))));
    const float cp = 1.0f + r2 * (-0.5f + r2 * (1.0f / 24 + r2 * (-1.0f / 720 + r2 * (1.0f / 40320 + r2 * (-1.0f / 3628800)))));
    const int qi = (int)q & 3;
    s = (qi == 0) ? sp : (qi == 1) ? cp : (qi == 2) ? -sp : -cp;
    c = (qi == 0) ? cp : (qi == 1) ? -sp : (qi == 2) ? -cp : sp;
}
constexpr int BU_STRIDE = 528, H_STRIDE = 272, SCAN_LDS_WAVE = 16 * BU_STRIDE + 16 * H_STRIDE;

__device__ __forceinline__ void scan_item(unsigned char* ws, float* out, int l, int item, LAS unsigned char* wl, int lane_in) {
    int lane = lane_in; asm volatile("" : "+v"(lane));
    const GAS float* sm = (const GAS float*)(ws + WS_SMALL);
    int b, g, row0, nblk; const bool prompt = item < NB * 32;
    if (prompt) { b = item >> 5; g = item & 31; row0 = b * SEQ; nblk = SEQ / 16; }
    else { const int i2 = item - NB * 32; b = i2 >> 5; g = i2 & 31; row0 = TP + b * DSEQ; nblk = DSEQ / 16; }
    const bf16_t* U = (const bf16_t*)(ws + WS_U); bf16_t* YG = (bf16_t*)(ws + WS_YG);
    const int lg = l * 32 + g, p = lane, t16 = lane & 15, q = lane >> 4;
    const float are = fminf(sm[SM_ARE + lg * 64 + p], -1e-4f), aim = sm[SM_AIM + lg * 64 + p];
    const float dt = expf(sm[SM_LOGDT + lg]);
    float sn, cs; sincos_small(aim * dt, sn, cs);
    const float mag = expf(are * dt), abr = mag * cs, abi = mag * sn;
    const float nr = abr - 1.0f, ni = abi, den = 1.0f / (are * are + aim * aim);
    const float c0 = (nr * are + ni * aim) * den, c1 = (ni * are - nr * aim) * den;
    bf16x8 af[8];
#pragma unroll
    for (int f = 0; f < 8; ++f) {
        const int i = 16 * f + t16, ps = i >> 1, cc = i & 1;
        const float k0 = __shfl(c0, ps), k1 = __shfl(c1, ps);
        u32x4 w = (u32x4){0u, 0u, 0u, 0u};
        if (q < 2) {
            const GAS f32x4* br = (const GAS f32x4*)(sm + SM_BRE + ((size_t)lg * 64 + ps) * 16 + 8 * q); const GAS f32x4* bi = (const GAS f32x4*)(sm + SM_BIM + ((size_t)lg * 64 + ps) * 16 + 8 * q);
            const f32x4 r0 = br[0], r1 = br[1], i0 = bi[0], i1 = bi[1];
            f32x4 v0, v1;
            if (cc == 0) { v0 = k0 * r0 - k1 * i0; v1 = k0 * r1 - k1 * i1; } else { v0 = k0 * i0 + k1 * r0; v1 = k0 * i1 + k1 * r1; }
            w.x = cvt_pk_bf16(v0[0], v0[1]); w.y = cvt_pk_bf16(v0[2], v0[3]); w.z = cvt_pk_bf16(v1[0], v1[1]); w.w = cvt_pk_bf16(v1[2], v1[3]);
        }
        af[f] = __builtin_bit_cast(bf16x8, w);
    }
    bf16x8 cf[4];
#pragma unroll
    for (int s = 0; s < 4; ++s) {
        const int p0 = 16 * s + 4 * q;
        const f32x4 cr = *(const GAS f32x4*)(sm + SM_CRE + ((size_t)lg * 16 + t16) * 64 + p0), ci = *(const GAS f32x4*)(sm + SM_CIM + ((size_t)lg * 16 + t16) * 64 + p0);
        u32x4 w; w.x = cvt_pk_bf16(cr[0], -ci[0]); w.y = cvt_pk_bf16(cr[1], -ci[1]); w.z = cvt_pk_bf16(cr[2], -ci[2]); w.w = cvt_pk_bf16(cr[3], -ci[3]);
        cf[s] = __builtin_bit_cast(bf16x8, w);
    }
    const f32x4 dsk = *(const GAS f32x4*)(sm + SM_SD + l * CH + g * 16 + 4 * q);
    float hre = 0.f, him = 0.f;
    if (!prompt) { hre = sm[SM_SRE + (((size_t)l * NDB + b) * 32 + g) * 64 + p]; him = sm[SM_SIM + (((size_t)l * NDB + b) * 32 + g) * 64 + p]; }
    LAS unsigned char* BU = wl; LAS unsigned char* HB = wl + 16 * BU_STRIDE;
    const char* ubase = (const char*)U + (size_t)row0 * CH * 2; char* ybase = (char*)YG + (size_t)row0 * CH * 2;
    const unsigned lo8 = (unsigned)((t16 * CH + g * 16 + 8 * (q & 1)) * 2), lo4 = (unsigned)((t16 * CH + g * 16 + 4 * q) * 2);
    constexpr size_t BSTEP = (size_t)16 * CH * 2;
    constexpr int PD = 6;
    u32x4 ubuf[PD]; u32x2 ebuf[PD];
#pragma unroll
    for (int j = 0; j < PD; ++j) { ubuf[j] = (u32x4){0u, 0u, 0u, 0u}; ebuf[j] = (u32x2){0u, 0u};
        if (j < nblk) { const char* un = ubase + (size_t)j * BSTEP; if (q < 2) ubuf[j] = *(const GAS u32x4*)(un + lo8); ebuf[j] = *(const GAS u32x2*)(un + lo4); } }
    for (int tb0 = 0; tb0 < nblk; tb0 += PD) {
#pragma unroll
        for (int j = 0; j < PD; ++j) {
            const int tb = tb0 + j;
            if (tb < nblk) {
                const u32x4 ubc = ubuf[j]; const u32x2 uec = ebuf[j];
                if (tb + PD < nblk) { const char* un = ubase + (size_t)(tb + PD) * BSTEP; if (q < 2) ubuf[j] = *(const GAS u32x4*)(un + lo8); ebuf[j] = *(const GAS u32x2*)(un + lo4); }
                const bf16x8 bfrag = __builtin_bit_cast(bf16x8, ubc);
#pragma unroll
                for (int f = 0; f < 8; ++f) {
                    const f32x4 r = __builtin_amdgcn_mfma_f32_16x16x32_bf16(af[f], bfrag, (f32x4){0.f, 0.f, 0.f, 0.f}, 0, 0, 0);
                    *(LAS f32x4*)(BU + t16 * BU_STRIDE + (16 * f + 4 * q) * 4) = r;
                }
                LDS_WAIT();
                f32x2 buv[16];
#pragma unroll
                for (int t = 0; t < 16; ++t) buv[t] = *(const LAS f32x2*)(BU + t * BU_STRIDE + p * 8);
#pragma unroll
                for (int t = 0; t < 16; ++t) {
                    const float nre = fmaf(abr, hre, fmaf(-abi, him, buv[t][0])), nim = fmaf(abr, him, fmaf(abi, hre, buv[t][1]));
                    hre = nre; him = nim;
                    *(LAS unsigned*)(HB + t * H_STRIDE + p * 4) = cvt_pk_bf16(hre, him);
                }
                LDS_WAIT();
                f32x4 y = (f32x4){0.f, 0.f, 0.f, 0.f};
#pragma unroll
                for (int s2 = 0; s2 < 4; ++s2) {
                    const bf16x8 hf = *(const LAS bf16x8*)(HB + t16 * H_STRIDE + (32 * s2 + 8 * q) * 2);
                    y = __builtin_amdgcn_mfma_f32_16x16x32_bf16(cf[s2], hf, y, 0, 0, 0);
                }
                const float u0 = bf_lo(uec.x), u1 = bf_hi(uec.x), u2 = bf_lo(uec.y), u3 = bf_hi(uec.y);
                const float g0 = gelu_tanh(y[0] + dsk[0] * u0), g1 = gelu_tanh(y[1] + dsk[1] * u1), g2 = gelu_tanh(y[2] + dsk[2] * u2), g3 = gelu_tanh(y[3] + dsk[3] * u3);
                u32x2 w; w.x = cvt_pk_bf16(g0, g1); w.y = cvt_pk_bf16(g2, g3);
                *(GAS u32x2*)(ybase + (size_t)tb * BSTEP + lo4) = w;
                LDS_WAIT();
            }
        }
    }
    GAS float* outg = (GAS float*)out;
    if (prompt) { outg[O_REP + (((size_t)l * NB + b) * 32 + g) * 64 + p] = hre; outg[O_IMP + (((size_t)l * NB + b) * 32 + g) * 64 + p] = him; }
    else { outg[O_RES + (((size_t)l * NDB + b) * 32 + g) * 64 + p] = hre; outg[O_IMS + (((size_t)l * NDB + b) * 32 + g) * 64 + p] = him; }
}
__device__ __forceinline__ void conv_run(unsigned char* ws, int l, int run, int lane_in) {
    int lane = lane_in; asm volatile("" : "+v"(lane));
    const GAS float* sm = (const GAS float*)(ws + WS_SMALL);
    const bf16_t* XIN = (const bf16_t*)(ws + WS_XIN); const bf16_t* BG = (const bf16_t*)(ws + WS_BG); bf16_t* YCAT = (bf16_t*)(ws + WS_YCAT);
    const int row0 = run * 64, c0 = lane * 8;
    f32x4 w0a, w0b, w1a, w1b, w2a, w2b;
    { const GAS float* cw = sm + SM_CONVW + (size_t)l * 3 * CH + c0; w0a = *(const GAS f32x4*)cw; w0b = *(const GAS f32x4*)(cw + 4); w1a = *(const GAS f32x4*)(cw + CH); w1b = *(const GAS f32x4*)(cw + CH + 4);
      w2a = *(const GAS f32x4*)(cw + 2 * CH); w2b = *(const GAS f32x4*)(cw + 2 * CH + 4); }
    f32x4 p2a, p2b, p1a, p1b;
    const bool seq_start = row0 < TP ? ((row0 & (SEQ - 1)) == 0) : true;
    if (!seq_start) { unpack8(*(const GAS u32x4*)(XIN + (size_t)(row0 - 2) * CH + c0), p2a, p2b); unpack8(*(const GAS u32x4*)(XIN + (size_t)(row0 - 1) * CH + c0), p1a, p1b); }
    else if (row0 < TP) { p2a = p2b = p1a = p1b = (f32x4){0.f, 0.f, 0.f, 0.f}; }
    else { const int b = (row0 - TP) >> 6; const GAS float* st = sm + SM_SCONV + ((size_t)(l * NDB + b) * 2) * CH + c0;
        p2a = *(const GAS f32x4*)st; p2b = *(const GAS f32x4*)(st + 4); p1a = *(const GAS f32x4*)(st + CH); p1b = *(const GAS f32x4*)(st + CH + 4); }
    for (int tb = 0; tb < 64; tb += 8) {
        u32x4 xr[8], br[8];
#pragma unroll
        for (int j = 0; j < 8; ++j) { const size_t o = (size_t)(row0 + tb + j) * CH + c0; xr[j] = *(const GAS u32x4*)(XIN + o); br[j] = *(const GAS u32x4*)(BG + o); }
#pragma unroll
        for (int j = 0; j < 8; ++j) {
            f32x4 xa, xb, ba, bb; unpack8(xr[j], xa, xb); unpack8(br[j], ba, bb);
            f32x4 ya = ba * (w0a * p2a + w1a * p1a + w2a * xa), yb = bb * (w0b * p2b + w1b * p1b + w2b * xb);
            float s = 0.f;
#pragma unroll
            for (int e = 0; e < 4; ++e) s += ya[e] * ya[e] + yb[e] * yb[e];
            s = wave_sum(s);
            const float inv = rsqrtf(s * (1.0f / CH) + EPS);
            store8_bf16(YCAT + (size_t)(row0 + tb + j) * D + 512 + c0, ya * inv, yb * inv);
            p2a = p1a; p2b = p1b; p1a = xa; p1b = xb;
        }
    }
}

constexpr int KST = 528, VST = 520;
__device__ __forceinline__ void attn_phase(unsigned char* ws, int l, LAS unsigned char* lds, int G, int bid) {
    int tid = threadIdx.x; asm volatile("" : "+v"(tid));
    const int wave = __builtin_amdgcn_readfirstlane(tid >> 6);
    const bf16_t* Q = (const bf16_t*)(ws + WS_Q); bf16_t* O = (bf16_t*)(ws + WS_O);
    const int NU = NB * 4 * 8 + NDB * 4;
    for (int u = bid; u < NU; u += G) {
        int qrow0, nq, ldv; const bf16_t* Kp; const bf16_t* Vp; int h;
        if (u < NB * 32) { const int b = u >> 5; h = (u >> 3) & 3; const int qt = u & 7; qrow0 = b * SEQ + qt * 256; nq = 256;
            Kp = (const bf16_t*)(ws + WS_KB) + (size_t)l * TM * D + (size_t)(b * NMEM) * D + h * 256; Vp = (const bf16_t*)(ws + WS_VT) + (size_t)l * D * TM + (size_t)(h * 256) * TM + b * NMEM; ldv = TM; }
        else { const int i = u - NB * 32, b = i >> 2; h = i & 3; qrow0 = TP + b * DSEQ; nq = DSEQ;
            Kp = (const bf16_t*)(ws + WS_KC) + (size_t)l * TMS * D + (size_t)(b * NMEM) * D + h * 256; Vp = (const bf16_t*)(ws + WS_VTC) + (size_t)l * D * TMS + (size_t)(h * 256) * TMS + b * NMEM; ldv = TMS; }
        const bool active = wave * 32 < nq;
        __syncthreads();
        int t2 = tid; asm volatile("" : "+v"(t2));
        {
            const int c = t2 & 31, rr = t2 >> 5; const unsigned off = (unsigned)((rr * D + c * 8) * 2); const char* kb = (const char*)Kp;
            LAS unsigned char* ld0 = lds + rr * KST + c * 16;
#pragma unroll
            for (int hb = 0; hb < 4; ++hb) {
                u32x4 v[4];
#pragma unroll
                for (int i = 0; i < 4; ++i) v[i] = *(const GAS u32x4*)(kb + (size_t)(16 * (hb * 4 + i)) * D * 2 + off);
#pragma unroll
                for (int i = 0; i < 4; ++i) *(LAS u32x4*)(ld0 + 16 * (hb * 4 + i) * KST) = v[i];
            }
        }
        bf16x8 qf[16];
        const int r32 = t2 & 31, hh = (t2 >> 5) & 1;
        const int qrow = qrow0 + wave * 32 + r32;
        if (active) {
#pragma unroll
            for (int ks = 0; ks < 16; ++ks) qf[ks] = *(const GAS bf16x8*)(Q + (size_t)qrow * D + h * 256 + 16 * ks + 8 * hh);
        } else {
#pragma unroll
            for (int ks = 0; ks < 16; ++ks) qf[ks] = (bf16x8){0, 0, 0, 0, 0, 0, 0, 0};
        }
        __syncthreads();
        constexpr int NQ = 4, MTQ = 8 / NQ;
        bf16x8 pf[16]; float qmax[NQ], qsum[NQ];
#pragma unroll
        for (int qi = 0; qi < NQ; ++qi) { qmax[qi] = 0.f; qsum[qi] = 1.f; }
        if (active) {
#pragma unroll
            for (int qi = 0; qi < NQ; ++qi) {
                f32x16 sc[MTQ];
#pragma unroll
                for (int mq = 0; mq < MTQ; ++mq)
#pragma unroll
                    for (int e = 0; e < 16; ++e) sc[mq][e] = 0.f;
#pragma unroll
                for (int ks = 0; ks < 16; ++ks)
#pragma unroll
                    for (int mq = 0; mq < MTQ; ++mq) {
                        const bf16x8 kf = *(const LAS bf16x8*)(lds + (32 * (qi * MTQ + mq) + r32) * KST + (16 * ks + 8 * hh) * 2);
                        sc[mq] = __builtin_amdgcn_mfma_f32_32x32x16_bf16(kf, qf[ks], sc[mq], 0, 0, 0);
                    }
                float mx = -3.0e38f;
#pragma unroll
                for (int mq = 0; mq < MTQ; ++mq)
#pragma unroll
                    for (int e = 0; e < 16; ++e) mx = fmaxf(mx, sc[mq][e]);
                mx = fmaxf(mx, __shfl_xor(mx, 32));
                float sum = 0.f;
#pragma unroll
                for (int mq = 0; mq < MTQ; ++mq) {
#pragma unroll
                    for (int e = 0; e < 16; ++e) { const float pe = __builtin_amdgcn_exp2f((sc[mq][e] - mx) * 1.44269504089f); sc[mq][e] = pe; sum += pe; }
#pragma unroll
                    for (int s2 = 0; s2 < 2; ++s2) {
                        u32x4 w; w.x = cvt_pk_bf16(sc[mq][8 * s2 + 0], sc[mq][8 * s2 + 1]); w.y = cvt_pk_bf16(sc[mq][8 * s2 + 2], sc[mq][8 * s2 + 3]);
                        w.z = cvt_pk_bf16(sc[mq][8 * s2 + 4], sc[mq][8 * s2 + 5]); w.w = cvt_pk_bf16(sc[mq][8 * s2 + 6], sc[mq][8 * s2 + 7]);
                        pf[2 * (qi * MTQ + mq) + s2] = __builtin_bit_cast(bf16x8, w);
                    }
                }
                sum += __shfl_xor(sum, 32);
                qmax[qi] = mx; qsum[qi] = sum;
                __builtin_amdgcn_sched_barrier(0);
            }
        } else {
#pragma unroll
            for (int i = 0; i < 16; ++i) pf[i] = (bf16x8){0, 0, 0, 0, 0, 0, 0, 0};
        }
        float fq_[NQ]; float rinv;
        { float M = qmax[0];
#pragma unroll
          for (int qi = 1; qi < NQ; ++qi) M = fmaxf(M, qmax[qi]);
          float tot = 0.f;
#pragma unroll
          for (int qi = 0; qi < NQ; ++qi) { fq_[qi] = __builtin_amdgcn_exp2f((qmax[qi] - M) * 1.44269504089f); tot += fq_[qi] * qsum[qi]; }
          rinv = 1.0f / tot;
#pragma unroll
          for (int qi = 0; qi < NQ; ++qi) fq_[qi] *= rinv; }
        __syncthreads();
        {
            const int c = t2 & 31, rr = t2 >> 5; const unsigned off = (unsigned)((rr * ldv + c * 8) * 2); const char* vb = (const char*)Vp;
            LAS unsigned char* ld0 = lds + rr * VST + c * 16;
#pragma unroll
            for (int hb = 0; hb < 4; ++hb) {
                u32x4 v[4];
#pragma unroll
                for (int i = 0; i < 4; ++i) v[i] = *(const GAS u32x4*)(vb + (size_t)(16 * (hb * 4 + i)) * ldv * 2 + off);
#pragma unroll
                for (int i = 0; i < 4; ++i) { LAS u32x2* d = (LAS u32x2*)(ld0 + 16 * (hb * 4 + i) * VST); d[0] = (u32x2){v[i].x, v[i].y}; d[1] = (u32x2){v[i].z, v[i].w}; }
            }
        }
        __syncthreads();
        if (active) {
#pragma unroll
            for (int dt = 0; dt < 8; ++dt) {
                f32x16 acc[NQ];
#pragma unroll
                for (int qi = 0; qi < NQ; ++qi)
#pragma unroll
                    for (int e = 0; e < 16; ++e) acc[qi][e] = 0.f;
#pragma unroll
                for (int mi = 0; mi < 16 / NQ; ++mi)
#pragma unroll
                    for (int qi = 0; qi < NQ; ++qi) {
                        const int ms = qi * (16 / NQ) + mi;
                        const LAS unsigned char* vp = lds + (32 * dt + r32) * VST + (16 * ms + 4 * hh) * 2;
                        const u32x2 lo = *(const LAS u32x2*)vp, hi = *(const LAS u32x2*)(vp + 16);
                        const u32x4 w = (u32x4){lo.x, lo.y, hi.x, hi.y};
                        acc[qi] = __builtin_amdgcn_mfma_f32_32x32x16_bf16(__builtin_bit_cast(bf16x8, w), pf[ms], acc[qi], 0, 0, 0);
                    }
#pragma unroll
                for (int g4 = 0; g4 < 4; ++g4) {
                    float o4[4];
#pragma unroll
                    for (int e = 0; e < 4; ++e) { float v = 0.f;
#pragma unroll
                        for (int qi = 0; qi < NQ; ++qi) v = fmaf(acc[qi][4 * g4 + e], fq_[qi], v);
                        o4[e] = v; }
                    u32x2 w; w.x = cvt_pk_bf16(o4[0], o4[1]); w.y = cvt_pk_bf16(o4[2], o4[3]);
                    *(GAS u32x2*)(O + (size_t)qrow * D + h * 256 + 32 * dt + 8 * g4 + 4 * hh) = w;
                }
                __builtin_amdgcn_sched_barrier(0);
            }
        }
    }
    __syncthreads();
}

#define XB_TMO      128
#define XB_XCNT(j)  (256  + 64 * (j))
#define XB_XSUB(j)  (1280 + 64 * (j))
#define XB_XGEN(j)  (2304 + 64 * (j))
#define XB_TOP      3328
#define XB_TOPGEN   3392
#define XCD_BAR_WORDS 3456
#define XB_SPIN_CAP (1u << 18)

__device__ __forceinline__ unsigned xb_ld(unsigned* p)              { return __hip_atomic_load(p, __ATOMIC_RELAXED, __HIP_MEMORY_SCOPE_AGENT); }
__device__ __forceinline__ unsigned xb_add(unsigned* p, unsigned v) { return __hip_atomic_fetch_add(p, v, __ATOMIC_RELAXED, __HIP_MEMORY_SCOPE_AGENT); }
__device__ __forceinline__ unsigned xb_xcc_id() { return (unsigned)__builtin_amdgcn_s_getreg((3 << 11) | 20) & 0xFu; }
#define XB_SPIN(cond, bar) do { unsigned _sp = 0; while (cond) { __builtin_amdgcn_s_sleep(1); \
    if ((++_sp & 255u) == 0u) { if (xb_ld(&(bar)[XB_TMO])) break; if (_sp > XB_SPIN_CAP) { atomicAdd(&(bar)[XB_TMO], 1u); break; } } } } while (0)

struct XcdBarrier {
    unsigned* bar; unsigned x;
    volatile LAS unsigned* st;
};

__device__ __forceinline__ XcdBarrier xcd_barrier_post(unsigned* bar, volatile LAS unsigned* st) {
    XcdBarrier b; b.bar = bar; b.x = xb_xcc_id(); b.st = st;
    if (threadIdx.x == 0) (void)xb_add(&bar[XB_XCNT(b.x)], 1u);
    return b;
}
__device__ __forceinline__ void xcd_barrier_complete(unsigned* bar, unsigned x, unsigned& nloc, unsigned& nx) {
    const unsigned G = gridDim.x * gridDim.y * gridDim.z;
    unsigned sum, cnt, mine, sp = 0u;
    for (;;) {
        sum = 0u; cnt = 0u; mine = 0u;
#pragma unroll
        for (unsigned j = 0; j < 16; ++j) { const unsigned c = xb_ld(&bar[XB_XCNT(j)]); sum += c; cnt += (c > 0u) ? 1u : 0u; mine = (j == x) ? c : mine; }
        if (sum == G) break;
        __builtin_amdgcn_s_sleep(1);
        if ((++sp & 255u) == 0u) { if (xb_ld(&bar[XB_TMO])) break; if (sp > XB_SPIN_CAP) { atomicAdd(&bar[XB_TMO], 1u); break; } }
    }
    nloc = mine > 0u ? mine : 1u; nx = cnt > 0u ? cnt : 1u;
}

__device__ __forceinline__ void xcd_barrier(const XcdBarrier& b) {
    asm volatile("s_waitcnt vmcnt(0)" ::: "memory");
    __syncthreads();
    if (threadIdx.x == 0) {
        unsigned* bar = b.bar;
        __builtin_amdgcn_s_waitcnt(0);
        unsigned nloc = b.st[0], nx = b.st[1];
        if (nloc == 0u) { xcd_barrier_complete(bar, b.x, nloc, nx); b.st[0] = nloc; b.st[1] = nx; }
        const unsigned old = xb_add(&bar[XB_XSUB(b.x)], 1u);
        const unsigned gen = old / nloc;
        if (old + 1u == (gen + 1u) * nloc) {
            __builtin_amdgcn_fence(__ATOMIC_RELEASE, "agent");
            asm volatile("s_waitcnt vmcnt(0)" ::: "memory");
            const unsigned og = xb_add(&bar[XB_TOP], 1u);
            const unsigned tg = og / nx;
            if (og + 1u == (tg + 1u) * nx) xb_add(&bar[XB_TOPGEN], 1u);
            else XB_SPIN(xb_ld(&bar[XB_TOPGEN]) == tg, bar);
            __builtin_amdgcn_fence(__ATOMIC_ACQUIRE, "agent");
            xb_add(&bar[XB_XGEN(b.x)], 1u);
            asm volatile("s_waitcnt vmcnt(0)" ::: "memory");
        } else {
            XB_SPIN(xb_ld(&bar[XB_XGEN(b.x)]) == gen, bar);
            __builtin_amdgcn_fence(__ATOMIC_ACQUIRE, "agent");
            asm volatile("s_waitcnt vmcnt(0)" ::: "memory");
        }
    }
    __syncthreads();
}

constexpr bool USE_SP2 = true;
__global__ void __launch_bounds__(512, 2) hybrid_fwd(Args a) {
    extern __shared__ __attribute__((aligned(16))) unsigned char lds_raw[];
    LAS unsigned char* lds = (LAS unsigned char*)lds_raw;
    cg::grid_group grid = cg::this_grid();
    volatile LAS unsigned* bst = (volatile LAS unsigned*)(lds + LDS_BYTES - 64);
    if (threadIdx.x < 16) bst[threadIdx.x] = 0u;
    __syncthreads();
    const XcdBarrier xbar = xcd_barrier_post((unsigned*)(a.ws + WS_BAR), bst);
    const int tid = threadIdx.x, lane = tid & 63, wave = __builtin_amdgcn_readfirstlane(tid >> 6);
    const int G = gridDim.x, bid = blockIdx.x;
    unsigned char* ws = as_global(a.ws);
    const int NGW = G * 8;

#ifndef NO_PREP
    for (int rep = 0; rep < REP_PREP; ++rep) { prep_phase(ws, lds, bid * 8 + wave, NGW, wave, lane); __syncthreads(); }
#endif
    grid.sync();

#define FRESH() unsigned char* wsp = ws; int ll = l, bb = bid, gg = G; asm volatile("" : "+s"(wsp), "+s"(ll), "+s"(bb), "+s"(gg)); wsp = as_global(wsp); float* outp = as_global(a.out); (void)outp; unsigned char* wl = wsp + WS_W + (size_t)ll * W_LAYER; (void)wl
#define SSA(k) ss_arr(wsp, 1 + 4 * ll + (k))
#pragma unroll 1
    for (int l = 0; l < DEPTH; ++l) {
        {
            FRESH();
            pg8::Gemm g{(const bf16_t*)(wsp + WS_XB), (const bf16_t*)(wl + W_IN), T, 2048, D, D, D}; pg8::StaticOrder S; S.init(T, 2048, gg, bb);
            EpiInProj E{(bf16_t*)(wsp + WS_BG), (bf16_t*)(wsp + WS_XIN), (bf16_t*)(wsp + WS_U), ll == 0 ? ss_arr(wsp, 0) : ss_arr(wsp, 4), outp + O_CONVP + (size_t)ll * NB * 2 * CH, outp + O_CONVS + (size_t)ll * NDB * 2 * CH};
#ifndef NO_GEMM
            pg8::gemm_phase<EpiInProj, USE_SP2, pg8::StaticOrder>(lds, g, S, E);
#endif
#ifndef NO_SMALL
            small_gemm(g.A, g.Bt, 2048, D, E, bb >= (gg >> 1) ? bb - (gg >> 1) : -1, gg >> 1);
#endif
        }
        {
            FRESH();
            pg8::Gemm g{(const bf16_t*)(wl + W_KV) + (size_t)D * D, (const bf16_t*)(wsp + WS_MNB), D, TM, D, D, D}; pg8::StaticOrder S; S.init(D, TM, gg, (bb + gg - (32 % gg)) % gg);
            EpiVT E{(bf16_t*)(wsp + WS_VT) + (size_t)ll * D * TM, invmem_arr(wsp)};
#ifndef NO_GEMM
            pg8::gemm_phase<EpiVT, USE_SP2, pg8::StaticOrder>(lds, g, S, E);
#endif
        }
        xcd_barrier(xbar);
        {
            FRESH();
            int tid2 = threadIdx.x; asm volatile("" : "+v"(tid2)); const int lane2 = tid2 & 63;
            const int w = wave * gg + bb; const int NGW2 = gg * 8;
            for (int rep = 0; rep < REP_SCAN; ++rep) {
#ifndef NO_SCAN
            for (int it = w; it < NB * 32 + NDB * 32; it += NGW2) scan_item(wsp, outp, ll, it, lds + wave * SCAN_LDS_WAVE, lane2);
#endif
#ifndef NO_CONV
            for (int run = NGW2 - 1 - w; run < T / 64; run += NGW2) conv_run(wsp, ll, run, lane2);
#endif
            }
        }
        xcd_barrier(xbar);
        {
            FRESH();
            pg8::Gemm g{(const bf16_t*)(wsp + WS_YG), (const bf16_t*)(wl + W_GLU), T, CH, CH, CH, CH}; pg8::StaticOrder S; S.init(T, CH, gg, bb);
            EpiGLU E{(const bf16_t*)(wsp + WS_YG), (bf16_t*)(wsp + WS_YCAT), SSA(0)};
#ifndef NO_GEMM
            pg8::gemm_phase<EpiGLU, USE_SP2, pg8::StaticOrder>(lds, g, S, E);
#endif
#ifndef NO_SMALL
            small_gemm(g.A, g.Bt, CH, CH, E, bb, gg);
#endif
        }
        xcd_barrier(xbar);
        {
            FRESH();
            pg8::Gemm g{(const bf16_t*)(wsp + WS_YCAT), (const bf16_t*)(wl + W_OUT), T, D, D, D, D}; pg8::StaticOrder S; S.init(T, D, gg, bb);
            EpiRes<true> E{(bf16_t*)(wsp + WS_XB), SSA(1), SSA(0)};
#ifndef NO_GEMM
            pg8::gemm_phase<EpiRes<true>, USE_SP2, pg8::StaticOrder>(lds, g, S, E);
#endif
#ifndef NO_SMALL
            small_gemm(g.A, g.Bt, D, D, E, bb, gg);
#endif
        }
        {
            FRESH();
            pg8::Gemm g{(const bf16_t*)(wsp + WS_MNB), (const bf16_t*)(wl + W_KV), TM, D, D, D, D}; pg8::StaticOrder S; S.init(TM, D, gg, (bb + gg - (16 % gg)) % gg);
            EpiKV<false> E{outp + O_MKP + (size_t)ll * TM * D, outp + O_MVP + (size_t)ll * TM * D, (bf16_t*)(wsp + WS_KB) + (size_t)ll * TM * D, invmem_arr(wsp)};
#if !defined(NO_GEMM)
            pg8::gemm_phase<EpiKV<false>, USE_SP2, pg8::StaticOrder>(lds, g, S, E);
#endif
        }
        xcd_barrier(xbar);
        {
            FRESH();
            pg8::Gemm g{(const bf16_t*)(wsp + WS_XB), (const bf16_t*)(wl + W_Q), T, D, D, D, D}; pg8::StaticOrder S; S.init(T, D, gg, bb);
            EpiScale<0> E{(bf16_t*)(wsp + WS_Q), D, SSA(1)};
#ifndef NO_GEMM
            pg8::gemm_phase<EpiScale<0>, USE_SP2, pg8::StaticOrder>(lds, g, S, E);
#endif
#ifndef NO_SMALL
            small_gemm(g.A, g.Bt, D, D, E, bb, gg);
#endif
        }
        {
            FRESH();
            pg8::Gemm g{(const bf16_t*)(wsp + WS_MNB), (const bf16_t*)(wl + W_KV) + (size_t)D * D, TM, D, D, D, D}; pg8::StaticOrder S; S.init(TM, D, gg, (bb + gg - (16 % gg)) % gg);
            EpiKV<true> E{outp + O_MKP + (size_t)ll * TM * D, outp + O_MVP + (size_t)ll * TM * D, (bf16_t*)(wsp + WS_KB) + (size_t)ll * TM * D, invmem_arr(wsp)};
#if !defined(NO_GEMM)
            pg8::gemm_phase<EpiKV<true>, USE_SP2, pg8::StaticOrder>(lds, g, S, E);
#endif
        }
        xcd_barrier(xbar);
        {
            FRESH();
#ifndef NO_ATTN
            for (int rep = 0; rep < REP_ATTN; ++rep) attn_phase(wsp, ll, lds, gg, bb);
#endif
        }
        xcd_barrier(xbar);
        {
            FRESH();
            pg8::Gemm g{(const bf16_t*)(wsp + WS_O), (const bf16_t*)(wl + W_O), T, D, D, D, D}; pg8::StaticOrder S; S.init(T, D, gg, bb);
            EpiRes<false> E{(bf16_t*)(wsp + WS_XB), SSA(2), nullptr};
#ifndef NO_GEMM
            pg8::gemm_phase<EpiRes<false>, USE_SP2, pg8::StaticOrder>(lds, g, S, E);
#endif
#ifndef NO_SMALL
            small_gemm(g.A, g.Bt, D, D, E, bb, gg);
#endif
        }
        xcd_barrier(xbar);
        {
            FRESH();
            pg8::Gemm g{(const bf16_t*)(wsp + WS_XB), (const bf16_t*)(wl + W_UP), T, DFF, D, D, D}; pg8::StaticOrder S; S.init(T, DFF, gg, bb);
            EpiScale<1> E{(bf16_t*)(wsp + WS_HDN), DFF, SSA(2)};
#ifndef NO_GEMM
            for (int rep = 0; rep < REP_UP; ++rep) pg8::gemm_phase<EpiScale<1>, USE_SP2, pg8::StaticOrder>(lds, g, S, E);
#endif
#ifndef NO_SMALL
            small_gemm(g.A, g.Bt, DFF, D, E, bb, gg);
#endif
        }
        xcd_barrier(xbar);
        {
            FRESH();
            pg8::Gemm g{(const bf16_t*)(wsp + WS_HDN), (const bf16_t*)(wl + W_DOWN), TP, D, DFF, DFF, DFF}; pg8::StaticOrder S; S.init(TP, D, gg, bb);
            EpiRes<false> E{(bf16_t*)(wsp + WS_XB), SSA(3), nullptr};
#if !defined(NO_GEMM)
            pg8::gemm_phase<EpiRes<false>, USE_SP2, pg8::StaticOrder>(lds, g, S, E);
#endif
        }
        {
            FRESH();
            pg8::Gemm g{(const bf16_t*)(wsp + WS_HDN) + (size_t)TP * DFF, (const bf16_t*)(wl + W_DOWN), TS, D, D, DFF, DFF}; pg8::KSplitOrder S; S.init(TS, D, 4, D, gg, bb);
            EpiAtomic E{(float*)(wsp + WS_SCR)};
#if !defined(NO_GEMM)
            pg8::gemm_phase<EpiAtomic, USE_SP2, pg8::KSplitOrder>(lds, g, S, E);
#endif
        }
        xcd_barrier(xbar);
        {
            FRESH();
            int tid4 = threadIdx.x; asm volatile("" : "+v"(tid4)); const int lane4 = tid4 & 63;
            GAS float* scr = (GAS float*)(wsp + WS_SCR); GAS float* ss3 = (GAS float*)SSA(3);
            for (int r = bb * 8 + wave; r < TS; r += gg * 8) {
                GAS f32x4* sp = (GAS f32x4*)(scr + (size_t)r * D) + lane4; GAS u32x2* xp = (GAS u32x2*)((bf16_t*)(wsp + WS_XB) + (size_t)(TP + r) * D) + lane4;
                float ssum = 0.f;
#pragma unroll
                for (int j = 0; j < 4; ++j) { const f32x4 d = (sp[64 * j] + sp[64 * j + (size_t)TS * D / 4]) + (sp[64 * j + 2 * ((size_t)TS * D / 4)] + sp[64 * j + 3 * ((size_t)TS * D / 4)]); const u32x2 w = xp[64 * j];
                    const f32x4 x = (f32x4){bf_lo(w.x), bf_hi(w.x), bf_lo(w.y), bf_hi(w.y)} + d;
                    ssum += (x[0] * x[0] + x[1] * x[1]) + (x[2] * x[2] + x[3] * x[3]);
                    u32x2 o; o.x = cvt_pk_bf16(x[0], x[1]); o.y = cvt_pk_bf16(x[2], x[3]); xp[64 * j] = o; }
                ssum = wave_sum(ssum);
                if (lane4 == 0) ss3[TP + r] = ssum;
            }
        }
        xcd_barrier(xbar);
    }
    {
        int tid3 = threadIdx.x; asm volatile("" : "+v"(tid3)); const int lane = tid3 & 63;
        const bf16_t* XB = (const bf16_t*)(ws + WS_XB); const float* ssf = ss_arr(ws, 1 + 4 + 3); const GAS float* gf = (const GAS float*)(ws + WS_SMALL) + SM_GFIN;
        f32x4 gv[4];
#pragma unroll
        for (int j = 0; j < 4; ++j) gv[j] = *(const GAS f32x4*)(gf + 256 * j + 4 * lane);
        for (int m0 = (bid * 8 + wave) * 4; m0 < T; m0 += NGW * 4) {
            u32x2 wv[4][4]; float inv[4];
#pragma unroll
            for (int r = 0; r < 4; ++r) { const GAS u32x2* xr = (const GAS u32x2*)(XB + (size_t)(m0 + r) * D) + lane;
#pragma unroll
                for (int j = 0; j < 4; ++j) wv[r][j] = xr[64 * j];
                inv[r] = rsqrtf(((const GAS float*)ssf)[m0 + r] * (1.0f / D) + EPS); }
#pragma unroll
            for (int r = 0; r < 4; ++r) { GAS f32x4* o = (GAS f32x4*)(a.out + (size_t)(m0 + r) * D) + lane;
#pragma unroll
                for (int j = 0; j < 4; ++j) { const u32x2 w = wv[r][j]; o[64 * j] = (f32x4){bf_lo(w.x), bf_hi(w.x), bf_lo(w.y), bf_hi(w.y)} * inv[r] * gv[j]; } }
        }
    }
}

extern "C" void kernel_launch(void* const* d_in, const int* in_sizes, int n_in, void* d_out, int out_size, void* d_ws, size_t ws_size, hipStream_t stream) {
    static int grid = 0;
    if (grid == 0) {
        if (n_in != 33 || (size_t)out_size != O_END || ws_size < WS_END) { fprintf(stderr, "kernel_launch: unexpected sizes n_in %d out %d ws %zu (need %zu)\n", n_in, out_size, ws_size, (size_t)WS_END); grid = -1; return; }
        int dev = 0, cus = 0, per_cu = 0;
        (void)hipGetDevice(&dev); (void)hipDeviceGetAttribute(&cus, hipDeviceAttributeMultiprocessorCount, dev);
        if (hipFuncSetAttribute((const void*)hybrid_fwd, hipFuncAttributeMaxDynamicSharedMemorySize, LDS_BYTES) != hipSuccess) { fprintf(stderr, "kernel_launch: hipFuncSetAttribute failed\n"); grid = -1; return; }
        if (hipOccupancyMaxActiveBlocksPerMultiprocessor(&per_cu, (const void*)hybrid_fwd, 512, LDS_BYTES) != hipSuccess || per_cu < 1) { fprintf(stderr, "kernel_launch: occupancy query says %d\n", per_cu); per_cu = 1; }
        (void)hipGetLastError();
        grid = cus > 0 ? cus : 256;
    }
    if (grid < 0) return;
    if (hipMemsetAsync((char*)d_ws + WS_BAR, 0, BAR_BYTES, stream) != hipSuccess) { fprintf(stderr, "kernel_launch: hipMemsetAsync failed\n"); return; }
    Args a{};
    for (int i = 0; i < 33; ++i) a.in[i] = (const float*)d_in[i];
    a.out = (float*)d_out; a.ws = (unsigned char*)d_ws;
    void* args[] = {&a};
    hipError_t e = hipLaunchCooperativeKernel((const void*)hybrid_fwd, dim3(grid), dim3(512), args, LDS_BYTES, stream);
    if (e != hipSuccess) fprintf(stderr, "kernel_launch: cooperative launch failed: %s (grid %d)\n", hipGetErrorString(e), grid);
}
```

```cpp
#include <hip/hip_runtime.h>
#include <hip/hip_cooperative_groups.h>
#include <cstdio>
#include <cstdint>
namespace cg = cooperative_groups;
#define NO_SMALL 1
#ifndef REP_PREP
#define REP_PREP 1
#endif
#ifndef REP_SCAN
#define REP_SCAN 1
#endif
#ifndef REP_ATTN
#define REP_ATTN 1
#endif
#ifndef REP_UP
#define REP_UP 1
#endif

#define LAS __attribute__((address_space(3)))
#define GAS __attribute__((address_space(1)))
typedef unsigned short bf16_t;
typedef short bf16x8 __attribute__((ext_vector_type(8)));
typedef short bf16x4 __attribute__((ext_vector_type(4)));
typedef float f32x2 __attribute__((ext_vector_type(2)));
typedef float f32x4 __attribute__((ext_vector_type(4)));
typedef float f32x16 __attribute__((ext_vector_type(16)));
typedef unsigned u32x4 __attribute__((ext_vector_type(4)));
typedef unsigned u32x2 __attribute__((ext_vector_type(2)));

constexpr int D = 1024, NB = 32, SEQ = 2048, NDB = 16, DSEQ = 64, DEPTH = 2;
constexpr int TP = NB * SEQ, TS = NDB * DSEQ, T = TP + TS;
constexpr int NMEM = 256, TM = NB * NMEM, TMS = NDB * NMEM;
constexpr int DFF = 4096, CH = 512;
constexpr float EPS = 1e-6f;
constexpr size_t O_YP = 0, O_YS = O_YP + (size_t)TP * D, O_CONVP = O_YS + (size_t)TS * D, O_REP = O_CONVP + (size_t)DEPTH * NB * 2 * CH,
                 O_IMP = O_REP + (size_t)DEPTH * NB * 32 * 64, O_MKP = O_IMP + (size_t)DEPTH * NB * 32 * 64, O_MVP = O_MKP + (size_t)DEPTH * TM * D,
                 O_CONVS = O_MVP + (size_t)DEPTH * TM * D, O_RES = O_CONVS + (size_t)DEPTH * NDB * 2 * CH, O_IMS = O_RES + (size_t)DEPTH * NDB * 32 * 64,
                 O_END = O_IMS + (size_t)DEPTH * NDB * 32 * 64;
constexpr size_t MiB = 1u << 20;
constexpr size_t WS_SS = 0;
constexpr size_t WS_BAR = 3 * MiB + MiB / 2, BAR_BYTES = 16384;
constexpr size_t WS_W = 4 * MiB, W_LAYER = 31 * MiB;
constexpr size_t W_IN = 0, W_GLU = 4 * MiB, W_OUT = 4 * MiB + MiB / 2, W_Q = 6 * MiB + MiB / 2, W_KV = 8 * MiB + MiB / 2, W_O = 12 * MiB + MiB / 2,
                 W_UP = 14 * MiB + MiB / 2, W_DOWN = 22 * MiB + MiB / 2;
constexpr size_t WS_XB = 66 * MiB;
constexpr size_t WS_MNB = 196 * MiB;
constexpr size_t WS_KB = 212 * MiB;
constexpr size_t WS_VT = 244 * MiB;
constexpr size_t WS_KC = 276 * MiB;
constexpr size_t WS_VTC = 292 * MiB;
constexpr size_t WS_BIG = 308 * MiB;
constexpr size_t SZ_T512 = (size_t)T * 512 * 2;
constexpr size_t WS_BG = WS_BIG, WS_XIN = WS_BG + SZ_T512, WS_U = WS_XIN + SZ_T512, WS_YG = WS_U + SZ_T512, WS_YCAT = WS_YG + SZ_T512;
constexpr size_t WS_Q = WS_BG, WS_O = WS_U, WS_HDN = WS_BIG;
constexpr size_t WS_SMALL = WS_BIG + (size_t)T * DFF * 2;
constexpr size_t WS_SCR = WS_SMALL + 4 * MiB;
constexpr size_t WS_END = WS_SCR + 16 * MiB;
constexpr int SM_ARE = 0, SM_AIM = 4096, SM_LOGDT = 8192, SM_BRE = 8256, SM_BIM = SM_BRE + 65536, SM_CRE = SM_BIM + 65536, SM_CIM = SM_CRE + 65536, SM_SD = SM_CIM + 65536,
              SM_CONVW = SM_SD + 1024, SM_SCONV = SM_CONVW + 3072, SM_SRE = SM_SCONV + 32768, SM_SIM = SM_SRE + 65536, SM_GFIN = SM_SIM + 65536, SM_END = SM_GFIN + 1024;
static_assert(WS_YCAT + 2 * SZ_T512 <= WS_END, "ws map");

constexpr int LDS_BYTES = 256 * 528 + 1024;

template <class Tp> __device__ __forceinline__ Tp* as_global(Tp* p) {
#if defined(__HIP_DEVICE_COMPILE__)
    __builtin_assume(!__builtin_amdgcn_is_shared((const __attribute__((address_space(0))) void*)p) && !__builtin_amdgcn_is_private((const __attribute__((address_space(0))) void*)p));
#endif
    return p;
}
__device__ __forceinline__ unsigned cvt_pk_bf16(float lo, float hi) { unsigned r; asm volatile("v_cvt_pk_bf16_f32 %0, %1, %2" : "=v"(r) : "v"(lo), "v"(hi)); return r; }
__device__ __forceinline__ float bf_lo(unsigned w) { return __uint_as_float(w << 16); }
__device__ __forceinline__ float bf_hi(unsigned w) { return __uint_as_float(w & 0xffff0000u); }
__device__ __forceinline__ float wave_sum(float v) {
#pragma unroll
    for (int o = 1; o < 64; o <<= 1) v += __shfl_xor(v, o);
    return v;
}
#define LDS_WAIT() asm volatile("s_waitcnt lgkmcnt(0)" ::: "memory")

namespace pg8 {
constexpr int BM = 256, BK = 64, HALF = 128, HTB = HALF * BK * 2, STAGE_BYTES = 8 * HTB, NXCD = 8, WGM = 8;
__host__ __device__ __forceinline__ int lds_byte(int r, int c) { const int st = (r >> 4) * 2 + (c >> 5), rr = r & 15, cc = c & 31, ob = rr * 64 + cc * 2; return st * 1024 + (ob ^ (((ob >> 9) & 1) << 5)); }
__host__ __device__ __forceinline__ void stage_rc(int b, int& R, int& C) { const int st = b / 1024, sb = b % 1024, swz = sb ^ (((sb >> 9) & 1) << 5); R = (st >> 1) * 16 + swz / 64; C = (st & 1) * 32 + (swz % 64) / 2; }
__host__ __device__ __forceinline__ int perm32(int rho) { const int n = rho >> 4, i = rho & 15; return 8 * (i >> 2) + 4 * n + (i & 3); }

struct Unit { int pm, pn, ko; };
struct Gemm { const bf16_t* A; const bf16_t* Bt; int M, N, K, lda, ldb; };

struct StaticOrder {
    int nM, nN, nwg, G, c;
    __device__ void init(int M, int N, int G_, int c_) { nM = M / BM; nN = N / BM; nwg = nM * nN; G = G_; c = c_; }
    __device__ bool next(int i, Unit& u) const {
        const long L = (long)i * G + c; if (L >= nwg) return false;
        int wgid = (int)L; { const int q = nwg / NXCD, r = nwg % NXCD, xcd = wgid % NXCD, off = wgid / NXCD; wgid = (xcd < r ? xcd * (q + 1) : r * (q + 1) + (xcd - r) * q) + off; }
        const int nig = WGM * nN, gid = wgid / nig, fm = gid * WGM, gsz = (nM - fm) < WGM ? (nM - fm) : WGM;
        u.pm = fm + ((wgid % nig) % gsz); u.pn = (wgid % nig) / gsz; u.ko = 0; return true;
    }
};
struct KSplitOrder {
    int nN, nS, nwg, G, c, kslice_bytes;
    __device__ void init(int M, int N, int nS_, int kslice, int G_, int c_) { nN = N / BM; nS = nS_; nwg = (M / BM) * nN * nS; G = G_; c = c_; kslice_bytes = kslice * 2; }
    __device__ bool next(int i, Unit& u) const {
        const long L = (long)i * G + c; if (L >= nwg) return false;
        const int l = (int)L, sidx = l % nS, t = l / nS; u.pn = t % nN; u.pm = t / nN; u.ko = sidx * kslice_bytes; return true;
    }
};

template <class Epi, bool SP2, class Sched>
__device__ __forceinline__ void gemm_phase(LAS unsigned char* lds, const Gemm g, const Sched& S, const Epi& E) {
    int tid = threadIdx.x; asm volatile("" : "+v"(tid));
    const int wid = __builtin_amdgcn_readfirstlane(tid >> 6), lane = tid & 63, wr = wid >> 2, wc = wid & 3, fr = lane & 15, fq = lane >> 4;
    const int K = g.K, nt = K / BK;
    unsigned voffA[2], voffB[2];
#pragma unroll
    for (int i = 0; i < 2; ++i) { int R, C; stage_rc(tid * 16 + i * 8192, R, C); const int Rb = Epi::PERM ? ((R & ~31) + perm32(R & 31)) : R;
        voffA[i] = (unsigned)(R * g.lda + C) * 2u; voffB[i] = (unsigned)(Rb * g.ldb + C) * 2u; }
    const size_t kstep = (size_t)(BK * 2);
    const size_t hstep = (size_t)HALF * g.lda * 2, hstepB = (size_t)HALF * g.ldb * 2;
    const size_t tstep = 2 * hstep, tstepB = 2 * hstepB;
    const unsigned ldsw = (unsigned)wid * 1024u;
    const int aoff = lds_byte(wr * 64 + fr, fq * 8), boff = lds_byte(wc * 32 + fr, fq * 8);
#define PG8_SA(b, h) (((b) * 2 + (h)) * HTB)
#define PG8_SB(b, h) ((4 + (b) * 2 + (h)) * HTB)
#define PG8_STAGE(bufoff, gbase, voff) do { _Pragma("unroll") for (int _i = 0; _i < 2; ++_i) \
        __builtin_amdgcn_global_load_lds((const unsigned*)((const char*)(gbase) + (voff)[_i]), (LAS unsigned*)(lds + (bufoff) + ldsw + _i * 8192), 16, 0, 0); } while (0)
#define PG8_LDA(dst, b, h) do { _Pragma("unroll") for (int m = 0; m < 4; ++m) _Pragma("unroll") for (int k = 0; k < 2; ++k) dst[m][k] = *(const LAS bf16x8*)(lds + PG8_SA(b, h) + aoff + m * 2048 + k * 1024); } while (0)
#define PG8_LDB(dst, b, h) do { _Pragma("unroll") for (int n = 0; n < 2; ++n) _Pragma("unroll") for (int k = 0; k < 2; ++k) dst[n][k] = *(const LAS bf16x8*)(lds + PG8_SB(b, h) + boff + n * 2048 + k * 1024); } while (0)
#define PG8_MMA(ai, bj, At, Bt) do { __builtin_amdgcn_s_setprio(1); _Pragma("unroll") for (int m = 0; m < 4; ++m) _Pragma("unroll") for (int n = 0; n < 2; ++n) _Pragma("unroll") for (int k = 0; k < 2; ++k) \
        acc[ai][bj][m][n] = __builtin_amdgcn_mfma_f32_16x16x32_bf16(Bt[n][k], At[m][k], acc[ai][bj][m][n], 0, 0, 0); __builtin_amdgcn_s_setprio(0); } while (0)
#define PG8_WAIT_V(n) asm volatile("s_waitcnt vmcnt(" #n ")" ::: "memory")
#define PG8_WAIT_L(n) asm volatile("s_waitcnt lgkmcnt(" #n ")" ::: "memory")
#define PG8_BAR __builtin_amdgcn_s_barrier()
#define PG8_SCHED __builtin_amdgcn_sched_barrier(0)
    Unit cur, nxt; int ui = 0;
    if (!S.next(0, cur)) return;
    f32x4 acc[2][2][4][2];
#pragma unroll
    for (int a = 0; a < 2; ++a)
#pragma unroll
        for (int b = 0; b < 2; ++b)
#pragma unroll
            for (int m = 0; m < 4; ++m)
#pragma unroll
                for (int n = 0; n < 2; ++n) acc[a][b][m][n] = (f32x4){0.f, 0.f, 0.f, 0.f};
    bf16x8 At[4][2], B0[2][2], B1[2][2];
    const char* cA = (const char*)g.A + (size_t)cur.pm * tstep + cur.ko; const char* cB = (const char*)g.Bt + (size_t)cur.pn * tstepB + cur.ko;
    if constexpr (SP2) {
        PG8_STAGE(PG8_SB(0, 0), cB, voffB); PG8_STAGE(PG8_SB(0, 1), cB + hstepB, voffB); PG8_STAGE(PG8_SA(0, 0), cA, voffA); PG8_STAGE(PG8_SA(0, 1), cA + hstep, voffA);
        if (wr == 1) PG8_BAR;
        PG8_WAIT_V(2); PG8_BAR;
        PG8_STAGE(PG8_SB(1, 0), cB + kstep, voffB); PG8_STAGE(PG8_SA(1, 0), cA + kstep, voffA); PG8_STAGE(PG8_SB(1, 1), cB + hstepB + kstep, voffB);
        PG8_WAIT_V(6); PG8_BAR;
    } else {
        PG8_STAGE(PG8_SB(0, 0), cB, voffB); PG8_STAGE(PG8_SA(0, 0), cA, voffA); PG8_STAGE(PG8_SB(0, 1), cB + hstepB, voffB); PG8_STAGE(PG8_SA(0, 1), cA + hstep, voffA);
        if (wr == 1) PG8_BAR;
        PG8_WAIT_V(4); PG8_BAR;
        PG8_STAGE(PG8_SB(1, 0), cB + kstep, voffB); PG8_STAGE(PG8_SA(1, 0), cA + kstep, voffA); PG8_STAGE(PG8_SB(1, 1), cB + hstepB + kstep, voffB);
        PG8_WAIT_V(6); PG8_BAR;
    }
    for (;;) {
        const bool has_next = S.next(ui + 1, nxt);
        const char* nA = has_next ? (const char*)g.A + (size_t)nxt.pm * tstep + nxt.ko : cA; const char* nB = has_next ? (const char*)g.Bt + (size_t)nxt.pn * tstepB + nxt.ko : cB;
        for (int t = 0; t < nt; t += 2) {
            const bool last = (t == nt - 2);
            const char* a1 = cA + (size_t)(t + 1) * kstep;
            const char* a2 = last ? nA : cA + (size_t)(t + 2) * kstep; const char* b2 = last ? nB : cB + (size_t)(t + 2) * kstep;
            const char* a3 = a2 + kstep; const char* b3 = b2 + kstep;
            if constexpr (Epi::MID) { if (t == (nt >> 1)) E.mid(acc, cur, wr, fr); }
            if constexpr (SP2) {
            PG8_LDB(B0, 0, 0); PG8_LDB(B1, 0, 1); PG8_SCHED; PG8_LDA(At, 0, 0); PG8_STAGE(PG8_SA(1, 1), a1 + hstep, voffA);
            PG8_WAIT_V(8); PG8_WAIT_L(0); PG8_BAR; PG8_MMA(0, 0, At, B0); PG8_MMA(0, 1, At, B1); PG8_BAR; PG8_SCHED;
            PG8_LDA(At, 0, 1); PG8_STAGE(PG8_SB(0, 0), b2, voffB); PG8_STAGE(PG8_SB(0, 1), b2 + hstepB, voffB); PG8_STAGE(PG8_SA(0, 0), a2, voffA);
            PG8_WAIT_V(8); PG8_WAIT_L(0); PG8_BAR; PG8_MMA(1, 0, At, B0); PG8_MMA(1, 1, At, B1); PG8_BAR; PG8_SCHED;
            PG8_LDB(B0, 1, 0); PG8_LDB(B1, 1, 1); PG8_SCHED; PG8_LDA(At, 1, 0); PG8_STAGE(PG8_SA(0, 1), a2 + hstep, voffA);
            PG8_WAIT_V(8); PG8_WAIT_L(0); PG8_BAR; PG8_MMA(0, 0, At, B0); PG8_MMA(0, 1, At, B1); PG8_BAR; PG8_SCHED;
            PG8_LDA(At, 1, 1); PG8_STAGE(PG8_SB(1, 0), b3, voffB); PG8_STAGE(PG8_SB(1, 1), b3 + hstepB, voffB); PG8_STAGE(PG8_SA(1, 0), a3, voffA);
            PG8_WAIT_V(8); PG8_WAIT_L(0); PG8_BAR; PG8_MMA(1, 0, At, B0); PG8_MMA(1, 1, At, B1); PG8_BAR; PG8_SCHED;
            } else {
            PG8_LDB(B0, 0, 0); PG8_SCHED; PG8_LDA(At, 0, 0); PG8_STAGE(PG8_SA(1, 1), a1 + hstep, voffA);
            PG8_WAIT_L(8); PG8_BAR; PG8_WAIT_L(0); PG8_MMA(0, 0, At, B0); PG8_BAR; PG8_SCHED;
            PG8_LDB(B1, 0, 1); PG8_STAGE(PG8_SB(0, 0), b2, voffB);
            PG8_BAR; PG8_WAIT_L(0); PG8_MMA(0, 1, At, B1); PG8_BAR;
            PG8_LDA(At, 0, 1); PG8_STAGE(PG8_SA(0, 0), a2, voffA);
            PG8_BAR; PG8_WAIT_L(0); PG8_MMA(1, 0, At, B0); PG8_BAR; PG8_SCHED;
            PG8_STAGE(PG8_SB(0, 1), b2 + hstepB, voffB);
            PG8_WAIT_V(6); PG8_BAR; PG8_MMA(1, 1, At, B1); PG8_BAR;
            PG8_LDB(B0, 1, 0); PG8_SCHED; PG8_LDA(At, 1, 0); PG8_STAGE(PG8_SA(0, 1), a2 + hstep, voffA);
            PG8_WAIT_L(8); PG8_BAR; PG8_WAIT_L(0); PG8_MMA(0, 0, At, B0); PG8_BAR; PG8_SCHED;
            PG8_LDB(B1, 1, 1); PG8_STAGE(PG8_SB(1, 0), b3, voffB);
            PG8_BAR; PG8_WAIT_L(0); PG8_MMA(0, 1, At, B1); PG8_BAR;
            PG8_LDA(At, 1, 1); PG8_STAGE(PG8_SA(1, 0), a3, voffA);
            PG8_BAR; PG8_WAIT_L(0); PG8_MMA(1, 0, At, B0); PG8_BAR; PG8_SCHED;
            PG8_STAGE(PG8_SB(1, 1), b3 + hstepB, voffB);
            PG8_WAIT_V(6); PG8_BAR; PG8_MMA(1, 1, At, B1); PG8_BAR;
            }
        }
        if (wr == 0) PG8_BAR;
        E(acc, cur, wr, wc, fr, fq);
        if (!has_next) break;
#pragma unroll
        for (int a = 0; a < 2; ++a)
#pragma unroll
            for (int b = 0; b < 2; ++b)
#pragma unroll
                for (int m = 0; m < 4; ++m)
#pragma unroll
                    for (int n = 0; n < 2; ++n) acc[a][b][m][n] = (f32x4){0.f, 0.f, 0.f, 0.f};
        cur = nxt; cA = nA; cB = nB; ++ui;
        if (wr == 1) PG8_BAR;
    }
    PG8_WAIT_V(0);
    PG8_BAR;
#undef PG8_SA
#undef PG8_SB
#undef PG8_STAGE
#undef PG8_LDA
#undef PG8_LDB
#undef PG8_MMA
#undef PG8_WAIT_V
#undef PG8_WAIT_L
#undef PG8_BAR
#undef PG8_SCHED
}
}
using pg8::Unit;
typedef f32x4 Acc[2][2][4][2];

__device__ __forceinline__ void store8_bf16(bf16_t* p, const f32x4& a, const f32x4& b) {
    u32x4 w; w.x = cvt_pk_bf16(a[0], a[1]); w.y = cvt_pk_bf16(a[2], a[3]); w.z = cvt_pk_bf16(b[0], b[1]); w.w = cvt_pk_bf16(b[2], b[3]);
    *(GAS u32x4*)p = w;
}
__device__ __forceinline__ void unpack8(const u32x4 w, f32x4& a, f32x4& b) {
    a = (f32x4){bf_lo(w.x), bf_hi(w.x), bf_lo(w.y), bf_hi(w.y)}; b = (f32x4){bf_lo(w.z), bf_hi(w.z), bf_lo(w.w), bf_hi(w.w)};
}

struct EpiInProj {
    static constexpr bool PERM = true, MID = false;
    bf16_t* BG; bf16_t* XIN; bf16_t* U; const float* ss; float* convp; float* convs;
    __device__ __forceinline__ int brow(int cb, int f) const {
        const int cg = cb >> 5;
        if (cg < 16) return cb + 16 * f;
        if (cg >= 48) return 1536 + 32 * (cg - 48) + 16 * f;
        const int c = 16 * (cg - 16), q = c >> 7, r = c & 127;
        return 512 + 256 * q + 128 * f + r;
    }
    __device__ __forceinline__ void small(const f32x4 (&acc)[2][2], int r0, int cb, int fr, int fq) const {
        const int cg = cb >> 5;
#pragma unroll
        for (int m = 0; m < 2; ++m) {
            const int r = r0 + 16 * m + fr; const float inv = rsqrtf(((const GAS float*)ss)[r] * (1.0f / D) + EPS);
            if (cg < 16 || cg >= 48) {
                bf16_t* dst = (cg < 16 ? BG + (size_t)r * CH + cb : U + (size_t)r * CH + (cb - 1536)) + 4 * fq;
#pragma unroll
                for (int f = 0; f < 2; ++f) { const f32x4 v = acc[m][f] * inv; u32x2 w; w.x = cvt_pk_bf16(v[0], v[1]); w.y = cvt_pk_bf16(v[2], v[3]); *(GAS u32x2*)(dst + 16 * f) = w; }
            } else {
                const int c0 = 16 * (cg - 16) + 4 * fq;
                const f32x4 x = (acc[m][0] * inv) * (acc[m][1] * inv);
                u32x2 w; w.x = cvt_pk_bf16(x[0], x[1]); w.y = cvt_pk_bf16(x[2], x[3]); *(GAS u32x2*)(XIN + (size_t)r * CH + c0) = w;
                const int rs = r - TP, t = rs & (DSEQ - 1);
                if (t >= DSEQ - 2) *(GAS f32x4*)(convs + ((size_t)(rs >> 6) * 2 + (t - (DSEQ - 2))) * CH + c0) = x;
            }
        }
    }
    __device__ __forceinline__ void operator()(const Acc& acc, const Unit& u, int wr, int wc, int fr, int fq) const {
        const int row0 = u.pm * 256 + wr * 64 + fr, cb = wc * 32 + 8 * fq;
#pragma unroll
        for (int ai = 0; ai < 2; ++ai)
#pragma unroll
            for (int m = 0; m < 4; ++m) {
                const int r = row0 + ai * 128 + m * 16;
                const float inv = rsqrtf(((const GAS float*)ss)[r] * (1.0f / D) + EPS);
                if (u.pn < 2 || u.pn >= 6) {
                    bf16_t* dst = (u.pn < 2 ? BG : U) + (size_t)r * CH + (u.pn & 1) * 256 + cb;
#pragma unroll
                    for (int bj = 0; bj < 2; ++bj) store8_bf16(dst + bj * 128, acc[ai][bj][m][0] * inv, acc[ai][bj][m][1] * inv);
                } else {
                    const int c0 = (u.pn - 2) * 128 + cb;
                    const f32x4 x0 = (acc[ai][0][m][0] * inv) * (acc[ai][1][m][0] * inv), x1 = (acc[ai][0][m][1] * inv) * (acc[ai][1][m][1] * inv);
                    store8_bf16(XIN + (size_t)r * CH + c0, x0, x1);
                    float* cd = nullptr;
                    if (r < TP) { const int t = r & (SEQ - 1); if (t >= SEQ - 2) cd = convp + ((size_t)(r >> 11) * 2 + (t - (SEQ - 2))) * CH + c0; }
                    else { const int rs = r - TP, t = rs & (DSEQ - 1); if (t >= DSEQ - 2) cd = convs + ((size_t)(rs >> 6) * 2 + (t - (DSEQ - 2))) * CH + c0; }
                    if (cd) { *(GAS f32x4*)cd = x0; *(GAS f32x4*)(cd + 4) = x1; }
                }
            }
    }
};
template <bool VPART> struct EpiKV {
    static constexpr bool PERM = false, MID = false;
    float* outK; float* outV; bf16_t* KB; const float* invm;
    __device__ __forceinline__ void operator()(const Acc& acc, const Unit& u, int wr, int wc, int fr, int fq) const {
        const int row0 = u.pm * 256 + wr * 64 + fr, col0 = (u.pn & 3) * 256 + wc * 32 + 4 * fq;
        float* outp = VPART ? outV : outK;
#pragma unroll
        for (int ai = 0; ai < 2; ++ai)
#pragma unroll
            for (int m = 0; m < 4; ++m) {
                const int r = row0 + ai * 128 + m * 16; const float inv = ((const GAS float*)invm)[r];
#pragma unroll
                for (int bj = 0; bj < 2; ++bj)
#pragma unroll
                    for (int n = 0; n < 2; ++n) {
                        const f32x4 v = acc[ai][bj][m][n] * inv; const size_t o = (size_t)r * D + col0 + bj * 128 + n * 16;
                        *(GAS f32x4*)(outp + o) = v;
                        if (!VPART) { u32x2 w; w.x = cvt_pk_bf16(v[0], v[1]); w.y = cvt_pk_bf16(v[2], v[3]); *(GAS u32x2*)(KB + o) = w; }
                    }
            }
    }
};
struct EpiVT {
    static constexpr bool PERM = true, MID = false;
    bf16_t* VT; const float* invm;
    __device__ __forceinline__ void operator()(const Acc& acc, const Unit& u, int wr, int wc, int fr, int fq) const {
        const int row0 = u.pm * 256 + wr * 64 + fr, col0 = u.pn * 256 + wc * 32 + 8 * fq;
        f32x4 s[2][2];
#pragma unroll
        for (int bj = 0; bj < 2; ++bj) { s[bj][0] = *(const GAS f32x4*)(invm + col0 + bj * 128); s[bj][1] = *(const GAS f32x4*)(invm + col0 + bj * 128 + 4); }
#pragma unroll
        for (int ai = 0; ai < 2; ++ai)
#pragma unroll
            for (int m = 0; m < 4; ++m) {
                const int r = row0 + ai * 128 + m * 16;
#pragma unroll
                for (int bj = 0; bj < 2; ++bj) store8_bf16(VT + (size_t)r * TM + col0 + bj * 128, acc[ai][bj][m][0] * s[bj][0], acc[ai][bj][m][1] * s[bj][1]);
            }
    }
};
struct EpiGLU {
    static constexpr bool PERM = true, MID = false;
    const bf16_t* YG; bf16_t* YCAT; float* ssb;
    __device__ __forceinline__ int brow(int cb, int f) const { return cb + 16 * f; }
    __device__ __forceinline__ void small(const f32x4 (&acc)[2][2], int r0, int cb, int fr, int fq) const {
#pragma unroll
        for (int m = 0; m < 2; ++m) {
            const int r = r0 + 16 * m + fr; float ssum = 0.f;
#pragma unroll
            for (int f = 0; f < 2; ++f) {
                const int c = cb + 16 * f + 4 * fq; const u32x2 yw = *(const GAS u32x2*)(YG + (size_t)r * CH + c);
                f32x4 y = (f32x4){bf_lo(yw.x), bf_hi(yw.x), bf_lo(yw.y), bf_hi(yw.y)};
#pragma unroll
                for (int e = 0; e < 4; ++e) { y[e] = y[e] * __builtin_amdgcn_rcpf(1.0f + __expf(-acc[m][f][e])); ssum += y[e] * y[e]; }
                u32x2 w; w.x = cvt_pk_bf16(y[0], y[1]); w.y = cvt_pk_bf16(y[2], y[3]); *(GAS u32x2*)(YCAT + (size_t)r * D + c) = w;
            }
            ssum += __shfl_xor(ssum, 16); ssum += __shfl_xor(ssum, 32);
            if (fq == 0) atomicAdd(ssb + r, ssum);
        }
    }
    __device__ __forceinline__ void operator()(const Acc& acc, const Unit& u, int wr, int wc, int fr, int fq) const {
        const int row0 = u.pm * 256 + wr * 64 + fr, col0 = u.pn * 256 + wc * 32 + 8 * fq;
#pragma unroll
        for (int ai = 0; ai < 2; ++ai)
#pragma unroll
            for (int m = 0; m < 4; ++m) {
                const int r = row0 + ai * 128 + m * 16; float ssum = 0.f;
#pragma unroll
                for (int bj = 0; bj < 2; ++bj) {
                    f32x4 y0, y1; unpack8(*(const GAS u32x4*)(YG + (size_t)r * CH + col0 + bj * 128), y0, y1);
                    f32x4 z0 = acc[ai][bj][m][0], z1 = acc[ai][bj][m][1];
#pragma unroll
                    for (int e = 0; e < 4; ++e) { y0[e] = y0[e] * __builtin_amdgcn_rcpf(1.0f + __expf(-z0[e])); y1[e] = y1[e] * __builtin_amdgcn_rcpf(1.0f + __expf(-z1[e]));
                        ssum += y0[e] * y0[e] + y1[e] * y1[e]; }
                    store8_bf16(YCAT + (size_t)r * D + col0 + bj * 128, y0, y1);
                }
                ssum += __shfl_xor(ssum, 16); ssum += __shfl_xor(ssum, 32);
                if (fq == 0) atomicAdd(ssb + r, ssum);
            }
    }
};
template <bool MIDS> struct EpiRes {
    static constexpr bool PERM = true, MID = MIDS;
    bf16_t* XB; float* ssout; const float* ssb;
    __device__ __forceinline__ int brow(int cb, int f) const { return cb + 16 * f; }
    __device__ __forceinline__ void mid_small(f32x4 (&acc)[2][2], int r0, int fr) const {
#pragma unroll
        for (int m = 0; m < 2; ++m) { const float sc = rsqrtf(((const GAS float*)ssb)[r0 + 16 * m + fr] * (1.0f / CH) + EPS); acc[m][0] *= sc; acc[m][1] *= sc; }
    }
    __device__ __forceinline__ void small(const f32x4 (&acc)[2][2], int r0, int cb, int fr, int fq) const {
#pragma unroll
        for (int m = 0; m < 2; ++m) {
            const int r = r0 + 16 * m + fr; float ssum = 0.f;
#pragma unroll
            for (int f = 0; f < 2; ++f) {
                bf16_t* p = XB + (size_t)r * D + cb + 16 * f + 4 * fq; const u32x2 xw = *(const GAS u32x2*)p;
                f32x4 x = (f32x4){bf_lo(xw.x), bf_hi(xw.x), bf_lo(xw.y), bf_hi(xw.y)} + acc[m][f];
#pragma unroll
                for (int e = 0; e < 4; ++e) ssum += x[e] * x[e];
                u32x2 w; w.x = cvt_pk_bf16(x[0], x[1]); w.y = cvt_pk_bf16(x[2], x[3]); *(GAS u32x2*)p = w;
            }
            ssum += __shfl_xor(ssum, 16); ssum += __shfl_xor(ssum, 32);
            if (fq == 0) atomicAdd(ssout + r, ssum);
        }
    }
    __device__ __forceinline__ void mid(Acc& acc, const Unit& u, int wr, int fr) const {
        const int row0 = u.pm * 256 + wr * 64 + fr;
#pragma unroll
        for (int ai = 0; ai < 2; ++ai)
#pragma unroll
            for (int m = 0; m < 4; ++m) {
                const float s = rsqrtf(((const GAS float*)ssb)[row0 + ai * 128 + m * 16] * (1.0f / CH) + EPS);
#pragma unroll
                for (int bj = 0; bj < 2; ++bj)
#pragma unroll
                    for (int n = 0; n < 2; ++n) acc[ai][bj][m][n] *= s;
            }
    }
    __device__ __forceinline__ void operator()(const Acc& acc, const Unit& u, int wr, int wc, int fr, int fq) const {
        const int row0 = u.pm * 256 + wr * 64 + fr, col0 = u.pn * 256 + wc * 32 + 8 * fq;
#pragma unroll
        for (int ai = 0; ai < 2; ++ai)
#pragma unroll
            for (int m = 0; m < 4; ++m) {
                const int r = row0 + ai * 128 + m * 16; float ssum = 0.f;
#pragma unroll
                for (int bj = 0; bj < 2; ++bj) {
                    bf16_t* p = XB + (size_t)r * D + col0 + bj * 128;
                    f32x4 x0, x1; unpack8(*(const GAS u32x4*)p, x0, x1);
                    x0 += acc[ai][bj][m][0]; x1 += acc[ai][bj][m][1];
#pragma unroll
                    for (int e = 0; e < 4; ++e) ssum += x0[e] * x0[e] + x1[e] * x1[e];
                    store8_bf16(p, x0, x1);
                }
                ssum += __shfl_xor(ssum, 16); ssum += __shfl_xor(ssum, 32);
                if (fq == 0) atomicAdd(ssout + r, ssum);
            }
    }
};
template <int ACT> struct EpiScale {
    static constexpr bool PERM = true, MID = false;
    bf16_t* OUT; int ldc; const float* ss;
    __device__ __forceinline__ int brow(int cb, int f) const { return cb + 16 * f; }
    __device__ __forceinline__ void small(const f32x4 (&acc)[2][2], int r0, int cb, int fr, int fq) const {
#pragma unroll
        for (int m = 0; m < 2; ++m) {
            const int r = r0 + 16 * m + fr; const float inv = rsqrtf(((const GAS float*)ss)[r] * (1.0f / D) + EPS);
#pragma unroll
            for (int f = 0; f < 2; ++f) {
                f32x4 v = acc[m][f] * inv;
                if (ACT == 1) {
#pragma unroll
                    for (int e = 0; e < 4; ++e) { const float a = fmaxf(v[e], 0.f); v[e] = a * a; }
                }
                u32x2 w; w.x = cvt_pk_bf16(v[0], v[1]); w.y = cvt_pk_bf16(v[2], v[3]); *(GAS u32x2*)(OUT + (size_t)r * ldc + cb + 16 * f + 4 * fq) = w;
            }
        }
    }
    __device__ __forceinline__ void operator()(const Acc& acc, const Unit& u, int wr, int wc, int fr, int fq) const {
        const int row0 = u.pm * 256 + wr * 64 + fr, col0 = u.pn * 256 + wc * 32 + 8 * fq;
#pragma unroll
        for (int ai = 0; ai < 2; ++ai)
#pragma unroll
            for (int m = 0; m < 4; ++m) {
                const int r = row0 + ai * 128 + m * 16; const float inv = rsqrtf(((const GAS float*)ss)[r] * (1.0f / D) + EPS);
#pragma unroll
                for (int bj = 0; bj < 2; ++bj) {
                    f32x4 v0 = acc[ai][bj][m][0] * inv, v1 = acc[ai][bj][m][1] * inv;
                    if (ACT == 1) {
#pragma unroll
                        for (int e = 0; e < 4; ++e) { const float a = fmaxf(v0[e], 0.f), b = fmaxf(v1[e], 0.f); v0[e] = a * a; v1[e] = b * b; }
                    }
                    store8_bf16(OUT + (size_t)r * ldc + col0 + bj * 128, v0, v1);
                }
            }
    }
};

template <class Epi>
__device__ __forceinline__ void small_gemm(const bf16_t* A, const bf16_t* Bt, int N, int K, const Epi& E, int c, int stride) {
    int tid = threadIdx.x; asm volatile("" : "+v"(tid));
    const int wave = __builtin_amdgcn_readfirstlane(tid >> 6), lane = tid & 63, fr = lane & 15, fq = lane >> 4;
    const int ntn = N >> 7, ntiles = (TS / 64) * ntn;
    if (c < 0) return;
    for (int tile = c; tile < ntiles; tile += stride) {
        const int tm = tile / ntn, tn = tile - tm * ntn;
        const int r0 = TP + tm * 64 + (wave >> 2) * 32, cb = tn * 128 + (wave & 3) * 32;
        const char* pa = (const char*)A + ((size_t)(r0 + fr) * K + 8 * fq) * 2;
        const char* pb0 = (const char*)Bt + ((size_t)(E.brow(cb, 0) + fr) * K + 8 * fq) * 2;
        const char* pb1 = (const char*)Bt + ((size_t)(E.brow(cb, 1) + fr) * K + 8 * fq) * 2;
        const size_t a16 = (size_t)16 * K * 2;
        f32x4 acc[2][2];
#pragma unroll
        for (int m = 0; m < 2; ++m)
#pragma unroll
            for (int f = 0; f < 2; ++f) acc[m][f] = (f32x4){0.f, 0.f, 0.f, 0.f};
        const int ng = K >> 7;
        bf16x8 A0[4], A1[4], B0[4], B1[4], C0[4], C1[4], D0[4], D1[4];
#define SG_LOAD(a0, a1, b0, b1, g) do { _Pragma("unroll") for (int j = 0; j < 4; ++j) { const size_t ko = (size_t)((g) * 4 + j) * 64; \
            a0[j] = *(const GAS bf16x8*)(pa + ko); a1[j] = *(const GAS bf16x8*)(pa + a16 + ko); b0[j] = *(const GAS bf16x8*)(pb0 + ko); b1[j] = *(const GAS bf16x8*)(pb1 + ko); } } while (0)
#define SG_MMA(a0, a1, b0, b1) do { _Pragma("unroll") for (int j = 0; j < 4; ++j) { \
            acc[0][0] = __builtin_amdgcn_mfma_f32_16x16x32_bf16(b0[j], a0[j], acc[0][0], 0, 0, 0); acc[0][1] = __builtin_amdgcn_mfma_f32_16x16x32_bf16(b1[j], a0[j], acc[0][1], 0, 0, 0); \
            acc[1][0] = __builtin_amdgcn_mfma_f32_16x16x32_bf16(b0[j], a1[j], acc[1][0], 0, 0, 0); acc[1][1] = __builtin_amdgcn_mfma_f32_16x16x32_bf16(b1[j], a1[j], acc[1][1], 0, 0, 0); } } while (0)
        SG_LOAD(A0, A1, B0, B1, 0);
        for (int g = 0; g < ng; g += 2) {
            if constexpr (Epi::MID) { if (g == (ng >> 1)) E.mid_small(acc, r0, fr); }
            SG_LOAD(C0, C1, D0, D1, g + 1);
            SG_MMA(A0, A1, B0, B1);
            if (g + 2 < ng) SG_LOAD(A0, A1, B0, B1, g + 2);
            SG_MMA(C0, C1, D0, D1);
        }
#undef SG_LOAD
#undef SG_MMA
        E.small(acc, r0, cb, fr, fq);
    }
}

struct EpiAtomic {
    static constexpr bool PERM = false, MID = false;
    float* SCR;
    __device__ __forceinline__ void operator()(const Acc& acc, const Unit& u, int wr, int wc, int fr, int fq) const {
        const int row0 = u.pm * 256 + wr * 64 + fr, col0 = u.pn * 256 + wc * 32 + 4 * fq;
        float* slab = SCR + (size_t)(u.ko >> 11) * TS * D;
#pragma unroll
        for (int ai = 0; ai < 2; ++ai)
#pragma unroll
            for (int m = 0; m < 4; ++m) {
                float* rp = slab + (size_t)(row0 + ai * 128 + m * 16) * D + col0;
#pragma unroll
                for (int bj = 0; bj < 2; ++bj)
#pragma unroll
                    for (int n = 0; n < 2; ++n) *(GAS f32x4*)(rp + bj * 128 + n * 16) = acc[ai][bj][m][n];
            }
    }
};
struct Args { const float* in[33]; float* out; unsigned char* ws; };
enum { I_XP = 0, I_XS, I_MEM, I_SCONV, I_SRE, I_SIM, I_CK, I_CV, I_GMIX, I_WIN, I_CONVW, I_ARE, I_AIM, I_LOGDT, I_BRE, I_BIM, I_CRE, I_CIM, I_SD, I_WGLU,
       I_GA, I_GB, I_WOUT, I_GX, I_GMEM, I_WQ, I_WK, I_WV, I_WO, I_GMLP, I_WUP, I_WDOWN, I_GFIN };

typedef const float* const __attribute__((address_space(4)))* KTab;
__device__ __forceinline__ KTab ktab() { unsigned long long p = (unsigned long long)__builtin_amdgcn_kernarg_segment_ptr(); asm volatile("" : "+s"(p)); return (KTab)p; }
__device__ __forceinline__ float* ss_arr(unsigned char* ws, int idx) { return (float*)(ws + WS_SS) + (size_t)idx * T; }
__device__ __forceinline__ float* invmem_arr(unsigned char* ws) { return (float*)(ws + WS_SS) + (size_t)9 * T; }

__device__ __forceinline__ int inproj_src_col(int vc) {
    if (vc < 512 || vc >= 1536) return vc;
    const int q = (vc - 512) >> 8, r = (vc - 512) & 255;
    return r < 128 ? 512 + q * 128 + r : 1024 + q * 128 + (r - 128);
}
__device__ __forceinline__ void transpose_item(const float* W, int ldw, int srck0, int srcn0, const float* gain, float gscale, bf16_t* WT, int ldt, int dn0, int dk0, LAS float* scr, int lane) {
#pragma unroll 8
    for (int i = 0; i < 32; ++i) { const int kk = 2 * i + (lane >> 5); float v = ((const GAS float*)W)[(size_t)(srck0 + kk) * ldw + srcn0 + (lane & 31)];
        const float gsc = gain ? ((const GAS float*)gain)[kk] * gscale : gscale; scr[kk * 33 + (lane & 31)] = v * gsc; }
    LDS_WAIT();
    const int c = lane & 7;
#pragma unroll
    for (int j = 0; j < 4; ++j) { const int n = (lane >> 3) + 8 * j; const LAS float* s = scr + (8 * c) * 33 + n;
        u32x4 o; o.x = cvt_pk_bf16(s[0 * 33], s[1 * 33]); o.y = cvt_pk_bf16(s[2 * 33], s[3 * 33]); o.z = cvt_pk_bf16(s[4 * 33], s[5 * 33]); o.w = cvt_pk_bf16(s[6 * 33], s[7 * 33]);
        *(GAS u32x4*)(WT + (size_t)(dn0 + n) * ldt + dk0 + 8 * c) = o; }
    LDS_WAIT();
}
__device__ __forceinline__ float convert_row(const float* src, bf16_t* dst, int lane) {
    const GAS f32x4* xr = (const GAS f32x4*)src + lane; f32x4 v[4]; float s = 0.f;
#pragma unroll
    for (int j = 0; j < 4; ++j) { v[j] = xr[64 * j]; s += (v[j][0] * v[j][0] + v[j][1] * v[j][1]) + (v[j][2] * v[j][2] + v[j][3] * v[j][3]); }
    GAS u32x2* o = (GAS u32x2*)dst + lane;
#pragma unroll
    for (int j = 0; j < 4; ++j) { u32x2 w; w.x = cvt_pk_bf16(v[j][0], v[j][1]); w.y = cvt_pk_bf16(v[j][2], v[j][3]); o[64 * j] = w; }
    return wave_sum(s);
}
constexpr int PI_IN = 1024, PI_GLU = 128, PI_SQ = 512, PI_UP = 2048, PI_CV = 2048;
constexpr int PI_LAYER = PI_IN + PI_GLU + 5 * PI_SQ + 2 * PI_UP + PI_CV;

__device__ __forceinline__ void prep_phase(unsigned char* ws, LAS unsigned char* lds, int gw, int NGW, int wave, int lane) {
    const KTab in = ktab();
    LAS float* scr = (LAS float*)(lds + wave * 8704);
    for (int it = gw; it < DEPTH * PI_LAYER; it += NGW) {
        const int l = it / PI_LAYER; int r = it - l * PI_LAYER;
        unsigned char* wl = ws + WS_W + (size_t)l * W_LAYER;
        if (r < PI_IN) { const int kb = r >> 6, nb = r & 63;
            transpose_item(as_global(in[I_WIN]) + (size_t)l * D * 2048, 2048, 64 * kb, inproj_src_col(32 * nb), as_global(in[I_GMIX]) + l * D + 64 * kb, 1.0f, (bf16_t*)(wl + W_IN), D, 32 * nb, 64 * kb, scr, lane); continue; }
        r -= PI_IN;
        if (r < PI_GLU) { const int kb = r >> 4, nb = r & 15;
            transpose_item(as_global(in[I_WGLU]) + (size_t)l * CH * CH, CH, 64 * kb, 32 * nb, nullptr, 1.0f, (bf16_t*)(wl + W_GLU), CH, 32 * nb, 64 * kb, scr, lane); continue; }
        r -= PI_GLU;
        if (r < PI_SQ) { const int kb = r >> 5, nb = r & 31, dk0 = 64 * kb;
            const float* gn = dk0 < 512 ? as_global(in[I_GB]) + l * CH + dk0 : as_global(in[I_GA]) + l * CH + dk0 - 512;
            transpose_item(as_global(in[I_WOUT]) + (size_t)l * D * D, D, (dk0 + 512) & 1023, 32 * nb, gn, 1.0f, (bf16_t*)(wl + W_OUT), D, 32 * nb, dk0, scr, lane); continue; }
        r -= PI_SQ;
        if (r < PI_SQ) { const int kb = r >> 5, nb = r & 31;
            transpose_item(as_global(in[I_WQ]) + (size_t)l * D * D, D, 64 * kb, 32 * nb, as_global(in[I_GX]) + l * D + 64 * kb, 0.0625f, (bf16_t*)(wl + W_Q), D, 32 * nb, 64 * kb, scr, lane); continue; }
        r -= PI_SQ;
        if (r < PI_SQ) { const int kb = r >> 5, nb = r & 31;
            transpose_item(as_global(in[I_WK]) + (size_t)l * D * D, D, 64 * kb, 32 * nb, as_global(in[I_GMEM]) + l * D + 64 * kb, 1.0f, (bf16_t*)(wl + W_KV), D, 32 * nb, 64 * kb, scr, lane); continue; }
        r -= PI_SQ;
        if (r < PI_SQ) { const int kb = r >> 5, nb = r & 31;
            transpose_item(as_global(in[I_WV]) + (size_t)l * D * D, D, 64 * kb, 32 * nb, as_global(in[I_GMEM]) + l * D + 64 * kb, 1.0f, (bf16_t*)(wl + W_KV), D, 1024 + 32 * nb, 64 * kb, scr, lane); continue; }
        r -= PI_SQ;
        if (r < PI_SQ) { const int kb = r >> 5, nb = r & 31;
            transpose_item(as_global(in[I_WO]) + (size_t)l * D * D, D, 64 * kb, 32 * nb, nullptr, 1.0f, (bf16_t*)(wl + W_O), D, 32 * nb, 64 * kb, scr, lane); continue; }
        r -= PI_SQ;
        if (r < PI_UP) { const int kb = r >> 7, nb = r & 127;
            transpose_item(as_global(in[I_WUP]) + (size_t)l * D * DFF, DFF, 64 * kb, 32 * nb, as_global(in[I_GMLP]) + l * D + 64 * kb, 1.0f, (bf16_t*)(wl + W_UP), D, 32 * nb, 64 * kb, scr, lane); continue; }
        r -= PI_UP;
        if (r < PI_UP) { const int kb = r >> 5, nb = r & 31;
            transpose_item(as_global(in[I_WDOWN]) + (size_t)l * DFF * D, D, 64 * kb, 32 * nb, nullptr, 1.0f, (bf16_t*)(wl + W_DOWN), DFF, 32 * nb, 64 * kb, scr, lane); continue; }
        r -= PI_UP;
        { const int kb = r >> 5, nb = r & 31;
            transpose_item(as_global(in[I_CV]) + (size_t)l * TMS * D, D, 64 * kb, 32 * nb, nullptr, 1.0f, (bf16_t*)(ws + WS_VTC) + (size_t)l * D * TMS, TMS, 32 * nb, 64 * kb, scr, lane); }
    }
    float* ss0 = ss_arr(ws, 0); float* invm = invmem_arr(ws);
    for (int m0 = gw * 2; m0 < T; m0 += NGW * 2) {
        const float* src = m0 < TP ? as_global(in[I_XP]) + (size_t)m0 * D : as_global(in[I_XS]) + (size_t)(m0 - TP) * D;
        const GAS f32x4* xr = (const GAS f32x4*)src + lane; f32x4 v[8]; float s0 = 0.f, s1 = 0.f;
#pragma unroll
        for (int j = 0; j < 8; ++j) v[j] = xr[64 * j];
#pragma unroll
        for (int j = 0; j < 4; ++j) { s0 += (v[j][0] * v[j][0] + v[j][1] * v[j][1]) + (v[j][2] * v[j][2] + v[j][3] * v[j][3]);
            s1 += (v[4 + j][0] * v[4 + j][0] + v[4 + j][1] * v[4 + j][1]) + (v[4 + j][2] * v[4 + j][2] + v[4 + j][3] * v[4 + j][3]); }
        GAS u32x2* o = (GAS u32x2*)((bf16_t*)(ws + WS_XB) + (size_t)m0 * D) + lane;
#pragma unroll
        for (int j = 0; j < 8; ++j) { u32x2 w; w.x = cvt_pk_bf16(v[j][0], v[j][1]); w.y = cvt_pk_bf16(v[j][2], v[j][3]); o[64 * j] = w; }
        s0 = wave_sum(s0); s1 = wave_sum(s1);
        if (lane == 0) { ((GAS float*)ss0)[m0] = s0; ((GAS float*)ss0)[m0 + 1] = s1; }
    }
    for (int m = T + gw; m < T + TM + 2 * TMS; m += NGW) {
        if (m < T) { const float* src = m < TP ? as_global(in[I_XP]) + (size_t)m * D : as_global(in[I_XS]) + (size_t)(m - TP) * D;
            const float s = convert_row(src, (bf16_t*)(ws + WS_XB) + (size_t)m * D, lane); if (lane == 0) ((GAS float*)ss0)[m] = s; }
        else if (m < T + TM) { const int mm = m - T; const float s = convert_row(as_global(in[I_MEM]) + (size_t)mm * D, (bf16_t*)(ws + WS_MNB) + (size_t)mm * D, lane);
            if (lane == 0) ((GAS float*)invm)[mm] = rsqrtf(s * (1.0f / D) + EPS); }
        else { const int mm = m - T - TM; (void)convert_row(as_global(in[I_CK]) + (size_t)mm * D, (bf16_t*)(ws + WS_KC) + (size_t)mm * D, lane); }
    }
    {
        float* sm = (float*)(ws + WS_SMALL); const int gt = gw * 64 + lane, NT = NGW * 64;
#define SMCOPY(off, idx, n) for (int i = gt; i < (n); i += NT) ((GAS float*)sm)[(off) + i] = ((const GAS float*)in[idx])[i]
        SMCOPY(SM_ARE, I_ARE, 4096); SMCOPY(SM_AIM, I_AIM, 4096); SMCOPY(SM_LOGDT, I_LOGDT, 64); SMCOPY(SM_BRE, I_BRE, 65536); SMCOPY(SM_BIM, I_BIM, 65536);
        SMCOPY(SM_CRE, I_CRE, 65536); SMCOPY(SM_CIM, I_CIM, 65536); SMCOPY(SM_SD, I_SD, 1024); SMCOPY(SM_CONVW, I_CONVW, 3072); SMCOPY(SM_SCONV, I_SCONV, 32768);
        SMCOPY(SM_SRE, I_SRE, 65536); SMCOPY(SM_SIM, I_SIM, 65536); SMCOPY(SM_GFIN, I_GFIN, 1024);
#undef SMCOPY
    }
    { float* z = ss_arr(ws, 1); const size_t n = (size_t)8 * T; for (size_t i = (size_t)gw * 64 + lane; i < n; i += (size_t)NGW * 64) ((GAS float*)z)[i] = 0.f; }
}

__device__ __forceinline__ float gelu_tanh(float x) {
    const float u = 0.7978845608f * (x + 0.044715f * x * x * x);
    const float e = __expf(2.0f * u);
    const float th = 1.0f - 2.0f * __builtin_amdgcn_rcpf(e + 1.0f);
    return 0.5f * x * (1.0f + th);
}
__device__ __forceinline__ void sincos_small(float x, float& s, float& c) {
    const float q = rintf(x * 0.63661977236f);
    float r = fmaf(-q, 1.57079637050628662109375f, x); r = fmaf(-q, -4.37113900018624283e-8f, r);
    const float r2 = r * r;
    const float sp = r + r * r2 * (-1.0f / 6 + r2 * (1.0f / 120 + r2 * (-1.0f / 5040 + r2 * (1.0f / 362880))));
    const float cp = 1.0f + r2 * (-0.5f + r2 * (1.0f / 24 + r2 * (-1.0f / 720 + r2 * (1.0f / 40320 + r2 * (-1.0f / 3628800)))));
    const int qi = (int)q & 3;
    s = (qi == 0) ? sp : (qi == 1) ? cp : (qi == 2) ? -sp : -cp;
    c = (qi == 0) ? cp : (qi == 1) ? -sp : (qi == 2) ? -cp : sp;
}
constexpr int BU_STRIDE = 528, H_STRIDE = 272, SCAN_LDS_WAVE = 16 * BU_STRIDE + 16 * H_STRIDE;

__device__ __forceinline__ void scan_item(unsigned char* ws, float* out, int l, int item, LAS unsigned char* wl, int lane_in) {
    int lane = lane_in; asm volatile("" : "+v"(lane));
    const GAS float* sm = (const GAS float*)(ws + WS_SMALL);
    int b, g, row0, nblk; const bool prompt = item < NB * 32;
    if (prompt) { b = item >> 5; g = item & 31; row0 = b * SEQ; nblk = SEQ / 16; }
    else { const int i2 = item - NB * 32; b = i2 >> 5; g = i2 & 31; row0 = TP + b * DSEQ; nblk = DSEQ / 16; }
    const bf16_t* U = (const bf16_t*)(ws + WS_U); bf16_t* YG = (bf16_t*)(ws + WS_YG);
    const int lg = l * 32 + g, p = lane, t16 = lane & 15, q = lane >> 4;
    const float are = fminf(sm[SM_ARE + lg * 64 + p], -1e-4f), aim = sm[SM_AIM + lg * 64 + p];
    const float dt = expf(sm[SM_LOGDT + lg]);
    float sn, cs; sincos_small(aim * dt, sn, cs);
    const float mag = expf(are * dt), abr = mag * cs, abi = mag * sn;
    const float nr = abr - 1.0f, ni = abi, den = 1.0f / (are * are + aim * aim);
    const float c0 = (nr * are + ni * aim) * den, c1 = (ni * are - nr * aim) * den;
    bf16x8 af[8];
#pragma unroll
    for (int f = 0; f < 8; ++f) {
        const int i = 16 * f + t16, ps = i >> 1, cc = i & 1;
        const float k0 = __shfl(c0, ps), k1 = __shfl(c1, ps);
        u32x4 w = (u32x4){0u, 0u, 0u, 0u};
        if (q < 2) {
            const GAS f32x4* br = (const GAS f32x4*)(sm + SM_BRE + ((size_t)lg * 64 + ps) * 16 + 8 * q); const GAS f32x4* bi = (const GAS f32x4*)(sm + SM_BIM + ((size_t)lg * 64 + ps) * 16 + 8 * q);
            const f32x4 r0 = br[0], r1 = br[1], i0 = bi[0], i1 = bi[1];
            f32x4 v0, v1;
            if (cc == 0) { v0 = k0 * r0 - k1 * i0; v1 = k0 * r1 - k1 * i1; } else { v0 = k0 * i0 + k1 * r0; v1 = k0 * i1 + k1 * r1; }
            w.x = cvt_pk_bf16(v0[0], v0[1]); w.y = cvt_pk_bf16(v0[2], v0[3]); w.z = cvt_pk_bf16(v1[0], v1[1]); w.w = cvt_pk_bf16(v1[2], v1[3]);
        }
        af[f] = __builtin_bit_cast(bf16x8, w);
    }
    bf16x8 cf[4];
#pragma unroll
    for (int s = 0; s < 4; ++s) {
        const int p0 = 16 * s + 4 * q;
        const f32x4 cr = *(const GAS f32x4*)(sm + SM_CRE + ((size_t)lg * 16 + t16) * 64 + p0), ci = *(const GAS f32x4*)(sm + SM_CIM + ((size_t)lg * 16 + t16) * 64 + p0);
        u32x4 w; w.x = cvt_pk_bf16(cr[0], -ci[0]); w.y = cvt_pk_bf16(cr[1], -ci[1]); w.z = cvt_pk_bf16(cr[2], -ci[2]); w.w = cvt_pk_bf16(cr[3], -ci[3]);
        cf[s] = __builtin_bit_cast(bf16x8, w);
    }
    const f32x4 dsk = *(const GAS f32x4*)(sm + SM_SD + l * CH + g * 16 + 4 * q);
    float hre = 0.f, him = 0.f;
    if (!prompt) { hre = sm[SM_SRE + (((size_t)l * NDB + b) * 32 + g) * 64 + p]; him = sm[SM_SIM + (((size_t)l * NDB + b) * 32 + g) * 64 + p]; }
    LAS unsigned char* BU = wl; LAS unsigned char* HB = wl + 16 * BU_STRIDE;
    const char* ubase = (const char*)U + (size_t)row0 * CH * 2; char* ybase = (char*)YG + (size_t)row0 * CH * 2;
    const unsigned lo8 = (unsigned)((t16 * CH + g * 16 + 8 * (q & 1)) * 2), lo4 = (unsigned)((t16 * CH + g * 16 + 4 * q) * 2);
    constexpr size_t BSTEP = (size_t)16 * CH * 2;
    constexpr int PD = 4;
    u32x4 ubuf[PD]; u32x2 ebuf[PD];
    const bool lowq = q < 2;
#pragma unroll
    for (int j = 0; j < PD; ++j) { const char* un = ubase + (size_t)j * BSTEP; ubuf[j] = *(const GAS u32x4*)(un + lo8); ebuf[j] = *(const GAS u32x2*)(un + lo4); }
#define U_BFRAG(v) __builtin_bit_cast(bf16x8, (u32x4){lowq ? (v).x : 0u, lowq ? (v).y : 0u, lowq ? (v).z : 0u, lowq ? (v).w : 0u})
    f32x2 buv[16];
    {
        const bf16x8 bfrag = U_BFRAG(ubuf[0]);
#pragma unroll
        for (int f = 0; f < 8; ++f) {
            const f32x4 r = __builtin_amdgcn_mfma_f32_16x16x32_bf16(af[f], bfrag, (f32x4){0.f, 0.f, 0.f, 0.f}, 0, 0, 0);
            *(LAS f32x4*)(BU + t16 * BU_STRIDE + (16 * f + 4 * q) * 4) = r;
        }
        LDS_WAIT();
#pragma unroll
        for (int t = 0; t < 16; ++t) buv[t] = *(const LAS f32x2*)(BU + t * BU_STRIDE + p * 8);
    }
    if (prompt) {
        for (int tb0 = 0; tb0 < nblk; tb0 += 32) {
#pragma unroll
        for (int j = 0; j < 32; ++j) {
            const int tb = tb0 + j;
            const u32x2 uec = ebuf[j % PD];
            const u32x4 ubn = ubuf[(j + 1) % PD];
            { const int tbn = (tb + PD < nblk) ? tb + PD : nblk - 1; const char* un = ubase + (size_t)tbn * BSTEP; ubuf[j % PD] = *(const GAS u32x4*)(un + lo8); ebuf[j % PD] = *(const GAS u32x2*)(un + lo4); }
            f32x4 rn[8];
            { const bf16x8 bfrag = U_BFRAG(ubn);
#pragma unroll
              for (int f = 0; f < 8; ++f) rn[f] = __builtin_amdgcn_mfma_f32_16x16x32_bf16(af[f], bfrag, (f32x4){0.f, 0.f, 0.f, 0.f}, 0, 0, 0); }
#pragma unroll
            for (int t = 0; t < 16; ++t) {
                const float nre = fmaf(abr, hre, fmaf(-abi, him, buv[t][0])), nim = fmaf(abr, him, fmaf(abi, hre, buv[t][1]));
                hre = nre; him = nim;
                *(LAS unsigned*)(HB + t * H_STRIDE + p * 4) = cvt_pk_bf16(hre, him);
            }
#pragma unroll
            for (int f = 0; f < 8; ++f) *(LAS f32x4*)(BU + t16 * BU_STRIDE + (16 * f + 4 * q) * 4) = rn[f];
            LDS_WAIT();
            bf16x8 hf[4];
#pragma unroll
            for (int s2 = 0; s2 < 4; ++s2) hf[s2] = *(const LAS bf16x8*)(HB + t16 * H_STRIDE + (32 * s2 + 8 * q) * 2);
#pragma unroll
            for (int t = 0; t < 16; ++t) buv[t] = *(const LAS f32x2*)(BU + t * BU_STRIDE + p * 8);
            f32x4 y = (f32x4){0.f, 0.f, 0.f, 0.f};
#pragma unroll
            for (int s2 = 0; s2 < 4; ++s2) y = __builtin_amdgcn_mfma_f32_16x16x32_bf16(cf[s2], hf[s2], y, 0, 0, 0);
            const float u0 = bf_lo(uec.x), u1 = bf_hi(uec.x), u2 = bf_lo(uec.y), u3 = bf_hi(uec.y);
            const float g0 = gelu_tanh(y[0] + dsk[0] * u0), g1 = gelu_tanh(y[1] + dsk[1] * u1), g2 = gelu_tanh(y[2] + dsk[2] * u2), g3 = gelu_tanh(y[3] + dsk[3] * u3);
            u32x2 w; w.x = cvt_pk_bf16(g0, g1); w.y = cvt_pk_bf16(g2, g3);
            *(GAS u32x2*)(ybase + (size_t)tb * BSTEP + lo4) = w;
        }
        }
    } else {
        for (int tb0 = 0; tb0 < nblk; tb0 += 4) {
#pragma unroll
        for (int j = 0; j < 4; ++j) {
            const int tb = tb0 + j;
            const u32x2 uec = ebuf[j % PD];
            const u32x4 ubn = ubuf[(j + 1) % PD];
            { const int tbn = (tb + PD < nblk) ? tb + PD : nblk - 1; const char* un = ubase + (size_t)tbn * BSTEP; ubuf[j % PD] = *(const GAS u32x4*)(un + lo8); ebuf[j % PD] = *(const GAS u32x2*)(un + lo4); }
            f32x4 rn[8];
            { const bf16x8 bfrag = U_BFRAG(ubn);
#pragma unroll
              for (int f = 0; f < 8; ++f) rn[f] = __builtin_amdgcn_mfma_f32_16x16x32_bf16(af[f], bfrag, (f32x4){0.f, 0.f, 0.f, 0.f}, 0, 0, 0); }
#pragma unroll
            for (int t = 0; t < 16; ++t) {
                const float nre = fmaf(abr, hre, fmaf(-abi, him, buv[t][0])), nim = fmaf(abr, him, fmaf(abi, hre, buv[t][1]));
                hre = nre; him = nim;
                *(LAS unsigned*)(HB + t * H_STRIDE + p * 4) = cvt_pk_bf16(hre, him);
            }
#pragma unroll
            for (int f = 0; f < 8; ++f) *(LAS f32x4*)(BU + t16 * BU_STRIDE + (16 * f + 4 * q) * 4) = rn[f];
            LDS_WAIT();
            bf16x8 hf[4];
#pragma unroll
            for (int s2 = 0; s2 < 4; ++s2) hf[s2] = *(const LAS bf16x8*)(HB + t16 * H_STRIDE + (32 * s2 + 8 * q) * 2);
#pragma unroll
            for (int t = 0; t < 16; ++t) buv[t] = *(const LAS f32x2*)(BU + t * BU_STRIDE + p * 8);
            f32x4 y = (f32x4){0.f, 0.f, 0.f, 0.f};
#pragma unroll
            for (int s2 = 0; s2 < 4; ++s2) y = __builtin_amdgcn_mfma_f32_16x16x32_bf16(cf[s2], hf[s2], y, 0, 0, 0);
            const float u0 = bf_lo(uec.x), u1 = bf_hi(uec.x), u2 = bf_lo(uec.y), u3 = bf_hi(uec.y);
            const float g0 = gelu_tanh(y[0] + dsk[0] * u0), g1 = gelu_tanh(y[1] + dsk[1] * u1), g2 = gelu_tanh(y[2] + dsk[2] * u2), g3 = gelu_tanh(y[3] + dsk[3] * u3);
            u32x2 w; w.x = cvt_pk_bf16(g0, g1); w.y = cvt_pk_bf16(g2, g3);
            *(GAS u32x2*)(ybase + (size_t)tb * BSTEP + lo4) = w;
        }
        }
    }
#undef U_BFRAG
    GAS float* outg = (GAS float*)out;
    if (prompt) { outg[O_REP + (((size_t)l * NB + b) * 32 + g) * 64 + p] = hre; outg[O_IMP + (((size_t)l * NB + b) * 32 + g) * 64 + p] = him; }
    else { outg[O_RES + (((size_t)l * NDB + b) * 32 + g) * 64 + p] = hre; outg[O_IMS + (((size_t)l * NDB + b) * 32 + g) * 64 + p] = him; }
}
__device__ __forceinline__ void conv_run(unsigned char* ws, int l, int run, int lane_in) {
    int lane = lane_in; asm volatile("" : "+v"(lane));
    const GAS float* sm = (const GAS float*)(ws + WS_SMALL);
    const bf16_t* XIN = (const bf16_t*)(ws + WS_XIN); const bf16_t* BG = (const bf16_t*)(ws + WS_BG); bf16_t* YCAT = (bf16_t*)(ws + WS_YCAT);
    const int row0 = run * 64, c0 = lane * 8;
    f32x4 w0a, w0b, w1a, w1b, w2a, w2b;
    { const GAS float* cw = sm + SM_CONVW + (size_t)l * 3 * CH + c0; w0a = *(const GAS f32x4*)cw; w0b = *(const GAS f32x4*)(cw + 4); w1a = *(const GAS f32x4*)(cw + CH); w1b = *(const GAS f32x4*)(cw + CH + 4);
      w2a = *(const GAS f32x4*)(cw + 2 * CH); w2b = *(const GAS f32x4*)(cw + 2 * CH + 4); }
    f32x4 p2a, p2b, p1a, p1b;
    const bool seq_start = row0 < TP ? ((row0 & (SEQ - 1)) == 0) : true;
    if (!seq_start) { unpack8(*(const GAS u32x4*)(XIN + (size_t)(row0 - 2) * CH + c0), p2a, p2b); unpack8(*(const GAS u32x4*)(XIN + (size_t)(row0 - 1) * CH + c0), p1a, p1b); }
    else if (row0 < TP) { p2a = p2b = p1a = p1b = (f32x4){0.f, 0.f, 0.f, 0.f}; }
    else { const int b = (row0 - TP) >> 6; const GAS float* st = sm + SM_SCONV + ((size_t)(l * NDB + b) * 2) * CH + c0;
        p2a = *(const GAS f32x4*)st; p2b = *(const GAS f32x4*)(st + 4); p1a = *(const GAS f32x4*)(st + CH); p1b = *(const GAS f32x4*)(st + CH + 4); }
    for (int tb = 0; tb < 64; tb += 8) {
        u32x4 xr[8], br[8];
#pragma unroll
        for (int j = 0; j < 8; ++j) { const size_t o = (size_t)(row0 + tb + j) * CH + c0; xr[j] = *(const GAS u32x4*)(XIN + o); br[j] = *(const GAS u32x4*)(BG + o); }
#pragma unroll
        for (int j = 0; j < 8; ++j) {
            f32x4 xa, xb, ba, bb; unpack8(xr[j], xa, xb); unpack8(br[j], ba, bb);
            f32x4 ya = ba * (w0a * p2a + w1a * p1a + w2a * xa), yb = bb * (w0b * p2b + w1b * p1b + w2b * xb);
            float s = 0.f;
#pragma unroll
            for (int e = 0; e < 4; ++e) s += ya[e] * ya[e] + yb[e] * yb[e];
            s = wave_sum(s);
            const float inv = rsqrtf(s * (1.0f / CH) + EPS);
            store8_bf16(YCAT + (size_t)(row0 + tb + j) * D + 512 + c0, ya * inv, yb * inv);
            p2a = p1a; p2b = p1b; p1a = xa; p1b = xb;
        }
    }
}

constexpr int KST = 528, VST = 520;
__device__ __forceinline__ void attn_phase(unsigned char* ws, int l, LAS unsigned char* lds, int G, int bid) {
    int tid = threadIdx.x; asm volatile("" : "+v"(tid));
    const int wave = __builtin_amdgcn_readfirstlane(tid >> 6);
    const bf16_t* Q = (const bf16_t*)(ws + WS_Q); bf16_t* O = (bf16_t*)(ws + WS_O);
    const int NU = NB * 4 * 8 + NDB * 4;
    for (int u = bid; u < NU; u += G) {
        int qrow0, nq, ldv; const bf16_t* Kp; const bf16_t* Vp; int h;
        if (u < NB * 32) { const int b = u >> 5; h = (u >> 3) & 3; const int qt = u & 7; qrow0 = b * SEQ + qt * 256; nq = 256;
            Kp = (const bf16_t*)(ws + WS_KB) + (size_t)l * TM * D + (size_t)(b * NMEM) * D + h * 256; Vp = (const bf16_t*)(ws + WS_VT) + (size_t)l * D * TM + (size_t)(h * 256) * TM + b * NMEM; ldv = TM; }
        else { const int i = u - NB * 32, b = i >> 2; h = i & 3; qrow0 = TP + b * DSEQ; nq = DSEQ;
            Kp = (const bf16_t*)(ws + WS_KC) + (size_t)l * TMS * D + (size_t)(b * NMEM) * D + h * 256; Vp = (const bf16_t*)(ws + WS_VTC) + (size_t)l * D * TMS + (size_t)(h * 256) * TMS + b * NMEM; ldv = TMS; }
        const bool active = wave * 32 < nq;
        __syncthreads();
        int t2 = tid; asm volatile("" : "+v"(t2));
        {
            const int c = t2 & 31, rr = t2 >> 5; const unsigned off = (unsigned)((rr * D + c * 8) * 2); const char* kb = (const char*)Kp;
            LAS unsigned char* ld0 = lds + rr * KST + c * 16;
#pragma unroll
            for (int hb = 0; hb < 4; ++hb) {
                u32x4 v[4];
#pragma unroll
                for (int i = 0; i < 4; ++i) v[i] = *(const GAS u32x4*)(kb + (size_t)(16 * (hb * 4 + i)) * D * 2 + off);
#pragma unroll
                for (int i = 0; i < 4; ++i) *(LAS u32x4*)(ld0 + 16 * (hb * 4 + i) * KST) = v[i];
            }
        }
        bf16x8 qf[16];
        const int r32 = t2 & 31, hh = (t2 >> 5) & 1;
        const int qrow = qrow0 + wave * 32 + r32;
        if (active) {
#pragma unroll
            for (int ks = 0; ks < 16; ++ks) qf[ks] = *(const GAS bf16x8*)(Q + (size_t)qrow * D + h * 256 + 16 * ks + 8 * hh);
        } else {
#pragma unroll
            for (int ks = 0; ks < 16; ++ks) qf[ks] = (bf16x8){0, 0, 0, 0, 0, 0, 0, 0};
        }
        __syncthreads();
        constexpr int NQ = 4, MTQ = 8 / NQ;
        bf16x8 pf[16]; float qmax[NQ], qsum[NQ];
#pragma unroll
        for (int qi = 0; qi < NQ; ++qi) { qmax[qi] = 0.f; qsum[qi] = 1.f; }
        if (active) {
#pragma unroll
            for (int qi = 0; qi < NQ; ++qi) {
                f32x16 sc[MTQ];
#pragma unroll
                for (int mq = 0; mq < MTQ; ++mq)
#pragma unroll
                    for (int e = 0; e < 16; ++e) sc[mq][e] = 0.f;
#pragma unroll
                for (int ks = 0; ks < 16; ++ks)
#pragma unroll
                    for (int mq = 0; mq < MTQ; ++mq) {
                        const bf16x8 kf = *(const LAS bf16x8*)(lds + (32 * (qi * MTQ + mq) + r32) * KST + (16 * ks + 8 * hh) * 2);
                        sc[mq] = __builtin_amdgcn_mfma_f32_32x32x16_bf16(kf, qf[ks], sc[mq], 0, 0, 0);
                    }
                float mx = -3.0e38f;
#pragma unroll
                for (int mq = 0; mq < MTQ; ++mq)
#pragma unroll
                    for (int e = 0; e < 16; ++e) mx = fmaxf(mx, sc[mq][e]);
                mx = fmaxf(mx, __shfl_xor(mx, 32));
                float sum = 0.f;
#pragma unroll
                for (int mq = 0; mq < MTQ; ++mq) {
#pragma unroll
                    for (int e = 0; e < 16; ++e) { const float pe = __builtin_amdgcn_exp2f((sc[mq][e] - mx) * 1.44269504089f); sc[mq][e] = pe; sum += pe; }
#pragma unroll
                    for (int s2 = 0; s2 < 2; ++s2) {
                        u32x4 w; w.x = cvt_pk_bf16(sc[mq][8 * s2 + 0], sc[mq][8 * s2 + 1]); w.y = cvt_pk_bf16(sc[mq][8 * s2 + 2], sc[mq][8 * s2 + 3]);
                        w.z = cvt_pk_bf16(sc[mq][8 * s2 + 4], sc[mq][8 * s2 + 5]); w.w = cvt_pk_bf16(sc[mq][8 * s2 + 6], sc[mq][8 * s2 + 7]);
                        pf[2 * (qi * MTQ + mq) + s2] = __builtin_bit_cast(bf16x8, w);
                    }
                }
                sum += __shfl_xor(sum, 32);
                qmax[qi] = mx; qsum[qi] = sum;
                __builtin_amdgcn_sched_barrier(0);
            }
        } else {
#pragma unroll
            for (int i = 0; i < 16; ++i) pf[i] = (bf16x8){0, 0, 0, 0, 0, 0, 0, 0};
        }
        float fq_[NQ]; float rinv;
        { float M = qmax[0];
#pragma unroll
          for (int qi = 1; qi < NQ; ++qi) M = fmaxf(M, qmax[qi]);
          float tot = 0.f;
#pragma unroll
          for (int qi = 0; qi < NQ; ++qi) { fq_[qi] = __builtin_amdgcn_exp2f((qmax[qi] - M) * 1.44269504089f); tot += fq_[qi] * qsum[qi]; }
          rinv = 1.0f / tot;
#pragma unroll
          for (int qi = 0; qi < NQ; ++qi) fq_[qi] *= rinv; }
        __syncthreads();
        {
            const int c = t2 & 31, rr = t2 >> 5; const unsigned off = (unsigned)((rr * ldv + c * 8) * 2); const char* vb = (const char*)Vp;
            LAS unsigned char* ld0 = lds + rr * VST + c * 16;
#pragma unroll
            for (int hb = 0; hb < 4; ++hb) {
                u32x4 v[4];
#pragma unroll
                for (int i = 0; i < 4; ++i) v[i] = *(const GAS u32x4*)(vb + (size_t)(16 * (hb * 4 + i)) * ldv * 2 + off);
#pragma unroll
                for (int i = 0; i < 4; ++i) { LAS u32x2* d = (LAS u32x2*)(ld0 + 16 * (hb * 4 + i) * VST); d[0] = (u32x2){v[i].x, v[i].y}; d[1] = (u32x2){v[i].z, v[i].w}; }
            }
        }
        __syncthreads();
        if (active) {
#pragma unroll
            for (int dt = 0; dt < 8; ++dt) {
                f32x16 acc[NQ];
#pragma unroll
                for (int qi = 0; qi < NQ; ++qi)
#pragma unroll
                    for (int e = 0; e < 16; ++e) acc[qi][e] = 0.f;
#pragma unroll
                for (int mi = 0; mi < 16 / NQ; ++mi)
#pragma unroll
                    for (int qi = 0; qi < NQ; ++qi) {
                        const int ms = qi * (16 / NQ) + mi;
                        const LAS unsigned char* vp = lds + (32 * dt + r32) * VST + (16 * ms + 4 * hh) * 2;
                        const u32x2 lo = *(const LAS u32x2*)vp, hi = *(const LAS u32x2*)(vp + 16);
                        const u32x4 w = (u32x4){lo.x, lo.y, hi.x, hi.y};
                        acc[qi] = __builtin_amdgcn_mfma_f32_32x32x16_bf16(__builtin_bit_cast(bf16x8, w), pf[ms], acc[qi], 0, 0, 0);
                    }
#pragma unroll
                for (int g4 = 0; g4 < 4; ++g4) {
                    float o4[4];
#pragma unroll
                    for (int e = 0; e < 4; ++e) { float v = 0.f;
#pragma unroll
                        for (int qi = 0; qi < NQ; ++qi) v = fmaf(acc[qi][4 * g4 + e], fq_[qi], v);
                        o4[e] = v; }
                    u32x2 w; w.x = cvt_pk_bf16(o4[0], o4[1]); w.y = cvt_pk_bf16(o4[2], o4[3]);
                    *(GAS u32x2*)(O + (size_t)qrow * D + h * 256 + 32 * dt + 8 * g4 + 4 * hh) = w;
                }
                __builtin_amdgcn_sched_barrier(0);
            }
        }
    }
    __syncthreads();
}

#define XB_TMO      128
#define XB_XCNT(j)  (256  + 64 * (j))
#define XB_XSUB(j)  (1280 + 64 * (j))
#define XB_XGEN(j)  (2304 + 64 * (j))
#define XB_TOP      3328
#define XB_TOPGEN   3392
#define XCD_BAR_WORDS 3456
#define XB_SPIN_CAP (1u << 18)

__device__ __forceinline__ unsigned xb_ld(unsigned* p)              { return __hip_atomic_load(p, __ATOMIC_RELAXED, __HIP_MEMORY_SCOPE_AGENT); }
__device__ __forceinline__ unsigned xb_add(unsigned* p, unsigned v) { return __hip_atomic_fetch_add(p, v, __ATOMIC_RELAXED, __HIP_MEMORY_SCOPE_AGENT); }
__device__ __forceinline__ unsigned xb_xcc_id() { return (unsigned)__builtin_amdgcn_s_getreg((3 << 11) | 20) & 0xFu; }
#define XB_SPIN(cond, bar) do { unsigned _sp = 0; while (cond) { __builtin_amdgcn_s_sleep(1); \
    if ((++_sp & 255u) == 0u) { if (xb_ld(&(bar)[XB_TMO])) break; if (_sp > XB_SPIN_CAP) { atomicAdd(&(bar)[XB_TMO], 1u); break; } } } } while (0)

struct XcdBarrier {
    unsigned* bar; unsigned x;
    volatile LAS unsigned* st;
};

__device__ __forceinline__ XcdBarrier xcd_barrier_post(unsigned* bar, volatile LAS unsigned* st) {
    XcdBarrier b; b.bar = bar; b.x = xb_xcc_id(); b.st = st;
    if (threadIdx.x == 0) (void)xb_add(&bar[XB_XCNT(b.x)], 1u);
    return b;
}
__device__ __forceinline__ void xcd_barrier_complete(unsigned* bar, unsigned x, unsigned& nloc, unsigned& nx) {
    const unsigned G = gridDim.x * gridDim.y * gridDim.z;
    unsigned sum, cnt, mine, sp = 0u;
    for (;;) {
        sum = 0u; cnt = 0u; mine = 0u;
#pragma unroll
        for (unsigned j = 0; j < 16; ++j) { const unsigned c = xb_ld(&bar[XB_XCNT(j)]); sum += c; cnt += (c > 0u) ? 1u : 0u; mine = (j == x) ? c : mine; }
        if (sum == G) break;
        __builtin_amdgcn_s_sleep(1);
        if ((++sp & 255u) == 0u) { if (xb_ld(&bar[XB_TMO])) break; if (sp > XB_SPIN_CAP) { atomicAdd(&bar[XB_TMO], 1u); break; } }
    }
    nloc = mine > 0u ? mine : 1u; nx = cnt > 0u ? cnt : 1u;
}

__device__ __forceinline__ void xcd_barrier(const XcdBarrier& b) {
    asm volatile("s_waitcnt vmcnt(0)" ::: "memory");
    __syncthreads();
    if (threadIdx.x == 0) {
        unsigned* bar = b.bar;
        __builtin_amdgcn_s_waitcnt(0);
        unsigned nloc = b.st[0], nx = b.st[1];
        if (nloc == 0u) { xcd_barrier_complete(bar, b.x, nloc, nx); b.st[0] = nloc; b.st[1] = nx; }
        const unsigned old = xb_add(&bar[XB_XSUB(b.x)], 1u);
        const unsigned gen = old / nloc;
        if (old + 1u == (gen + 1u) * nloc) {
            __builtin_amdgcn_fence(__ATOMIC_RELEASE, "agent");
            asm volatile("s_waitcnt vmcnt(0)" ::: "memory");
            const unsigned og = xb_add(&bar[XB_TOP], 1u);
            const unsigned tg = og / nx;
            if (og + 1u == (tg + 1u) * nx) xb_add(&bar[XB_TOPGEN], 1u);
            else XB_SPIN(xb_ld(&bar[XB_TOPGEN]) == tg, bar);
            __builtin_amdgcn_fence(__ATOMIC_ACQUIRE, "agent");
            xb_add(&bar[XB_XGEN(b.x)], 1u);
            asm volatile("s_waitcnt vmcnt(0)" ::: "memory");
        } else {
            XB_SPIN(xb_ld(&bar[XB_XGEN(b.x)]) == gen, bar);
            __builtin_amdgcn_fence(__ATOMIC_ACQUIRE, "agent");
            asm volatile("s_waitcnt vmcnt(0)" ::: "memory");
        }
    }
    __syncthreads();
}

constexpr bool USE_SP2 = true;
__global__ void __launch_bounds__(512, 2) hybrid_fwd(Args a) {
    extern __shared__ __attribute__((aligned(16))) unsigned char lds_raw[];
    LAS unsigned char* lds = (LAS unsigned char*)lds_raw;
    cg::grid_group grid = cg::this_grid();
    volatile LAS unsigned* bst = (volatile LAS unsigned*)(lds + LDS_BYTES - 64);
    if (threadIdx.x < 16) bst[threadIdx.x] = 0u;
    __syncthreads();
    const XcdBarrier xbar = xcd_barrier_post((unsigned*)(a.ws + WS_BAR), bst);
    const int tid = threadIdx.x, lane = tid & 63, wave = __builtin_amdgcn_readfirstlane(tid >> 6);
    const int G = gridDim.x, bid = blockIdx.x;
    unsigned char* ws = as_global(a.ws);
    const int NGW = G * 8;

#ifndef NO_PREP
    for (int rep = 0; rep < REP_PREP; ++rep) { prep_phase(ws, lds, bid * 8 + wave, NGW, wave, lane); __syncthreads(); }
#endif
    grid.sync();

#define FRESH() unsigned char* wsp = ws; int ll = l, bb = bid, gg = G; asm volatile("" : "+s"(wsp), "+s"(ll), "+s"(bb), "+s"(gg)); wsp = as_global(wsp); float* outp = as_global(a.out); (void)outp; unsigned char* wl = wsp + WS_W + (size_t)ll * W_LAYER; (void)wl
#define SSA(k) ss_arr(wsp, 1 + 4 * ll + (k))
#pragma unroll 1
    for (int l = 0; l < DEPTH; ++l) {
        {
            FRESH();
            pg8::Gemm g{(const bf16_t*)(wsp + WS_XB), (const bf16_t*)(wl + W_IN), T, 2048, D, D, D}; pg8::StaticOrder S; S.init(T, 2048, gg, bb);
            EpiInProj E{(bf16_t*)(wsp + WS_BG), (bf16_t*)(wsp + WS_XIN), (bf16_t*)(wsp + WS_U), ll == 0 ? ss_arr(wsp, 0) : ss_arr(wsp, 4), outp + O_CONVP + (size_t)ll * NB * 2 * CH, outp + O_CONVS + (size_t)ll * NDB * 2 * CH};
#ifndef NO_GEMM
            pg8::gemm_phase<EpiInProj, USE_SP2, pg8::StaticOrder>(lds, g, S, E);
#endif
#ifndef NO_SMALL
            small_gemm(g.A, g.Bt, 2048, D, E, bb >= (gg >> 1) ? bb - (gg >> 1) : -1, gg >> 1);
#endif
        }
        {
            FRESH();
            pg8::Gemm g{(const bf16_t*)(wl + W_KV) + (size_t)D * D, (const bf16_t*)(wsp + WS_MNB), D, TM, D, D, D}; pg8::StaticOrder S; S.init(D, TM, gg, (bb + gg - (32 % gg)) % gg);
            EpiVT E{(bf16_t*)(wsp + WS_VT) + (size_t)ll * D * TM, invmem_arr(wsp)};
#ifndef NO_GEMM
            pg8::gemm_phase<EpiVT, USE_SP2, pg8::StaticOrder>(lds, g, S, E);
#endif
        }
        xcd_barrier(xbar);
        {
            FRESH();
            int tid2 = threadIdx.x; asm volatile("" : "+v"(tid2)); const int lane2 = tid2 & 63;
            const int w = wave * gg + bb; const int NGW2 = gg * 8;
            for (int rep = 0; rep < REP_SCAN; ++rep) {
#ifndef NO_SCAN
            for (int it = w; it < NB * 32 + NDB * 32; it += NGW2) scan_item(wsp, outp, ll, it, lds + wave * SCAN_LDS_WAVE, lane2);
#endif
#ifndef NO_CONV
            for (int run = NGW2 - 1 - w; run < T / 64; run += NGW2) conv_run(wsp, ll, run, lane2);
#endif
            }
        }
        xcd_barrier(xbar);
        {
            FRESH();
            pg8::Gemm g{(const bf16_t*)(wsp + WS_YG), (const bf16_t*)(wl + W_GLU), T, CH, CH, CH, CH}; pg8::StaticOrder S; S.init(T, CH, gg, bb);
            EpiGLU E{(const bf16_t*)(wsp + WS_YG), (bf16_t*)(wsp + WS_YCAT), SSA(0)};
#ifndef NO_GEMM
            pg8::gemm_phase<EpiGLU, USE_SP2, pg8::StaticOrder>(lds, g, S, E);
#endif
#ifndef NO_SMALL
            small_gemm(g.A, g.Bt, CH, CH, E, bb, gg);
#endif
        }
        xcd_barrier(xbar);
        {
            FRESH();
            pg8::Gemm g{(const bf16_t*)(wsp + WS_YCAT), (const bf16_t*)(wl + W_OUT), T, D, D, D, D}; pg8::StaticOrder S; S.init(T, D, gg, bb);
            EpiRes<true> E{(bf16_t*)(wsp + WS_XB), SSA(1), SSA(0)};
#ifndef NO_GEMM
            pg8::gemm_phase<EpiRes<true>, USE_SP2, pg8::StaticOrder>(lds, g, S, E);
#endif
#ifndef NO_SMALL
            small_gemm(g.A, g.Bt, D, D, E, bb, gg);
#endif
        }
        {
            FRESH();
            pg8::Gemm g{(const bf16_t*)(wsp + WS_MNB), (const bf16_t*)(wl + W_KV), TM, D, D, D, D}; pg8::StaticOrder S; S.init(TM, D, gg, (bb + gg - (16 % gg)) % gg);
            EpiKV<false> E{outp + O_MKP + (size_t)ll * TM * D, outp + O_MVP + (size_t)ll * TM * D, (bf16_t*)(wsp + WS_KB) + (size_t)ll * TM * D, invmem_arr(wsp)};
#if !defined(NO_GEMM)
            pg8::gemm_phase<EpiKV<false>, USE_SP2, pg8::StaticOrder>(lds, g, S, E);
#endif
        }
        xcd_barrier(xbar);
        {
            FRESH();
            pg8::Gemm g{(const bf16_t*)(wsp + WS_XB), (const bf16_t*)(wl + W_Q), T, D, D, D, D}; pg8::StaticOrder S; S.init(T, D, gg, bb);
            EpiScale<0> E{(bf16_t*)(wsp + WS_Q), D, SSA(1)};
#ifndef NO_GEMM
            pg8::gemm_phase<EpiScale<0>, USE_SP2, pg8::StaticOrder>(lds, g, S, E);
#endif
#ifndef NO_SMALL
            small_gemm(g.A, g.Bt, D, D, E, bb, gg);
#endif
        }
        {
            FRESH();
            pg8::Gemm g{(const bf16_t*)(wsp + WS_MNB), (const bf16_t*)(wl + W_KV) + (size_t)D * D, TM, D, D, D, D}; pg8::StaticOrder S; S.init(TM, D, gg, (bb + gg - (16 % gg)) % gg);
            EpiKV<true> E{outp + O_MKP + (size_t)ll * TM * D, outp + O_MVP + (size_t)ll * TM * D, (bf16_t*)(wsp + WS_KB) + (size_t)ll * TM * D, invmem_arr(wsp)};
#if !defined(NO_GEMM)
            pg8::gemm_phase<EpiKV<true>, USE_SP2, pg8::StaticOrder>(lds, g, S, E);
#endif
        }
        xcd_barrier(xbar);
        {
            FRESH();
#ifndef NO_ATTN
            for (int rep = 0; rep < REP_ATTN; ++rep) attn_phase(wsp, ll, lds, gg, bb);
#endif
        }
        xcd_barrier(xbar);
        {
            FRESH();
            pg8::Gemm g{(const bf16_t*)(wsp + WS_O), (const bf16_t*)(wl + W_O), T, D, D, D, D}; pg8::StaticOrder S; S.init(T, D, gg, bb);
            EpiRes<false> E{(bf16_t*)(wsp + WS_XB), SSA(2), nullptr};
#ifndef NO_GEMM
            pg8::gemm_phase<EpiRes<false>, USE_SP2, pg8::StaticOrder>(lds, g, S, E);
#endif
#ifndef NO_SMALL
            small_gemm(g.A, g.Bt, D, D, E, bb, gg);
#endif
        }
        xcd_barrier(xbar);
        {
            FRESH();
            pg8::Gemm g{(const bf16_t*)(wsp + WS_XB), (const bf16_t*)(wl + W_UP), T, DFF, D, D, D}; pg8::StaticOrder S; S.init(T, DFF, gg, bb);
            EpiScale<1> E{(bf16_t*)(wsp + WS_HDN), DFF, SSA(2)};
#ifndef NO_GEMM
            for (int rep = 0; rep < REP_UP; ++rep) pg8::gemm_phase<EpiScale<1>, USE_SP2, pg8::StaticOrder>(lds, g, S, E);
#endif
#ifndef NO_SMALL
            small_gemm(g.A, g.Bt, DFF, D, E, bb, gg);
#endif
        }
        xcd_barrier(xbar);
        {
            FRESH();
            pg8::Gemm g{(const bf16_t*)(wsp + WS_HDN), (const bf16_t*)(wl + W_DOWN), TP, D, DFF, DFF, DFF}; pg8::StaticOrder S; S.init(TP, D, gg, bb);
            EpiRes<false> E{(bf16_t*)(wsp + WS_XB), SSA(3), nullptr};
#if !defined(NO_GEMM)
            pg8::gemm_phase<EpiRes<false>, USE_SP2, pg8::StaticOrder>(lds, g, S, E);
#endif
        }
        {
            FRESH();
            pg8::Gemm g{(const bf16_t*)(wsp + WS_HDN) + (size_t)TP * DFF, (const bf16_t*)(wl + W_DOWN), TS, D, D, DFF, DFF}; pg8::KSplitOrder S; S.init(TS, D, 4, D, gg, bb);
            EpiAtomic E{(float*)(wsp + WS_SCR)};
#if !defined(NO_GEMM)
            pg8::gemm_phase<EpiAtomic, USE_SP2, pg8::KSplitOrder>(lds, g, S, E);
#endif
        }
        xcd_barrier(xbar);
        {
            FRESH();
            int tid4 = threadIdx.x; asm volatile("" : "+v"(tid4)); const int lane4 = tid4 & 63;
            GAS float* scr = (GAS float*)(wsp + WS_SCR); GAS float* ss3 = (GAS float*)SSA(3);
            for (int r = bb * 8 + wave; r < TS; r += gg * 8) {
                GAS f32x4* sp = (GAS f32x4*)(scr + (size_t)r * D) + lane4; GAS u32x2* xp = (GAS u32x2*)((bf16_t*)(wsp + WS_XB) + (size_t)(TP + r) * D) + lane4;
                float ssum = 0.f;
#pragma unroll
                for (int j = 0; j < 4; ++j) { const f32x4 d = (sp[64 * j] + sp[64 * j + (size_t)TS * D / 4]) + (sp[64 * j + 2 * ((size_t)TS * D / 4)] + sp[64 * j + 3 * ((size_t)TS * D / 4)]); const u32x2 w = xp[64 * j];
                    const f32x4 x = (f32x4){bf_lo(w.x), bf_hi(w.x), bf_lo(w.y), bf_hi(w.y)} + d;
                    ssum += (x[0] * x[0] + x[1] * x[1]) + (x[2] * x[2] + x[3] * x[3]);
                    u32x2 o; o.x = cvt_pk_bf16(x[0], x[1]); o.y = cvt_pk_bf16(x[2], x[3]); xp[64 * j] = o; }
                ssum = wave_sum(ssum);
                if (lane4 == 0) ss3[TP + r] = ssum;
            }
        }
        xcd_barrier(xbar);
    }
    {
        int tid3 = threadIdx.x; asm volatile("" : "+v"(tid3)); const int lane = tid3 & 63;
        const bf16_t* XB = (const bf16_t*)(ws + WS_XB); const float* ssf = ss_arr(ws, 1 + 4 + 3); const GAS float* gf = (const GAS float*)(ws + WS_SMALL) + SM_GFIN;
        f32x4 gv[4];
#pragma unroll
        for (int j = 0; j < 4; ++j) gv[j] = *(const GAS f32x4*)(gf + 256 * j + 4 * lane);
        for (int m0 = (bid * 8 + wave) * 4; m0 < T; m0 += NGW * 4) {
            u32x2 wv[4][4]; float inv[4];
#pragma unroll
            for (int r = 0; r < 4; ++r) { const GAS u32x2* xr = (const GAS u32x2*)(XB + (size_t)(m0 + r) * D) + lane;
#pragma unroll
                for (int j = 0; j < 4; ++j) wv[r][j] = xr[64 * j];
                inv[r] = rsqrtf(((const GAS float*)ssf)[m0 + r] * (1.0f / D) + EPS); }
#pragma unroll
            for (int r = 0; r < 4; ++r) { GAS f32x4* o = (GAS f32x4*)(a.out + (size_t)(m0 + r) * D) + lane;
#pragma unroll
                for (int j = 0; j < 4; ++j) { const u32x2 w = wv[r][j]; o[64 * j] = (f32x4){bf_lo(w.x), bf_hi(w.x), bf_lo(w.y), bf_hi(w.y)} * inv[r] * gv[j]; } }
        }
    }
}

extern "C" void kernel_launch(void* const* d_in, const int* in_sizes, int n_in, void* d_out, int out_size, void* d_ws, size_t ws_size, hipStream_t stream) {
    static int grid = 0;
    if (grid == 0) {
        if (n_in != 33 || (size_t)out_size != O_END || ws_size < WS_END) { fprintf(stderr, "kernel_launch: unexpected sizes n_in %d out %d ws %zu (need %zu)\n", n_in, out_size, ws_size, (size_t)WS_END); grid = -1; return; }
        int dev = 0, cus = 0, per_cu = 0;
        (void)hipGetDevice(&dev); (void)hipDeviceGetAttribute(&cus, hipDeviceAttributeMultiprocessorCount, dev);
        if (hipFuncSetAttribute((const void*)hybrid_fwd, hipFuncAttributeMaxDynamicSharedMemorySize, LDS_BYTES) != hipSuccess) { fprintf(stderr, "kernel_launch: hipFuncSetAttribute failed\n"); grid = -1; return; }
        if (hipOccupancyMaxActiveBlocksPerMultiprocessor(&per_cu, (const void*)hybrid_fwd, 512, LDS_BYTES) != hipSuccess || per_cu < 1) { fprintf(stderr, "kernel_launch: occupancy query says %d\n", per_cu); per_cu = 1; }
        (void)hipGetLastError();
        grid = cus > 0 ? cus : 256;
    }
    if (grid < 0) return;
    if (hipMemsetAsync((char*)d_ws + WS_BAR, 0, BAR_BYTES, stream) != hipSuccess) { fprintf(stderr, "kernel_launch: hipMemsetAsync failed\n"); return; }
    Args a{};
    for (int i = 0; i < 33; ++i) a.in[i] = (const float*)d_in[i];
    a.out = (float*)d_out; a.ws = (unsigned char*)d_ws;
    void* args[] = {&a};
    hipError_t e = hipLaunchCooperativeKernel((const void*)hybrid_fwd, dim3(grid), dim3(512), args, LDS_BYTES, stream);
    if (e != hipSuccess) fprintf(stderr, "kernel_launch: cooperative launch failed: %s (grid %d)\n", hipGetErrorString(e), grid);
}
```

```cpp
#include <hip/hip_runtime.h>
#include <hip/hip_cooperative_groups.h>
#include <cstdio>
#include <cstdint>
namespace cg = cooperative_groups;
#define NO_SMALL 1
#ifndef REP_PREP
#define REP_PREP 1
#endif
#ifndef REP_SCAN
#define REP_SCAN 1
#endif
#ifndef REP_ATTN
#define REP_ATTN 1
#endif
#ifndef REP_UP
#define REP_UP 1
#endif

#define LAS __attribute__((address_space(3)))
#define GAS __attribute__((address_space(1)))
typedef unsigned short bf16_t;
typedef short bf16x8 __attribute__((ext_vector_type(8)));
typedef short bf16x4 __attribute__((ext_vector_type(4)));
typedef float f32x2 __attribute__((ext_vector_type(2)));
typedef float f32x4 __attribute__((ext_vector_type(4)));
typedef float f32x16 __attribute__((ext_vector_type(16)));
typedef unsigned u32x4 __attribute__((ext_vector_type(4)));
typedef unsigned u32x2 __attribute__((ext_vector_type(2)));

constexpr int D = 1024, NB = 32, SEQ = 2048, NDB = 16, DSEQ = 64, DEPTH = 2;
constexpr int TP = NB * SEQ, TS = NDB * DSEQ, T = TP + TS;
constexpr int NMEM = 256, TM = NB * NMEM, TMS = NDB * NMEM;
constexpr int DFF = 4096, CH = 512;
constexpr float EPS = 1e-6f;
constexpr size_t O_YP = 0, O_YS = O_YP + (size_t)TP * D, O_CONVP = O_YS + (size_t)TS * D, O_REP = O_CONVP + (size_t)DEPTH * NB * 2 * CH,
                 O_IMP = O_REP + (size_t)DEPTH * NB * 32 * 64, O_MKP = O_IMP + (size_t)DEPTH * NB * 32 * 64, O_MVP = O_MKP + (size_t)DEPTH * TM * D,
                 O_CONVS = O_MVP + (size_t)DEPTH * TM * D, O_RES = O_CONVS + (size_t)DEPTH * NDB * 2 * CH, O_IMS = O_RES + (size_t)DEPTH * NDB * 32 * 64,
                 O_END = O_IMS + (size_t)DEPTH * NDB * 32 * 64;
constexpr size_t MiB = 1u << 20;
constexpr size_t WS_SS = 0;
constexpr size_t WS_BAR = 3 * MiB + MiB / 2, BAR_BYTES = 16384;
constexpr size_t WS_W = 4 * MiB, W_LAYER = 31 * MiB;
constexpr size_t W_IN = 0, W_GLU = 4 * MiB, W_OUT = 4 * MiB + MiB / 2, W_Q = 6 * MiB + MiB / 2, W_KV = 8 * MiB + MiB / 2, W_O = 12 * MiB + MiB / 2,
                 W_UP = 14 * MiB + MiB / 2, W_DOWN = 22 * MiB + MiB / 2;
constexpr size_t WS_XB = 66 * MiB;
constexpr size_t WS_MNB = 196 * MiB;
constexpr size_t WS_KB = 212 * MiB;
constexpr size_t WS_VT = 244 * MiB;
constexpr size_t WS_KC = 276 * MiB;
constexpr size_t WS_VTC = 292 * MiB;
constexpr size_t WS_BIG = 308 * MiB;
constexpr size_t SZ_T512 = (size_t)T * 512 * 2;
constexpr size_t WS_BG = WS_BIG, WS_XIN = WS_BG + SZ_T512, WS_U = WS_XIN + SZ_T512, WS_YG = WS_U + SZ_T512, WS_YCAT = WS_YG + SZ_T512;
constexpr size_t WS_Q = WS_BG, WS_O = WS_U, WS_HDN = WS_BIG;
constexpr size_t WS_SMALL = WS_BIG + (size_t)T * DFF * 2;
constexpr size_t WS_SCR = WS_SMALL + 4 * MiB;
constexpr size_t WS_END = WS_SCR + 16 * MiB;
constexpr int SM_ARE = 0, SM_AIM = 4096, SM_LOGDT = 8192, SM_BRE = 8256, SM_BIM = SM_BRE + 65536, SM_CRE = SM_BIM + 65536, SM_CIM = SM_CRE + 65536, SM_SD = SM_CIM + 65536,
              SM_CONVW = SM_SD + 1024, SM_SCONV = SM_CONVW + 3072, SM_SRE = SM_SCONV + 32768, SM_SIM = SM_SRE + 65536, SM_GFIN = SM_SIM + 65536, SM_END = SM_GFIN + 1024;
static_assert(WS_YCAT + 2 * SZ_T512 <= WS_END, "ws map");

constexpr int LDS_BYTES = 256 * 528 + 1024;

template <class Tp> __device__ __forceinline__ Tp* as_global(Tp* p) {
#if defined(__HIP_DEVICE_COMPILE__)
    __builtin_assume(!__builtin_amdgcn_is_shared((const __attribute__((address_space(0))) void*)p) && !__builtin_amdgcn_is_private((const __attribute__((address_space(0))) void*)p));
#endif
    return p;
}
__device__ __forceinline__ unsigned cvt_pk_bf16(float lo, float hi) { unsigned r; asm volatile("v_cvt_pk_bf16_f32 %0, %1, %2" : "=v"(r) : "v"(lo), "v"(hi)); return r; }
__device__ __forceinline__ float bf_lo(unsigned w) { return __uint_as_float(w << 16); }
__device__ __forceinline__ float bf_hi(unsigned w) { return __uint_as_float(w & 0xffff0000u); }
__device__ __forceinline__ float wave_sum(float v) {
#pragma unroll
    for (int o = 1; o < 64; o <<= 1) v += __shfl_xor(v, o);
    return v;
}
#define LDS_WAIT() asm volatile("s_waitcnt lgkmcnt(0)" ::: "memory")

namespace pg8 {
constexpr int BM = 256, BK = 64, HALF = 128, HTB = HALF * BK * 2, STAGE_BYTES = 8 * HTB, NXCD = 8, WGM = 8;
__host__ __device__ __forceinline__ int lds_byte(int r, int c) { const int st = (r >> 4) * 2 + (c >> 5), rr = r & 15, cc = c & 31, ob = rr * 64 + cc * 2; return st * 1024 + (ob ^ (((ob >> 9) & 1) << 5)); }
__host__ __device__ __forceinline__ void stage_rc(int b, int& R, int& C) { const int st = b / 1024, sb = b % 1024, swz = sb ^ (((sb >> 9) & 1) << 5); R = (st >> 1) * 16 + swz / 64; C = (st & 1) * 32 + (swz % 64) / 2; }
__host__ __device__ __forceinline__ int perm32(int rho) { const int n = rho >> 4, i = rho & 15; return 8 * (i >> 2) + 4 * n + (i & 3); }

struct Unit { int pm, pn, ko; };
struct Gemm { const bf16_t* A; const bf16_t* Bt; int M, N, K, lda, ldb; };

struct StaticOrder {
    int nM, nN, nwg, G, c;
    __device__ void init(int M, int N, int G_, int c_) { nM = M / BM; nN = N / BM; nwg = nM * nN; G = G_; c = c_; }
    __device__ bool next(int i, Unit& u) const {
        const long L = (long)i * G + c; if (L >= nwg) return false;
        int wgid = (int)L; { const int q = nwg / NXCD, r = nwg % NXCD, xcd = wgid % NXCD, off = wgid / NXCD; wgid = (xcd < r ? xcd * (q + 1) : r * (q + 1) + (xcd - r) * q) + off; }
        const int nig = WGM * nN, gid = wgid / nig, fm = gid * WGM, gsz = (nM - fm) < WGM ? (nM - fm) : WGM;
        u.pm = fm + ((wgid % nig) % gsz); u.pn = (wgid % nig) / gsz; u.ko = 0; return true;
    }
};
struct KSplitOrder {
    int nN, nS, nwg, G, c, kslice_bytes;
    __device__ void init(int M, int N, int nS_, int kslice, int G_, int c_) { nN = N / BM; nS = nS_; nwg = (M / BM) * nN * nS; G = G_; c = c_; kslice_bytes = kslice * 2; }
    __device__ bool next(int i, Unit& u) const {
        const long L = (long)i * G + c; if (L >= nwg) return false;
        const int l = (int)L, sidx = l % nS, t = l / nS; u.pn = t % nN; u.pm = t / nN; u.ko = sidx * kslice_bytes; return true;
    }
};

template <class Epi, bool SP2, class Sched>
__device__ __forceinline__ void gemm_phase(LAS unsigned char* lds, const Gemm g, const Sched& S, const Epi& E) {
    int tid = threadIdx.x; asm volatile("" : "+v"(tid));
    const int wid = __builtin_amdgcn_readfirstlane(tid >> 6), lane = tid & 63, wr = wid >> 2, wc = wid & 3, fr = lane & 15, fq = lane >> 4;
    const int K = g.K, nt = K / BK;
    unsigned voffA[2], voffB[2];
#pragma unroll
    for (int i = 0; i < 2; ++i) { int R, C; stage_rc(tid * 16 + i * 8192, R, C); const int Rb = Epi::PERM ? ((R & ~31) + perm32(R & 31)) : R;
        voffA[i] = (unsigned)(R * g.lda + C) * 2u; voffB[i] = (unsigned)(Rb * g.ldb + C) * 2u; }
    const size_t kstep = (size_t)(BK * 2);
    const size_t hstep = (size_t)HALF * g.lda * 2, hstepB = (size_t)HALF * g.ldb * 2;
    const size_t tstep = 2 * hstep, tstepB = 2 * hstepB;
    const unsigned ldsw = (unsigned)wid * 1024u;
    const int aoff = lds_byte(wr * 64 + fr, fq * 8), boff = lds_byte(wc * 32 + fr, fq * 8);
#define PG8_SA(b, h) (((b) * 2 + (h)) * HTB)
#define PG8_SB(b, h) ((4 + (b) * 2 + (h)) * HTB)
#define PG8_STAGE(bufoff, gbase, voff) do { _Pragma("unroll") for (int _i = 0; _i < 2; ++_i) \
        __builtin_amdgcn_global_load_lds((const unsigned*)((const char*)(gbase) + (voff)[_i]), (LAS unsigned*)(lds + (bufoff) + ldsw + _i * 8192), 16, 0, 0); } while (0)
#define PG8_LDA(dst, b, h) do { _Pragma("unroll") for (int m = 0; m < 4; ++m) _Pragma("unroll") for (int k = 0; k < 2; ++k) dst[m][k] = *(const LAS bf16x8*)(lds + PG8_SA(b, h) + aoff + m * 2048 + k * 1024); } while (0)
#define PG8_LDB(dst, b, h) do { _Pragma("unroll") for (int n = 0; n < 2; ++n) _Pragma("unroll") for (int k = 0; k < 2; ++k) dst[n][k] = *(const LAS bf16x8*)(lds + PG8_SB(b, h) + boff + n * 2048 + k * 1024); } while (0)
#define PG8_MMA(ai, bj, At, Bt) do { __builtin_amdgcn_s_setprio(1); _Pragma("unroll") for (int m = 0; m < 4; ++m) _Pragma("unroll") for (int n = 0; n < 2; ++n) _Pragma("unroll") for (int k = 0; k < 2; ++k) \
        acc[ai][bj][m][n] = __builtin_amdgcn_mfma_f32_16x16x32_bf16(Bt[n][k], At[m][k], acc[ai][bj][m][n], 0, 0, 0); __builtin_amdgcn_s_setprio(0); } while (0)
#define PG8_WAIT_V(n) asm volatile("s_waitcnt vmcnt(" #n ")" ::: "memory")
#define PG8_WAIT_L(n) asm volatile("s_waitcnt lgkmcnt(" #n ")" ::: "memory")
#define PG8_BAR __builtin_amdgcn_s_barrier()
#define PG8_SCHED __builtin_amdgcn_sched_barrier(0)
    Unit cur, nxt; int ui = 0;
    if (!S.next(0, cur)) return;
    f32x4 acc[2][2][4][2];
#pragma unroll
    for (int a = 0; a < 2; ++a)
#pragma unroll
        for (int b = 0; b < 2; ++b)
#pragma unroll
            for (int m = 0; m < 4; ++m)
#pragma unroll
                for (int n = 0; n < 2; ++n) acc[a][b][m][n] = (f32x4){0.f, 0.f, 0.f, 0.f};
    bf16x8 At[4][2], B0[2][2], B1[2][2];
    const char* cA = (const char*)g.A + (size_t)cur.pm * tstep + cur.ko; const char* cB = (const char*)g.Bt + (size_t)cur.pn * tstepB + cur.ko;
    if constexpr (SP2) {
        PG8_STAGE(PG8_SB(0, 0), cB, voffB); PG8_STAGE(PG8_SB(0, 1), cB + hstepB, voffB); PG8_STAGE(PG8_SA(0, 0), cA, voffA); PG8_STAGE(PG8_SA(0, 1), cA + hstep, voffA);
        if (wr == 1) PG8_BAR;
        PG8_WAIT_V(2); PG8_BAR;
        PG8_STAGE(PG8_SB(1, 0), cB + kstep, voffB); PG8_STAGE(PG8_SA(1, 0), cA + kstep, voffA); PG8_STAGE(PG8_SB(1, 1), cB + hstepB + kstep, voffB);
        PG8_WAIT_V(6); PG8_BAR;
    } else {
        PG8_STAGE(PG8_SB(0, 0), cB, voffB); PG8_STAGE(PG8_SA(0, 0), cA, voffA); PG8_STAGE(PG8_SB(0, 1), cB + hstepB, voffB); PG8_STAGE(PG8_SA(0, 1), cA + hstep, voffA);
        if (wr == 1) PG8_BAR;
        PG8_WAIT_V(4); PG8_BAR;
        PG8_STAGE(PG8_SB(1, 0), cB + kstep, voffB); PG8_STAGE(PG8_SA(1, 0), cA + kstep, voffA); PG8_STAGE(PG8_SB(1, 1), cB + hstepB + kstep, voffB);
        PG8_WAIT_V(6); PG8_BAR;
    }
    for (;;) {
        const bool has_next = S.next(ui + 1, nxt);
        const char* nA = has_next ? (const char*)g.A + (size_t)nxt.pm * tstep + nxt.ko : cA; const char* nB = has_next ? (const char*)g.Bt + (size_t)nxt.pn * tstepB + nxt.ko : cB;
        for (int t = 0; t < nt; t += 2) {
            const bool last = (t == nt - 2);
            const char* a1 = cA + (size_t)(t + 1) * kstep;
            const char* a2 = last ? nA : cA + (size_t)(t + 2) * kstep; const char* b2 = last ? nB : cB + (size_t)(t + 2) * kstep;
            const char* a3 = a2 + kstep; const char* b3 = b2 + kstep;
            if constexpr (Epi::MID) { if (t == (nt >> 1)) E.mid(acc, cur, wr, fr); }
            if constexpr (SP2) {
            PG8_LDB(B0, 0, 0); PG8_LDB(B1, 0, 1); PG8_SCHED; PG8_LDA(At, 0, 0); PG8_STAGE(PG8_SA(1, 1), a1 + hstep, voffA);
            PG8_WAIT_V(8); PG8_WAIT_L(0); PG8_BAR; PG8_MMA(0, 0, At, B0); PG8_MMA(0, 1, At, B1); PG8_BAR; PG8_SCHED;
            PG8_LDA(At, 0, 1); PG8_STAGE(PG8_SB(0, 0), b2, voffB); PG8_STAGE(PG8_SB(0, 1), b2 + hstepB, voffB); PG8_STAGE(PG8_SA(0, 0), a2, voffA);
            PG8_WAIT_V(8); PG8_WAIT_L(0); PG8_BAR; PG8_MMA(1, 0, At, B0); PG8_MMA(1, 1, At, B1); PG8_BAR; PG8_SCHED;
            PG8_LDB(B0, 1, 0); PG8_LDB(B1, 1, 1); PG8_SCHED; PG8_LDA(At, 1, 0); PG8_STAGE(PG8_SA(0, 1), a2 + hstep, voffA);
            PG8_WAIT_V(8); PG8_WAIT_L(0); PG8_BAR; PG8_MMA(0, 0, At, B0); PG8_MMA(0, 1, At, B1); PG8_BAR; PG8_SCHED;
            PG8_LDA(At, 1, 1); PG8_STAGE(PG8_SB(1, 0), b3, voffB); PG8_STAGE(PG8_SB(1, 1), b3 + hstepB, voffB); PG8_STAGE(PG8_SA(1, 0), a3, voffA);
            PG8_WAIT_V(8); PG8_WAIT_L(0); PG8_BAR; PG8_MMA(1, 0, At, B0); PG8_MMA(1, 1, At, B1); PG8_BAR; PG8_SCHED;
            } else {
            PG8_LDB(B0, 0, 0); PG8_SCHED; PG8_LDA(At, 0, 0); PG8_STAGE(PG8_SA(1, 1), a1 + hstep, voffA);
            PG8_WAIT_L(8); PG8_BAR; PG8_WAIT_L(0); PG8_MMA(0, 0, At, B0); PG8_BAR; PG8_SCHED;
            PG8_LDB(B1, 0, 1); PG8_STAGE(PG8_SB(0, 0), b2, voffB);
            PG8_BAR; PG8_WAIT_L(0); PG8_MMA(0, 1, At, B1); PG8_BAR;
            PG8_LDA(At, 0, 1); PG8_STAGE(PG8_SA(0, 0), a2, voffA);
            PG8_BAR; PG8_WAIT_L(0); PG8_MMA(1, 0, At, B0); PG8_BAR; PG8_SCHED;
            PG8_STAGE(PG8_SB(0, 1), b2 + hstepB, voffB);
            PG8_WAIT_V(6); PG8_BAR; PG8_MMA(1, 1, At, B1); PG8_BAR;
            PG8_LDB(B0, 1, 0); PG8_SCHED; PG8_LDA(At, 1, 0); PG8_STAGE(PG8_SA(0, 1), a2 + hstep, voffA);
            PG8_WAIT_L(8); PG8_BAR; PG8_WAIT_L(0); PG8_MMA(0, 0, At, B0); PG8_BAR; PG8_SCHED;
            PG8_LDB(B1, 1, 1); PG8_STAGE(PG8_SB(1, 0), b3, voffB);
            PG8_BAR; PG8_WAIT_L(0); PG8_MMA(0, 1, At, B1); PG8_BAR;
            PG8_LDA(At, 1, 1); PG8_STAGE(PG8_SA(1, 0), a3, voffA);
            PG8_BAR; PG8_WAIT_L(0); PG8_MMA(1, 0, At, B0); PG8_BAR; PG8_SCHED;
            PG8_STAGE(PG8_SB(1, 1), b3 + hstepB, voffB);
            PG8_WAIT_V(6); PG8_BAR; PG8_MMA(1, 1, At, B1); PG8_BAR;
            }
        }
        if (wr == 0) PG8_BAR;
        E(acc, cur, wr, wc, fr, fq);
        if (!has_next) break;
#pragma unroll
        for (int a = 0; a < 2; ++a)
#pragma unroll
            for (int b = 0; b < 2; ++b)
#pragma unroll
                for (int m = 0; m < 4; ++m)
#pragma unroll
                    for (int n = 0; n < 2; ++n) acc[a][b][m][n] = (f32x4){0.f, 0.f, 0.f, 0.f};
        cur = nxt; cA = nA; cB = nB; ++ui;
        if (wr == 1) PG8_BAR;
    }
    PG8_WAIT_V(0);
    PG8_BAR;
#undef PG8_SA
#undef PG8_SB
#undef PG8_STAGE
#undef PG8_LDA
#undef PG8_LDB
#undef PG8_MMA
#undef PG8_WAIT_V
#undef PG8_WAIT_L
#undef PG8_BAR
#undef PG8_SCHED
}
}
using pg8::Unit;
typedef f32x4 Acc[2][2][4][2];

__device__ __forceinline__ void store8_bf16(bf16_t* p, const f32x4& a, const f32x4& b) {
    u32x4 w; w.x = cvt_pk_bf16(a[0], a[1]); w.y = cvt_pk_bf16(a[2], a[3]); w.z = cvt_pk_bf16(b[0], b[1]); w.w = cvt_pk_bf16(b[2], b[3]);
    *(GAS u32x4*)p = w;
}
__device__ __forceinline__ void unpack8(const u32x4 w, f32x4& a, f32x4& b) {
    a = (f32x4){bf_lo(w.x), bf_hi(w.x), bf_lo(w.y), bf_hi(w.y)}; b = (f32x4){bf_lo(w.z), bf_hi(w.z), bf_lo(w.w), bf_hi(w.w)};
}

struct EpiInProj {
    static constexpr bool PERM = true, MID = false;
    bf16_t* BG; bf16_t* XIN; bf16_t* U; const float* ss; float* convp; float* convs;
    __device__ __forceinline__ int brow(int cb, int f) const {
        const int cg = cb >> 5;
        if (cg < 16) return cb + 16 * f;
        if (cg >= 48) return 1536 + 32 * (cg - 48) + 16 * f;
        const int c = 16 * (cg - 16), q = c >> 7, r = c & 127;
        return 512 + 256 * q + 128 * f + r;
    }
    __device__ __forceinline__ void small(const f32x4 (&acc)[2][2], int r0, int cb, int fr, int fq) const {
        const int cg = cb >> 5;
#pragma unroll
        for (int m = 0; m < 2; ++m) {
            const int r = r0 + 16 * m + fr; const float inv = rsqrtf(((const GAS float*)ss)[r] * (1.0f / D) + EPS);
            if (cg < 16 || cg >= 48) {
                bf16_t* dst = (cg < 16 ? BG + (size_t)r * CH + cb : U + (size_t)r * CH + (cb - 1536)) + 4 * fq;
#pragma unroll
                for (int f = 0; f < 2; ++f) { const f32x4 v = acc[m][f] * inv; u32x2 w; w.x = cvt_pk_bf16(v[0], v[1]); w.y = cvt_pk_bf16(v[2], v[3]); *(GAS u32x2*)(dst + 16 * f) = w; }
            } else {
                const int c0 = 16 * (cg - 16) + 4 * fq;
                const f32x4 x = (acc[m][0] * inv) * (acc[m][1] * inv);
                u32x2 w; w.x = cvt_pk_bf16(x[0], x[1]); w.y = cvt_pk_bf16(x[2], x[3]); *(GAS u32x2*)(XIN + (size_t)r * CH + c0) = w;
                const int rs = r - TP, t = rs & (DSEQ - 1);
                if (t >= DSEQ - 2) *(GAS f32x4*)(convs + ((size_t)(rs >> 6) * 2 + (t - (DSEQ - 2))) * CH + c0) = x;
            }
        }
    }
    __device__ __forceinline__ void operator()(const Acc& acc, const Unit& u, int wr, int wc, int fr, int fq) const {
        const int row0 = u.pm * 256 + wr * 64 + fr, cb = wc * 32 + 8 * fq;
#pragma unroll
        for (int ai = 0; ai < 2; ++ai)
#pragma unroll
            for (int m = 0; m < 4; ++m) {
                const int r = row0 + ai * 128 + m * 16;
                const float inv = rsqrtf(((const GAS float*)ss)[r] * (1.0f / D) + EPS);
                if (u.pn < 2 || u.pn >= 6) {
                    bf16_t* dst = (u.pn < 2 ? BG : U) + (size_t)r * CH + (u.pn & 1) * 256 + cb;
#pragma unroll
                    for (int bj = 0; bj < 2; ++bj) store8_bf16(dst + bj * 128, acc[ai][bj][m][0] * inv, acc[ai][bj][m][1] * inv);
                } else {
                    const int c0 = (u.pn - 2) * 128 + cb;
                    const f32x4 x0 = (acc[ai][0][m][0] * inv) * (acc[ai][1][m][0] * inv), x1 = (acc[ai][0][m][1] * inv) * (acc[ai][1][m][1] * inv);
                    store8_bf16(XIN + (size_t)r * CH + c0, x0, x1);
                    float* cd = nullptr;
                    if (r < TP) { const int t = r & (SEQ - 1); if (t >= SEQ - 2) cd = convp + ((size_t)(r >> 11) * 2 + (t - (SEQ - 2))) * CH + c0; }
                    else { const int rs = r - TP, t = rs & (DSEQ - 1); if (t >= DSEQ - 2) cd = convs + ((size_t)(rs >> 6) * 2 + (t - (DSEQ - 2))) * CH + c0; }
                    if (cd) { *(GAS f32x4*)cd = x0; *(GAS f32x4*)(cd + 4) = x1; }
                }
            }
    }
};
template <bool VPART> struct EpiKV {
    static constexpr bool PERM = false, MID = false;
    float* outK; float* outV; bf16_t* KB; const float* invm;
    __device__ __forceinline__ void operator()(const Acc& acc, const Unit& u, int wr, int wc, int fr, int fq) const {
        const int row0 = u.pm * 256 + wr * 64 + fr, col0 = (u.pn & 3) * 256 + wc * 32 + 4 * fq;
        float* outp = VPART ? outV : outK;
#pragma unroll
        for (int ai = 0; ai < 2; ++ai)
#pragma unroll
            for (int m = 0; m < 4; ++m) {
                const int r = row0 + ai * 128 + m * 16; const float inv = ((const GAS float*)invm)[r];
#pragma unroll
                for (int bj = 0; bj < 2; ++bj)
#pragma unroll
                    for (int n = 0; n < 2; ++n) {
                        const f32x4 v = acc[ai][bj][m][n] * inv; const size_t o = (size_t)r * D + col0 + bj * 128 + n * 16;
                        *(GAS f32x4*)(outp + o) = v;
                        if (!VPART) { u32x2 w; w.x = cvt_pk_bf16(v[0], v[1]); w.y = cvt_pk_bf16(v[2], v[3]); *(GAS u32x2*)(KB + o) = w; }
                    }
            }
    }
};
struct EpiVT {
    static constexpr bool PERM = true, MID = false;
    bf16_t* VT; const float* invm;
    __device__ __forceinline__ void operator()(const Acc& acc, const Unit& u, int wr, int wc, int fr, int fq) const {
        const int row0 = u.pm * 256 + wr * 64 + fr, col0 = u.pn * 256 + wc * 32 + 8 * fq;
        f32x4 s[2][2];
#pragma unroll
        for (int bj = 0; bj < 2; ++bj) { s[bj][0] = *(const GAS f32x4*)(invm + col0 + bj * 128); s[bj][1] = *(const GAS f32x4*)(invm + col0 + bj * 128 + 4); }
#pragma unroll
        for (int ai = 0; ai < 2; ++ai)
#pragma unroll
            for (int m = 0; m < 4; ++m) {
                const int r = row0 + ai * 128 + m * 16;
#pragma unroll
                for (int bj = 0; bj < 2; ++bj) store8_bf16(VT + (size_t)r * TM + col0 + bj * 128, acc[ai][bj][m][0] * s[bj][0], acc[ai][bj][m][1] * s[bj][1]);
            }
    }
};
struct EpiGLU {
    static constexpr bool PERM = true, MID = false;
    const bf16_t* YG; bf16_t* YCAT; float* ssb;
    __device__ __forceinline__ int brow(int cb, int f) const { return cb + 16 * f; }
    __device__ __forceinline__ void small(const f32x4 (&acc)[2][2], int r0, int cb, int fr, int fq) const {
#pragma unroll
        for (int m = 0; m < 2; ++m) {
            const int r = r0 + 16 * m + fr; float ssum = 0.f;
#pragma unroll
            for (int f = 0; f < 2; ++f) {
                const int c = cb + 16 * f + 4 * fq; const u32x2 yw = *(const GAS u32x2*)(YG + (size_t)r * CH + c);
                f32x4 y = (f32x4){bf_lo(yw.x), bf_hi(yw.x), bf_lo(yw.y), bf_hi(yw.y)};
#pragma unroll
                for (int e = 0; e < 4; ++e) { y[e] = y[e] * __builtin_amdgcn_rcpf(1.0f + __expf(-acc[m][f][e])); ssum += y[e] * y[e]; }
                u32x2 w; w.x = cvt_pk_bf16(y[0], y[1]); w.y = cvt_pk_bf16(y[2], y[3]); *(GAS u32x2*)(YCAT + (size_t)r * D + c) = w;
            }
            ssum += __shfl_xor(ssum, 16); ssum += __shfl_xor(ssum, 32);
            if (fq == 0) atomicAdd(ssb + r, ssum);
        }
    }
    __device__ __forceinline__ void operator()(const Acc& acc, const Unit& u, int wr, int wc, int fr, int fq) const {
        const int row0 = u.pm * 256 + wr * 64 + fr, col0 = u.pn * 256 + wc * 32 + 8 * fq;
#pragma unroll
        for (int ai = 0; ai < 2; ++ai)
#pragma unroll
            for (int m = 0; m < 4; ++m) {
                const int r = row0 + ai * 128 + m * 16; float ssum = 0.f;
#pragma unroll
                for (int bj = 0; bj < 2; ++bj) {
                    f32x4 y0, y1; unpack8(*(const GAS u32x4*)(YG + (size_t)r * CH + col0 + bj * 128), y0, y1);
                    f32x4 z0 = acc[ai][bj][m][0], z1 = acc[ai][bj][m][1];
#pragma unroll
                    for (int e = 0; e < 4; ++e) { y0[e] = y0[e] * __builtin_amdgcn_rcpf(1.0f + __expf(-z0[e])); y1[e] = y1[e] * __builtin_amdgcn_rcpf(1.0f + __expf(-z1[e]));
                        ssum += y0[e] * y0[e] + y1[e] * y1[e]; }
                    store8_bf16(YCAT + (size_t)r * D + col0 + bj * 128, y0, y1);
                }
                ssum += __shfl_xor(ssum, 16); ssum += __shfl_xor(ssum, 32);
                if (fq == 0) atomicAdd(ssb + r, ssum);
            }
    }
};
template <bool MIDS> struct EpiRes {
    static constexpr bool PERM = true, MID = MIDS;
    bf16_t* XB; float* ssout; const float* ssb;
    __device__ __forceinline__ int brow(int cb, int f) const { return cb + 16 * f; }
    __device__ __forceinline__ void mid_small(f32x4 (&acc)[2][2], int r0, int fr) const {
#pragma unroll
        for (int m = 0; m < 2; ++m) { const float sc = rsqrtf(((const GAS float*)ssb)[r0 + 16 * m + fr] * (1.0f / CH) + EPS); acc[m][0] *= sc; acc[m][1] *= sc; }
    }
    __device__ __forceinline__ void small(const f32x4 (&acc)[2][2], int r0, int cb, int fr, int fq) const {
#pragma unroll
        for (int m = 0; m < 2; ++m) {
            const int r = r0 + 16 * m + fr; float ssum = 0.f;
#pragma unroll
            for (int f = 0; f < 2; ++f) {
                bf16_t* p = XB + (size_t)r * D + cb + 16 * f + 4 * fq; const u32x2 xw = *(const GAS u32x2*)p;
                f32x4 x = (f32x4){bf_lo(xw.x), bf_hi(xw.x), bf_lo(xw.y), bf_hi(xw.y)} + acc[m][f];
#pragma unroll
                for (int e = 0; e < 4; ++e) ssum += x[e] * x[e];
                u32x2 w; w.x = cvt_pk_bf16(x[0], x[1]); w.y = cvt_pk_bf16(x[2], x[3]); *(GAS u32x2*)p = w;
            }
            ssum += __shfl_xor(ssum, 16); ssum += __shfl_xor(ssum, 32);
            if (fq == 0) atomicAdd(ssout + r, ssum);
        }
    }
    __device__ __forceinline__ void mid(Acc& acc, const Unit& u, int wr, int fr) const {
        const int row0 = u.pm * 256 + wr * 64 + fr;
#pragma unroll
        for (int ai = 0; ai < 2; ++ai)
#pragma unroll
            for (int m = 0; m < 4; ++m) {
                const float s = rsqrtf(((const GAS float*)ssb)[row0 + ai * 128 + m * 16] * (1.0f / CH) + EPS);
#pragma unroll
                for (int bj = 0; bj < 2; ++bj)
#pragma unroll
                    for (int n = 0; n < 2; ++n) acc[ai][bj][m][n] *= s;
            }
    }
    __device__ __forceinline__ void operator()(const Acc& acc, const Unit& u, int wr, int wc, int fr, int fq) const {
        const int row0 = u.pm * 256 + wr * 64 + fr, col0 = u.pn * 256 + wc * 32 + 8 * fq;
#pragma unroll
        for (int ai = 0; ai < 2; ++ai)
#pragma unroll
            for (int m = 0; m < 4; ++m) {
                const int r = row0 + ai * 128 + m * 16; float ssum = 0.f;
#pragma unroll
                for (int bj = 0; bj < 2; ++bj) {
                    bf16_t* p = XB + (size_t)r * D + col0 + bj * 128;
                    f32x4 x0, x1; unpack8(*(const GAS u32x4*)p, x0, x1);
                    x0 += acc[ai][bj][m][0]; x1 += acc[ai][bj][m][1];
#pragma unroll
                    for (int e = 0; e < 4; ++e) ssum += x0[e] * x0[e] + x1[e] * x1[e];
                    store8_bf16(p, x0, x1);
                }
                ssum += __shfl_xor(ssum, 16); ssum += __shfl_xor(ssum, 32);
                if (fq == 0) atomicAdd(ssout + r, ssum);
            }
    }
};
template <int ACT> struct EpiScale {
    static constexpr bool PERM = true, MID = false;
    bf16_t* OUT; int ldc; const float* ss;
    __device__ __forceinline__ int brow(int cb, int f) const { return cb + 16 * f; }
    __device__ __forceinline__ void small(const f32x4 (&acc)[2][2], int r0, int cb, int fr, int fq) const {
#pragma unroll
        for (int m = 0; m < 2; ++m) {
            const int r = r0 + 16 * m + fr; const float inv = rsqrtf(((const GAS float*)ss)[r] * (1.0f / D) + EPS);
#pragma unroll
            for (int f = 0; f < 2; ++f) {
                f32x4 v = acc[m][f] * inv;
                if (ACT == 1) {
#pragma unroll
                    for (int e = 0; e < 4; ++e) { const float a = fmaxf(v[e], 0.f); v[e] = a * a; }
                }
                u32x2 w; w.x = cvt_pk_bf16(v[0], v[1]); w.y = cvt_pk_bf16(v[2], v[3]); *(GAS u32x2*)(OUT + (size_t)r * ldc + cb + 16 * f + 4 * fq) = w;
            }
        }
    }
    __device__ __forceinline__ void operator()(const Acc& acc, const Unit& u, int wr, int wc, int fr, int fq) const {
        const int row0 = u.pm * 256 + wr * 64 + fr, col0 = u.pn * 256 + wc * 32 + 8 * fq;
#pragma unroll
        for (int ai = 0; ai < 2; ++ai)
#pragma unroll
            for (int m = 0; m < 4; ++m) {
                const int r = row0 + ai * 128 + m * 16; const float inv = rsqrtf(((const GAS float*)ss)[r] * (1.0f / D) + EPS);
#pragma unroll
                for (int bj = 0; bj < 2; ++bj) {
                    f32x4 v0 = acc[ai][bj][m][0] * inv, v1 = acc[ai][bj][m][1] * inv;
                    if (ACT == 1) {
#pragma unroll
                        for (int e = 0; e < 4; ++e) { const float a = fmaxf(v0[e], 0.f), b = fmaxf(v1[e], 0.f); v0[e] = a * a; v1[e] = b * b; }
                    }
                    store8_bf16(OUT + (size_t)r * ldc + col0 + bj * 128, v0, v1);
                }
            }
    }
};

template <class Epi>
__device__ __forceinline__ void small_gemm(const bf16_t* A, const bf16_t* Bt, int N, int K, const Epi& E, int c, int stride) {
    int tid = threadIdx.x; asm volatile("" : "+v"(tid));
    const int wave = __builtin_amdgcn_readfirstlane(tid >> 6), lane = tid & 63, fr = lane & 15, fq = lane >> 4;
    const int ntn = N >> 7, ntiles = (TS / 64) * ntn;
    if (c < 0) return;
    for (int tile = c; tile < ntiles; tile += stride) {
        const int tm = tile / ntn, tn = tile - tm * ntn;
        const int r0 = TP + tm * 64 + (wave >> 2) * 32, cb = tn * 128 + (wave & 3) * 32;
        const char* pa = (const char*)A + ((size_t)(r0 + fr) * K + 8 * fq) * 2;
        const char* pb0 = (const char*)Bt + ((size_t)(E.brow(cb, 0) + fr) * K + 8 * fq) * 2;
        const char* pb1 = (const char*)Bt + ((size_t)(E.brow(cb, 1) + fr) * K + 8 * fq) * 2;
        const size_t a16 = (size_t)16 * K * 2;
        f32x4 acc[2][2];
#pragma unroll
        for (int m = 0; m < 2; ++m)
#pragma unroll
            for (int f = 0; f < 2; ++f) acc[m][f] = (f32x4){0.f, 0.f, 0.f, 0.f};
        const int ng = K >> 7;
        bf16x8 A0[4], A1[4], B0[4], B1[4], C0[4], C1[4], D0[4], D1[4];
#define SG_LOAD(a0, a1, b0, b1, g) do { _Pragma("unroll") for (int j = 0; j < 4; ++j) { const size_t ko = (size_t)((g) * 4 + j) * 64; \
            a0[j] = *(const GAS bf16x8*)(pa + ko); a1[j] = *(const GAS bf16x8*)(pa + a16 + ko); b0[j] = *(const GAS bf16x8*)(pb0 + ko); b1[j] = *(const GAS bf16x8*)(pb1 + ko); } } while (0)
#define SG_MMA(a0, a1, b0, b1) do { _Pragma("unroll") for (int j = 0; j < 4; ++j) { \
            acc[0][0] = __builtin_amdgcn_mfma_f32_16x16x32_bf16(b0[j], a0[j], acc[0][0], 0, 0, 0); acc[0][1] = __builtin_amdgcn_mfma_f32_16x16x32_bf16(b1[j], a0[j], acc[0][1], 0, 0, 0); \
            acc[1][0] = __builtin_amdgcn_mfma_f32_16x16x32_bf16(b0[j], a1[j], acc[1][0], 0, 0, 0); acc[1][1] = __builtin_amdgcn_mfma_f32_16x16x32_bf16(b1[j], a1[j], acc[1][1], 0, 0, 0); } } while (0)
        SG_LOAD(A0, A1, B0, B1, 0);
        for (int g = 0; g < ng; g += 2) {
            if constexpr (Epi::MID) { if (g == (ng >> 1)) E.mid_small(acc, r0, fr); }
            SG_LOAD(C0, C1, D0, D1, g + 1);
            SG_MMA(A0, A1, B0, B1);
            if (g + 2 < ng) SG_LOAD(A0, A1, B0, B1, g + 2);
            SG_MMA(C0, C1, D0, D1);
        }
#undef SG_LOAD
#undef SG_MMA
        E.small(acc, r0, cb, fr, fq);
    }
}

struct EpiAtomic {
    static constexpr bool PERM = false, MID = false;
    float* SCR;
    __device__ __forceinline__ void operator()(const Acc& acc, const Unit& u, int wr, int wc, int fr, int fq) const {
        const int row0 = u.pm * 256 + wr * 64 + fr, col0 = u.pn * 256 + wc * 32 + 4 * fq;
        float* slab = SCR + (size_t)(u.ko >> 11) * TS * D;
#pragma unroll
        for (int ai = 0; ai < 2; ++ai)
#pragma unroll
            for (int m = 0; m < 4; ++m) {
                float* rp = slab + (size_t)(row0 + ai * 128 + m * 16) * D + col0;
#pragma unroll
                for (int bj = 0; bj < 2; ++bj)
#pragma unroll
                    for (int n = 0; n < 2; ++n) *(GAS f32x4*)(rp + bj * 128 + n * 16) = acc[ai][bj][m][n];
            }
    }
};
struct Args { const float* in[33]; float* out; unsigned char* ws; };
enum { I_XP = 0, I_XS, I_MEM, I_SCONV, I_SRE, I_SIM, I_CK, I_CV, I_GMIX, I_WIN, I_CONVW, I_ARE, I_AIM, I_LOGDT, I_BRE, I_BIM, I_CRE, I_CIM, I_SD, I_WGLU,
       I_GA, I_GB, I_WOUT, I_GX, I_GMEM, I_WQ, I_WK, I_WV, I_WO, I_GMLP, I_WUP, I_WDOWN, I_GFIN };

typedef const float* const __attribute__((address_space(4)))* KTab;
__device__ __forceinline__ KTab ktab() { unsigned long long p = (unsigned long long)__builtin_amdgcn_kernarg_segment_ptr(); asm volatile("" : "+s"(p)); return (KTab)p; }
__device__ __forceinline__ float* ss_arr(unsigned char* ws, int idx) { return (float*)(ws + WS_SS) + (size_t)idx * T; }
__device__ __forceinline__ float* invmem_arr(unsigned char* ws) { return (float*)(ws + WS_SS) + (size_t)9 * T; }

__device__ __forceinline__ int inproj_src_col(int vc) {
    if (vc < 512 || vc >= 1536) return vc;
    const int q = (vc - 512) >> 8, r = (vc - 512) & 255;
    return r < 128 ? 512 + q * 128 + r : 1024 + q * 128 + (r - 128);
}
__device__ __forceinline__ void transpose_item(const float* W, int ldw, int srck0, int srcn0, const float* gain, float gscale, bf16_t* WT, int ldt, int dn0, int dk0, LAS float* scr, int lane) {
#pragma unroll 8
    for (int i = 0; i < 32; ++i) { const int kk = 2 * i + (lane >> 5); float v = ((const GAS float*)W)[(size_t)(srck0 + kk) * ldw + srcn0 + (lane & 31)];
        const float gsc = gain ? ((const GAS float*)gain)[kk] * gscale : gscale; scr[kk * 33 + (lane & 31)] = v * gsc; }
    LDS_WAIT();
    const int c = lane & 7;
#pragma unroll
    for (int j = 0; j < 4; ++j) { const int n = (lane >> 3) + 8 * j; const LAS float* s = scr + (8 * c) * 33 + n;
        u32x4 o; o.x = cvt_pk_bf16(s[0 * 33], s[1 * 33]); o.y = cvt_pk_bf16(s[2 * 33], s[3 * 33]); o.z = cvt_pk_bf16(s[4 * 33], s[5 * 33]); o.w = cvt_pk_bf16(s[6 * 33], s[7 * 33]);
        *(GAS u32x4*)(WT + (size_t)(dn0 + n) * ldt + dk0 + 8 * c) = o; }
    LDS_WAIT();
}
__device__ __forceinline__ float convert_row(const float* src, bf16_t* dst, int lane) {
    const GAS f32x4* xr = (const GAS f32x4*)src + lane; f32x4 v[4]; float s = 0.f;
#pragma unroll
    for (int j = 0; j < 4; ++j) { v[j] = xr[64 * j]; s += (v[j][0] * v[j][0] + v[j][1] * v[j][1]) + (v[j][2] * v[j][2] + v[j][3] * v[j][3]); }
    GAS u32x2* o = (GAS u32x2*)dst + lane;
#pragma unroll
    for (int j = 0; j < 4; ++j) { u32x2 w; w.x = cvt_pk_bf16(v[j][0], v[j][1]); w.y = cvt_pk_bf16(v[j][2], v[j][3]); o[64 * j] = w; }
    return wave_sum(s);
}
constexpr int PI_IN = 1024, PI_GLU = 128, PI_SQ = 512, PI_UP = 2048, PI_CV = 2048;
constexpr int PI_LAYER = PI_IN + PI_GLU + 5 * PI_SQ + 2 * PI_UP + PI_CV;

__device__ __forceinline__ void prep_phase(unsigned char* ws, LAS unsigned char* lds, int gw, int NGW, int wave, int lane) {
    const KTab in = ktab();
    LAS float* scr = (LAS float*)(lds + wave * 8704);
    for (int it = gw; it < DEPTH * PI_LAYER; it += NGW) {
        const int l = it / PI_LAYER; int r = it - l * PI_LAYER;
        unsigned char* wl = ws + WS_W + (size_t)l * W_LAYER;
        if (r < PI_IN) { const int kb = r >> 6, nb = r & 63;
            transpose_item(as_global(in[I_WIN]) + (size_t)l * D * 2048, 2048, 64 * kb, inproj_src_col(32 * nb), as_global(in[I_GMIX]) + l * D + 64 * kb, 1.0f, (bf16_t*)(wl + W_IN), D, 32 * nb, 64 * kb, scr, lane); continue; }
        r -= PI_IN;
        if (r < PI_GLU) { const int kb = r >> 4, nb = r & 15;
            transpose_item(as_global(in[I_WGLU]) + (size_t)l * CH * CH, CH, 64 * kb, 32 * nb, nullptr, 1.0f, (bf16_t*)(wl + W_GLU), CH, 32 * nb, 64 * kb, scr, lane); continue; }
        r -= PI_GLU;
        if (r < PI_SQ) { const int kb = r >> 5, nb = r & 31, dk0 = 64 * kb;
            const float* gn = dk0 < 512 ? as_global(in[I_GB]) + l * CH + dk0 : as_global(in[I_GA]) + l * CH + dk0 - 512;
            transpose_item(as_global(in[I_WOUT]) + (size_t)l * D * D, D, (dk0 + 512) & 1023, 32 * nb, gn, 1.0f, (bf16_t*)(wl + W_OUT), D, 32 * nb, dk0, scr, lane); continue; }
        r -= PI_SQ;
        if (r < PI_SQ) { const int kb = r >> 5, nb = r & 31;
            transpose_item(as_global(in[I_WQ]) + (size_t)l * D * D, D, 64 * kb, 32 * nb, as_global(in[I_GX]) + l * D + 64 * kb, 0.0625f, (bf16_t*)(wl + W_Q), D, 32 * nb, 64 * kb, scr, lane); continue; }
        r -= PI_SQ;
        if (r < PI_SQ) { const int kb = r >> 5, nb = r & 31;
            transpose_item(as_global(in[I_WK]) + (size_t)l * D * D, D, 64 * kb, 32 * nb, as_global(in[I_GMEM]) + l * D + 64 * kb, 1.0f, (bf16_t*)(wl + W_KV), D, 32 * nb, 64 * kb, scr, lane); continue; }
        r -= PI_SQ;
        if (r < PI_SQ) { const int kb = r >> 5, nb = r & 31;
            transpose_item(as_global(in[I_WV]) + (size_t)l * D * D, D, 64 * kb, 32 * nb, as_global(in[I_GMEM]) + l * D + 64 * kb, 1.0f, (bf16_t*)(wl + W_KV), D, 1024 + 32 * nb, 64 * kb, scr, lane); continue; }
        r -= PI_SQ;
        if (r < PI_SQ) { const int kb = r >> 5, nb = r & 31;
            transpose_item(as_global(in[I_WO]) + (size_t)l * D * D, D, 64 * kb, 32 * nb, nullptr, 1.0f, (bf16_t*)(wl + W_O), D, 32 * nb, 64 * kb, scr, lane); continue; }
        r -= PI_SQ;
        if (r < PI_UP) { const int kb = r >> 7, nb = r & 127;
            transpose_item(as_global(in[I_WUP]) + (size_t)l * D * DFF, DFF, 64 * kb, 32 * nb, as_global(in[I_GMLP]) + l * D + 64 * kb, 1.0f, (bf16_t*)(wl + W_UP), D, 32 * nb, 64 * kb, scr, lane); continue; }
        r -= PI_UP;
        if (r < PI_UP) { const int kb = r >> 5, nb = r & 31;
            transpose_item(as_global(in[I_WDOWN]) + (size_t)l * DFF * D, D, 64 * kb, 32 * nb, nullptr, 1.0f, (bf16_t*)(wl + W_DOWN), DFF, 32 * nb, 64 * kb, scr, lane); continue; }
        r -= PI_UP;
        { const int kb = r >> 5, nb = r & 31;
            transpose_item(as_global(in[I_CV]) + (size_t)l * TMS * D, D, 64 * kb, 32 * nb, nullptr, 1.0f, (bf16_t*)(ws + WS_VTC) + (size_t)l * D * TMS, TMS, 32 * nb, 64 * kb, scr, lane); }
    }
    float* ss0 = ss_arr(ws, 0); float* invm = invmem_arr(ws);
    for (int m0 = gw * 2; m0 < T; m0 += NGW * 2) {
        const float* src = m0 < TP ? as_global(in[I_XP]) + (size_t)m0 * D : as_global(in[I_XS]) + (size_t)(m0 - TP) * D;
        const GAS f32x4* xr = (const GAS f32x4*)src + lane; f32x4 v[8]; float s0 = 0.f, s1 = 0.f;
#pragma unroll
        for (int j = 0; j < 8; ++j) v[j] = xr[64 * j];
#pragma unroll
        for (int j = 0; j < 4; ++j) { s0 += (v[j][0] * v[j][0] + v[j][1] * v[j][1]) + (v[j][2] * v[j][2] + v[j][3] * v[j][3]);
            s1 += (v[4 + j][0] * v[4 + j][0] + v[4 + j][1] * v[4 + j][1]) + (v[4 + j][2] * v[4 + j][2] + v[4 + j][3] * v[4 + j][3]); }
        GAS u32x2* o = (GAS u32x2*)((bf16_t*)(ws + WS_XB) + (size_t)m0 * D) + lane;
#pragma unroll
        for (int j = 0; j < 8; ++j) { u32x2 w; w.x = cvt_pk_bf16(v[j][0], v[j][1]); w.y = cvt_pk_bf16(v[j][2], v[j][3]); o[64 * j] = w; }
        s0 = wave_sum(s0); s1 = wave_sum(s1);
        if (lane == 0) { ((GAS float*)ss0)[m0] = s0; ((GAS float*)ss0)[m0 + 1] = s1; }
    }
    for (int m = T + gw; m < T + TM + 2 * TMS; m += NGW) {
        if (m < T) { const float* src = m < TP ? as_global(in[I_XP]) + (size_t)m * D : as_global(in[I_XS]) + (size_t)(m - TP) * D;
            const float s = convert_row(src, (bf16_t*)(ws + WS_XB) + (size_t)m * D, lane); if (lane == 0) ((GAS float*)ss0)[m] = s; }
        else if (m < T + TM) { const int mm = m - T; const float s = convert_row(as_global(in[I_MEM]) + (size_t)mm * D, (bf16_t*)(ws + WS_MNB) + (size_t)mm * D, lane);
            if (lane == 0) ((GAS float*)invm)[mm] = rsqrtf(s * (1.0f / D) + EPS); }
        else { const int mm = m - T - TM; (void)convert_row(as_global(in[I_CK]) + (size_t)mm * D, (bf16_t*)(ws + WS_KC) + (size_t)mm * D, lane); }
    }
    {
        float* sm = (float*)(ws + WS_SMALL); const int gt = gw * 64 + lane, NT = NGW * 64;
#define SMCOPY(off, idx, n) for (int i = gt; i < (n); i += NT) ((GAS float*)sm)[(off) + i] = ((const GAS float*)in[idx])[i]
        SMCOPY(SM_ARE, I_ARE, 4096); SMCOPY(SM_AIM, I_AIM, 4096); SMCOPY(SM_LOGDT, I_LOGDT, 64); SMCOPY(SM_BRE, I_BRE, 65536); SMCOPY(SM_BIM, I_BIM, 65536);
        SMCOPY(SM_CRE, I_CRE, 65536); SMCOPY(SM_CIM, I_CIM, 65536); SMCOPY(SM_SD, I_SD, 1024); SMCOPY(SM_CONVW, I_CONVW, 3072); SMCOPY(SM_SCONV, I_SCONV, 32768);
        SMCOPY(SM_SRE, I_SRE, 65536); SMCOPY(SM_SIM, I_SIM, 65536); SMCOPY(SM_GFIN, I_GFIN, 1024);
#undef SMCOPY
    }
    { float* z = ss_arr(ws, 1); const size_t n = (size_t)8 * T; for (size_t i = (size_t)gw * 64 + lane; i < n; i += (size_t)NGW * 64) ((GAS float*)z)[i] = 0.f; }
}

__device__ __forceinline__ float gelu_tanh(float x) {
    const float u = 0.7978845608f * (x + 0.044715f * x * x * x);
    const float e = __expf(2.0f * u);
    const float th = 1.0f - 2.0f * __builtin_amdgcn_rcpf(e + 1.0f);
    return 0.5f * x * (1.0f + th);
}
__device__ __forceinline__ void sincos_small(float x, float& s, float& c) {
    const float q = rintf(x * 0.63661977236f);
    float r = fmaf(-q, 1.57079637050628662109375f, x); r = fmaf(-q, -4.37113900018624283e-8f, r);
    const float r2 = r * r;
    const float sp = r + r * r2 * (-1.0f / 6 + r2 * (1.0f / 120 + r2 * (-1.0f / 5040 + r2 * (1.0f / 362880))));
    const float cp = 1.0f + r2 * (-0.5f + r2 * (1.0f / 24 + r2 * (-1.0f / 720 + r2 * (1.0f / 40320 + r2 * (-1.0f / 3628800)))));
    const int qi = (int)q & 3;
    s = (qi == 0) ? sp : (qi == 1) ? cp : (qi == 2) ? -sp : -cp;
    c = (qi == 0) ? cp : (qi == 1) ? -sp : (qi == 2) ? -cp : sp;
}
constexpr int BU_STRIDE = 528, H_STRIDE = 272, SCAN_LDS_WAVE = 16 * BU_STRIDE + 16 * H_STRIDE;

__device__ __forceinline__ void scan_item(unsigned char* ws, float* out, int l, int item, LAS unsigned char* wl, int lane_in) {
    int lane = lane_in; asm volatile("" : "+v"(lane));
    const GAS float* sm = (const GAS float*)(ws + WS_SMALL);
    int b, g, row0, nblk; const bool prompt = item < NB * 32;
    if (prompt) { b = item >> 5; g = item & 31; row0 = b * SEQ; nblk = SEQ / 16; }
    else { const int i2 = item - NB * 32; b = i2 >> 5; g = i2 & 31; row0 = TP + b * DSEQ; nblk = DSEQ / 16; }
    const bf16_t* U = (const bf16_t*)(ws + WS_U); bf16_t* YG = (bf16_t*)(ws + WS_YG);
    const int lg = l * 32 + g, p = lane, t16 = lane & 15, q = lane >> 4;
    const float are = fminf(sm[SM_ARE + lg * 64 + p], -1e-4f), aim = sm[SM_AIM + lg * 64 + p];
    const float dt = expf(sm[SM_LOGDT + lg]);
    float sn, cs; sincos_small(aim * dt, sn, cs);
    const float mag = expf(are * dt), abr = mag * cs, abi = mag * sn;
    const float nr = abr - 1.0f, ni = abi, den = 1.0f / (are * are + aim * aim);
    const float c0 = (nr * are + ni * aim) * den, c1 = (ni * are - nr * aim) * den;
    bf16x8 af[8];
#pragma unroll
    for (int f = 0; f < 8; ++f) {
        const int i = 16 * f + t16, ps = i >> 1, cc = i & 1;
        const float k0 = __shfl(c0, ps), k1 = __shfl(c1, ps);
        u32x4 w = (u32x4){0u, 0u, 0u, 0u};
        if (q < 2) {
            const GAS f32x4* br = (const GAS f32x4*)(sm + SM_BRE + ((size_t)lg * 64 + ps) * 16 + 8 * q); const GAS f32x4* bi = (const GAS f32x4*)(sm + SM_BIM + ((size_t)lg * 64 + ps) * 16 + 8 * q);
            const f32x4 r0 = br[0], r1 = br[1], i0 = bi[0], i1 = bi[1];
            f32x4 v0, v1;
            if (cc == 0) { v0 = k0 * r0 - k1 * i0; v1 = k0 * r1 - k1 * i1; } else { v0 = k0 * i0 + k1 * r0; v1 = k0 * i1 + k1 * r1; }
            w.x = cvt_pk_bf16(v0[0], v0[1]); w.y = cvt_pk_bf16(v0[2], v0[3]); w.z = cvt_pk_bf16(v1[0], v1[1]); w.w = cvt_pk_bf16(v1[2], v1[3]);
        }
        af[f] = __builtin_bit_cast(bf16x8, w);
    }
    bf16x8 cf[4];
#pragma unroll
    for (int s = 0; s < 4; ++s) {
        const int p0 = 16 * s + 4 * q;
        const f32x4 cr = *(const GAS f32x4*)(sm + SM_CRE + ((size_t)lg * 16 + t16) * 64 + p0), ci = *(const GAS f32x4*)(sm + SM_CIM + ((size_t)lg * 16 + t16) * 64 + p0);
        u32x4 w; w.x = cvt_pk_bf16(cr[0], -ci[0]); w.y = cvt_pk_bf16(cr[1], -ci[1]); w.z = cvt_pk_bf16(cr[2], -ci[2]); w.w = cvt_pk_bf16(cr[3], -ci[3]);
        cf[s] = __builtin_bit_cast(bf16x8, w);
    }
    const f32x4 dsk = *(const GAS f32x4*)(sm + SM_SD + l * CH + g * 16 + 4 * q);
    float hre = 0.f, him = 0.f;
    if (!prompt) { hre = sm[SM_SRE + (((size_t)l * NDB + b) * 32 + g) * 64 + p]; him = sm[SM_SIM + (((size_t)l * NDB + b) * 32 + g) * 64 + p]; }
    LAS unsigned char* BU = wl; LAS unsigned char* HB = wl + 16 * BU_STRIDE;
    const char* ubase = (const char*)U + (size_t)row0 * CH * 2; char* ybase = (char*)YG + (size_t)row0 * CH * 2;
    const unsigned lo8 = (unsigned)((t16 * CH + g * 16 + 8 * (q & 1)) * 2), lo4 = (unsigned)((t16 * CH + g * 16 + 4 * q) * 2);
    constexpr size_t BSTEP = (size_t)16 * CH * 2;
    constexpr int PD = 4;
    u32x4 ubuf[PD]; u32x2 ebuf[PD];
    const bool lowq = q < 2;
#pragma unroll
    for (int j = 0; j < PD; ++j) { const char* un = ubase + (size_t)j * BSTEP; ubuf[j] = *(const GAS u32x4*)(un + lo8); ebuf[j] = *(const GAS u32x2*)(un + lo4); }
#define U_BFRAG(v) __builtin_bit_cast(bf16x8, (u32x4){lowq ? (v).x : 0u, lowq ? (v).y : 0u, lowq ? (v).z : 0u, lowq ? (v).w : 0u})
    f32x2 buv[16];
    {
        const bf16x8 bfrag = U_BFRAG(ubuf[0]);
#pragma unroll
        for (int f = 0; f < 8; ++f) {
            const f32x4 r = __builtin_amdgcn_mfma_f32_16x16x32_bf16(af[f], bfrag, (f32x4){0.f, 0.f, 0.f, 0.f}, 0, 0, 0);
            *(LAS f32x4*)(BU + t16 * BU_STRIDE + (16 * f + 4 * q) * 4) = r;
        }
        LDS_WAIT();
#pragma unroll
        for (int t = 0; t < 16; ++t) buv[t] = *(const LAS f32x2*)(BU + t * BU_STRIDE + p * 8);
    }
    if (prompt) {
        for (int tb0 = 0; tb0 < nblk; tb0 += 32) {
#pragma unroll
        for (int j = 0; j < 32; ++j) {
            const int tb = tb0 + j;
            const u32x2 uec = ebuf[j % PD];
            const u32x4 ubn = ubuf[(j + 1) % PD];
            { const int tbn = (tb + PD < nblk) ? tb + PD : nblk - 1; const char* un = ubase + (size_t)tbn * BSTEP; ubuf[j % PD] = *(const GAS u32x4*)(un + lo8); ebuf[j % PD] = *(const GAS u32x2*)(un + lo4); }
            f32x4 rn[8];
            { const bf16x8 bfrag = U_BFRAG(ubn);
#pragma unroll
              for (int f = 0; f < 8; ++f) rn[f] = __builtin_amdgcn_mfma_f32_16x16x32_bf16(af[f], bfrag, (f32x4){0.f, 0.f, 0.f, 0.f}, 0, 0, 0); }
#pragma unroll
            for (int t = 0; t < 16; ++t) {
                const float nre = fmaf(abr, hre, fmaf(-abi, him, buv[t][0])), nim = fmaf(abr, him, fmaf(abi, hre, buv[t][1]));
                hre = nre; him = nim;
                *(LAS unsigned*)(HB + t * H_STRIDE + p * 4) = cvt_pk_bf16(hre, him);
            }
#pragma unroll
            for (int f = 0; f < 8; ++f) *(LAS f32x4*)(BU + t16 * BU_STRIDE + (16 * f + 4 * q) * 4) = rn[f];
            LDS_WAIT();
            bf16x8 hf[4];
#pragma unroll
            for (int s2 = 0; s2 < 4; ++s2) hf[s2] = *(const LAS bf16x8*)(HB + t16 * H_STRIDE + (32 * s2 + 8 * q) * 2);
#pragma unroll
            for (int t = 0; t < 16; ++t) buv[t] = *(const LAS f32x2*)(BU + t * BU_STRIDE + p * 8);
            f32x4 y = (f32x4){0.f, 0.f, 0.f, 0.f};
#pragma unroll
            for (int s2 = 0; s2 < 4; ++s2) y = __builtin_amdgcn_mfma_f32_16x16x32_bf16(cf[s2], hf[s2], y, 0, 0, 0);
            const float u0 = bf_lo(uec.x), u1 = bf_hi(uec.x), u2 = bf_lo(uec.y), u3 = bf_hi(uec.y);
            const float g0 = gelu_tanh(y[0] + dsk[0] * u0), g1 = gelu_tanh(y[1] + dsk[1] * u1), g2 = gelu_tanh(y[2] + dsk[2] * u2), g3 = gelu_tanh(y[3] + dsk[3] * u3);
            u32x2 w; w.x = cvt_pk_bf16(g0, g1); w.y = cvt_pk_bf16(g2, g3);
            *(GAS u32x2*)(ybase + (size_t)tb * BSTEP + lo4) = w;
        }
        }
    } else {
        for (int tb0 = 0; tb0 < nblk; tb0 += 4) {
#pragma unroll
        for (int j = 0; j < 4; ++j) {
            const int tb = tb0 + j;
            const u32x2 uec = ebuf[j % PD];
            const u32x4 ubn = ubuf[(j + 1) % PD];
            { const int tbn = (tb + PD < nblk) ? tb + PD : nblk - 1; const char* un = ubase + (size_t)tbn * BSTEP; ubuf[j % PD] = *(const GAS u32x4*)(un + lo8); ebuf[j % PD] = *(const GAS u32x2*)(un + lo4); }
            f32x4 rn[8];
            { const bf16x8 bfrag = U_BFRAG(ubn);
#pragma unroll
              for (int f = 0; f < 8; ++f) rn[f] = __builtin_amdgcn_mfma_f32_16x16x32_bf16(af[f], bfrag, (f32x4){0.f, 0.f, 0.f, 0.f}, 0, 0, 0); }
#pragma unroll
            for (int t = 0; t < 16; ++t) {
                const float nre = fmaf(abr, hre, fmaf(-abi, him, buv[t][0])), nim = fmaf(abr, him, fmaf(abi, hre, buv[t][1]));
                hre = nre; him = nim;
                *(LAS unsigned*)(HB + t * H_STRIDE + p * 4) = cvt_pk_bf16(hre, him);
            }
#pragma unroll
            for (int f = 0; f < 8; ++f) *(LAS f32x4*)(BU + t16 * BU_STRIDE + (16 * f + 4 * q) * 4) = rn[f];
            LDS_WAIT();
            bf16x8 hf[4];
#pragma unroll
            for (int s2 = 0; s2 < 4; ++s2) hf[s2] = *(const LAS bf16x8*)(HB + t16 * H_STRIDE + (32 * s2 + 8 * q) * 2);
#pragma unroll
            for (int t = 0; t < 16; ++t) buv[t] = *(const LAS f32x2*)(BU + t * BU_STRIDE + p * 8);
            f32x4 y = (f32x4){0.f, 0.f, 0.f, 0.f};
#pragma unroll
            for (int s2 = 0; s2 < 4; ++s2) y = __builtin_amdgcn_mfma_f32_16x16x32_bf16(cf[s2], hf[s2], y, 0, 0, 0);
            const float u0 = bf_lo(uec.x), u1 = bf_hi(uec.x), u2 = bf_lo(uec.y), u3 = bf_hi(uec.y);
            const float g0 = gelu_tanh(y[0] + dsk[0] * u0), g1 = gelu_tanh(y[1] + dsk[1] * u1), g2 = gelu_tanh(y[2] + dsk[2] * u2), g3 = gelu_tanh(y[3] + dsk[3] * u3);
            u32x2 w; w.x = cvt_pk_bf16(g0, g1); w.y = cvt_pk_bf16(g2, g3);
            *(GAS u32x2*)(ybase + (size_t)tb * BSTEP + lo4) = w;
        }
        }
    }
#undef U_BFRAG
    GAS float* outg = (GAS float*)out;
    if (prompt) { outg[O_REP + (((size_t)l * NB + b) * 32 + g) * 64 + p] = hre; outg[O_IMP + (((size_t)l * NB + b) * 32 + g) * 64 + p] = him; }
    else { outg[O_RES + (((size_t)l * NDB + b) * 32 + g) * 64 + p] = hre; outg[O_IMS + (((size_t)l * NDB + b) * 32 + g) * 64 + p] = him; }
}
__device__ __forceinline__ void conv_run(unsigned char* ws, int l, int run, int lane_in) {
    int lane = lane_in; asm volatile("" : "+v"(lane));
    const GAS float* sm = (const GAS float*)(ws + WS_SMALL);
    const bf16_t* XIN = (const bf16_t*)(ws + WS_XIN); const bf16_t* BG = (const bf16_t*)(ws + WS_BG); bf16_t* YCAT = (bf16_t*)(ws + WS_YCAT);
    const int row0 = run * 64, c0 = lane * 8;
    f32x4 w0a, w0b, w1a, w1b, w2a, w2b;
    { const GAS float* cw = sm + SM_CONVW + (size_t)l * 3 * CH + c0; w0a = *(const GAS f32x4*)cw; w0b = *(const GAS f32x4*)(cw + 4); w1a = *(const GAS f32x4*)(cw + CH); w1b = *(const GAS f32x4*)(cw + CH + 4);
      w2a = *(const GAS f32x4*)(cw + 2 * CH); w2b = *(const GAS f32x4*)(cw + 2 * CH + 4); }
    f32x4 p2a, p2b, p1a, p1b;
    const bool seq_start = row0 < TP ? ((row0 & (SEQ - 1)) == 0) : true;
    if (!seq_start) { unpack8(*(const GAS u32x4*)(XIN + (size_t)(row0 - 2) * CH + c0), p2a, p2b); unpack8(*(const GAS u32x4*)(XIN + (size_t)(row0 - 1) * CH + c0), p1a, p1b); }
    else if (row0 < TP) { p2a = p2b = p1a = p1b = (f32x4){0.f, 0.f, 0.f, 0.f}; }
    else { const int b = (row0 - TP) >> 6; const GAS float* st = sm + SM_SCONV + ((size_t)(l * NDB + b) * 2) * CH + c0;
        p2a = *(const GAS f32x4*)st; p2b = *(const GAS f32x4*)(st + 4); p1a = *(const GAS f32x4*)(st + CH); p1b = *(const GAS f32x4*)(st + CH + 4); }
    for (int tb = 0; tb < 64; tb += 8) {
        u32x4 xr[8], br[8];
#pragma unroll
        for (int j = 0; j < 8; ++j) { const size_t o = (size_t)(row0 + tb + j) * CH + c0; xr[j] = *(const GAS u32x4*)(XIN + o); br[j] = *(const GAS u32x4*)(BG + o); }
#pragma unroll
        for (int j = 0; j < 8; ++j) {
            f32x4 xa, xb, ba, bb; unpack8(xr[j], xa, xb); unpack8(br[j], ba, bb);
            f32x4 ya = ba * (w0a * p2a + w1a * p1a + w2a * xa), yb = bb * (w0b * p2b + w1b * p1b + w2b * xb);
            float s = 0.f;
#pragma unroll
            for (int e = 0; e < 4; ++e) s += ya[e] * ya[e] + yb[e] * yb[e];
            s = wave_sum(s);
            const float inv = rsqrtf(s * (1.0f / CH) + EPS);
            store8_bf16(YCAT + (size_t)(row0 + tb + j) * D + 512 + c0, ya * inv, yb * inv);
            p2a = p1a; p2b = p1b; p1a = xa; p1b = xb;
        }
    }
}

constexpr int KST = 528, VST = 520;
__device__ __forceinline__ const bf16_t* attn_kptr(unsigned char* ws, int l, int u) {
    if (u < NB * 32) { const int b = u >> 5, h = (u >> 3) & 3; return (const bf16_t*)(ws + WS_KB) + (size_t)l * TM * D + (size_t)(b * NMEM) * D + h * 256; }
    const int i = u - NB * 32, b = i >> 2, h = i & 3; return (const bf16_t*)(ws + WS_KC) + (size_t)l * TMS * D + (size_t)(b * NMEM) * D + h * 256;
}
__device__ __forceinline__ void attn_phase(unsigned char* ws, int l, LAS unsigned char* lds, int G, int bid) {
    int tid = threadIdx.x; asm volatile("" : "+v"(tid));
    const int wave = __builtin_amdgcn_readfirstlane(tid >> 6);
    const bf16_t* Q = (const bf16_t*)(ws + WS_Q); bf16_t* O = (bf16_t*)(ws + WS_O);
    const int NU = NB * 4 * 8 + NDB * 4;
    u32x4 kpre[16]; bool have = false;
#pragma unroll
    for (int i = 0; i < 16; ++i) kpre[i] = (u32x4){0u, 0u, 0u, 0u};
    for (int u = bid; u < NU; u += G) {
        int qrow0, nq, ldv; const bf16_t* Kp; const bf16_t* Vp; int h;
        if (u < NB * 32) { const int b = u >> 5; h = (u >> 3) & 3; const int qt = u & 7; qrow0 = b * SEQ + qt * 256; nq = 256;
            Kp = (const bf16_t*)(ws + WS_KB) + (size_t)l * TM * D + (size_t)(b * NMEM) * D + h * 256; Vp = (const bf16_t*)(ws + WS_VT) + (size_t)l * D * TM + (size_t)(h * 256) * TM + b * NMEM; ldv = TM; }
        else { const int i = u - NB * 32, b = i >> 2; h = i & 3; qrow0 = TP + b * DSEQ; nq = DSEQ;
            Kp = (const bf16_t*)(ws + WS_KC) + (size_t)l * TMS * D + (size_t)(b * NMEM) * D + h * 256; Vp = (const bf16_t*)(ws + WS_VTC) + (size_t)l * D * TMS + (size_t)(h * 256) * TMS + b * NMEM; ldv = TMS; }
        const bool active = wave * 32 < nq;
        __syncthreads();
        int t2 = tid; asm volatile("" : "+v"(t2));
        {
            const int c = t2 & 31, rr = t2 >> 5; const unsigned off = (unsigned)((rr * D + c * 8) * 2); const char* kb = (const char*)Kp;
            if (!have) {
#pragma unroll
                for (int i = 0; i < 16; ++i) kpre[i] = *(const GAS u32x4*)(kb + (size_t)(16 * i) * D * 2 + off);
            }
            LAS unsigned char* ld0 = lds + rr * KST + c * 16;
#pragma unroll
            for (int i = 0; i < 16; ++i) *(LAS u32x4*)(ld0 + 16 * i * KST) = kpre[i];
        }
        bf16x8 qf[16];
        const int r32 = t2 & 31, hh = (t2 >> 5) & 1;
        const int qrow = qrow0 + wave * 32 + r32;
        if (active) {
#pragma unroll
            for (int ks = 0; ks < 16; ++ks) qf[ks] = *(const GAS bf16x8*)(Q + (size_t)qrow * D + h * 256 + 16 * ks + 8 * hh);
        } else {
#pragma unroll
            for (int ks = 0; ks < 16; ++ks) qf[ks] = (bf16x8){0, 0, 0, 0, 0, 0, 0, 0};
        }
        __syncthreads();
        constexpr int NQ = 4, MTQ = 8 / NQ;
        bf16x8 pf[16]; float qmax[NQ], qsum[NQ];
#pragma unroll
        for (int qi = 0; qi < NQ; ++qi) { qmax[qi] = 0.f; qsum[qi] = 1.f; }
        if (active) {
#pragma unroll
            for (int qi = 0; qi < NQ; ++qi) {
                f32x16 sc[MTQ];
#pragma unroll
                for (int mq = 0; mq < MTQ; ++mq)
#pragma unroll
                    for (int e = 0; e < 16; ++e) sc[mq][e] = 0.f;
#pragma unroll
                for (int ks = 0; ks < 16; ++ks)
#pragma unroll
                    for (int mq = 0; mq < MTQ; ++mq) {
                        const bf16x8 kf = *(const LAS bf16x8*)(lds + (32 * (qi * MTQ + mq) + r32) * KST + (16 * ks + 8 * hh) * 2);
                        sc[mq] = __builtin_amdgcn_mfma_f32_32x32x16_bf16(kf, qf[ks], sc[mq], 0, 0, 0);
                    }
                float mx = -3.0e38f;
#pragma unroll
                for (int mq = 0; mq < MTQ; ++mq)
#pragma unroll
                    for (int e = 0; e < 16; ++e) mx = fmaxf(mx, sc[mq][e]);
                mx = fmaxf(mx, __shfl_xor(mx, 32));
                float sum = 0.f;
#pragma unroll
                for (int mq = 0; mq < MTQ; ++mq) {
#pragma unroll
                    for (int e = 0; e < 16; ++e) { const float pe = __builtin_amdgcn_exp2f((sc[mq][e] - mx) * 1.44269504089f); sc[mq][e] = pe; sum += pe; }
#pragma unroll
                    for (int s2 = 0; s2 < 2; ++s2) {
                        u32x4 w; w.x = cvt_pk_bf16(sc[mq][8 * s2 + 0], sc[mq][8 * s2 + 1]); w.y = cvt_pk_bf16(sc[mq][8 * s2 + 2], sc[mq][8 * s2 + 3]);
                        w.z = cvt_pk_bf16(sc[mq][8 * s2 + 4], sc[mq][8 * s2 + 5]); w.w = cvt_pk_bf16(sc[mq][8 * s2 + 6], sc[mq][8 * s2 + 7]);
                        pf[2 * (qi * MTQ + mq) + s2] = __builtin_bit_cast(bf16x8, w);
                    }
                }
                sum += __shfl_xor(sum, 32);
                qmax[qi] = mx; qsum[qi] = sum;
                __builtin_amdgcn_sched_barrier(0);
            }
        } else {
#pragma unroll
            for (int i = 0; i < 16; ++i) pf[i] = (bf16x8){0, 0, 0, 0, 0, 0, 0, 0};
        }
        float fq_[NQ]; float rinv;
        { float M = qmax[0];
#pragma unroll
          for (int qi = 1; qi < NQ; ++qi) M = fmaxf(M, qmax[qi]);
          float tot = 0.f;
#pragma unroll
          for (int qi = 0; qi < NQ; ++qi) { fq_[qi] = __builtin_amdgcn_exp2f((qmax[qi] - M) * 1.44269504089f); tot += fq_[qi] * qsum[qi]; }
          rinv = 1.0f / tot;
#pragma unroll
          for (int qi = 0; qi < NQ; ++qi) fq_[qi] *= rinv; }
        __builtin_amdgcn_sched_barrier(0);
        u32x4 vpre[16];
        const int vc = t2 & 31, vr = t2 >> 5;
        { const unsigned off = (unsigned)((vr * ldv + vc * 8) * 2); const char* vb = (const char*)Vp;
#pragma unroll
          for (int i = 0; i < 16; ++i) vpre[i] = *(const GAS u32x4*)(vb + (size_t)(16 * i) * ldv * 2 + off); }
        __syncthreads();
        {
            LAS unsigned char* ld0 = lds + vr * VST + vc * 16;
#pragma unroll
            for (int i = 0; i < 16; ++i) { LAS u32x2* d = (LAS u32x2*)(ld0 + 16 * i * VST); d[0] = (u32x2){vpre[i].x, vpre[i].y}; d[1] = (u32x2){vpre[i].z, vpre[i].w}; }
        }
        __syncthreads();
        {
            const int un = u + G; have = un < NU;
            if (have) { const char* kb = (const char*)attn_kptr(ws, l, un); const unsigned off = (unsigned)((vr * D + vc * 8) * 2);
#pragma unroll
                for (int i = 0; i < 16; ++i) kpre[i] = *(const GAS u32x4*)(kb + (size_t)(16 * i) * D * 2 + off); }
            else {
#pragma unroll
                for (int i = 0; i < 16; ++i) kpre[i] = (u32x4){0u, 0u, 0u, 0u}; }
            __builtin_amdgcn_sched_barrier(0);
        }
        if (active) {
#pragma unroll
            for (int dt = 0; dt < 8; ++dt) {
                f32x16 acc[NQ];
#pragma unroll
                for (int qi = 0; qi < NQ; ++qi)
#pragma unroll
                    for (int e = 0; e < 16; ++e) acc[qi][e] = 0.f;
#pragma unroll
                for (int mi = 0; mi < 16 / NQ; ++mi)
#pragma unroll
                    for (int qi = 0; qi < NQ; ++qi) {
                        const int ms = qi * (16 / NQ) + mi;
                        const LAS unsigned char* vp = lds + (32 * dt + r32) * VST + (16 * ms + 4 * hh) * 2;
                        const u32x2 lo = *(const LAS u32x2*)vp, hi = *(const LAS u32x2*)(vp + 16);
                        const u32x4 w = (u32x4){lo.x, lo.y, hi.x, hi.y};
                        acc[qi] = __builtin_amdgcn_mfma_f32_32x32x16_bf16(__builtin_bit_cast(bf16x8, w), pf[ms], acc[qi], 0, 0, 0);
                    }
#pragma unroll
                for (int g4 = 0; g4 < 4; ++g4) {
                    float o4[4];
#pragma unroll
                    for (int e = 0; e < 4; ++e) { float v = 0.f;
#pragma unroll
                        for (int qi = 0; qi < NQ; ++qi) v = fmaf(acc[qi][4 * g4 + e], fq_[qi], v);
                        o4[e] = v; }
                    u32x2 w; w.x = cvt_pk_bf16(o4[0], o4[1]); w.y = cvt_pk_bf16(o4[2], o4[3]);
                    *(GAS u32x2*)(O + (size_t)qrow * D + h * 256 + 32 * dt + 8 * g4 + 4 * hh) = w;
                }
                __builtin_amdgcn_sched_barrier(0);
            }
        }
    }
    __syncthreads();
}

#define XB_TMO      128
#define XB_XCNT(j)  (256  + 64 * (j))
#define XB_XSUB(j)  (1280 + 64 * (j))
#define XB_XGEN(j)  (2304 + 64 * (j))
#define XB_TOP      3328
#define XB_TOPGEN   3392
#define XCD_BAR_WORDS 3456
#define XB_SPIN_CAP (1u << 18)

__device__ __forceinline__ unsigned xb_ld(unsigned* p)              { return __hip_atomic_load(p, __ATOMIC_RELAXED, __HIP_MEMORY_SCOPE_AGENT); }
__device__ __forceinline__ unsigned xb_add(unsigned* p, unsigned v) { return __hip_atomic_fetch_add(p, v, __ATOMIC_RELAXED, __HIP_MEMORY_SCOPE_AGENT); }
__device__ __forceinline__ unsigned xb_xcc_id() { return (unsigned)__builtin_amdgcn_s_getreg((3 << 11) | 20) & 0xFu; }
#define XB_SPIN(cond, bar) do { unsigned _sp = 0; while (cond) { __builtin_amdgcn_s_sleep(1); \
    if ((++_sp & 255u) == 0u) { if (xb_ld(&(bar)[XB_TMO])) break; if (_sp > XB_SPIN_CAP) { atomicAdd(&(bar)[XB_TMO], 1u); break; } } } } while (0)

struct XcdBarrier {
    unsigned* bar; unsigned x;
    volatile LAS unsigned* st;
};

__device__ __forceinline__ XcdBarrier xcd_barrier_post(unsigned* bar, volatile LAS unsigned* st) {
    XcdBarrier b; b.bar = bar; b.x = xb_xcc_id(); b.st = st;
    if (threadIdx.x == 0) (void)xb_add(&bar[XB_XCNT(b.x)], 1u);
    return b;
}
__device__ __forceinline__ void xcd_barrier_complete(unsigned* bar, unsigned x, unsigned& nloc, unsigned& nx) {
    const unsigned G = gridDim.x * gridDim.y * gridDim.z;
    unsigned sum, cnt, mine, sp = 0u;
    for (;;) {
        sum = 0u; cnt = 0u; mine = 0u;
#pragma unroll
        for (unsigned j = 0; j < 16; ++j) { const unsigned c = xb_ld(&bar[XB_XCNT(j)]); sum += c; cnt += (c > 0u) ? 1u : 0u; mine = (j == x) ? c : mine; }
        if (sum == G) break;
        __builtin_amdgcn_s_sleep(1);
        if ((++sp & 255u) == 0u) { if (xb_ld(&bar[XB_TMO])) break; if (sp > XB_SPIN_CAP) { atomicAdd(&bar[XB_TMO], 1u); break; } }
    }
    nloc = mine > 0u ? mine : 1u; nx = cnt > 0u ? cnt : 1u;
}

__device__ __forceinline__ void xcd_barrier(const XcdBarrier& b) {
    asm volatile("s_waitcnt vmcnt(0)" ::: "memory");
    __syncthreads();
    if (threadIdx.x == 0) {
        unsigned* bar = b.bar;
        __builtin_amdgcn_s_waitcnt(0);
        unsigned nloc = b.st[0], nx = b.st[1];
        if (nloc == 0u) { xcd_barrier_complete(bar, b.x, nloc, nx); b.st[0] = nloc; b.st[1] = nx; }
        const unsigned old = xb_add(&bar[XB_XSUB(b.x)], 1u);
        const unsigned gen = old / nloc;
        if (old + 1u == (gen + 1u) * nloc) {
            __builtin_amdgcn_fence(__ATOMIC_RELEASE, "agent");
            asm volatile("s_waitcnt vmcnt(0)" ::: "memory");
            const unsigned og = xb_add(&bar[XB_TOP], 1u);
            const unsigned tg = og / nx;
            if (og + 1u == (tg + 1u) * nx) xb_add(&bar[XB_TOPGEN], 1u);
            else XB_SPIN(xb_ld(&bar[XB_TOPGEN]) == tg, bar);
            __builtin_amdgcn_fence(__ATOMIC_ACQUIRE, "agent");
            xb_add(&bar[XB_XGEN(b.x)], 1u);
            asm volatile("s_waitcnt vmcnt(0)" ::: "memory");
        } else {
            XB_SPIN(xb_ld(&bar[XB_XGEN(b.x)]) == gen, bar);
            __builtin_amdgcn_fence(__ATOMIC_ACQUIRE, "agent");
            asm volatile("s_waitcnt vmcnt(0)" ::: "memory");
        }
    }
    __syncthreads();
}

constexpr bool USE_SP2 = true;
__global__ void __launch_bounds__(512, 2) hybrid_fwd(Args a) {
    extern __shared__ __attribute__((aligned(16))) unsigned char lds_raw[];
    LAS unsigned char* lds = (LAS unsigned char*)lds_raw;
    cg::grid_group grid = cg::this_grid();
    volatile LAS unsigned* bst = (volatile LAS unsigned*)(lds + LDS_BYTES - 64);
    if (threadIdx.x < 16) bst[threadIdx.x] = 0u;
    __syncthreads();
    const XcdBarrier xbar = xcd_barrier_post((unsigned*)(a.ws + WS_BAR), bst);
    const int tid = threadIdx.x, lane = tid & 63, wave = __builtin_amdgcn_readfirstlane(tid >> 6);
    const int G = gridDim.x, bid = blockIdx.x;
    unsigned char* ws = as_global(a.ws);
    const int NGW = G * 8;

#ifndef NO_PREP
    for (int rep = 0; rep < REP_PREP; ++rep) { prep_phase(ws, lds, bid * 8 + wave, NGW, wave, lane); __syncthreads(); }
#endif
#define XBAR() do { XcdBarrier xb_ = xbar; asm volatile("" : "+s"(xb_.x)); xcd_barrier(xb_); } while (0)
    if (a.ws == nullptr) grid.sync();
    XBAR();

#define FRESH() unsigned char* wsp = ws; int ll = l, bb = bid, gg = G; asm volatile("" : "+s"(wsp), "+s"(ll), "+s"(bb), "+s"(gg)); wsp = as_global(wsp); float* outp = as_global(a.out); (void)outp; unsigned char* wl = wsp + WS_W + (size_t)ll * W_LAYER; (void)wl
#define SSA(k) ss_arr(wsp, 1 + 4 * ll + (k))
#pragma unroll 1
    for (int l = 0; l < DEPTH; ++l) {
        {
            FRESH();
            pg8::Gemm g{(const bf16_t*)(wsp + WS_XB), (const bf16_t*)(wl + W_IN), T, 2048, D, D, D}; pg8::StaticOrder S; S.init(T, 2048, gg, bb);
            EpiInProj E{(bf16_t*)(wsp + WS_BG), (bf16_t*)(wsp + WS_XIN), (bf16_t*)(wsp + WS_U), ll == 0 ? ss_arr(wsp, 0) : ss_arr(wsp, 4), outp + O_CONVP + (size_t)ll * NB * 2 * CH, outp + O_CONVS + (size_t)ll * NDB * 2 * CH};
#ifndef NO_GEMM
            pg8::gemm_phase<EpiInProj, USE_SP2, pg8::StaticOrder>(lds, g, S, E);
#endif
#ifndef NO_SMALL
            small_gemm(g.A, g.Bt, 2048, D, E, bb >= (gg >> 1) ? bb - (gg >> 1) : -1, gg >> 1);
#endif
        }
        {
            FRESH();
            pg8::Gemm g{(const bf16_t*)(wl + W_KV) + (size_t)D * D, (const bf16_t*)(wsp + WS_MNB), D, TM, D, D, D}; pg8::StaticOrder S; S.init(D, TM, gg, (bb + gg - (32 % gg)) % gg);
            EpiVT E{(bf16_t*)(wsp + WS_VT) + (size_t)ll * D * TM, invmem_arr(wsp)};
#ifndef NO_GEMM
            pg8::gemm_phase<EpiVT, USE_SP2, pg8::StaticOrder>(lds, g, S, E);
#endif
        }
        XBAR();
        {
            FRESH();
            int tid2 = threadIdx.x; asm volatile("" : "+v"(tid2)); const int lane2 = tid2 & 63;
            const int w = wave * gg + bb; const int NGW2 = gg * 8;
            for (int rep = 0; rep < REP_SCAN; ++rep) {
#ifndef NO_SCAN
            for (int it = w; it < NB * 32 + NDB * 32; it += NGW2) scan_item(wsp, outp, ll, it, lds + wave * SCAN_LDS_WAVE, lane2);
#endif
#ifndef NO_CONV
            for (int run = NGW2 - 1 - w; run < T / 64; run += NGW2) conv_run(wsp, ll, run, lane2);
#endif
            }
        }
        XBAR();
        {
            FRESH();
            pg8::Gemm g{(const bf16_t*)(wsp + WS_YG), (const bf16_t*)(wl + W_GLU), T, CH, CH, CH, CH}; pg8::StaticOrder S; S.init(T, CH, gg, bb);
            EpiGLU E{(const bf16_t*)(wsp + WS_YG), (bf16_t*)(wsp + WS_YCAT), SSA(0)};
#ifndef NO_GEMM
            pg8::gemm_phase<EpiGLU, USE_SP2, pg8::StaticOrder>(lds, g, S, E);
#endif
#ifndef NO_SMALL
            small_gemm(g.A, g.Bt, CH, CH, E, bb, gg);
#endif
        }
        XBAR();
        {
            FRESH();
            pg8::Gemm g{(const bf16_t*)(wsp + WS_YCAT), (const bf16_t*)(wl + W_OUT), T, D, D, D, D}; pg8::StaticOrder S; S.init(T, D, gg, bb);
            EpiRes<true> E{(bf16_t*)(wsp + WS_XB), SSA(1), SSA(0)};
#ifndef NO_GEMM
            pg8::gemm_phase<EpiRes<true>, USE_SP2, pg8::StaticOrder>(lds, g, S, E);
#endif
#ifndef NO_SMALL
            small_gemm(g.A, g.Bt, D, D, E, bb, gg);
#endif
        }
        {
            FRESH();
            pg8::Gemm g{(const bf16_t*)(wsp + WS_MNB), (const bf16_t*)(wl + W_KV), TM, D, D, D, D}; pg8::StaticOrder S; S.init(TM, D, gg, (bb + gg - (16 % gg)) % gg);
            EpiKV<false> E{outp + O_MKP + (size_t)ll * TM * D, outp + O_MVP + (size_t)ll * TM * D, (bf16_t*)(wsp + WS_KB) + (size_t)ll * TM * D, invmem_arr(wsp)};
#if !defined(NO_GEMM)
            pg8::gemm_phase<EpiKV<false>, USE_SP2, pg8::StaticOrder>(lds, g, S, E);
#endif
        }
        XBAR();
        {
            FRESH();
            pg8::Gemm g{(const bf16_t*)(wsp + WS_XB), (const bf16_t*)(wl + W_Q), T, D, D, D, D}; pg8::StaticOrder S; S.init(T, D, gg, bb);
            EpiScale<0> E{(bf16_t*)(wsp + WS_Q), D, SSA(1)};
#ifndef NO_GEMM
            pg8::gemm_phase<EpiScale<0>, USE_SP2, pg8::StaticOrder>(lds, g, S, E);
#endif
#ifndef NO_SMALL
            small_gemm(g.A, g.Bt, D, D, E, bb, gg);
#endif
        }
        {
            FRESH();
            pg8::Gemm g{(const bf16_t*)(wsp + WS_MNB), (const bf16_t*)(wl + W_KV) + (size_t)D * D, TM, D, D, D, D}; pg8::StaticOrder S; S.init(TM, D, gg, (bb + gg - (16 % gg)) % gg);
            EpiKV<true> E{outp + O_MKP + (size_t)ll * TM * D, outp + O_MVP + (size_t)ll * TM * D, (bf16_t*)(wsp + WS_KB) + (size_t)ll * TM * D, invmem_arr(wsp)};
#if !defined(NO_GEMM)
            pg8::gemm_phase<EpiKV<true>, USE_SP2, pg8::StaticOrder>(lds, g, S, E);
#endif
        }
        XBAR();
        {
            FRESH();
#ifndef NO_ATTN
            for (int rep = 0; rep < REP_ATTN; ++rep) attn_phase(wsp, ll, lds, gg, bb);
#endif
        }
        XBAR();
        {
            FRESH();
            pg8::Gemm g{(const bf16_t*)(wsp + WS_O), (const bf16_t*)(wl + W_O), T, D, D, D, D}; pg8::StaticOrder S; S.init(T, D, gg, bb);
            EpiRes<false> E{(bf16_t*)(wsp + WS_XB), SSA(2), nullptr};
#ifndef NO_GEMM
            pg8::gemm_phase<EpiRes<false>, USE_SP2, pg8::StaticOrder>(lds, g, S, E);
#endif
#ifndef NO_SMALL
            small_gemm(g.A, g.Bt, D, D, E, bb, gg);
#endif
        }
        XBAR();
        {
            FRESH();
            pg8::Gemm g{(const bf16_t*)(wsp + WS_XB), (const bf16_t*)(wl + W_UP), T, DFF, D, D, D}; pg8::StaticOrder S; S.init(T, DFF, gg, bb);
            EpiScale<1> E{(bf16_t*)(wsp + WS_HDN), DFF, SSA(2)};
#ifndef NO_GEMM
            for (int rep = 0; rep < REP_UP; ++rep) pg8::gemm_phase<EpiScale<1>, USE_SP2, pg8::StaticOrder>(lds, g, S, E);
#endif
#ifndef NO_SMALL
            small_gemm(g.A, g.Bt, DFF, D, E, bb, gg);
#endif
        }
        XBAR();
        {
            FRESH();
            pg8::Gemm g{(const bf16_t*)(wsp + WS_HDN), (const bf16_t*)(wl + W_DOWN), TP, D, DFF, DFF, DFF}; pg8::StaticOrder S; S.init(TP, D, gg, bb);
            EpiRes<false> E{(bf16_t*)(wsp + WS_XB), SSA(3), nullptr};
#if !defined(NO_GEMM)
            pg8::gemm_phase<EpiRes<false>, USE_SP2, pg8::StaticOrder>(lds, g, S, E);
#endif
        }
        {
            FRESH();
            pg8::Gemm g{(const bf16_t*)(wsp + WS_HDN) + (size_t)TP * DFF, (const bf16_t*)(wl + W_DOWN), TS, D, D, DFF, DFF}; pg8::KSplitOrder S; S.init(TS, D, 4, D, gg, bb);
            EpiAtomic E{(float*)(wsp + WS_SCR)};
#if !defined(NO_GEMM)
            pg8::gemm_phase<EpiAtomic, USE_SP2, pg8::KSplitOrder>(lds, g, S, E);
#endif
        }
        XBAR();
        {
            FRESH();
            int tid4 = threadIdx.x; asm volatile("" : "+v"(tid4)); const int lane4 = tid4 & 63;
            GAS float* scr = (GAS float*)(wsp + WS_SCR); GAS float* ss3 = (GAS float*)SSA(3);
            for (int r = bb * 8 + wave; r < TS; r += gg * 8) {
                GAS f32x4* sp = (GAS f32x4*)(scr + (size_t)r * D) + lane4; GAS u32x2* xp = (GAS u32x2*)((bf16_t*)(wsp + WS_XB) + (size_t)(TP + r) * D) + lane4;
                float ssum = 0.f;
#pragma unroll
                for (int j = 0; j < 4; ++j) { const f32x4 d = (sp[64 * j] + sp[64 * j + (size_t)TS * D / 4]) + (sp[64 * j + 2 * ((size_t)TS * D / 4)] + sp[64 * j + 3 * ((size_t)TS * D / 4)]); const u32x2 w = xp[64 * j];
                    const f32x4 x = (f32x4){bf_lo(w.x), bf_hi(w.x), bf_lo(w.y), bf_hi(w.y)} + d;
                    ssum += (x[0] * x[0] + x[1] * x[1]) + (x[2] * x[2] + x[3] * x[3]);
                    u32x2 o; o.x = cvt_pk_bf16(x[0], x[1]); o.y = cvt_pk_bf16(x[2], x[3]); xp[64 * j] = o; }
                ssum = wave_sum(ssum);
                if (lane4 == 0) ss3[TP + r] = ssum;
            }
        }
        XBAR();
    }
    {
        int tid3 = threadIdx.x; asm volatile("" : "+v"(tid3)); const int lane = tid3 & 63;
        const bf16_t* XB = (const bf16_t*)(ws + WS_XB); const float* ssf = ss_arr(ws, 1 + 4 + 3); const GAS float* gf = (const GAS float*)(ws + WS_SMALL) + SM_GFIN;
        f32x4 gv[4];
#pragma unroll
        for (int j = 0; j < 4; ++j) gv[j] = *(const GAS f32x4*)(gf + 256 * j + 4 * lane);
        for (int m0 = (bid * 8 + wave) * 4; m0 < T; m0 += NGW * 4) {
            u32x2 wv[4][4]; float inv[4];
#pragma unroll
            for (int r = 0; r < 4; ++r) { const GAS u32x2* xr = (const GAS u32x2*)(XB + (size_t)(m0 + r) * D) + lane;
#pragma unroll
                for (int j = 0; j < 4; ++j) wv[r][j] = xr[64 * j];
                inv[r] = rsqrtf(((const GAS float*)ssf)[m0 + r] * (1.0f / D) + EPS); }
#pragma unroll
            for (int r = 0; r < 4; ++r) { GAS f32x4* o = (GAS f32x4*)(a.out + (size_t)(m0 + r) * D) + lane;
#pragma unroll
                for (int j = 0; j < 4; ++j) { const u32x2 w = wv[r][j]; o[64 * j] = (f32x4){bf_lo(w.x), bf_hi(w.x), bf_lo(w.y), bf_hi(w.y)} * inv[r] * gv[j]; } }
        }
    }
}

extern "C" void kernel_launch(void* const* d_in, const int* in_sizes, int n_in, void* d_out, int out_size, void* d_ws, size_t ws_size, hipStream_t stream) {
    static int grid = 0;
    if (grid == 0) {
        if (n_in != 33 || (size_t)out_size != O_END || ws_size < WS_END) { fprintf(stderr, "kernel_launch: unexpected sizes n_in %d out %d ws %zu (need %zu)\n", n_in, out_size, ws_size, (size_t)WS_END); grid = -1; return; }
        int dev = 0, cus = 0, per_cu = 0;
        (void)hipGetDevice(&dev); (void)hipDeviceGetAttribute(&cus, hipDeviceAttributeMultiprocessorCount, dev);
        if (hipFuncSetAttribute((const void*)hybrid_fwd, hipFuncAttributeMaxDynamicSharedMemorySize, LDS_BYTES) != hipSuccess) { fprintf(stderr, "kernel_launch: hipFuncSetAttribute failed\n"); grid = -1; return; }
        if (hipOccupancyMaxActiveBlocksPerMultiprocessor(&per_cu, (const void*)hybrid_fwd, 512, LDS_BYTES) != hipSuccess || per_cu < 1) { fprintf(stderr, "kernel_launch: occupancy query says %d\n", per_cu); per_cu = 1; }
        (void)hipGetLastError();
        grid = cus > 0 ? cus : 256;
    }
    if (grid < 0) return;
    if (hipMemsetAsync((char*)d_ws + WS_BAR, 0, BAR_BYTES, stream) != hipSuccess) { fprintf(stderr, "kernel_launch: hipMemsetAsync failed\n"); return; }
    Args a{};
    for (int i = 0; i < 33; ++i) a.in[i] = (const float*)d_in[i];
    a.out = (float*)d_out; a.ws = (unsigned char*)d_ws;
    void* args[] = {&a};
    hipError_t e = hipLaunchCooperativeKernel((const void*)hybrid_fwd, dim3(grid), dim3(512), args, LDS_BYTES, stream);
    if (e != hipSuccess) fprintf(stderr, "kernel_launch: cooperative launch failed: %s (grid %d)\n", hipGetErrorString(e), grid);
}
```

```cpp
#include <hip/hip_runtime.h>
#include <hip/hip_cooperative_groups.h>
#include <cstdio>
#include <cstdint>
namespace cg = cooperative_groups;
#define NO_SMALL 1
#ifndef REP_PREP
#define REP_PREP 1
#endif
#ifndef REP_SCAN
#define REP_SCAN 1
#endif
#ifndef REP_ATTN
#define REP_ATTN 1
#endif
#ifndef REP_UP
#define REP_UP 1
#endif

#define LAS __attribute__((address_space(3)))
#define GAS __attribute__((address_space(1)))
typedef unsigned short bf16_t;
typedef short bf16x8 __attribute__((ext_vector_type(8)));
typedef short bf16x4 __attribute__((ext_vector_type(4)));
typedef float f32x2 __attribute__((ext_vector_type(2)));
typedef float f32x4 __attribute__((ext_vector_type(4)));
typedef float f32x16 __attribute__((ext_vector_type(16)));
typedef unsigned u32x4 __attribute__((ext_vector_type(4)));
typedef unsigned u32x2 __attribute__((ext_vector_type(2)));

constexpr int D = 1024, NB = 32, SEQ = 2048, NDB = 16, DSEQ = 64, DEPTH = 2;
constexpr int TP = NB * SEQ, TS = NDB * DSEQ, T = TP + TS;
constexpr int NMEM = 256, TM = NB * NMEM, TMS = NDB * NMEM;
constexpr int DFF = 4096, CH = 512;
constexpr float EPS = 1e-6f;
constexpr size_t O_YP = 0, O_YS = O_YP + (size_t)TP * D, O_CONVP = O_YS + (size_t)TS * D, O_REP = O_CONVP + (size_t)DEPTH * NB * 2 * CH,
                 O_IMP = O_REP + (size_t)DEPTH * NB * 32 * 64, O_MKP = O_IMP + (size_t)DEPTH * NB * 32 * 64, O_MVP = O_MKP + (size_t)DEPTH * TM * D,
                 O_CONVS = O_MVP + (size_t)DEPTH * TM * D, O_RES = O_CONVS + (size_t)DEPTH * NDB * 2 * CH, O_IMS = O_RES + (size_t)DEPTH * NDB * 32 * 64,
                 O_END = O_IMS + (size_t)DEPTH * NDB * 32 * 64;
constexpr size_t MiB = 1u << 20;
constexpr size_t WS_SS = 0;
constexpr size_t WS_BAR = 3 * MiB + MiB / 2, BAR_BYTES = 16384;
constexpr size_t WS_W = 4 * MiB, W_LAYER = 31 * MiB;
constexpr size_t W_IN = 0, W_GLU = 4 * MiB, W_OUT = 4 * MiB + MiB / 2, W_Q = 6 * MiB + MiB / 2, W_KV = 8 * MiB + MiB / 2, W_O = 12 * MiB + MiB / 2,
                 W_UP = 14 * MiB + MiB / 2, W_DOWN = 22 * MiB + MiB / 2;
constexpr size_t WS_XB = 66 * MiB;
constexpr size_t WS_MNB = 196 * MiB;
constexpr size_t WS_KB = 212 * MiB;
constexpr size_t WS_VT = 244 * MiB;
constexpr size_t WS_KC = 276 * MiB;
constexpr size_t WS_VTC = 292 * MiB;
constexpr size_t WS_BIG = 308 * MiB;
constexpr size_t SZ_T512 = (size_t)T * 512 * 2;
constexpr size_t WS_BG = WS_BIG, WS_XIN = WS_BG + SZ_T512, WS_U = WS_XIN + SZ_T512, WS_YG = WS_U + SZ_T512, WS_YCAT = WS_YG + SZ_T512;
constexpr size_t WS_Q = WS_BG, WS_O = WS_U, WS_HDN = WS_BIG;
constexpr size_t WS_SMALL = WS_BIG + (size_t)T * DFF * 2;
constexpr size_t WS_SCR = WS_SMALL + 4 * MiB;
constexpr size_t WS_END = WS_SCR + 16 * MiB;
constexpr int SM_ARE = 0, SM_AIM = 4096, SM_LOGDT = 8192, SM_BRE = 8256, SM_BIM = SM_BRE + 65536, SM_CRE = SM_BIM + 65536, SM_CIM = SM_CRE + 65536, SM_SD = SM_CIM + 65536,
              SM_CONVW = SM_SD + 1024, SM_SCONV = SM_CONVW + 3072, SM_SRE = SM_SCONV + 32768, SM_SIM = SM_SRE + 65536, SM_GFIN = SM_SIM + 65536, SM_END = SM_GFIN + 1024;
static_assert(WS_YCAT + 2 * SZ_T512 <= WS_END, "ws map");

constexpr int LDS_BYTES = 256 * 528 + 1024;

template <class Tp> __device__ __forceinline__ Tp* as_global(Tp* p) {
#if defined(__HIP_DEVICE_COMPILE__)
    __builtin_assume(!__builtin_amdgcn_is_shared((const __attribute__((address_space(0))) void*)p) && !__builtin_amdgcn_is_private((const __attribute__((address_space(0))) void*)p));
#endif
    return p;
}
__device__ __forceinline__ unsigned cvt_pk_bf16(float lo, float hi) { unsigned r; asm volatile("v_cvt_pk_bf16_f32 %0, %1, %2" : "=v"(r) : "v"(lo), "v"(hi)); return r; }
__device__ __forceinline__ float bf_lo(unsigned w) { return __uint_as_float(w << 16); }
__device__ __forceinline__ float bf_hi(unsigned w) { return __uint_as_float(w & 0xffff0000u); }
__device__ __forceinline__ float wave_sum(float v) {
#pragma unroll
    for (int o = 1; o < 64; o <<= 1) v += __shfl_xor(v, o);
    return v;
}
#define LDS_WAIT() asm volatile("s_waitcnt lgkmcnt(0)" ::: "memory")

namespace pg8 {
constexpr int BM = 256, BK = 64, HALF = 128, HTB = HALF * BK * 2, STAGE_BYTES = 8 * HTB, NXCD = 8, WGM = 8;
__host__ __device__ __forceinline__ int lds_byte(int r, int c) { const int st = (r >> 4) * 2 + (c >> 5), rr = r & 15, cc = c & 31, ob = rr * 64 + cc * 2; return st * 1024 + (ob ^ (((ob >> 9) & 1) << 5)); }
__host__ __device__ __forceinline__ void stage_rc(int b, int& R, int& C) { const int st = b / 1024, sb = b % 1024, swz = sb ^ (((sb >> 9) & 1) << 5); R = (st >> 1) * 16 + swz / 64; C = (st & 1) * 32 + (swz % 64) / 2; }
__host__ __device__ __forceinline__ int perm32(int rho) { const int n = rho >> 4, i = rho & 15; return 8 * (i >> 2) + 4 * n + (i & 3); }

struct Unit { int pm, pn, ko; };
struct Gemm { const bf16_t* A; const bf16_t* Bt; int M, N, K, lda, ldb; };

struct StaticOrder {
    int nM, nN, nwg, G, c;
    __device__ void init(int M, int N, int G_, int c_) { nM = M / BM; nN = N / BM; nwg = nM * nN; G = G_; c = c_; }
    __device__ bool next(int i, Unit& u) const {
        const long L = (long)i * G + c; if (L >= nwg) return false;
        int wgid = (int)L; { const int q = nwg / NXCD, r = nwg % NXCD, xcd = wgid % NXCD, off = wgid / NXCD; wgid = (xcd < r ? xcd * (q + 1) : r * (q + 1) + (xcd - r) * q) + off; }
        const int nig = WGM * nN, gid = wgid / nig, fm = gid * WGM, gsz = (nM - fm) < WGM ? (nM - fm) : WGM;
        u.pm = fm + ((wgid % nig) % gsz); u.pn = (wgid % nig) / gsz; u.ko = 0; return true;
    }
};
struct KSplitOrder {
    int nN, nS, nwg, G, c, kslice_bytes;
    __device__ void init(int M, int N, int nS_, int kslice, int G_, int c_) { nN = N / BM; nS = nS_; nwg = (M / BM) * nN * nS; G = G_; c = c_; kslice_bytes = kslice * 2; }
    __device__ bool next(int i, Unit& u) const {
        const long L = (long)i * G + c; if (L >= nwg) return false;
        const int l = (int)L, sidx = l % nS, t = l / nS; u.pn = t % nN; u.pm = t / nN; u.ko = sidx * kslice_bytes; return true;
    }
};

template <class Epi, bool SP2, class Sched>
__device__ __forceinline__ void gemm_phase(LAS unsigned char* lds, const Gemm g, const Sched& S, const Epi& E) {
    int tid = threadIdx.x; asm volatile("" : "+v"(tid));
    const int wid = __builtin_amdgcn_readfirstlane(tid >> 6), lane = tid & 63, wr = wid >> 2, wc = wid & 3, fr = lane & 15, fq = lane >> 4;
    const int K = g.K, nt = K / BK;
    unsigned voffA[2], voffB[2];
#pragma unroll
    for (int i = 0; i < 2; ++i) { int R, C; stage_rc(tid * 16 + i * 8192, R, C); const int Rb = Epi::PERM ? ((R & ~31) + perm32(R & 31)) : R;
        voffA[i] = (unsigned)(R * g.lda + C) * 2u; voffB[i] = (unsigned)(Rb * g.ldb + C) * 2u; }
    const size_t kstep = (size_t)(BK * 2);
    const size_t hstep = (size_t)HALF * g.lda * 2, hstepB = (size_t)HALF * g.ldb * 2;
    const size_t tstep = 2 * hstep, tstepB = 2 * hstepB;
    const unsigned ldsw = (unsigned)wid * 1024u;
    const int aoff = lds_byte(wr * 64 + fr, fq * 8), boff = lds_byte(wc * 32 + fr, fq * 8);
#define PG8_SA(b, h) (((b) * 2 + (h)) * HTB)
#define PG8_SB(b, h) ((4 + (b) * 2 + (h)) * HTB)
#define PG8_STAGE(bufoff, gbase, voff) do { _Pragma("unroll") for (int _i = 0; _i < 2; ++_i) \
        __builtin_amdgcn_global_load_lds((const unsigned*)((const char*)(gbase) + (voff)[_i]), (LAS unsigned*)(lds + (bufoff) + ldsw + _i * 8192), 16, 0, 0); } while (0)
#define PG8_LDA(dst, b, h) do { _Pragma("unroll") for (int m = 0; m < 4; ++m) _Pragma("unroll") for (int k = 0; k < 2; ++k) dst[m][k] = *(const LAS bf16x8*)(lds + PG8_SA(b, h) + aoff + m * 2048 + k * 1024); } while (0)
#define PG8_LDB(dst, b, h) do { _Pragma("unroll") for (int n = 0; n < 2; ++n) _Pragma("unroll") for (int k = 0; k < 2; ++k) dst[n][k] = *(const LAS bf16x8*)(lds + PG8_SB(b, h) + boff + n * 2048 + k * 1024); } while (0)
#define PG8_MMA(ai, bj, At, Bt) do { __builtin_amdgcn_s_setprio(1); _Pragma("unroll") for (int m = 0; m < 4; ++m) _Pragma("unroll") for (int n = 0; n < 2; ++n) _Pragma("unroll") for (int k = 0; k < 2; ++k) \
        acc[ai][bj][m][n] = __builtin_amdgcn_mfma_f32_16x16x32_bf16(Bt[n][k], At[m][k], acc[ai][bj][m][n], 0, 0, 0); __builtin_amdgcn_s_setprio(0); } while (0)
#define PG8_WAIT_V(n) asm volatile("s_waitcnt vmcnt(" #n ")" ::: "memory")
#define PG8_WAIT_L(n) asm volatile("s_waitcnt lgkmcnt(" #n ")" ::: "memory")
#define PG8_BAR __builtin_amdgcn_s_barrier()
#define PG8_SCHED __builtin_amdgcn_sched_barrier(0)
    Unit cur, nxt; int ui = 0;
    if (!S.next(0, cur)) return;
    f32x4 acc[2][2][4][2];
#pragma unroll
    for (int a = 0; a < 2; ++a)
#pragma unroll
        for (int b = 0; b < 2; ++b)
#pragma unroll
            for (int m = 0; m < 4; ++m)
#pragma unroll
                for (int n = 0; n < 2; ++n) acc[a][b][m][n] = (f32x4){0.f, 0.f, 0.f, 0.f};
    bf16x8 At[4][2], B0[2][2], B1[2][2];
    const char* cA = (const char*)g.A + (size_t)cur.pm * tstep + cur.ko; const char* cB = (const char*)g.Bt + (size_t)cur.pn * tstepB + cur.ko;
    if constexpr (SP2) {
        PG8_STAGE(PG8_SB(0, 0), cB, voffB); PG8_STAGE(PG8_SB(0, 1), cB + hstepB, voffB); PG8_STAGE(PG8_SA(0, 0), cA, voffA); PG8_STAGE(PG8_SA(0, 1), cA + hstep, voffA);
        if (wr == 1) PG8_BAR;
        PG8_WAIT_V(2); PG8_BAR;
        PG8_STAGE(PG8_SB(1, 0), cB + kstep, voffB); PG8_STAGE(PG8_SA(1, 0), cA + kstep, voffA); PG8_STAGE(PG8_SB(1, 1), cB + hstepB + kstep, voffB);
        PG8_WAIT_V(6); PG8_BAR;
    } else {
        PG8_STAGE(PG8_SB(0, 0), cB, voffB); PG8_STAGE(PG8_SA(0, 0), cA, voffA); PG8_STAGE(PG8_SB(0, 1), cB + hstepB, voffB); PG8_STAGE(PG8_SA(0, 1), cA + hstep, voffA);
        if (wr == 1) PG8_BAR;
        PG8_WAIT_V(4); PG8_BAR;
        PG8_STAGE(PG8_SB(1, 0), cB + kstep, voffB); PG8_STAGE(PG8_SA(1, 0), cA + kstep, voffA); PG8_STAGE(PG8_SB(1, 1), cB + hstepB + kstep, voffB);
        PG8_WAIT_V(6); PG8_BAR;
    }
    for (;;) {
        const bool has_next = S.next(ui + 1, nxt);
        const char* nA = has_next ? (const char*)g.A + (size_t)nxt.pm * tstep + nxt.ko : cA; const char* nB = has_next ? (const char*)g.Bt + (size_t)nxt.pn * tstepB + nxt.ko : cB;
        for (int t = 0; t < nt; t += 2) {
            const bool last = (t == nt - 2);
            const char* a1 = cA + (size_t)(t + 1) * kstep;
            const char* a2 = last ? nA : cA + (size_t)(t + 2) * kstep; const char* b2 = last ? nB : cB + (size_t)(t + 2) * kstep;
            const char* a3 = a2 + kstep; const char* b3 = b2 + kstep;
            if constexpr (Epi::MID) { if (t == (nt >> 1)) E.mid(acc, cur, wr, fr); }
            if constexpr (SP2) {
            PG8_LDB(B0, 0, 0); PG8_LDB(B1, 0, 1); PG8_SCHED; PG8_LDA(At, 0, 0); PG8_STAGE(PG8_SA(1, 1), a1 + hstep, voffA);
            PG8_WAIT_V(8); PG8_WAIT_L(0); PG8_BAR; PG8_MMA(0, 0, At, B0); PG8_MMA(0, 1, At, B1); PG8_BAR; PG8_SCHED;
            PG8_LDA(At, 0, 1); PG8_STAGE(PG8_SB(0, 0), b2, voffB); PG8_STAGE(PG8_SB(0, 1), b2 + hstepB, voffB); PG8_STAGE(PG8_SA(0, 0), a2, voffA);
            PG8_WAIT_V(8); PG8_WAIT_L(0); PG8_BAR; PG8_MMA(1, 0, At, B0); PG8_MMA(1, 1, At, B1); PG8_BAR; PG8_SCHED;
            PG8_LDB(B0, 1, 0); PG8_LDB(B1, 1, 1); PG8_SCHED; PG8_LDA(At, 1, 0); PG8_STAGE(PG8_SA(0, 1), a2 + hstep, voffA);
            PG8_WAIT_V(8); PG8_WAIT_L(0); PG8_BAR; PG8_MMA(0, 0, At, B0); PG8_MMA(0, 1, At, B1); PG8_BAR; PG8_SCHED;
            PG8_LDA(At, 1, 1); PG8_STAGE(PG8_SB(1, 0), b3, voffB); PG8_STAGE(PG8_SB(1, 1), b3 + hstepB, voffB); PG8_STAGE(PG8_SA(1, 0), a3, voffA);
            PG8_WAIT_V(8); PG8_WAIT_L(0); PG8_BAR; PG8_MMA(1, 0, At, B0); PG8_MMA(1, 1, At, B1); PG8_BAR; PG8_SCHED;
            } else {
            PG8_LDB(B0, 0, 0); PG8_SCHED; PG8_LDA(At, 0, 0); PG8_STAGE(PG8_SA(1, 1), a1 + hstep, voffA);
            PG8_WAIT_L(8); PG8_BAR; PG8_WAIT_L(0); PG8_MMA(0, 0, At, B0); PG8_BAR; PG8_SCHED;
            PG8_LDB(B1, 0, 1); PG8_STAGE(PG8_SB(0, 0), b2, voffB);
            PG8_BAR; PG8_WAIT_L(0); PG8_MMA(0, 1, At, B1); PG8_BAR;
            PG8_LDA(At, 0, 1); PG8_STAGE(PG8_SA(0, 0), a2, voffA);
            PG8_BAR; PG8_WAIT_L(0); PG8_MMA(1, 0, At, B0); PG8_BAR; PG8_SCHED;
            PG8_STAGE(PG8_SB(0, 1), b2 + hstepB, voffB);
            PG8_WAIT_V(6); PG8_BAR; PG8_MMA(1, 1, At, B1); PG8_BAR;
            PG8_LDB(B0, 1, 0); PG8_SCHED; PG8_LDA(At, 1, 0); PG8_STAGE(PG8_SA(0, 1), a2 + hstep, voffA);
            PG8_WAIT_L(8); PG8_BAR; PG8_WAIT_L(0); PG8_MMA(0, 0, At, B0); PG8_BAR; PG8_SCHED;
            PG8_LDB(B1, 1, 1); PG8_STAGE(PG8_SB(1, 0), b3, voffB);
            PG8_BAR; PG8_WAIT_L(0); PG8_MMA(0, 1, At, B1); PG8_BAR;
            PG8_LDA(At, 1, 1); PG8_STAGE(PG8_SA(1, 0), a3, voffA);
            PG8_BAR; PG8_WAIT_L(0); PG8_MMA(1, 0, At, B0); PG8_BAR; PG8_SCHED;
            PG8_STAGE(PG8_SB(1, 1), b3 + hstepB, voffB);
            PG8_WAIT_V(6); PG8_BAR; PG8_MMA(1, 1, At, B1); PG8_BAR;
            }
        }
        if (wr == 0) PG8_BAR;
        E(acc, cur, wr, wc, fr, fq);
        if (!has_next) break;
#pragma unroll
        for (int a = 0; a < 2; ++a)
#pragma unroll
            for (int b = 0; b < 2; ++b)
#pragma unroll
                for (int m = 0; m < 4; ++m)
#pragma unroll
                    for (int n = 0; n < 2; ++n) acc[a][b][m][n] = (f32x4){0.f, 0.f, 0.f, 0.f};
        cur = nxt; cA = nA; cB = nB; ++ui;
        if (wr == 1) PG8_BAR;
    }
    PG8_WAIT_V(0);
    PG8_BAR;
#undef PG8_SA
#undef PG8_SB
#undef PG8_STAGE
#undef PG8_LDA
#undef PG8_LDB
#undef PG8_MMA
#undef PG8_WAIT_V
#undef PG8_WAIT_L
#undef PG8_BAR
#undef PG8_SCHED
}
}
using pg8::Unit;
typedef f32x4 Acc[2][2][4][2];

__device__ __forceinline__ void store8_bf16(bf16_t* p, const f32x4& a, const f32x4& b) {
    u32x4 w; w.x = cvt_pk_bf16(a[0], a[1]); w.y = cvt_pk_bf16(a[2], a[3]); w.z = cvt_pk_bf16(b[0], b[1]); w.w = cvt_pk_bf16(b[2], b[3]);
    *(GAS u32x4*)p = w;
}
__device__ __forceinline__ void unpack8(const u32x4 w, f32x4& a, f32x4& b) {
    a = (f32x4){bf_lo(w.x), bf_hi(w.x), bf_lo(w.y), bf_hi(w.y)}; b = (f32x4){bf_lo(w.z), bf_hi(w.z), bf_lo(w.w), bf_hi(w.w)};
}

struct EpiInProj {
    static constexpr bool PERM = true, MID = false;
    bf16_t* BG; bf16_t* XIN; bf16_t* U; const float* ss; float* convp; float* convs;
    __device__ __forceinline__ int brow(int cb, int f) const {
        const int cg = cb >> 5;
        if (cg < 16) return cb + 16 * f;
        if (cg >= 48) return 1536 + 32 * (cg - 48) + 16 * f;
        const int c = 16 * (cg - 16), q = c >> 7, r = c & 127;
        return 512 + 256 * q + 128 * f + r;
    }
    __device__ __forceinline__ void small(const f32x4 (&acc)[2][2], int r0, int cb, int fr, int fq) const {
        const int cg = cb >> 5;
#pragma unroll
        for (int m = 0; m < 2; ++m) {
            const int r = r0 + 16 * m + fr; const float inv = rsqrtf(((const GAS float*)ss)[r] * (1.0f / D) + EPS);
            if (cg < 16 || cg >= 48) {
                bf16_t* dst = (cg < 16 ? BG + (size_t)r * CH + cb : U + (size_t)r * CH + (cb - 1536)) + 4 * fq;
#pragma unroll
                for (int f = 0; f < 2; ++f) { const f32x4 v = acc[m][f] * inv; u32x2 w; w.x = cvt_pk_bf16(v[0], v[1]); w.y = cvt_pk_bf16(v[2], v[3]); *(GAS u32x2*)(dst + 16 * f) = w; }
            } else {
                const int c0 = 16 * (cg - 16) + 4 * fq;
                const f32x4 x = (acc[m][0] * inv) * (acc[m][1] * inv);
                u32x2 w; w.x = cvt_pk_bf16(x[0], x[1]); w.y = cvt_pk_bf16(x[2], x[3]); *(GAS u32x2*)(XIN + (size_t)r * CH + c0) = w;
                const int rs = r - TP, t = rs & (DSEQ - 1);
                if (t >= DSEQ - 2) *(GAS f32x4*)(convs + ((size_t)(rs >> 6) * 2 + (t - (DSEQ - 2))) * CH + c0) = x;
            }
        }
    }
    __device__ __forceinline__ void operator()(const Acc& acc, const Unit& u, int wr, int wc, int fr, int fq) const {
        const int row0 = u.pm * 256 + wr * 64 + fr, cb = wc * 32 + 8 * fq;
#pragma unroll
        for (int ai = 0; ai < 2; ++ai)
#pragma unroll
            for (int m = 0; m < 4; ++m) {
                const int r = row0 + ai * 128 + m * 16;
                const float inv = rsqrtf(((const GAS float*)ss)[r] * (1.0f / D) + EPS);
                if (u.pn < 2 || u.pn >= 6) {
                    bf16_t* dst = (u.pn < 2 ? BG : U) + (size_t)r * CH + (u.pn & 1) * 256 + cb;
#pragma unroll
                    for (int bj = 0; bj < 2; ++bj) store8_bf16(dst + bj * 128, acc[ai][bj][m][0] * inv, acc[ai][bj][m][1] * inv);
                } else {
                    const int c0 = (u.pn - 2) * 128 + cb;
                    const f32x4 x0 = (acc[ai][0][m][0] * inv) * (acc[ai][1][m][0] * inv), x1 = (acc[ai][0][m][1] * inv) * (acc[ai][1][m][1] * inv);
                    store8_bf16(XIN + (size_t)r * CH + c0, x0, x1);
                    float* cd = nullptr;
                    if (r < TP) { const int t = r & (SEQ - 1); if (t >= SEQ - 2) cd = convp + ((size_t)(r >> 11) * 2 + (t - (SEQ - 2))) * CH + c0; }
                    else { const int rs = r - TP, t = rs & (DSEQ - 1); if (t >= DSEQ - 2) cd = convs + ((size_t)(rs >> 6) * 2 + (t - (DSEQ - 2))) * CH + c0; }
                    if (cd) { *(GAS f32x4*)cd = x0; *(GAS f32x4*)(cd + 4) = x1; }
                }
            }
    }
};
template <bool VPART> struct EpiKV {
    static constexpr bool PERM = false, MID = false;
    float* outK; float* outV; bf16_t* KB; const float* invm;
    __device__ __forceinline__ void operator()(const Acc& acc, const Unit& u, int wr, int wc, int fr, int fq) const {
        const int row0 = u.pm * 256 + wr * 64 + fr, col0 = (u.pn & 3) * 256 + wc * 32 + 4 * fq;
        float* outp = VPART ? outV : outK;
#pragma unroll
        for (int ai = 0; ai < 2; ++ai)
#pragma unroll
            for (int m = 0; m < 4; ++m) {
                const int r = row0 + ai * 128 + m * 16; const float inv = ((const GAS float*)invm)[r];
#pragma unroll
                for (int bj = 0; bj < 2; ++bj)
#pragma unroll
                    for (int n = 0; n < 2; ++n) {
                        const f32x4 v = acc[ai][bj][m][n] * inv; const size_t o = (size_t)r * D + col0 + bj * 128 + n * 16;
                        *(GAS f32x4*)(outp + o) = v;
                        if (!VPART) { u32x2 w; w.x = cvt_pk_bf16(v[0], v[1]); w.y = cvt_pk_bf16(v[2], v[3]); *(GAS u32x2*)(KB + o) = w; }
                    }
            }
    }
};
struct EpiVT {
    static constexpr bool PERM = true, MID = false;
    bf16_t* VT; const float* invm;
    __device__ __forceinline__ void operator()(const Acc& acc, const Unit& u, int wr, int wc, int fr, int fq) const {
        const int row0 = u.pm * 256 + wr * 64 + fr, col0 = u.pn * 256 + wc * 32 + 8 * fq;
        f32x4 s[2][2];
#pragma unroll
        for (int bj = 0; bj < 2; ++bj) { s[bj][0] = *(const GAS f32x4*)(invm + col0 + bj * 128); s[bj][1] = *(const GAS f32x4*)(invm + col0 + bj * 128 + 4); }
#pragma unroll
        for (int ai = 0; ai < 2; ++ai)
#pragma unroll
            for (int m = 0; m < 4; ++m) {
                const int r = row0 + ai * 128 + m * 16;
#pragma unroll
                for (int bj = 0; bj < 2; ++bj) store8_bf16(VT + (size_t)r * TM + col0 + bj * 128, acc[ai][bj][m][0] * s[bj][0], acc[ai][bj][m][1] * s[bj][1]);
            }
    }
};
struct EpiGLU {
    static constexpr bool PERM = true, MID = false;
    const bf16_t* YG; bf16_t* YCAT; float* ssb;
    __device__ __forceinline__ int brow(int cb, int f) const { return cb + 16 * f; }
    __device__ __forceinline__ void small(const f32x4 (&acc)[2][2], int r0, int cb, int fr, int fq) const {
#pragma unroll
        for (int m = 0; m < 2; ++m) {
            const int r = r0 + 16 * m + fr; float ssum = 0.f;
#pragma unroll
            for (int f = 0; f < 2; ++f) {
                const int c = cb + 16 * f + 4 * fq; const u32x2 yw = *(const GAS u32x2*)(YG + (size_t)r * CH + c);
                f32x4 y = (f32x4){bf_lo(yw.x), bf_hi(yw.x), bf_lo(yw.y), bf_hi(yw.y)};
#pragma unroll
                for (int e = 0; e < 4; ++e) { y[e] = y[e] * __builtin_amdgcn_rcpf(1.0f + __expf(-acc[m][f][e])); ssum += y[e] * y[e]; }
                u32x2 w; w.x = cvt_pk_bf16(y[0], y[1]); w.y = cvt_pk_bf16(y[2], y[3]); *(GAS u32x2*)(YCAT + (size_t)r * D + c) = w;
            }
            ssum += __shfl_xor(ssum, 16); ssum += __shfl_xor(ssum, 32);
            if (fq == 0) atomicAdd(ssb + r, ssum);
        }
    }
    __device__ __forceinline__ void operator()(const Acc& acc, const Unit& u, int wr, int wc, int fr, int fq) const {
        const int row0 = u.pm * 256 + wr * 64 + fr, col0 = u.pn * 256 + wc * 32 + 8 * fq;
#pragma unroll
        for (int ai = 0; ai < 2; ++ai)
#pragma unroll
            for (int m = 0; m < 4; ++m) {
                const int r = row0 + ai * 128 + m * 16; float ssum = 0.f;
#pragma unroll
                for (int bj = 0; bj < 2; ++bj) {
                    f32x4 y0, y1; unpack8(*(const GAS u32x4*)(YG + (size_t)r * CH + col0 + bj * 128), y0, y1);
                    f32x4 z0 = acc[ai][bj][m][0], z1 = acc[ai][bj][m][1];
#pragma unroll
                    for (int e = 0; e < 4; ++e) { y0[e] = y0[e] * __builtin_amdgcn_rcpf(1.0f + __expf(-z0[e])); y1[e] = y1[e] * __builtin_amdgcn_rcpf(1.0f + __expf(-z1[e]));
                        ssum += y0[e] * y0[e] + y1[e] * y1[e]; }
                    store8_bf16(YCAT + (size_t)r * D + col0 + bj * 128, y0, y1);
                }
                ssum += __shfl_xor(ssum, 16); ssum += __shfl_xor(ssum, 32);
                if (fq == 0) atomicAdd(ssb + r, ssum);
            }
    }
};
template <bool MIDS> struct EpiRes {
    static constexpr bool PERM = true, MID = MIDS;
    bf16_t* XB; float* ssout; const float* ssb;
    __device__ __forceinline__ int brow(int cb, int f) const { return cb + 16 * f; }
    __device__ __forceinline__ void mid_small(f32x4 (&acc)[2][2], int r0, int fr) const {
#pragma unroll
        for (int m = 0; m < 2; ++m) { const float sc = rsqrtf(((const GAS float*)ssb)[r0 + 16 * m + fr] * (1.0f / CH) + EPS); acc[m][0] *= sc; acc[m][1] *= sc; }
    }
    __device__ __forceinline__ void small(const f32x4 (&acc)[2][2], int r0, int cb, int fr, int fq) const {
#pragma unroll
        for (int m = 0; m < 2; ++m) {
            const int r = r0 + 16 * m + fr; float ssum = 0.f;
#pragma unroll
            for (int f = 0; f < 2; ++f) {
                bf16_t* p = XB + (size_t)r * D + cb + 16 * f + 4 * fq; const u32x2 xw = *(const GAS u32x2*)p;
                f32x4 x = (f32x4){bf_lo(xw.x), bf_hi(xw.x), bf_lo(xw.y), bf_hi(xw.y)} + acc[m][f];
#pragma unroll
                for (int e = 0; e < 4; ++e) ssum += x[e] * x[e];
                u32x2 w; w.x = cvt_pk_bf16(x[0], x[1]); w.y = cvt_pk_bf16(x[2], x[3]); *(GAS u32x2*)p = w;
            }
            ssum += __shfl_xor(ssum, 16); ssum += __shfl_xor(ssum, 32);
            if (fq == 0) atomicAdd(ssout + r, ssum);
        }
    }
    __device__ __forceinline__ void mid(Acc& acc, const Unit& u, int wr, int fr) const {
        const int row0 = u.pm * 256 + wr * 64 + fr;
#pragma unroll
        for (int ai = 0; ai < 2; ++ai)
#pragma unroll
            for (int m = 0; m < 4; ++m) {
                const float s = rsqrtf(((const GAS float*)ssb)[row0 + ai * 128 + m * 16] * (1.0f / CH) + EPS);
#pragma unroll
                for (int bj = 0; bj < 2; ++bj)
#pragma unroll
                    for (int n = 0; n < 2; ++n) acc[ai][bj][m][n] *= s;
            }
    }
    __device__ __forceinline__ void operator()(const Acc& acc, const Unit& u, int wr, int wc, int fr, int fq) const {
        const int row0 = u.pm * 256 + wr * 64 + fr, col0 = u.pn * 256 + wc * 32 + 8 * fq;
#pragma unroll
        for (int ai = 0; ai < 2; ++ai)
#pragma unroll
            for (int m = 0; m < 4; ++m) {
                const int r = row0 + ai * 128 + m * 16; float ssum = 0.f;
#pragma unroll
                for (int bj = 0; bj < 2; ++bj) {
                    bf16_t* p = XB + (size_t)r * D + col0 + bj * 128;
                    f32x4 x0, x1; unpack8(*(const GAS u32x4*)p, x0, x1);
                    x0 += acc[ai][bj][m][0]; x1 += acc[ai][bj][m][1];
#pragma unroll
                    for (int e = 0; e < 4; ++e) ssum += x0[e] * x0[e] + x1[e] * x1[e];
                    store8_bf16(p, x0, x1);
                }
                ssum += __shfl_xor(ssum, 16); ssum += __shfl_xor(ssum, 32);
                if (fq == 0) atomicAdd(ssout + r, ssum);
            }
    }
};
template <int ACT> struct EpiScale {
    static constexpr bool PERM = true, MID = false;
    bf16_t* OUT; int ldc; const float* ss;
    __device__ __forceinline__ int brow(int cb, int f) const { return cb + 16 * f; }
    __device__ __forceinline__ void small(const f32x4 (&acc)[2][2], int r0, int cb, int fr, int fq) const {
#pragma unroll
        for (int m = 0; m < 2; ++m) {
            const int r = r0 + 16 * m + fr; const float inv = rsqrtf(((const GAS float*)ss)[r] * (1.0f / D) + EPS);
#pragma unroll
            for (int f = 0; f < 2; ++f) {
                f32x4 v = acc[m][f] * inv;
                if (ACT == 1) {
#pragma unroll
                    for (int e = 0; e < 4; ++e) { const float a = fmaxf(v[e], 0.f); v[e] = a * a; }
                }
                u32x2 w; w.x = cvt_pk_bf16(v[0], v[1]); w.y = cvt_pk_bf16(v[2], v[3]); *(GAS u32x2*)(OUT + (size_t)r * ldc + cb + 16 * f + 4 * fq) = w;
            }
        }
    }
    __device__ __forceinline__ void operator()(const Acc& acc, const Unit& u, int wr, int wc, int fr, int fq) const {
        const int row0 = u.pm * 256 + wr * 64 + fr, col0 = u.pn * 256 + wc * 32 + 8 * fq;
#pragma unroll
        for (int ai = 0; ai < 2; ++ai)
#pragma unroll
            for (int m = 0; m < 4; ++m) {
                const int r = row0 + ai * 128 + m * 16; const float inv = rsqrtf(((const GAS float*)ss)[r] * (1.0f / D) + EPS);
#pragma unroll
                for (int bj = 0; bj < 2; ++bj) {
                    f32x4 v0 = acc[ai][bj][m][0] * inv, v1 = acc[ai][bj][m][1] * inv;
                    if (ACT == 1) {
#pragma unroll
                        for (int e = 0; e < 4; ++e) { const float a = fmaxf(v0[e], 0.f), b = fmaxf(v1[e], 0.f); v0[e] = a * a; v1[e] = b * b; }
                    }
                    if (ACT == 1) {
                        u32x4 w; w.x = cvt_pk_bf16(v0[0], v0[1]); w.y = cvt_pk_bf16(v0[2], v0[3]); w.z = cvt_pk_bf16(v1[0], v1[1]); w.w = cvt_pk_bf16(v1[2], v1[3]);
                        __builtin_nontemporal_store(w, (GAS u32x4*)(OUT + (size_t)r * ldc + col0 + bj * 128));
                    } else store8_bf16(OUT + (size_t)r * ldc + col0 + bj * 128, v0, v1);
                }
            }
    }
};

template <class Epi>
__device__ __forceinline__ void small_gemm(const bf16_t* A, const bf16_t* Bt, int N, int K, const Epi& E, int c, int stride) {
    int tid = threadIdx.x; asm volatile("" : "+v"(tid));
    const int wave = __builtin_amdgcn_readfirstlane(tid >> 6), lane = tid & 63, fr = lane & 15, fq = lane >> 4;
    const int ntn = N >> 7, ntiles = (TS / 64) * ntn;
    if (c < 0) return;
    for (int tile = c; tile < ntiles; tile += stride) {
        const int tm = tile / ntn, tn = tile - tm * ntn;
        const int r0 = TP + tm * 64 + (wave >> 2) * 32, cb = tn * 128 + (wave & 3) * 32;
        const char* pa = (const char*)A + ((size_t)(r0 + fr) * K + 8 * fq) * 2;
        const char* pb0 = (const char*)Bt + ((size_t)(E.brow(cb, 0) + fr) * K + 8 * fq) * 2;
        const char* pb1 = (const char*)Bt + ((size_t)(E.brow(cb, 1) + fr) * K + 8 * fq) * 2;
        const size_t a16 = (size_t)16 * K * 2;
        f32x4 acc[2][2];
#pragma unroll
        for (int m = 0; m < 2; ++m)
#pragma unroll
            for (int f = 0; f < 2; ++f) acc[m][f] = (f32x4){0.f, 0.f, 0.f, 0.f};
        const int ng = K >> 7;
        bf16x8 A0[4], A1[4], B0[4], B1[4], C0[4], C1[4], D0[4], D1[4];
#define SG_LOAD(a0, a1, b0, b1, g) do { _Pragma("unroll") for (int j = 0; j < 4; ++j) { const size_t ko = (size_t)((g) * 4 + j) * 64; \
            a0[j] = *(const GAS bf16x8*)(pa + ko); a1[j] = *(const GAS bf16x8*)(pa + a16 + ko); b0[j] = *(const GAS bf16x8*)(pb0 + ko); b1[j] = *(const GAS bf16x8*)(pb1 + ko); } } while (0)
#define SG_MMA(a0, a1, b0, b1) do { _Pragma("unroll") for (int j = 0; j < 4; ++j) { \
            acc[0][0] = __builtin_amdgcn_mfma_f32_16x16x32_bf16(b0[j], a0[j], acc[0][0], 0, 0, 0); acc[0][1] = __builtin_amdgcn_mfma_f32_16x16x32_bf16(b1[j], a0[j], acc[0][1], 0, 0, 0); \
            acc[1][0] = __builtin_amdgcn_mfma_f32_16x16x32_bf16(b0[j], a1[j], acc[1][0], 0, 0, 0); acc[1][1] = __builtin_amdgcn_mfma_f32_16x16x32_bf16(b1[j], a1[j], acc[1][1], 0, 0, 0); } } while (0)
        SG_LOAD(A0, A1, B0, B1, 0);
        for (int g = 0; g < ng; g += 2) {
            if constexpr (Epi::MID) { if (g == (ng >> 1)) E.mid_small(acc, r0, fr); }
            SG_LOAD(C0, C1, D0, D1, g + 1);
            SG_MMA(A0, A1, B0, B1);
            if (g + 2 < ng) SG_LOAD(A0, A1, B0, B1, g + 2);
            SG_MMA(C0, C1, D0, D1);
        }
#undef SG_LOAD
#undef SG_MMA
        E.small(acc, r0, cb, fr, fq);
    }
}

struct EpiAtomic {
    static constexpr bool PERM = false, MID = false;
    float* SCR;
    __device__ __forceinline__ void operator()(const Acc& acc, const Unit& u, int wr, int wc, int fr, int fq) const {
        const int row0 = u.pm * 256 + wr * 64 + fr, col0 = u.pn * 256 + wc * 32 + 4 * fq;
        float* slab = SCR + (size_t)(u.ko >> 11) * TS * D;
#pragma unroll
        for (int ai = 0; ai < 2; ++ai)
#pragma unroll
            for (int m = 0; m < 4; ++m) {
                float* rp = slab + (size_t)(row0 + ai * 128 + m * 16) * D + col0;
#pragma unroll
                for (int bj = 0; bj < 2; ++bj)
#pragma unroll
                    for (int n = 0; n < 2; ++n) *(GAS f32x4*)(rp + bj * 128 + n * 16) = acc[ai][bj][m][n];
            }
    }
};
struct Args { const float* in[33]; float* out; unsigned char* ws; };
enum { I_XP = 0, I_XS, I_MEM, I_SCONV, I_SRE, I_SIM, I_CK, I_CV, I_GMIX, I_WIN, I_CONVW, I_ARE, I_AIM, I_LOGDT, I_BRE, I_BIM, I_CRE, I_CIM, I_SD, I_WGLU,
       I_GA, I_GB, I_WOUT, I_GX, I_GMEM, I_WQ, I_WK, I_WV, I_WO, I_GMLP, I_WUP, I_WDOWN, I_GFIN };

typedef const float* const __attribute__((address_space(4)))* KTab;
__device__ __forceinline__ KTab ktab() { unsigned long long p = (unsigned long long)__builtin_amdgcn_kernarg_segment_ptr(); asm volatile("" : "+s"(p)); return (KTab)p; }
__device__ __forceinline__ float* ss_arr(unsigned char* ws, int idx) { return (float*)(ws + WS_SS) + (size_t)idx * T; }
__device__ __forceinline__ float* invmem_arr(unsigned char* ws) { return (float*)(ws + WS_SS) + (size_t)9 * T; }

__device__ __forceinline__ int inproj_src_col(int vc) {
    if (vc < 512 || vc >= 1536) return vc;
    const int q = (vc - 512) >> 8, r = (vc - 512) & 255;
    return r < 128 ? 512 + q * 128 + r : 1024 + q * 128 + (r - 128);
}
__device__ __forceinline__ void transpose_item(const float* W, int ldw, int srck0, int srcn0, const float* gain, float gscale, bf16_t* WT, int ldt, int dn0, int dk0, LAS float* scr, int lane) {
#pragma unroll 8
    for (int i = 0; i < 32; ++i) { const int kk = 2 * i + (lane >> 5); float v = ((const GAS float*)W)[(size_t)(srck0 + kk) * ldw + srcn0 + (lane & 31)];
        const float gsc = gain ? ((const GAS float*)gain)[kk] * gscale : gscale; scr[kk * 33 + (lane & 31)] = v * gsc; }
    LDS_WAIT();
    const int c = lane & 7;
#pragma unroll
    for (int j = 0; j < 4; ++j) { const int n = (lane >> 3) + 8 * j; const LAS float* s = scr + (8 * c) * 33 + n;
        u32x4 o; o.x = cvt_pk_bf16(s[0 * 33], s[1 * 33]); o.y = cvt_pk_bf16(s[2 * 33], s[3 * 33]); o.z = cvt_pk_bf16(s[4 * 33], s[5 * 33]); o.w = cvt_pk_bf16(s[6 * 33], s[7 * 33]);
        *(GAS u32x4*)(WT + (size_t)(dn0 + n) * ldt + dk0 + 8 * c) = o; }
    LDS_WAIT();
}
__device__ __forceinline__ float convert_row(const float* src, bf16_t* dst, int lane) {
    const GAS f32x4* xr = (const GAS f32x4*)src + lane; f32x4 v[4]; float s = 0.f;
#pragma unroll
    for (int j = 0; j < 4; ++j) { v[j] = xr[64 * j]; s += (v[j][0] * v[j][0] + v[j][1] * v[j][1]) + (v[j][2] * v[j][2] + v[j][3] * v[j][3]); }
    GAS u32x2* o = (GAS u32x2*)dst + lane;
#pragma unroll
    for (int j = 0; j < 4; ++j) { u32x2 w; w.x = cvt_pk_bf16(v[j][0], v[j][1]); w.y = cvt_pk_bf16(v[j][2], v[j][3]); o[64 * j] = w; }
    return wave_sum(s);
}
constexpr int PI_IN = 1024, PI_GLU = 128, PI_SQ = 512, PI_UP = 2048, PI_CV = 2048;
constexpr int PI_LAYER = PI_IN + PI_GLU + 5 * PI_SQ + 2 * PI_UP + PI_CV;

__device__ __forceinline__ void prep_phase(unsigned char* ws, LAS unsigned char* lds, int gw, int NGW, int wave, int lane) {
    const KTab in = ktab();
    LAS float* scr = (LAS float*)(lds + wave * 8704);
    for (int it = gw; it < DEPTH * PI_LAYER; it += NGW) {
        const int l = it / PI_LAYER; int r = it - l * PI_LAYER;
        unsigned char* wl = ws + WS_W + (size_t)l * W_LAYER;
        if (r < PI_IN) { const int kb = r >> 6, nb = r & 63;
            transpose_item(as_global(in[I_WIN]) + (size_t)l * D * 2048, 2048, 64 * kb, inproj_src_col(32 * nb), as_global(in[I_GMIX]) + l * D + 64 * kb, 1.0f, (bf16_t*)(wl + W_IN), D, 32 * nb, 64 * kb, scr, lane); continue; }
        r -= PI_IN;
        if (r < PI_GLU) { const int kb = r >> 4, nb = r & 15;
            transpose_item(as_global(in[I_WGLU]) + (size_t)l * CH * CH, CH, 64 * kb, 32 * nb, nullptr, 1.0f, (bf16_t*)(wl + W_GLU), CH, 32 * nb, 64 * kb, scr, lane); continue; }
        r -= PI_GLU;
        if (r < PI_SQ) { const int kb = r >> 5, nb = r & 31, dk0 = 64 * kb;
            const float* gn = dk0 < 512 ? as_global(in[I_GB]) + l * CH + dk0 : as_global(in[I_GA]) + l * CH + dk0 - 512;
            transpose_item(as_global(in[I_WOUT]) + (size_t)l * D * D, D, (dk0 + 512) & 1023, 32 * nb, gn, 1.0f, (bf16_t*)(wl + W_OUT), D, 32 * nb, dk0, scr, lane); continue; }
        r -= PI_SQ;
        if (r < PI_SQ) { const int kb = r >> 5, nb = r & 31;
            transpose_item(as_global(in[I_WQ]) + (size_t)l * D * D, D, 64 * kb, 32 * nb, as_global(in[I_GX]) + l * D + 64 * kb, 0.0625f, (bf16_t*)(wl + W_Q), D, 32 * nb, 64 * kb, scr, lane); continue; }
        r -= PI_SQ;
        if (r < PI_SQ) { const int kb = r >> 5, nb = r & 31;
            transpose_item(as_global(in[I_WK]) + (size_t)l * D * D, D, 64 * kb, 32 * nb, as_global(in[I_GMEM]) + l * D + 64 * kb, 1.0f, (bf16_t*)(wl + W_KV), D, 32 * nb, 64 * kb, scr, lane); continue; }
        r -= PI_SQ;
        if (r < PI_SQ) { const int kb = r >> 5, nb = r & 31;
            transpose_item(as_global(in[I_WV]) + (size_t)l * D * D, D, 64 * kb, 32 * nb, as_global(in[I_GMEM]) + l * D + 64 * kb, 1.0f, (bf16_t*)(wl + W_KV), D, 1024 + 32 * nb, 64 * kb, scr, lane); continue; }
        r -= PI_SQ;
        if (r < PI_SQ) { const int kb = r >> 5, nb = r & 31;
            transpose_item(as_global(in[I_WO]) + (size_t)l * D * D, D, 64 * kb, 32 * nb, nullptr, 1.0f, (bf16_t*)(wl + W_O), D, 32 * nb, 64 * kb, scr, lane); continue; }
        r -= PI_SQ;
        if (r < PI_UP) { const int kb = r >> 7, nb = r & 127;
            transpose_item(as_global(in[I_WUP]) + (size_t)l * D * DFF, DFF, 64 * kb, 32 * nb, as_global(in[I_GMLP]) + l * D + 64 * kb, 1.0f, (bf16_t*)(wl + W_UP), D, 32 * nb, 64 * kb, scr, lane); continue; }
        r -= PI_UP;
        if (r < PI_UP) { const int kb = r >> 5, nb = r & 31;
            transpose_item(as_global(in[I_WDOWN]) + (size_t)l * DFF * D, D, 64 * kb, 32 * nb, nullptr, 1.0f, (bf16_t*)(wl + W_DOWN), DFF, 32 * nb, 64 * kb, scr, lane); continue; }
        r -= PI_UP;
        { const int kb = r >> 5, nb = r & 31;
            transpose_item(as_global(in[I_CV]) + (size_t)l * TMS * D, D, 64 * kb, 32 * nb, nullptr, 1.0f, (bf16_t*)(ws + WS_VTC) + (size_t)l * D * TMS, TMS, 32 * nb, 64 * kb, scr, lane); }
    }
    float* ss0 = ss_arr(ws, 0); float* invm = invmem_arr(ws);
    for (int m0 = gw * 2; m0 < T; m0 += NGW * 2) {
        const float* src = m0 < TP ? as_global(in[I_XP]) + (size_t)m0 * D : as_global(in[I_XS]) + (size_t)(m0 - TP) * D;
        const GAS f32x4* xr = (const GAS f32x4*)src + lane; f32x4 v[8]; float s0 = 0.f, s1 = 0.f;
#pragma unroll
        for (int j = 0; j < 8; ++j) v[j] = xr[64 * j];
#pragma unroll
        for (int j = 0; j < 4; ++j) { s0 += (v[j][0] * v[j][0] + v[j][1] * v[j][1]) + (v[j][2] * v[j][2] + v[j][3] * v[j][3]);
            s1 += (v[4 + j][0] * v[4 + j][0] + v[4 + j][1] * v[4 + j][1]) + (v[4 + j][2] * v[4 + j][2] + v[4 + j][3] * v[4 + j][3]); }
        GAS u32x2* o = (GAS u32x2*)((bf16_t*)(ws + WS_XB) + (size_t)m0 * D) + lane;
#pragma unroll
        for (int j = 0; j < 8; ++j) { u32x2 w; w.x = cvt_pk_bf16(v[j][0], v[j][1]); w.y = cvt_pk_bf16(v[j][2], v[j][3]); o[64 * j] = w; }
        s0 = wave_sum(s0); s1 = wave_sum(s1);
        if (lane == 0) { ((GAS float*)ss0)[m0] = s0; ((GAS float*)ss0)[m0 + 1] = s1; }
    }
    for (int m = T + gw; m < T + TM + 2 * TMS; m += NGW) {
        if (m < T) { const float* src = m < TP ? as_global(in[I_XP]) + (size_t)m * D : as_global(in[I_XS]) + (size_t)(m - TP) * D;
            const float s = convert_row(src, (bf16_t*)(ws + WS_XB) + (size_t)m * D, lane); if (lane == 0) ((GAS float*)ss0)[m] = s; }
        else if (m < T + TM) { const int mm = m - T; const float s = convert_row(as_global(in[I_MEM]) + (size_t)mm * D, (bf16_t*)(ws + WS_MNB) + (size_t)mm * D, lane);
            if (lane == 0) ((GAS float*)invm)[mm] = rsqrtf(s * (1.0f / D) + EPS); }
        else { const int mm = m - T - TM; (void)convert_row(as_global(in[I_CK]) + (size_t)mm * D, (bf16_t*)(ws + WS_KC) + (size_t)mm * D, lane); }
    }
    {
        float* sm = (float*)(ws + WS_SMALL); const int gt = gw * 64 + lane, NT = NGW * 64;
#define SMCOPY(off, idx, n) for (int i = gt; i < (n); i += NT) ((GAS float*)sm)[(off) + i] = ((const GAS float*)in[idx])[i]
        SMCOPY(SM_ARE, I_ARE, 4096); SMCOPY(SM_AIM, I_AIM, 4096); SMCOPY(SM_LOGDT, I_LOGDT, 64); SMCOPY(SM_BRE, I_BRE, 65536); SMCOPY(SM_BIM, I_BIM, 65536);
        SMCOPY(SM_CRE, I_CRE, 65536); SMCOPY(SM_CIM, I_CIM, 65536); SMCOPY(SM_SD, I_SD, 1024); SMCOPY(SM_CONVW, I_CONVW, 3072); SMCOPY(SM_SCONV, I_SCONV, 32768);
        SMCOPY(SM_SRE, I_SRE, 65536); SMCOPY(SM_SIM, I_SIM, 65536); SMCOPY(SM_GFIN, I_GFIN, 1024);
#undef SMCOPY
    }
    { float* z = ss_arr(ws, 1); const size_t n = (size_t)8 * T; for (size_t i = (size_t)gw * 64 + lane; i < n; i += (size_t)NGW * 64) ((GAS float*)z)[i] = 0.f; }
}

__device__ __forceinline__ float gelu_tanh(float x) {
    const float u = 0.7978845608f * (x + 0.044715f * x * x * x);
    const float e = __expf(2.0f * u);
    const float th = 1.0f - 2.0f * __builtin_amdgcn_rcpf(e + 1.0f);
    return 0.5f * x * (1.0f + th);
}
__device__ __forceinline__ void sincos_small(float x, float& s, float& c) {
    const float q = rintf(x * 0.63661977236f);
    float r = fmaf(-q, 1.57079637050628662109375f, x); r = fmaf(-q, -4.37113900018624283e-8f, r);
    const float r2 = r * r;
    const float sp = r + r * r2 * (-1.0f / 6 + r2 * (1.0f / 120 + r2 * (-1.0f / 5040 + r2 * (1.0f / 362880))));
    const float cp = 1.0f + r2 * (-0.5f + r2 * (1.0f / 24 + r2 * (-1.0f / 720 + r2 * (1.0f / 40320 + r2 * (-1.0f / 3628800)))));
    const int qi = (int)q & 3;
    s = (qi == 0) ? sp : (qi == 1) ? cp : (qi == 2) ? -sp : -cp;
    c = (qi == 0) ? cp : (qi == 1) ? -sp : (qi == 2) ? -cp : sp;
}
constexpr int BU_STRIDE = 528, H_STRIDE = 272, SCAN_LDS_WAVE = 16 * BU_STRIDE + 16 * H_STRIDE;

__device__ __forceinline__ void scan_item(unsigned char* ws, float* out, int l, int item, LAS unsigned char* wl, int lane_in) {
    int lane = lane_in; asm volatile("" : "+v"(lane));
    const GAS float* sm = (const GAS float*)(ws + WS_SMALL);
    int b, g, row0, nblk; const bool prompt = item < NB * 32;
    if (prompt) { b = item >> 5; g = item & 31; row0 = b * SEQ; nblk = SEQ / 16; }
    else { const int i2 = item - NB * 32; b = i2 >> 5; g = i2 & 31; row0 = TP + b * DSEQ; nblk = DSEQ / 16; }
    const bf16_t* U = (const bf16_t*)(ws + WS_U); bf16_t* YG = (bf16_t*)(ws + WS_YG);
    const int lg = l * 32 + g, p = lane, t16 = lane & 15, q = lane >> 4;
    const float are = fminf(sm[SM_ARE + lg * 64 + p], -1e-4f), aim = sm[SM_AIM + lg * 64 + p];
    const float dt = expf(sm[SM_LOGDT + lg]);
    float sn, cs; sincos_small(aim * dt, sn, cs);
    const float mag = expf(are * dt), abr = mag * cs, abi = mag * sn;
    const float nr = abr - 1.0f, ni = abi, den = 1.0f / (are * are + aim * aim);
    const float c0 = (nr * are + ni * aim) * den, c1 = (ni * are - nr * aim) * den;
    bf16x8 af[8];
#pragma unroll
    for (int f = 0; f < 8; ++f) {
        const int i = 16 * f + t16, ps = i >> 1, cc = i & 1;
        const float k0 = __shfl(c0, ps), k1 = __shfl(c1, ps);
        u32x4 w = (u32x4){0u, 0u, 0u, 0u};
        if (q < 2) {
            const GAS f32x4* br = (const GAS f32x4*)(sm + SM_BRE + ((size_t)lg * 64 + ps) * 16 + 8 * q); const GAS f32x4* bi = (const GAS f32x4*)(sm + SM_BIM + ((size_t)lg * 64 + ps) * 16 + 8 * q);
            const f32x4 r0 = br[0], r1 = br[1], i0 = bi[0], i1 = bi[1];
            f32x4 v0, v1;
            if (cc == 0) { v0 = k0 * r0 - k1 * i0; v1 = k0 * r1 - k1 * i1; } else { v0 = k0 * i0 + k1 * r0; v1 = k0 * i1 + k1 * r1; }
            w.x = cvt_pk_bf16(v0[0], v0[1]); w.y = cvt_pk_bf16(v0[2], v0[3]); w.z = cvt_pk_bf16(v1[0], v1[1]); w.w = cvt_pk_bf16(v1[2], v1[3]);
        }
        af[f] = __builtin_bit_cast(bf16x8, w);
    }
    bf16x8 cf[4];
#pragma unroll
    for (int s = 0; s < 4; ++s) {
        const int p0 = 16 * s + 4 * q;
        const f32x4 cr = *(const GAS f32x4*)(sm + SM_CRE + ((size_t)lg * 16 + t16) * 64 + p0), ci = *(const GAS f32x4*)(sm + SM_CIM + ((size_t)lg * 16 + t16) * 64 + p0);
        u32x4 w; w.x = cvt_pk_bf16(cr[0], -ci[0]); w.y = cvt_pk_bf16(cr[1], -ci[1]); w.z = cvt_pk_bf16(cr[2], -ci[2]); w.w = cvt_pk_bf16(cr[3], -ci[3]);
        cf[s] = __builtin_bit_cast(bf16x8, w);
    }
    const f32x4 dsk = *(const GAS f32x4*)(sm + SM_SD + l * CH + g * 16 + 4 * q);
    float hre = 0.f, him = 0.f;
    if (!prompt) { hre = sm[SM_SRE + (((size_t)l * NDB + b) * 32 + g) * 64 + p]; him = sm[SM_SIM + (((size_t)l * NDB + b) * 32 + g) * 64 + p]; }
    LAS unsigned char* BU = wl; LAS unsigned char* HB = wl + 16 * BU_STRIDE;
    const char* ubase = (const char*)U + (size_t)row0 * CH * 2; char* ybase = (char*)YG + (size_t)row0 * CH * 2;
    const unsigned lo8 = (unsigned)((t16 * CH + g * 16 + 8 * (q & 1)) * 2), lo4 = (unsigned)((t16 * CH + g * 16 + 4 * q) * 2);
    constexpr size_t BSTEP = (size_t)16 * CH * 2;
    constexpr int PD = 4;
    u32x4 ubuf[PD]; u32x2 ebuf[PD];
    const bool lowq = q < 2;
#pragma unroll
    for (int j = 0; j < PD; ++j) { const char* un = ubase + (size_t)j * BSTEP; ubuf[j] = *(const GAS u32x4*)(un + lo8); ebuf[j] = *(const GAS u32x2*)(un + lo4); }
#define U_BFRAG(v) __builtin_bit_cast(bf16x8, (u32x4){lowq ? (v).x : 0u, lowq ? (v).y : 0u, lowq ? (v).z : 0u, lowq ? (v).w : 0u})
    f32x2 buv[16];
    {
        const bf16x8 bfrag = U_BFRAG(ubuf[0]);
#pragma unroll
        for (int f = 0; f < 8; ++f) {
            const f32x4 r = __builtin_amdgcn_mfma_f32_16x16x32_bf16(af[f], bfrag, (f32x4){0.f, 0.f, 0.f, 0.f}, 0, 0, 0);
            *(LAS f32x4*)(BU + t16 * BU_STRIDE + (16 * f + 4 * q) * 4) = r;
        }
        LDS_WAIT();
#pragma unroll
        for (int t = 0; t < 16; ++t) buv[t] = *(const LAS f32x2*)(BU + t * BU_STRIDE + p * 8);
    }
    if (prompt) {
        for (int tb0 = 0; tb0 < nblk; tb0 += 32) {
#pragma unroll
        for (int j = 0; j < 32; ++j) {
            const int tb = tb0 + j;
            const u32x2 uec = ebuf[j % PD];
            const u32x4 ubn = ubuf[(j + 1) % PD];
            { const int tbn = (tb + PD < nblk) ? tb + PD : nblk - 1; const char* un = ubase + (size_t)tbn * BSTEP; ubuf[j % PD] = *(const GAS u32x4*)(un + lo8); ebuf[j % PD] = *(const GAS u32x2*)(un + lo4); }
            f32x4 rn[8];
            { const bf16x8 bfrag = U_BFRAG(ubn);
#pragma unroll
              for (int f = 0; f < 8; ++f) rn[f] = __builtin_amdgcn_mfma_f32_16x16x32_bf16(af[f], bfrag, (f32x4){0.f, 0.f, 0.f, 0.f}, 0, 0, 0); }
#pragma unroll
            for (int t = 0; t < 16; ++t) {
                const float nre = fmaf(abr, hre, fmaf(-abi, him, buv[t][0])), nim = fmaf(abr, him, fmaf(abi, hre, buv[t][1]));
                hre = nre; him = nim;
                *(LAS unsigned*)(HB + t * H_STRIDE + p * 4) = cvt_pk_bf16(hre, him);
            }
#pragma unroll
            for (int f = 0; f < 8; ++f) *(LAS f32x4*)(BU + t16 * BU_STRIDE + (16 * f + 4 * q) * 4) = rn[f];
            LDS_WAIT();
            bf16x8 hf[4];
#pragma unroll
            for (int s2 = 0; s2 < 4; ++s2) hf[s2] = *(const LAS bf16x8*)(HB + t16 * H_STRIDE + (32 * s2 + 8 * q) * 2);
#pragma unroll
            for (int t = 0; t < 16; ++t) buv[t] = *(const LAS f32x2*)(BU + t * BU_STRIDE + p * 8);
            f32x4 y = (f32x4){0.f, 0.f, 0.f, 0.f};
#pragma unroll
            for (int s2 = 0; s2 < 4; ++s2) y = __builtin_amdgcn_mfma_f32_16x16x32_bf16(cf[s2], hf[s2], y, 0, 0, 0);
            const float u0 = bf_lo(uec.x), u1 = bf_hi(uec.x), u2 = bf_lo(uec.y), u3 = bf_hi(uec.y);
            const float g0 = gelu_tanh(y[0] + dsk[0] * u0), g1 = gelu_tanh(y[1] + dsk[1] * u1), g2 = gelu_tanh(y[2] + dsk[2] * u2), g3 = gelu_tanh(y[3] + dsk[3] * u3);
            u32x2 w; w.x = cvt_pk_bf16(g0, g1); w.y = cvt_pk_bf16(g2, g3);
            *(GAS u32x2*)(ybase + (size_t)tb * BSTEP + lo4) = w;
        }
        }
    } else {
        for (int tb0 = 0; tb0 < nblk; tb0 += 4) {
#pragma unroll
        for (int j = 0; j < 4; ++j) {
            const int tb = tb0 + j;
            const u32x2 uec = ebuf[j % PD];
            const u32x4 ubn = ubuf[(j + 1) % PD];
            { const int tbn = (tb + PD < nblk) ? tb + PD : nblk - 1; const char* un = ubase + (size_t)tbn * BSTEP; ubuf[j % PD] = *(const GAS u32x4*)(un + lo8); ebuf[j % PD] = *(const GAS u32x2*)(un + lo4); }
            f32x4 rn[8];
            { const bf16x8 bfrag = U_BFRAG(ubn);
#pragma unroll
              for (int f = 0; f < 8; ++f) rn[f] = __builtin_amdgcn_mfma_f32_16x16x32_bf16(af[f], bfrag, (f32x4){0.f, 0.f, 0.f, 0.f}, 0, 0, 0); }
#pragma unroll
            for (int t = 0; t < 16; ++t) {
                const float nre = fmaf(abr, hre, fmaf(-abi, him, buv[t][0])), nim = fmaf(abr, him, fmaf(abi, hre, buv[t][1]));
                hre = nre; him = nim;
                *(LAS unsigned*)(HB + t * H_STRIDE + p * 4) = cvt_pk_bf16(hre, him);
            }
#pragma unroll
            for (int f = 0; f < 8; ++f) *(LAS f32x4*)(BU + t16 * BU_STRIDE + (16 * f + 4 * q) * 4) = rn[f];
            LDS_WAIT();
            bf16x8 hf[4];
#pragma unroll
            for (int s2 = 0; s2 < 4; ++s2) hf[s2] = *(const LAS bf16x8*)(HB + t16 * H_STRIDE + (32 * s2 + 8 * q) * 2);
#pragma unroll
            for (int t = 0; t < 16; ++t) buv[t] = *(const LAS f32x2*)(BU + t * BU_STRIDE + p * 8);
            f32x4 y = (f32x4){0.f, 0.f, 0.f, 0.f};
#pragma unroll
            for (int s2 = 0; s2 < 4; ++s2) y = __builtin_amdgcn_mfma_f32_16x16x32_bf16(cf[s2], hf[s2], y, 0, 0, 0);
            const float u0 = bf_lo(uec.x), u1 = bf_hi(uec.x), u2 = bf_lo(uec.y), u3 = bf_hi(uec.y);
            const float g0 = gelu_tanh(y[0] + dsk[0] * u0), g1 = gelu_tanh(y[1] + dsk[1] * u1), g2 = gelu_tanh(y[2] + dsk[2] * u2), g3 = gelu_tanh(y[3] + dsk[3] * u3);
            u32x2 w; w.x = cvt_pk_bf16(g0, g1); w.y = cvt_pk_bf16(g2, g3);
            *(GAS u32x2*)(ybase + (size_t)tb * BSTEP + lo4) = w;
        }
        }
    }
#undef U_BFRAG
    GAS float* outg = (GAS float*)out;
    if (prompt) { outg[O_REP + (((size_t)l * NB + b) * 32 + g) * 64 + p] = hre; outg[O_IMP + (((size_t)l * NB + b) * 32 + g) * 64 + p] = him; }
    else { outg[O_RES + (((size_t)l * NDB + b) * 32 + g) * 64 + p] = hre; outg[O_IMS + (((size_t)l * NDB + b) * 32 + g) * 64 + p] = him; }
}
__device__ __forceinline__ void conv_run(unsigned char* ws, int l, int run, int lane_in) {
    int lane = lane_in; asm volatile("" : "+v"(lane));
    const GAS float* sm = (const GAS float*)(ws + WS_SMALL);
    const bf16_t* XIN = (const bf16_t*)(ws + WS_XIN); const bf16_t* BG = (const bf16_t*)(ws + WS_BG); bf16_t* YCAT = (bf16_t*)(ws + WS_YCAT);
    const int row0 = run * 64, c0 = lane * 8;
    f32x4 w0a, w0b, w1a, w1b, w2a, w2b;
    { const GAS float* cw = sm + SM_CONVW + (size_t)l * 3 * CH + c0; w0a = *(const GAS f32x4*)cw; w0b = *(const GAS f32x4*)(cw + 4); w1a = *(const GAS f32x4*)(cw + CH); w1b = *(const GAS f32x4*)(cw + CH + 4);
      w2a = *(const GAS f32x4*)(cw + 2 * CH); w2b = *(const GAS f32x4*)(cw + 2 * CH + 4); }
    f32x4 p2a, p2b, p1a, p1b;
    const bool seq_start = row0 < TP ? ((row0 & (SEQ - 1)) == 0) : true;
    if (!seq_start) { unpack8(*(const GAS u32x4*)(XIN + (size_t)(row0 - 2) * CH + c0), p2a, p2b); unpack8(*(const GAS u32x4*)(XIN + (size_t)(row0 - 1) * CH + c0), p1a, p1b); }
    else if (row0 < TP) { p2a = p2b = p1a = p1b = (f32x4){0.f, 0.f, 0.f, 0.f}; }
    else { const int b = (row0 - TP) >> 6; const GAS float* st = sm + SM_SCONV + ((size_t)(l * NDB + b) * 2) * CH + c0;
        p2a = *(const GAS f32x4*)st; p2b = *(const GAS f32x4*)(st + 4); p1a = *(const GAS f32x4*)(st + CH); p1b = *(const GAS f32x4*)(st + CH + 4); }
    for (int tb = 0; tb < 64; tb += 8) {
        u32x4 xr[8], br[8];
#pragma unroll
        for (int j = 0; j < 8; ++j) { const size_t o = (size_t)(row0 + tb + j) * CH + c0; xr[j] = *(const GAS u32x4*)(XIN + o); br[j] = *(const GAS u32x4*)(BG + o); }
#pragma unroll
        for (int j = 0; j < 8; ++j) {
            f32x4 xa, xb, ba, bb; unpack8(xr[j], xa, xb); unpack8(br[j], ba, bb);
            f32x4 ya = ba * (w0a * p2a + w1a * p1a + w2a * xa), yb = bb * (w0b * p2b + w1b * p1b + w2b * xb);
            float s = 0.f;
#pragma unroll
            for (int e = 0; e < 4; ++e) s += ya[e] * ya[e] + yb[e] * yb[e];
            s = wave_sum(s);
            const float inv = rsqrtf(s * (1.0f / CH) + EPS);
            store8_bf16(YCAT + (size_t)(row0 + tb + j) * D + 512 + c0, ya * inv, yb * inv);
            p2a = p1a; p2b = p1b; p1a = xa; p1b = xb;
        }
    }
}

constexpr int KST = 528, VST = 520;
__device__ __forceinline__ const bf16_t* attn_kptr(unsigned char* ws, int l, int u) {
    if (u < NB * 32) { const int b = u >> 5, h = (u >> 3) & 3; return (const bf16_t*)(ws + WS_KB) + (size_t)l * TM * D + (size_t)(b * NMEM) * D + h * 256; }
    const int i = u - NB * 32, b = i >> 2, h = i & 3; return (const bf16_t*)(ws + WS_KC) + (size_t)l * TMS * D + (size_t)(b * NMEM) * D + h * 256;
}
__device__ __forceinline__ void attn_phase(unsigned char* ws, int l, LAS unsigned char* lds, int G, int bid) {
    int tid = threadIdx.x; asm volatile("" : "+v"(tid));
    const int wave = __builtin_amdgcn_readfirstlane(tid >> 6);
    const bf16_t* Q = (const bf16_t*)(ws + WS_Q); bf16_t* O = (bf16_t*)(ws + WS_O);
    const int NU = NB * 4 * 8 + NDB * 4;
    u32x4 kpre[16]; bool have = false;
#pragma unroll
    for (int i = 0; i < 16; ++i) kpre[i] = (u32x4){0u, 0u, 0u, 0u};
    for (int u = bid; u < NU; u += G) {
        int qrow0, nq, ldv; const bf16_t* Kp; const bf16_t* Vp; int h;
        if (u < NB * 32) { const int b = u >> 5; h = (u >> 3) & 3; const int qt = u & 7; qrow0 = b * SEQ + qt * 256; nq = 256;
            Kp = (const bf16_t*)(ws + WS_KB) + (size_t)l * TM * D + (size_t)(b * NMEM) * D + h * 256; Vp = (const bf16_t*)(ws + WS_VT) + (size_t)l * D * TM + (size_t)(h * 256) * TM + b * NMEM; ldv = TM; }
        else { const int i = u - NB * 32, b = i >> 2; h = i & 3; qrow0 = TP + b * DSEQ; nq = DSEQ;
            Kp = (const bf16_t*)(ws + WS_KC) + (size_t)l * TMS * D + (size_t)(b * NMEM) * D + h * 256; Vp = (const bf16_t*)(ws + WS_VTC) + (size_t)l * D * TMS + (size_t)(h * 256) * TMS + b * NMEM; ldv = TMS; }
        const bool active = wave * 32 < nq;
        __syncthreads();
        int t2 = tid; asm volatile("" : "+v"(t2));
        {
            const int c = t2 & 31, rr = t2 >> 5; const unsigned off = (unsigned)((rr * D + c * 8) * 2); const char* kb = (const char*)Kp;
            if (!have) {
#pragma unroll
                for (int i = 0; i < 16; ++i) kpre[i] = *(const GAS u32x4*)(kb + (size_t)(16 * i) * D * 2 + off);
            }
            LAS unsigned char* ld0 = lds + rr * KST + c * 16;
#pragma unroll
            for (int i = 0; i < 16; ++i) *(LAS u32x4*)(ld0 + 16 * i * KST) = kpre[i];
        }
        bf16x8 qf[16];
        const int r32 = t2 & 31, hh = (t2 >> 5) & 1;
        const int qrow = qrow0 + wave * 32 + r32;
        if (active) {
#pragma unroll
            for (int ks = 0; ks < 16; ++ks) qf[ks] = *(const GAS bf16x8*)(Q + (size_t)qrow * D + h * 256 + 16 * ks + 8 * hh);
        } else {
#pragma unroll
            for (int ks = 0; ks < 16; ++ks) qf[ks] = (bf16x8){0, 0, 0, 0, 0, 0, 0, 0};
        }
        __syncthreads();
        constexpr int NQ = 4, MTQ = 8 / NQ;
        bf16x8 pf[16]; float qmax[NQ], qsum[NQ];
#pragma unroll
        for (int qi = 0; qi < NQ; ++qi) { qmax[qi] = 0.f; qsum[qi] = 1.f; }
        if (active) {
#pragma unroll
            for (int qi = 0; qi < NQ; ++qi) {
                f32x16 sc[MTQ];
#pragma unroll
                for (int mq = 0; mq < MTQ; ++mq)
#pragma unroll
                    for (int e = 0; e < 16; ++e) sc[mq][e] = 0.f;
#pragma unroll
                for (int ks = 0; ks < 16; ++ks)
#pragma unroll
                    for (int mq = 0; mq < MTQ; ++mq) {
                        const bf16x8 kf = *(const LAS bf16x8*)(lds + (32 * (qi * MTQ + mq) + r32) * KST + (16 * ks + 8 * hh) * 2);
                        sc[mq] = __builtin_amdgcn_mfma_f32_32x32x16_bf16(kf, qf[ks], sc[mq], 0, 0, 0);
                    }
                float mx = -3.0e38f;
#pragma unroll
                for (int mq = 0; mq < MTQ; ++mq)
#pragma unroll
                    for (int e = 0; e < 16; ++e) mx = fmaxf(mx, sc[mq][e]);
                mx = fmaxf(mx, __shfl_xor(mx, 32));
                float sum = 0.f;
#pragma unroll
                for (int mq = 0; mq < MTQ; ++mq) {
#pragma unroll
                    for (int e = 0; e < 16; ++e) { const float pe = __builtin_amdgcn_exp2f((sc[mq][e] - mx) * 1.44269504089f); sc[mq][e] = pe; sum += pe; }
#pragma unroll
                    for (int s2 = 0; s2 < 2; ++s2) {
                        u32x4 w; w.x = cvt_pk_bf16(sc[mq][8 * s2 + 0], sc[mq][8 * s2 + 1]); w.y = cvt_pk_bf16(sc[mq][8 * s2 + 2], sc[mq][8 * s2 + 3]);
                        w.z = cvt_pk_bf16(sc[mq][8 * s2 + 4], sc[mq][8 * s2 + 5]); w.w = cvt_pk_bf16(sc[mq][8 * s2 + 6], sc[mq][8 * s2 + 7]);
                        pf[2 * (qi * MTQ + mq) + s2] = __builtin_bit_cast(bf16x8, w);
                    }
                }
                sum += __shfl_xor(sum, 32);
                qmax[qi] = mx; qsum[qi] = sum;
                __builtin_amdgcn_sched_barrier(0);
            }
        } else {
#pragma unroll
            for (int i = 0; i < 16; ++i) pf[i] = (bf16x8){0, 0, 0, 0, 0, 0, 0, 0};
        }
        float fq_[NQ]; float rinv;
        { float M = qmax[0];
#pragma unroll
          for (int qi = 1; qi < NQ; ++qi) M = fmaxf(M, qmax[qi]);
          float tot = 0.f;
#pragma unroll
          for (int qi = 0; qi < NQ; ++qi) { fq_[qi] = __builtin_amdgcn_exp2f((qmax[qi] - M) * 1.44269504089f); tot += fq_[qi] * qsum[qi]; }
          rinv = 1.0f / tot;
#pragma unroll
          for (int qi = 0; qi < NQ; ++qi) fq_[qi] *= rinv; }
        __builtin_amdgcn_sched_barrier(0);
        u32x4 vpre[16];
        const int vc = t2 & 31, vr = t2 >> 5;
        { const unsigned off = (unsigned)((vr * ldv + vc * 8) * 2); const char* vb = (const char*)Vp;
#pragma unroll
          for (int i = 0; i < 16; ++i) vpre[i] = *(const GAS u32x4*)(vb + (size_t)(16 * i) * ldv * 2 + off); }
        __syncthreads();
        {
            LAS unsigned char* ld0 = lds + vr * VST + vc * 16;
#pragma unroll
            for (int i = 0; i < 16; ++i) { LAS u32x2* d = (LAS u32x2*)(ld0 + 16 * i * VST); d[0] = (u32x2){vpre[i].x, vpre[i].y}; d[1] = (u32x2){vpre[i].z, vpre[i].w}; }
        }
        __syncthreads();
        {
            const int un = u + G; have = un < NU;
            if (have) { const char* kb = (const char*)attn_kptr(ws, l, un); const unsigned off = (unsigned)((vr * D + vc * 8) * 2);
#pragma unroll
                for (int i = 0; i < 16; ++i) kpre[i] = *(const GAS u32x4*)(kb + (size_t)(16 * i) * D * 2 + off); }
            else {
#pragma unroll
                for (int i = 0; i < 16; ++i) kpre[i] = (u32x4){0u, 0u, 0u, 0u}; }
            __builtin_amdgcn_sched_barrier(0);
        }
        if (active) {
#pragma unroll
            for (int dt = 0; dt < 8; ++dt) {
                f32x16 acc[NQ];
#pragma unroll
                for (int qi = 0; qi < NQ; ++qi)
#pragma unroll
                    for (int e = 0; e < 16; ++e) acc[qi][e] = 0.f;
#pragma unroll
                for (int mi = 0; mi < 16 / NQ; ++mi)
#pragma unroll
                    for (int qi = 0; qi < NQ; ++qi) {
                        const int ms = qi * (16 / NQ) + mi;
                        const LAS unsigned char* vp = lds + (32 * dt + r32) * VST + (16 * ms + 4 * hh) * 2;
                        const u32x2 lo = *(const LAS u32x2*)vp, hi = *(const LAS u32x2*)(vp + 16);
                        const u32x4 w = (u32x4){lo.x, lo.y, hi.x, hi.y};
                        acc[qi] = __builtin_amdgcn_mfma_f32_32x32x16_bf16(__builtin_bit_cast(bf16x8, w), pf[ms], acc[qi], 0, 0, 0);
                    }
#pragma unroll
                for (int g4 = 0; g4 < 4; ++g4) {
                    float o4[4];
#pragma unroll
                    for (int e = 0; e < 4; ++e) { float v = 0.f;
#pragma unroll
                        for (int qi = 0; qi < NQ; ++qi) v = fmaf(acc[qi][4 * g4 + e], fq_[qi], v);
                        o4[e] = v; }
                    u32x2 w; w.x = cvt_pk_bf16(o4[0], o4[1]); w.y = cvt_pk_bf16(o4[2], o4[3]);
                    *(GAS u32x2*)(O + (size_t)qrow * D + h * 256 + 32 * dt + 8 * g4 + 4 * hh) = w;
                }
                __builtin_amdgcn_sched_barrier(0);
            }
        }
    }
    __syncthreads();
}

#define XB_TMO      128
#define XB_XCNT(j)  (256  + 64 * (j))
#define XB_XSUB(j)  (1280 + 64 * (j))
#define XB_XGEN(j)  (2304 + 64 * (j))
#define XB_TOP      3328
#define XB_TOPGEN   3392
#define XCD_BAR_WORDS 3456
#define XB_SPIN_CAP (1u << 18)

__device__ __forceinline__ unsigned xb_ld(unsigned* p)              { return __hip_atomic_load(p, __ATOMIC_RELAXED, __HIP_MEMORY_SCOPE_AGENT); }
__device__ __forceinline__ unsigned xb_add(unsigned* p, unsigned v) { return __hip_atomic_fetch_add(p, v, __ATOMIC_RELAXED, __HIP_MEMORY_SCOPE_AGENT); }
__device__ __forceinline__ unsigned xb_xcc_id() { return (unsigned)__builtin_amdgcn_s_getreg((3 << 11) | 20) & 0xFu; }
#define XB_SPIN(cond, bar) do { unsigned _sp = 0; while (cond) { __builtin_amdgcn_s_sleep(1); \
    if ((++_sp & 255u) == 0u) { if (xb_ld(&(bar)[XB_TMO])) break; if (_sp > XB_SPIN_CAP) { atomicAdd(&(bar)[XB_TMO], 1u); break; } } } } while (0)

struct XcdBarrier {
    unsigned* bar; unsigned x;
    volatile LAS unsigned* st;
};

__device__ __forceinline__ XcdBarrier xcd_barrier_post(unsigned* bar, volatile LAS unsigned* st) {
    XcdBarrier b; b.bar = bar; b.x = xb_xcc_id(); b.st = st;
    if (threadIdx.x == 0) (void)xb_add(&bar[XB_XCNT(b.x)], 1u);
    return b;
}
__device__ __forceinline__ void xcd_barrier_complete(unsigned* bar, unsigned x, unsigned& nloc, unsigned& nx) {
    const unsigned G = gridDim.x * gridDim.y * gridDim.z;
    unsigned sum, cnt, mine, sp = 0u;
    for (;;) {
        sum = 0u; cnt = 0u; mine = 0u;
#pragma unroll
        for (unsigned j = 0; j < 16; ++j) { const unsigned c = xb_ld(&bar[XB_XCNT(j)]); sum += c; cnt += (c > 0u) ? 1u : 0u; mine = (j == x) ? c : mine; }
        if (sum == G) break;
        __builtin_amdgcn_s_sleep(1);
        if ((++sp & 255u) == 0u) { if (xb_ld(&bar[XB_TMO])) break; if (sp > XB_SPIN_CAP) { atomicAdd(&bar[XB_TMO], 1u); break; } }
    }
    nloc = mine > 0u ? mine : 1u; nx = cnt > 0u ? cnt : 1u;
}

__device__ __forceinline__ void xcd_barrier(const XcdBarrier& b) {
    asm volatile("s_waitcnt vmcnt(0)" ::: "memory");
    __syncthreads();
    if (threadIdx.x == 0) {
        unsigned* bar = b.bar;
        __builtin_amdgcn_s_waitcnt(0);
        unsigned nloc = b.st[0], nx = b.st[1];
        if (nloc == 0u) { xcd_barrier_complete(bar, b.x, nloc, nx); b.st[0] = nloc; b.st[1] = nx; }
        const unsigned old = xb_add(&bar[XB_XSUB(b.x)], 1u);
        const unsigned gen = old / nloc;
        if (old + 1u == (gen + 1u) * nloc) {
            __builtin_amdgcn_fence(__ATOMIC_RELEASE, "agent");
            asm volatile("s_waitcnt vmcnt(0)" ::: "memory");
            const unsigned og = xb_add(&bar[XB_TOP], 1u);
            const unsigned tg = og / nx;
            if (og + 1u == (tg + 1u) * nx) xb_add(&bar[XB_TOPGEN], 1u);
            else XB_SPIN(xb_ld(&bar[XB_TOPGEN]) == tg, bar);
            __builtin_amdgcn_fence(__ATOMIC_ACQUIRE, "agent");
            xb_add(&bar[XB_XGEN(b.x)], 1u);
            asm volatile("s_waitcnt vmcnt(0)" ::: "memory");
        } else {
            XB_SPIN(xb_ld(&bar[XB_XGEN(b.x)]) == gen, bar);
            __builtin_amdgcn_fence(__ATOMIC_ACQUIRE, "agent");
            asm volatile("s_waitcnt vmcnt(0)" ::: "memory");
        }
    }
    __syncthreads();
}

constexpr bool USE_SP2 = true;
__global__ void __launch_bounds__(512, 2) hybrid_fwd(Args a) {
    extern __shared__ __attribute__((aligned(16))) unsigned char lds_raw[];
    LAS unsigned char* lds = (LAS unsigned char*)lds_raw;
    cg::grid_group grid = cg::this_grid();
    volatile LAS unsigned* bst = (volatile LAS unsigned*)(lds + LDS_BYTES - 64);
    if (threadIdx.x < 16) bst[threadIdx.x] = 0u;
    __syncthreads();
    const XcdBarrier xbar = xcd_barrier_post((unsigned*)(a.ws + WS_BAR), bst);
    const int tid = threadIdx.x, lane = tid & 63, wave = __builtin_amdgcn_readfirstlane(tid >> 6);
    const int G = gridDim.x, bid = blockIdx.x;
    unsigned char* ws = as_global(a.ws);
    const int NGW = G * 8;

#ifndef NO_PREP
    for (int rep = 0; rep < REP_PREP; ++rep) { prep_phase(ws, lds, bid * 8 + wave, NGW, wave, lane); __syncthreads(); }
#endif
#define XBAR() do { XcdBarrier xb_ = xbar; asm volatile("" : "+s"(xb_.x)); xcd_barrier(xb_); } while (0)
    if (a.ws == nullptr) grid.sync();
    XBAR();

#define FRESH() unsigned char* wsp = ws; int ll = l, bb = bid, gg = G; asm volatile("" : "+s"(wsp), "+s"(ll), "+s"(bb), "+s"(gg)); wsp = as_global(wsp); float* outp = as_global(a.out); (void)outp; unsigned char* wl = wsp + WS_W + (size_t)ll * W_LAYER; (void)wl
#define SSA(k) ss_arr(wsp, 1 + 4 * ll + (k))
#pragma unroll 1
    for (int l = 0; l < DEPTH; ++l) {
        {
            FRESH();
            pg8::Gemm g{(const bf16_t*)(wsp + WS_XB), (const bf16_t*)(wl + W_IN), T, 2048, D, D, D}; pg8::StaticOrder S; S.init(T, 2048, gg, bb);
            EpiInProj E{(bf16_t*)(wsp + WS_BG), (bf16_t*)(wsp + WS_XIN), (bf16_t*)(wsp + WS_U), ll == 0 ? ss_arr(wsp, 0) : ss_arr(wsp, 4), outp + O_CONVP + (size_t)ll * NB * 2 * CH, outp + O_CONVS + (size_t)ll * NDB * 2 * CH};
#ifndef NO_GEMM
            pg8::gemm_phase<EpiInProj, USE_SP2, pg8::StaticOrder>(lds, g, S, E);
#endif
#ifndef NO_SMALL
            small_gemm(g.A, g.Bt, 2048, D, E, bb >= (gg >> 1) ? bb - (gg >> 1) : -1, gg >> 1);
#endif
        }
        {
            FRESH();
            pg8::Gemm g{(const bf16_t*)(wl + W_KV) + (size_t)D * D, (const bf16_t*)(wsp + WS_MNB), D, TM, D, D, D}; pg8::StaticOrder S; S.init(D, TM, gg, (bb + gg - (32 % gg)) % gg);
            EpiVT E{(bf16_t*)(wsp + WS_VT) + (size_t)ll * D * TM, invmem_arr(wsp)};
#ifndef NO_GEMM
            pg8::gemm_phase<EpiVT, USE_SP2, pg8::StaticOrder>(lds, g, S, E);
#endif
        }
        XBAR();
        {
            FRESH();
            int tid2 = threadIdx.x; asm volatile("" : "+v"(tid2)); const int lane2 = tid2 & 63;
            const int w = wave * gg + bb; const int NGW2 = gg * 8;
            for (int rep = 0; rep < REP_SCAN; ++rep) {
#ifndef NO_SCAN
            for (int it = w; it < NB * 32 + NDB * 32; it += NGW2) scan_item(wsp, outp, ll, it, lds + wave * SCAN_LDS_WAVE, lane2);
#endif
#ifndef NO_CONV
            for (int run = NGW2 - 1 - w; run < T / 64; run += NGW2) conv_run(wsp, ll, run, lane2);
#endif
            }
        }
        XBAR();
        {
            FRESH();
            pg8::Gemm g{(const bf16_t*)(wsp + WS_YG), (const bf16_t*)(wl + W_GLU), T, CH, CH, CH, CH}; pg8::StaticOrder S; S.init(T, CH, gg, bb);
            EpiGLU E{(const bf16_t*)(wsp + WS_YG), (bf16_t*)(wsp + WS_YCAT), SSA(0)};
#ifndef NO_GEMM
            pg8::gemm_phase<EpiGLU, USE_SP2, pg8::StaticOrder>(lds, g, S, E);
#endif
#ifndef NO_SMALL
            small_gemm(g.A, g.Bt, CH, CH, E, bb, gg);
#endif
        }
        XBAR();
        {
            FRESH();
            pg8::Gemm g{(const bf16_t*)(wsp + WS_YCAT), (const bf16_t*)(wl + W_OUT), T, D, D, D, D}; pg8::StaticOrder S; S.init(T, D, gg, bb);
            EpiRes<true> E{(bf16_t*)(wsp + WS_XB), SSA(1), SSA(0)};
#ifndef NO_GEMM
            pg8::gemm_phase<EpiRes<true>, USE_SP2, pg8::StaticOrder>(lds, g, S, E);
#endif
#ifndef NO_SMALL
            small_gemm(g.A, g.Bt, D, D, E, bb, gg);
#endif
        }
        {
            FRESH();
            pg8::Gemm g{(const bf16_t*)(wsp + WS_MNB), (const bf16_t*)(wl + W_KV), TM, D, D, D, D}; pg8::StaticOrder S; S.init(TM, D, gg, (bb + gg - (16 % gg)) % gg);
            EpiKV<false> E{outp + O_MKP + (size_t)ll * TM * D, outp + O_MVP + (size_t)ll * TM * D, (bf16_t*)(wsp + WS_KB) + (size_t)ll * TM * D, invmem_arr(wsp)};
#if !defined(NO_GEMM)
            pg8::gemm_phase<EpiKV<false>, USE_SP2, pg8::StaticOrder>(lds, g, S, E);
#endif
        }
        XBAR();
        {
            FRESH();
            pg8::Gemm g{(const bf16_t*)(wsp + WS_XB), (const bf16_t*)(wl + W_Q), T, D, D, D, D}; pg8::StaticOrder S; S.init(T, D, gg, bb);
            EpiScale<0> E{(bf16_t*)(wsp + WS_Q), D, SSA(1)};
#ifndef NO_GEMM
            pg8::gemm_phase<EpiScale<0>, USE_SP2, pg8::StaticOrder>(lds, g, S, E);
#endif
#ifndef NO_SMALL
            small_gemm(g.A, g.Bt, D, D, E, bb, gg);
#endif
        }
        {
            FRESH();
            pg8::Gemm g{(const bf16_t*)(wsp + WS_MNB), (const bf16_t*)(wl + W_KV) + (size_t)D * D, TM, D, D, D, D}; pg8::StaticOrder S; S.init(TM, D, gg, (bb + gg - (16 % gg)) % gg);
            EpiKV<true> E{outp + O_MKP + (size_t)ll * TM * D, outp + O_MVP + (size_t)ll * TM * D, (bf16_t*)(wsp + WS_KB) + (size_t)ll * TM * D, invmem_arr(wsp)};
#if !defined(NO_GEMM)
            pg8::gemm_phase<EpiKV<true>, USE_SP2, pg8::StaticOrder>(lds, g, S, E);
#endif
        }
        XBAR();
        {
            FRESH();
#ifndef NO_ATTN
            for (int rep = 0; rep < REP_ATTN; ++rep) attn_phase(wsp, ll, lds, gg, bb);
#endif
        }
        XBAR();
        {
            FRESH();
            pg8::Gemm g{(const bf16_t*)(wsp + WS_O), (const bf16_t*)(wl + W_O), T, D, D, D, D}; pg8::StaticOrder S; S.init(T, D, gg, bb);
            EpiRes<false> E{(bf16_t*)(wsp + WS_XB), SSA(2), nullptr};
#ifndef NO_GEMM
            pg8::gemm_phase<EpiRes<false>, USE_SP2, pg8::StaticOrder>(lds, g, S, E);
#endif
#ifndef NO_SMALL
            small_gemm(g.A, g.Bt, D, D, E, bb, gg);
#endif
        }
        XBAR();
        {
            FRESH();
            pg8::Gemm g{(const bf16_t*)(wsp + WS_XB), (const bf16_t*)(wl + W_UP), T, DFF, D, D, D}; pg8::StaticOrder S; S.init(T, DFF, gg, bb);
            EpiScale<1> E{(bf16_t*)(wsp + WS_HDN), DFF, SSA(2)};
#ifndef NO_GEMM
            for (int rep = 0; rep < REP_UP; ++rep) pg8::gemm_phase<EpiScale<1>, USE_SP2, pg8::StaticOrder>(lds, g, S, E);
#endif
#ifndef NO_SMALL
            small_gemm(g.A, g.Bt, DFF, D, E, bb, gg);
#endif
        }
        XBAR();
        {
            FRESH();
            pg8::Gemm g{(const bf16_t*)(wsp + WS_HDN), (const bf16_t*)(wl + W_DOWN), TP, D, DFF, DFF, DFF}; pg8::StaticOrder S; S.init(TP, D, gg, bb);
            EpiRes<false> E{(bf16_t*)(wsp + WS_XB), SSA(3), nullptr};
#if !defined(NO_GEMM)
            pg8::gemm_phase<EpiRes<false>, USE_SP2, pg8::StaticOrder>(lds, g, S, E);
#endif
        }
        {
            FRESH();
            pg8::Gemm g{(const bf16_t*)(wsp + WS_HDN) + (size_t)TP * DFF, (const bf16_t*)(wl + W_DOWN), TS, D, D, DFF, DFF}; pg8::KSplitOrder S; S.init(TS, D, 4, D, gg, bb);
            EpiAtomic E{(float*)(wsp + WS_SCR)};
#if !defined(NO_GEMM)
            pg8::gemm_phase<EpiAtomic, USE_SP2, pg8::KSplitOrder>(lds, g, S, E);
#endif
        }
        XBAR();
        {
            FRESH();
            int tid4 = threadIdx.x; asm volatile("" : "+v"(tid4)); const int lane4 = tid4 & 63;
            GAS float* scr = (GAS float*)(wsp + WS_SCR); GAS float* ss3 = (GAS float*)SSA(3);
            for (int r = bb * 8 + wave; r < TS; r += gg * 8) {
                GAS f32x4* sp = (GAS f32x4*)(scr + (size_t)r * D) + lane4; GAS u32x2* xp = (GAS u32x2*)((bf16_t*)(wsp + WS_XB) + (size_t)(TP + r) * D) + lane4;
                float ssum = 0.f;
#pragma unroll
                for (int j = 0; j < 4; ++j) { const f32x4 d = (sp[64 * j] + sp[64 * j + (size_t)TS * D / 4]) + (sp[64 * j + 2 * ((size_t)TS * D / 4)] + sp[64 * j + 3 * ((size_t)TS * D / 4)]); const u32x2 w = xp[64 * j];
                    const f32x4 x = (f32x4){bf_lo(w.x), bf_hi(w.x), bf_lo(w.y), bf_hi(w.y)} + d;
                    ssum += (x[0] * x[0] + x[1] * x[1]) + (x[2] * x[2] + x[3] * x[3]);
                    u32x2 o; o.x = cvt_pk_bf16(x[0], x[1]); o.y = cvt_pk_bf16(x[2], x[3]); xp[64 * j] = o; }
                ssum = wave_sum(ssum);
                if (lane4 == 0) ss3[TP + r] = ssum;
            }
        }
        XBAR();
    }
    {
        int tid3 = threadIdx.x; asm volatile("" : "+v"(tid3)); const int lane = tid3 & 63;
        const bf16_t* XB = (const bf16_t*)(ws + WS_XB); const float* ssf = ss_arr(ws, 1 + 4 + 3); const GAS float* gf = (const GAS float*)(ws + WS_SMALL) + SM_GFIN;
        f32x4 gv[4];
#pragma unroll
        for (int j = 0; j < 4; ++j) gv[j] = *(const GAS f32x4*)(gf + 256 * j + 4 * lane);
        for (int m0 = (bid * 8 + wave) * 4; m0 < T; m0 += NGW * 4) {
            u32x2 wv[4][4]; float inv[4];
#pragma unroll
            for (int r = 0; r < 4; ++r) { const GAS u32x2* xr = (const GAS u32x2*)(XB + (size_t)(m0 + r) * D) + lane;
#pragma unroll
                for (int j = 0; j < 4; ++j) wv[r][j] = xr[64 * j];
                inv[r] = rsqrtf(((const GAS float*)ssf)[m0 + r] * (1.0f / D) + EPS); }
#pragma unroll
            for (int r = 0; r < 4; ++r) { GAS f32x4* o = (GAS f32x4*)(a.out + (size_t)(m0 + r) * D) + lane;
#pragma unroll
                for (int j = 0; j < 4; ++j) { const u32x2 w = wv[r][j]; o[64 * j] = (f32x4){bf_lo(w.x), bf_hi(w.x), bf_lo(w.y), bf_hi(w.y)} * inv[r] * gv[j]; } }
        }
    }
}

extern "C" void kernel_launch(void* const* d_in, const int* in_sizes, int n_in, void* d_out, int out_size, void* d_ws, size_t ws_size, hipStream_t stream) {
    static int grid = 0;
    if (grid == 0) {
        if (n_in != 33 || (size_t)out_size != O_END || ws_size < WS_END) { fprintf(stderr, "kernel_launch: unexpected sizes n_in %d out %d ws %zu (need %zu)\n", n_in, out_size, ws_size, (size_t)WS_END); grid = -1; return; }
        int dev = 0, cus = 0, per_cu = 0;
        (void)hipGetDevice(&dev); (void)hipDeviceGetAttribute(&cus, hipDeviceAttributeMultiprocessorCount, dev);
        if (hipFuncSetAttribute((const void*)hybrid_fwd, hipFuncAttributeMaxDynamicSharedMemorySize, LDS_BYTES) != hipSuccess) { fprintf(stderr, "kernel_launch: hipFuncSetAttribute failed\n"); grid = -1; return; }
        if (hipOccupancyMaxActiveBlocksPerMultiprocessor(&per_cu, (const void*)hybrid_fwd, 512, LDS_BYTES) != hipSuccess || per_cu < 1) { fprintf(stderr, "kernel_launch: occupancy query says %d\n", per_cu); per_cu = 1; }
        (void)hipGetLastError();
        grid = cus > 0 ? cus : 256;
    }
    if (grid < 0) return;
    if (hipMemsetAsync((char*)d_ws + WS_BAR, 0, BAR_BYTES, stream) != hipSuccess) { fprintf(stderr, "kernel_launch: hipMemsetAsync failed\n"); return; }
    Args a{};
    for (int i = 0; i < 33; ++i) a.in[i] = (const float*)d_in[i];
    a.out = (float*)d_out; a.ws = (unsigned char*)d_ws;
    void* args[] = {&a};
    hipError_t e = hipLaunchCooperativeKernel((const void*)hybrid_fwd, dim3(grid), dim3(512), args, LDS_BYTES, stream);
    if (e != hipSuccess) fprintf(stderr, "kernel_launch: cooperative launch failed: %s (grid %d)\n", hipGetErrorString(e), grid);
}
```

```cpp
#include <hip/hip_runtime.h>
#include <hip/hip_cooperative_groups.h>
#include <cstdio>
#include <cstdint>
namespace cg = cooperative_groups;
#define NO_SMALL 1
#ifndef REP_PREP
#define REP_PREP 1
#endif
#ifndef REP_SCAN
#define REP_SCAN 1
#endif
#ifndef REP_ATTN
#define REP_ATTN 1
#endif
#ifndef REP_UP
#define REP_UP 1
#endif

#define LAS __attribute__((address_space(3)))
#define GAS __attribute__((address_space(1)))
typedef unsigned short bf16_t;
typedef short bf16x8 __attribute__((ext_vector_type(8)));
typedef short bf16x4 __attribute__((ext_vector_type(4)));
typedef float f32x2 __attribute__((ext_vector_type(2)));
typedef float f32x4 __attribute__((ext_vector_type(4)));
typedef float f32x16 __attribute__((ext_vector_type(16)));
typedef unsigned u32x4 __attribute__((ext_vector_type(4)));
typedef unsigned u32x2 __attribute__((ext_vector_type(2)));

constexpr int D = 1024, NB = 32, SEQ = 2048, NDB = 16, DSEQ = 64, DEPTH = 2;
constexpr int TP = NB * SEQ, TS = NDB * DSEQ, T = TP + TS;
constexpr int NMEM = 256, TM = NB * NMEM, TMS = NDB * NMEM;
constexpr int DFF = 4096, CH = 512;
constexpr float EPS = 1e-6f;
constexpr size_t O_YP = 0, O_YS = O_YP + (size_t)TP * D, O_CONVP = O_YS + (size_t)TS * D, O_REP = O_CONVP + (size_t)DEPTH * NB * 2 * CH,
                 O_IMP = O_REP + (size_t)DEPTH * NB * 32 * 64, O_MKP = O_IMP + (size_t)DEPTH * NB * 32 * 64, O_MVP = O_MKP + (size_t)DEPTH * TM * D,
                 O_CONVS = O_MVP + (size_t)DEPTH * TM * D, O_RES = O_CONVS + (size_t)DEPTH * NDB * 2 * CH, O_IMS = O_RES + (size_t)DEPTH * NDB * 32 * 64,
                 O_END = O_IMS + (size_t)DEPTH * NDB * 32 * 64;
constexpr size_t MiB = 1u << 20;
constexpr size_t WS_SS = 0;
constexpr size_t WS_BAR = 3 * MiB + MiB / 2, BAR_BYTES = 16384;
constexpr size_t WS_W = 4 * MiB, W_LAYER = 31 * MiB;
constexpr size_t W_IN = 0, W_GLU = 4 * MiB, W_OUT = 4 * MiB + MiB / 2, W_Q = 6 * MiB + MiB / 2, W_KV = 8 * MiB + MiB / 2, W_O = 12 * MiB + MiB / 2,
                 W_UP = 14 * MiB + MiB / 2, W_DOWN = 22 * MiB + MiB / 2;
constexpr size_t WS_XB = 66 * MiB;
constexpr size_t WS_MNB = 196 * MiB;
constexpr size_t WS_KB = 212 * MiB;
constexpr size_t WS_VT = 244 * MiB;
constexpr size_t WS_KC = 276 * MiB;
constexpr size_t WS_VTC = 292 * MiB;
constexpr size_t WS_BIG = 308 * MiB;
constexpr size_t SZ_T512 = (size_t)T * 512 * 2;
constexpr size_t WS_BG = WS_BIG, WS_XIN = WS_BG + SZ_T512, WS_U = WS_XIN + SZ_T512, WS_YG = WS_U + SZ_T512, WS_YCAT = WS_YG + SZ_T512;
constexpr size_t WS_Q = WS_BG, WS_O = WS_U, WS_HDN = WS_BIG;
constexpr size_t WS_SMALL = WS_BIG + (size_t)T * DFF * 2;
constexpr size_t WS_SCR = WS_SMALL + 4 * MiB;
constexpr size_t WS_END = WS_SCR + 16 * MiB;
constexpr int SM_ARE = 0, SM_AIM = 4096, SM_LOGDT = 8192, SM_BRE = 8256, SM_BIM = SM_BRE + 65536, SM_CRE = SM_BIM + 65536, SM_CIM = SM_CRE + 65536, SM_SD = SM_CIM + 65536,
              SM_CONVW = SM_SD + 1024, SM_SCONV = SM_CONVW + 3072, SM_SRE = SM_SCONV + 32768, SM_SIM = SM_SRE + 65536, SM_GFIN = SM_SIM + 65536, SM_END = SM_GFIN + 1024;
static_assert(WS_YCAT + 2 * SZ_T512 <= WS_END, "ws map");

constexpr int LDS_BYTES = 256 * 528 + 1024;

template <class Tp> __device__ __forceinline__ Tp* as_global(Tp* p) {
#if defined(__HIP_DEVICE_COMPILE__)
    __builtin_assume(!__builtin_amdgcn_is_shared((const __attribute__((address_space(0))) void*)p) && !__builtin_amdgcn_is_private((const __attribute__((address_space(0))) void*)p));
#endif
    return p;
}
__device__ __forceinline__ unsigned cvt_pk_bf16(float lo, float hi) { unsigned r; asm volatile("v_cvt_pk_bf16_f32 %0, %1, %2" : "=v"(r) : "v"(lo), "v"(hi)); return r; }
__device__ __forceinline__ float bf_lo(unsigned w) { return __uint_as_float(w << 16); }
__device__ __forceinline__ float bf_hi(unsigned w) { return __uint_as_float(w & 0xffff0000u); }
__device__ __forceinline__ float wave_sum(float v) {
#pragma unroll
    for (int o = 1; o < 64; o <<= 1) v += __shfl_xor(v, o);
    return v;
}
#define LDS_WAIT() asm volatile("s_waitcnt lgkmcnt(0)" ::: "memory")

namespace pg8 {
constexpr int BM = 256, BK = 64, HALF = 128, HTB = HALF * BK * 2, STAGE_BYTES = 8 * HTB, NXCD = 8, WGM = 8;
__host__ __device__ __forceinline__ int lds_byte(int r, int c) { const int st = (r >> 4) * 2 + (c >> 5), rr = r & 15, cc = c & 31, ob = rr * 64 + cc * 2; return st * 1024 + (ob ^ (((ob >> 9) & 1) << 5)); }
__host__ __device__ __forceinline__ void stage_rc(int b, int& R, int& C) { const int st = b / 1024, sb = b % 1024, swz = sb ^ (((sb >> 9) & 1) << 5); R = (st >> 1) * 16 + swz / 64; C = (st & 1) * 32 + (swz % 64) / 2; }
__host__ __device__ __forceinline__ int perm32(int rho) { const int n = rho >> 4, i = rho & 15; return 8 * (i >> 2) + 4 * n + (i & 3); }

struct Unit { int pm, pn, ko; };
struct Gemm { const bf16_t* A; const bf16_t* Bt; int M, N, K, lda, ldb; };

struct StaticOrder {
    int nM, nN, nwg, G, c;
    __device__ void init(int M, int N, int G_, int c_) { nM = M / BM; nN = N / BM; nwg = nM * nN; G = G_; c = c_; }
    __device__ bool next(int i, Unit& u) const {
        const long L = (long)i * G + c; if (L >= nwg) return false;
        int wgid = (int)L; { const int q = nwg / NXCD, r = nwg % NXCD, xcd = wgid % NXCD, off = wgid / NXCD; wgid = (xcd < r ? xcd * (q + 1) : r * (q + 1) + (xcd - r) * q) + off; }
        const int nig = WGM * nN, gid = wgid / nig, fm = gid * WGM, gsz = (nM - fm) < WGM ? (nM - fm) : WGM;
        u.pm = fm + ((wgid % nig) % gsz); u.pn = (wgid % nig) / gsz; u.ko = 0; return true;
    }
};
struct KSplitOrder {
    int nN, nS, nwg, G, c, kslice_bytes;
    __device__ void init(int M, int N, int nS_, int kslice, int G_, int c_) { nN = N / BM; nS = nS_; nwg = (M / BM) * nN * nS; G = G_; c = c_; kslice_bytes = kslice * 2; }
    __device__ bool next(int i, Unit& u) const {
        const long L = (long)i * G + c; if (L >= nwg) return false;
        const int l = (int)L, sidx = l % nS, t = l / nS; u.pn = t % nN; u.pm = t / nN; u.ko = sidx * kslice_bytes; return true;
    }
};

template <class Epi, bool SP2, class Sched>
__device__ __forceinline__ void gemm_phase(LAS unsigned char* lds, const Gemm g, const Sched& S, const Epi& E) {
    int tid = threadIdx.x; asm volatile("" : "+v"(tid));
    const int wid = __builtin_amdgcn_readfirstlane(tid >> 6), lane = tid & 63, wr = wid >> 2, wc = wid & 3, fr = lane & 15, fq = lane >> 4;
    const int K = g.K, nt = K / BK;
    unsigned voffA[2], voffB[2];
#pragma unroll
    for (int i = 0; i < 2; ++i) { int R, C; stage_rc(tid * 16 + i * 8192, R, C); const int Rb = Epi::PERM ? ((R & ~31) + perm32(R & 31)) : R;
        voffA[i] = (unsigned)(R * g.lda + C) * 2u; voffB[i] = (unsigned)(Rb * g.ldb + C) * 2u; }
    const size_t kstep = (size_t)(BK * 2);
    const size_t hstep = (size_t)HALF * g.lda * 2, hstepB = (size_t)HALF * g.ldb * 2;
    const size_t tstep = 2 * hstep, tstepB = 2 * hstepB;
    const unsigned ldsw = (unsigned)wid * 1024u;
    const int aoff = lds_byte(wr * 64 + fr, fq * 8), boff = lds_byte(wc * 32 + fr, fq * 8);
#define PG8_SA(b, h) (((b) * 2 + (h)) * HTB)
#define PG8_SB(b, h) ((4 + (b) * 2 + (h)) * HTB)
#define PG8_STAGE(bufoff, gbase, voff) do { _Pragma("unroll") for (int _i = 0; _i < 2; ++_i) \
        __builtin_amdgcn_global_load_lds((const unsigned*)((const char*)(gbase) + (voff)[_i]), (LAS unsigned*)(lds + (bufoff) + ldsw + _i * 8192), 16, 0, 0); } while (0)
#define PG8_LDA(dst, b, h) do { _Pragma("unroll") for (int m = 0; m < 4; ++m) _Pragma("unroll") for (int k = 0; k < 2; ++k) dst[m][k] = *(const LAS bf16x8*)(lds + PG8_SA(b, h) + aoff + m * 2048 + k * 1024); } while (0)
#define PG8_LDB(dst, b, h) do { _Pragma("unroll") for (int n = 0; n < 2; ++n) _Pragma("unroll") for (int k = 0; k < 2; ++k) dst[n][k] = *(const LAS bf16x8*)(lds + PG8_SB(b, h) + boff + n * 2048 + k * 1024); } while (0)
#define PG8_MMA(ai, bj, At, Bt) do { __builtin_amdgcn_s_setprio(1); _Pragma("unroll") for (int m = 0; m < 4; ++m) _Pragma("unroll") for (int n = 0; n < 2; ++n) _Pragma("unroll") for (int k = 0; k < 2; ++k) \
        acc[ai][bj][m][n] = __builtin_amdgcn_mfma_f32_16x16x32_bf16(Bt[n][k], At[m][k], acc[ai][bj][m][n], 0, 0, 0); __builtin_amdgcn_s_setprio(0); } while (0)
#define PG8_WAIT_V(n) asm volatile("s_waitcnt vmcnt(" #n ")" ::: "memory")
#define PG8_WAIT_L(n) asm volatile("s_waitcnt lgkmcnt(" #n ")" ::: "memory")
#define PG8_BAR __builtin_amdgcn_s_barrier()
#define PG8_SCHED __builtin_amdgcn_sched_barrier(0)
    Unit cur, nxt; int ui = 0;
    if (!S.next(0, cur)) return;
    f32x4 acc[2][2][4][2];
#pragma unroll
    for (int a = 0; a < 2; ++a)
#pragma unroll
        for (int b = 0; b < 2; ++b)
#pragma unroll
            for (int m = 0; m < 4; ++m)
#pragma unroll
                for (int n = 0; n < 2; ++n) acc[a][b][m][n] = (f32x4){0.f, 0.f, 0.f, 0.f};
    bf16x8 At[4][2], B0[2][2], B1[2][2];
    const char* cA = (const char*)g.A + (size_t)cur.pm * tstep + cur.ko; const char* cB = (const char*)g.Bt + (size_t)cur.pn * tstepB + cur.ko;
    if constexpr (SP2) {
        PG8_STAGE(PG8_SB(0, 0), cB, voffB); PG8_STAGE(PG8_SB(0, 1), cB + hstepB, voffB); PG8_STAGE(PG8_SA(0, 0), cA, voffA); PG8_STAGE(PG8_SA(0, 1), cA + hstep, voffA);
        if (wr == 1) PG8_BAR;
        PG8_WAIT_V(2); PG8_BAR;
        PG8_STAGE(PG8_SB(1, 0), cB + kstep, voffB); PG8_STAGE(PG8_SA(1, 0), cA + kstep, voffA); PG8_STAGE(PG8_SB(1, 1), cB + hstepB + kstep, voffB);
        PG8_WAIT_V(6); PG8_BAR;
    } else {
        PG8_STAGE(PG8_SB(0, 0), cB, voffB); PG8_STAGE(PG8_SA(0, 0), cA, voffA); PG8_STAGE(PG8_SB(0, 1), cB + hstepB, voffB); PG8_STAGE(PG8_SA(0, 1), cA + hstep, voffA);
        if (wr == 1) PG8_BAR;
        PG8_WAIT_V(4); PG8_BAR;
        PG8_STAGE(PG8_SB(1, 0), cB + kstep, voffB); PG8_STAGE(PG8_SA(1, 0), cA + kstep, voffA); PG8_STAGE(PG8_SB(1, 1), cB + hstepB + kstep, voffB);
        PG8_WAIT_V(6); PG8_BAR;
    }
    for (;;) {
        const bool has_next = S.next(ui + 1, nxt);
        const char* nA = has_next ? (const char*)g.A + (size_t)nxt.pm * tstep + nxt.ko : cA; const char* nB = has_next ? (const char*)g.Bt + (size_t)nxt.pn * tstepB + nxt.ko : cB;
        for (int t = 0; t < nt; t += 2) {
            const bool last = (t == nt - 2);
            const char* a1 = cA + (size_t)(t + 1) * kstep;
            const char* a2 = last ? nA : cA + (size_t)(t + 2) * kstep; const char* b2 = last ? nB : cB + (size_t)(t + 2) * kstep;
            const char* a3 = a2 + kstep; const char* b3 = b2 + kstep;
            if constexpr (Epi::MID) { if (t == (nt >> 1)) E.mid(acc, cur, wr, fr); }
            if constexpr (SP2) {
            PG8_LDB(B0, 0, 0); PG8_LDB(B1, 0, 1); PG8_SCHED; PG8_LDA(At, 0, 0); PG8_STAGE(PG8_SA(1, 1), a1 + hstep, voffA);
            PG8_WAIT_V(8); PG8_WAIT_L(0); PG8_BAR; PG8_MMA(0, 0, At, B0); PG8_MMA(0, 1, At, B1); PG8_BAR; PG8_SCHED;
            PG8_LDA(At, 0, 1); PG8_STAGE(PG8_SB(0, 0), b2, voffB); PG8_STAGE(PG8_SB(0, 1), b2 + hstepB, voffB); PG8_STAGE(PG8_SA(0, 0), a2, voffA);
            PG8_WAIT_V(8); PG8_WAIT_L(0); PG8_BAR; PG8_MMA(1, 0, At, B0); PG8_MMA(1, 1, At, B1); PG8_BAR; PG8_SCHED;
            PG8_LDB(B0, 1, 0); PG8_LDB(B1, 1, 1); PG8_SCHED; PG8_LDA(At, 1, 0); PG8_STAGE(PG8_SA(0, 1), a2 + hstep, voffA);
            PG8_WAIT_V(8); PG8_WAIT_L(0); PG8_BAR; PG8_MMA(0, 0, At, B0); PG8_MMA(0, 1, At, B1); PG8_BAR; PG8_SCHED;
            PG8_LDA(At, 1, 1); PG8_STAGE(PG8_SB(1, 0), b3, voffB); PG8_STAGE(PG8_SB(1, 1), b3 + hstepB, voffB); PG8_STAGE(PG8_SA(1, 0), a3, voffA);
            PG8_WAIT_V(8); PG8_WAIT_L(0); PG8_BAR; PG8_MMA(1, 0, At, B0); PG8_MMA(1, 1, At, B1); PG8_BAR; PG8_SCHED;
            } else {
            PG8_LDB(B0, 0, 0); PG8_SCHED; PG8_LDA(At, 0, 0); PG8_STAGE(PG8_SA(1, 1), a1 + hstep, voffA);
            PG8_WAIT_L(8); PG8_BAR; PG8_WAIT_L(0); PG8_MMA(0, 0, At, B0); PG8_BAR; PG8_SCHED;
            PG8_LDB(B1, 0, 1); PG8_STAGE(PG8_SB(0, 0), b2, voffB);
            PG8_BAR; PG8_WAIT_L(0); PG8_MMA(0, 1, At, B1); PG8_BAR;
            PG8_LDA(At, 0, 1); PG8_STAGE(PG8_SA(0, 0), a2, voffA);
            PG8_BAR; PG8_WAIT_L(0); PG8_MMA(1, 0, At, B0); PG8_BAR; PG8_SCHED;
            PG8_STAGE(PG8_SB(0, 1), b2 + hstepB, voffB);
            PG8_WAIT_V(6); PG8_BAR; PG8_MMA(1, 1, At, B1); PG8_BAR;
            PG8_LDB(B0, 1, 0); PG8_SCHED; PG8_LDA(At, 1, 0); PG8_STAGE(PG8_SA(0, 1), a2 + hstep, voffA);
            PG8_WAIT_L(8); PG8_BAR; PG8_WAIT_L(0); PG8_MMA(0, 0, At, B0); PG8_BAR; PG8_SCHED;
            PG8_LDB(B1, 1, 1); PG8_STAGE(PG8_SB(1, 0), b3, voffB);
            PG8_BAR; PG8_WAIT_L(0); PG8_MMA(0, 1, At, B1); PG8_BAR;
            PG8_LDA(At, 1, 1); PG8_STAGE(PG8_SA(1, 0), a3, voffA);
            PG8_BAR; PG8_WAIT_L(0); PG8_MMA(1, 0, At, B0); PG8_BAR; PG8_SCHED;
            PG8_STAGE(PG8_SB(1, 1), b3 + hstepB, voffB);
            PG8_WAIT_V(6); PG8_BAR; PG8_MMA(1, 1, At, B1); PG8_BAR;
            }
        }
        if (wr == 0) PG8_BAR;
        E(acc, cur, wr, wc, fr, fq);
        if (!has_next) break;
#pragma unroll
        for (int a = 0; a < 2; ++a)
#pragma unroll
            for (int b = 0; b < 2; ++b)
#pragma unroll
                for (int m = 0; m < 4; ++m)
#pragma unroll
                    for (int n = 0; n < 2; ++n) acc[a][b][m][n] = (f32x4){0.f, 0.f, 0.f, 0.f};
        cur = nxt; cA = nA; cB = nB; ++ui;
        if (wr == 1) PG8_BAR;
    }
    PG8_WAIT_V(0);
    PG8_BAR;
#undef PG8_SA
#undef PG8_SB
#undef PG8_STAGE
#undef PG8_LDA
#undef PG8_LDB
#undef PG8_MMA
#undef PG8_WAIT_V
#undef PG8_WAIT_L
#undef PG8_BAR
#undef PG8_SCHED
}
}
using pg8::Unit;
typedef f32x4 Acc[2][2][4][2];

__device__ __forceinline__ void store8_bf16(bf16_t* p, const f32x4& a, const f32x4& b) {
    u32x4 w; w.x = cvt_pk_bf16(a[0], a[1]); w.y = cvt_pk_bf16(a[2], a[3]); w.z = cvt_pk_bf16(b[0], b[1]); w.w = cvt_pk_bf16(b[2], b[3]);
    *(GAS u32x4*)p = w;
}
__device__ __forceinline__ void unpack8(const u32x4 w, f32x4& a, f32x4& b) {
    a = (f32x4){bf_lo(w.x), bf_hi(w.x), bf_lo(w.y), bf_hi(w.y)}; b = (f32x4){bf_lo(w.z), bf_hi(w.z), bf_lo(w.w), bf_hi(w.w)};
}

struct EpiInProj {
    static constexpr bool PERM = true, MID = false;
    bf16_t* BG; bf16_t* XIN; bf16_t* U; const float* ss; float* convp; float* convs;
    __device__ __forceinline__ int brow(int cb, int f) const {
        const int cg = cb >> 5;
        if (cg < 16) return cb + 16 * f;
        if (cg >= 48) return 1536 + 32 * (cg - 48) + 16 * f;
        const int c = 16 * (cg - 16), q = c >> 7, r = c & 127;
        return 512 + 256 * q + 128 * f + r;
    }
    __device__ __forceinline__ void small(const f32x4 (&acc)[2][2], int r0, int cb, int fr, int fq) const {
        const int cg = cb >> 5;
#pragma unroll
        for (int m = 0; m < 2; ++m) {
            const int r = r0 + 16 * m + fr; const float inv = rsqrtf(((const GAS float*)ss)[r] * (1.0f / D) + EPS);
            if (cg < 16 || cg >= 48) {
                bf16_t* dst = (cg < 16 ? BG + (size_t)r * CH + cb : U + (size_t)r * CH + (cb - 1536)) + 4 * fq;
#pragma unroll
                for (int f = 0; f < 2; ++f) { const f32x4 v = acc[m][f] * inv; u32x2 w; w.x = cvt_pk_bf16(v[0], v[1]); w.y = cvt_pk_bf16(v[2], v[3]); *(GAS u32x2*)(dst + 16 * f) = w; }
            } else {
                const int c0 = 16 * (cg - 16) + 4 * fq;
                const f32x4 x = (acc[m][0] * inv) * (acc[m][1] * inv);
                u32x2 w; w.x = cvt_pk_bf16(x[0], x[1]); w.y = cvt_pk_bf16(x[2], x[3]); *(GAS u32x2*)(XIN + (size_t)r * CH + c0) = w;
                const int rs = r - TP, t = rs & (DSEQ - 1);
                if (t >= DSEQ - 2) *(GAS f32x4*)(convs + ((size_t)(rs >> 6) * 2 + (t - (DSEQ - 2))) * CH + c0) = x;
            }
        }
    }
    __device__ __forceinline__ void operator()(const Acc& acc, const Unit& u, int wr, int wc, int fr, int fq) const {
        const int row0 = u.pm * 256 + wr * 64 + fr, cb = wc * 32 + 8 * fq;
#pragma unroll
        for (int ai = 0; ai < 2; ++ai)
#pragma unroll
            for (int m = 0; m < 4; ++m) {
                const int r = row0 + ai * 128 + m * 16;
                const float inv = rsqrtf(((const GAS float*)ss)[r] * (1.0f / D) + EPS);
                if (u.pn < 2 || u.pn >= 6) {
                    bf16_t* dst = (u.pn < 2 ? BG : U) + (size_t)r * CH + (u.pn & 1) * 256 + cb;
#pragma unroll
                    for (int bj = 0; bj < 2; ++bj) store8_bf16(dst + bj * 128, acc[ai][bj][m][0] * inv, acc[ai][bj][m][1] * inv);
                } else {
                    const int c0 = (u.pn - 2) * 128 + cb;
                    const f32x4 x0 = (acc[ai][0][m][0] * inv) * (acc[ai][1][m][0] * inv), x1 = (acc[ai][0][m][1] * inv) * (acc[ai][1][m][1] * inv);
                    store8_bf16(XIN + (size_t)r * CH + c0, x0, x1);
                    float* cd = nullptr;
                    if (r < TP) { const int t = r & (SEQ - 1); if (t >= SEQ - 2) cd = convp + ((size_t)(r >> 11) * 2 + (t - (SEQ - 2))) * CH + c0; }
                    else { const int rs = r - TP, t = rs & (DSEQ - 1); if (t >= DSEQ - 2) cd = convs + ((size_t)(rs >> 6) * 2 + (t - (DSEQ - 2))) * CH + c0; }
                    if (cd) { *(GAS f32x4*)cd = x0; *(GAS f32x4*)(cd + 4) = x1; }
                }
            }
    }
};
template <bool VPART> struct EpiKV {
    static constexpr bool PERM = false, MID = false;
    float* outK; float* outV; bf16_t* KB; const float* invm;
    __device__ __forceinline__ void operator()(const Acc& acc, const Unit& u, int wr, int wc, int fr, int fq) const {
        const int row0 = u.pm * 256 + wr * 64 + fr, col0 = (u.pn & 3) * 256 + wc * 32 + 4 * fq;
        float* outp = VPART ? outV : outK;
#pragma unroll
        for (int ai = 0; ai < 2; ++ai)
#pragma unroll
            for (int m = 0; m < 4; ++m) {
                const int r = row0 + ai * 128 + m * 16; const float inv = ((const GAS float*)invm)[r];
#pragma unroll
                for (int bj = 0; bj < 2; ++bj)
#pragma unroll
                    for (int n = 0; n < 2; ++n) {
                        const f32x4 v = acc[ai][bj][m][n] * inv; const size_t o = (size_t)r * D + col0 + bj * 128 + n * 16;
                        *(GAS f32x4*)(outp + o) = v;
                        if (!VPART) { u32x2 w; w.x = cvt_pk_bf16(v[0], v[1]); w.y = cvt_pk_bf16(v[2], v[3]); *(GAS u32x2*)(KB + o) = w; }
                    }
            }
    }
};
struct EpiVT {
    static constexpr bool PERM = true, MID = false;
    bf16_t* VT; const float* invm;
    __device__ __forceinline__ void operator()(const Acc& acc, const Unit& u, int wr, int wc, int fr, int fq) const {
        const int row0 = u.pm * 256 + wr * 64 + fr, col0 = u.pn * 256 + wc * 32 + 8 * fq;
        f32x4 s[2][2];
#pragma unroll
        for (int bj = 0; bj < 2; ++bj) { s[bj][0] = *(const GAS f32x4*)(invm + col0 + bj * 128); s[bj][1] = *(const GAS f32x4*)(invm + col0 + bj * 128 + 4); }
#pragma unroll
        for (int ai = 0; ai < 2; ++ai)
#pragma unroll
            for (int m = 0; m < 4; ++m) {
                const int r = row0 + ai * 128 + m * 16;
#pragma unroll
                for (int bj = 0; bj < 2; ++bj) store8_bf16(VT + (size_t)r * TM + col0 + bj * 128, acc[ai][bj][m][0] * s[bj][0], acc[ai][bj][m][1] * s[bj][1]);
            }
    }
};
struct EpiGLU {
    static constexpr bool PERM = true, MID = false;
    const bf16_t* YG; bf16_t* YCAT; float* ssb;
    __device__ __forceinline__ int brow(int cb, int f) const { return cb + 16 * f; }
    __device__ __forceinline__ void small(const f32x4 (&acc)[2][2], int r0, int cb, int fr, int fq) const {
#pragma unroll
        for (int m = 0; m < 2; ++m) {
            const int r = r0 + 16 * m + fr; float ssum = 0.f;
#pragma unroll
            for (int f = 0; f < 2; ++f) {
                const int c = cb + 16 * f + 4 * fq; const u32x2 yw = *(const GAS u32x2*)(YG + (size_t)r * CH + c);
                f32x4 y = (f32x4){bf_lo(yw.x), bf_hi(yw.x), bf_lo(yw.y), bf_hi(yw.y)};
#pragma unroll
                for (int e = 0; e < 4; ++e) { y[e] = y[e] * __builtin_amdgcn_rcpf(1.0f + __expf(-acc[m][f][e])); ssum += y[e] * y[e]; }
                u32x2 w; w.x = cvt_pk_bf16(y[0], y[1]); w.y = cvt_pk_bf16(y[2], y[3]); *(GAS u32x2*)(YCAT + (size_t)r * D + c) = w;
            }
            ssum += __shfl_xor(ssum, 16); ssum += __shfl_xor(ssum, 32);
            if (fq == 0) atomicAdd(ssb + r, ssum);
        }
    }
    __device__ __forceinline__ void operator()(const Acc& acc, const Unit& u, int wr, int wc, int fr, int fq) const {
        const int row0 = u.pm * 256 + wr * 64 + fr, col0 = u.pn * 256 + wc * 32 + 8 * fq;
#pragma unroll
        for (int ai = 0; ai < 2; ++ai)
#pragma unroll
            for (int m = 0; m < 4; ++m) {
                const int r = row0 + ai * 128 + m * 16; float ssum = 0.f;
#pragma unroll
                for (int bj = 0; bj < 2; ++bj) {
                    f32x4 y0, y1; unpack8(*(const GAS u32x4*)(YG + (size_t)r * CH + col0 + bj * 128), y0, y1);
                    f32x4 z0 = acc[ai][bj][m][0], z1 = acc[ai][bj][m][1];
#pragma unroll
                    for (int e = 0; e < 4; ++e) { y0[e] = y0[e] * __builtin_amdgcn_rcpf(1.0f + __expf(-z0[e])); y1[e] = y1[e] * __builtin_amdgcn_rcpf(1.0f + __expf(-z1[e]));
                        ssum += y0[e] * y0[e] + y1[e] * y1[e]; }
                    store8_bf16(YCAT + (size_t)r * D + col0 + bj * 128, y0, y1);
                }
                ssum += __shfl_xor(ssum, 16); ssum += __shfl_xor(ssum, 32);
                if (fq == 0) atomicAdd(ssb + r, ssum);
            }
    }
};
template <bool MIDS> struct EpiRes {
    static constexpr bool PERM = true, MID = MIDS;
    bf16_t* XB; float* ssout; const float* ssb;
    __device__ __forceinline__ int brow(int cb, int f) const { return cb + 16 * f; }
    __device__ __forceinline__ void mid_small(f32x4 (&acc)[2][2], int r0, int fr) const {
#pragma unroll
        for (int m = 0; m < 2; ++m) { const float sc = rsqrtf(((const GAS float*)ssb)[r0 + 16 * m + fr] * (1.0f / CH) + EPS); acc[m][0] *= sc; acc[m][1] *= sc; }
    }
    __device__ __forceinline__ void small(const f32x4 (&acc)[2][2], int r0, int cb, int fr, int fq) const {
#pragma unroll
        for (int m = 0; m < 2; ++m) {
            const int r = r0 + 16 * m + fr; float ssum = 0.f;
#pragma unroll
            for (int f = 0; f < 2; ++f) {
                bf16_t* p = XB + (size_t)r * D + cb + 16 * f + 4 * fq; const u32x2 xw = *(const GAS u32x2*)p;
                f32x4 x = (f32x4){bf_lo(xw.x), bf_hi(xw.x), bf_lo(xw.y), bf_hi(xw.y)} + acc[m][f];
#pragma unroll
                for (int e = 0; e < 4; ++e) ssum += x[e] * x[e];
                u32x2 w; w.x = cvt_pk_bf16(x[0], x[1]); w.y = cvt_pk_bf16(x[2], x[3]); *(GAS u32x2*)p = w;
            }
            ssum += __shfl_xor(ssum, 16); ssum += __shfl_xor(ssum, 32);
            if (fq == 0) atomicAdd(ssout + r, ssum);
        }
    }
    __device__ __forceinline__ void mid(Acc& acc, const Unit& u, int wr, int fr) const {
        const int row0 = u.pm * 256 + wr * 64 + fr;
#pragma unroll
        for (int ai = 0; ai < 2; ++ai)
#pragma unroll
            for (int m = 0; m < 4; ++m) {
                const float s = rsqrtf(((const GAS float*)ssb)[row0 + ai * 128 + m * 16] * (1.0f / CH) + EPS);
#pragma unroll
                for (int bj = 0; bj < 2; ++bj)
#pragma unroll
                    for (int n = 0; n < 2; ++n) acc[ai][bj][m][n] *= s;
            }
    }
    __device__ __forceinline__ void operator()(const Acc& acc, const Unit& u, int wr, int wc, int fr, int fq) const {
        const int row0 = u.pm * 256 + wr * 64 + fr, col0 = u.pn * 256 + wc * 32 + 8 * fq;
#pragma unroll
        for (int ai = 0; ai < 2; ++ai)
#pragma unroll
            for (int m = 0; m < 4; ++m) {
                const int r = row0 + ai * 128 + m * 16; float ssum = 0.f;
#pragma unroll
                for (int bj = 0; bj < 2; ++bj) {
                    bf16_t* p = XB + (size_t)r * D + col0 + bj * 128;
                    f32x4 x0, x1; unpack8(*(const GAS u32x4*)p, x0, x1);
                    x0 += acc[ai][bj][m][0]; x1 += acc[ai][bj][m][1];
#pragma unroll
                    for (int e = 0; e < 4; ++e) ssum += x0[e] * x0[e] + x1[e] * x1[e];
                    store8_bf16(p, x0, x1);
                }
                ssum += __shfl_xor(ssum, 16); ssum += __shfl_xor(ssum, 32);
                if (fq == 0) atomicAdd(ssout + r, ssum);
            }
    }
};
template <int ACT> struct EpiScale {
    static constexpr bool PERM = true, MID = false;
    bf16_t* OUT; int ldc; const float* ss;
    __device__ __forceinline__ int brow(int cb, int f) const { return cb + 16 * f; }
    __device__ __forceinline__ void small(const f32x4 (&acc)[2][2], int r0, int cb, int fr, int fq) const {
#pragma unroll
        for (int m = 0; m < 2; ++m) {
            const int r = r0 + 16 * m + fr; const float inv = rsqrtf(((const GAS float*)ss)[r] * (1.0f / D) + EPS);
#pragma unroll
            for (int f = 0; f < 2; ++f) {
                f32x4 v = acc[m][f] * inv;
                if (ACT == 1) {
#pragma unroll
                    for (int e = 0; e < 4; ++e) { const float a = fmaxf(v[e], 0.f); v[e] = a * a; }
                }
                u32x2 w; w.x = cvt_pk_bf16(v[0], v[1]); w.y = cvt_pk_bf16(v[2], v[3]); *(GAS u32x2*)(OUT + (size_t)r * ldc + cb + 16 * f + 4 * fq) = w;
            }
        }
    }
    __device__ __forceinline__ void operator()(const Acc& acc, const Unit& u, int wr, int wc, int fr, int fq) const {
        const int row0 = u.pm * 256 + wr * 64 + fr, col0 = u.pn * 256 + wc * 32 + 8 * fq;
#pragma unroll
        for (int ai = 0; ai < 2; ++ai)
#pragma unroll
            for (int m = 0; m < 4; ++m) {
                const int r = row0 + ai * 128 + m * 16; const float inv = rsqrtf(((const GAS float*)ss)[r] * (1.0f / D) + EPS);
#pragma unroll
                for (int bj = 0; bj < 2; ++bj) {
                    f32x4 v0 = acc[ai][bj][m][0] * inv, v1 = acc[ai][bj][m][1] * inv;
                    if (ACT == 1) {
#pragma unroll
                        for (int e = 0; e < 4; ++e) { const float a = fmaxf(v0[e], 0.f), b = fmaxf(v1[e], 0.f); v0[e] = a * a; v1[e] = b * b; }
                    }
                    if (ACT == 1) {
                        u32x4 w; w.x = cvt_pk_bf16(v0[0], v0[1]); w.y = cvt_pk_bf16(v0[2], v0[3]); w.z = cvt_pk_bf16(v1[0], v1[1]); w.w = cvt_pk_bf16(v1[2], v1[3]);
                        __builtin_nontemporal_store(w, (GAS u32x4*)(OUT + (size_t)r * ldc + col0 + bj * 128));
                    } else store8_bf16(OUT + (size_t)r * ldc + col0 + bj * 128, v0, v1);
                }
            }
    }
};

template <class Epi>
__device__ __forceinline__ void small_gemm(const bf16_t* A, const bf16_t* Bt, int N, int K, const Epi& E, int c, int stride) {
    int tid = threadIdx.x; asm volatile("" : "+v"(tid));
    const int wave = __builtin_amdgcn_readfirstlane(tid >> 6), lane = tid & 63, fr = lane & 15, fq = lane >> 4;
    const int ntn = N >> 7, ntiles = (TS / 64) * ntn;
    if (c < 0) return;
    for (int tile = c; tile < ntiles; tile += stride) {
        const int tm = tile / ntn, tn = tile - tm * ntn;
        const int r0 = TP + tm * 64 + (wave >> 2) * 32, cb = tn * 128 + (wave & 3) * 32;
        const char* pa = (const char*)A + ((size_t)(r0 + fr) * K + 8 * fq) * 2;
        const char* pb0 = (const char*)Bt + ((size_t)(E.brow(cb, 0) + fr) * K + 8 * fq) * 2;
        const char* pb1 = (const char*)Bt + ((size_t)(E.brow(cb, 1) + fr) * K + 8 * fq) * 2;
        const size_t a16 = (size_t)16 * K * 2;
        f32x4 acc[2][2];
#pragma unroll
        for (int m = 0; m < 2; ++m)
#pragma unroll
            for (int f = 0; f < 2; ++f) acc[m][f] = (f32x4){0.f, 0.f, 0.f, 0.f};
        const int ng = K >> 7;
        bf16x8 A0[4], A1[4], B0[4], B1[4], C0[4], C1[4], D0[4], D1[4];
#define SG_LOAD(a0, a1, b0, b1, g) do { _Pragma("unroll") for (int j = 0; j < 4; ++j) { const size_t ko = (size_t)((g) * 4 + j) * 64; \
            a0[j] = *(const GAS bf16x8*)(pa + ko); a1[j] = *(const GAS bf16x8*)(pa + a16 + ko); b0[j] = *(const GAS bf16x8*)(pb0 + ko); b1[j] = *(const GAS bf16x8*)(pb1 + ko); } } while (0)
#define SG_MMA(a0, a1, b0, b1) do { _Pragma("unroll") for (int j = 0; j < 4; ++j) { \
            acc[0][0] = __builtin_amdgcn_mfma_f32_16x16x32_bf16(b0[j], a0[j], acc[0][0], 0, 0, 0); acc[0][1] = __builtin_amdgcn_mfma_f32_16x16x32_bf16(b1[j], a0[j], acc[0][1], 0, 0, 0); \
            acc[1][0] = __builtin_amdgcn_mfma_f32_16x16x32_bf16(b0[j], a1[j], acc[1][0], 0, 0, 0); acc[1][1] = __builtin_amdgcn_mfma_f32_16x16x32_bf16(b1[j], a1[j], acc[1][1], 0, 0, 0); } } while (0)
        SG_LOAD(A0, A1, B0, B1, 0);
        for (int g = 0; g < ng; g += 2) {
            if constexpr (Epi::MID) { if (g == (ng >> 1)) E.mid_small(acc, r0, fr); }
            SG_LOAD(C0, C1, D0, D1, g + 1);
            SG_MMA(A0, A1, B0, B1);
            if (g + 2 < ng) SG_LOAD(A0, A1, B0, B1, g + 2);
            SG_MMA(C0, C1, D0, D1);
        }
#undef SG_LOAD
#undef SG_MMA
        E.small(acc, r0, cb, fr, fq);
    }
}

struct EpiAtomic {
    static constexpr bool PERM = false, MID = false;
    float* SCR;
    __device__ __forceinline__ void operator()(const Acc& acc, const Unit& u, int wr, int wc, int fr, int fq) const {
        const int row0 = u.pm * 256 + wr * 64 + fr, col0 = u.pn * 256 + wc * 32 + 4 * fq;
        float* slab = SCR + (size_t)(u.ko >> 11) * TS * D;
#pragma unroll
        for (int ai = 0; ai < 2; ++ai)
#pragma unroll
            for (int m = 0; m < 4; ++m) {
                float* rp = slab + (size_t)(row0 + ai * 128 + m * 16) * D + col0;
#pragma unroll
                for (int bj = 0; bj < 2; ++bj)
#pragma unroll
                    for (int n = 0; n < 2; ++n) *(GAS f32x4*)(rp + bj * 128 + n * 16) = acc[ai][bj][m][n];
            }
    }
};
struct Args { const float* in[33]; float* out; unsigned char* ws; };
enum { I_XP = 0, I_XS, I_MEM, I_SCONV, I_SRE, I_SIM, I_CK, I_CV, I_GMIX, I_WIN, I_CONVW, I_ARE, I_AIM, I_LOGDT, I_BRE, I_BIM, I_CRE, I_CIM, I_SD, I_WGLU,
       I_GA, I_GB, I_WOUT, I_GX, I_GMEM, I_WQ, I_WK, I_WV, I_WO, I_GMLP, I_WUP, I_WDOWN, I_GFIN };

typedef const float* const __attribute__((address_space(4)))* KTab;
__device__ __forceinline__ KTab ktab() { unsigned long long p = (unsigned long long)__builtin_amdgcn_kernarg_segment_ptr(); asm volatile("" : "+s"(p)); return (KTab)p; }
__device__ __forceinline__ float* ss_arr(unsigned char* ws, int idx) { return (float*)(ws + WS_SS) + (size_t)idx * T; }
__device__ __forceinline__ float* invmem_arr(unsigned char* ws) { return (float*)(ws + WS_SS) + (size_t)9 * T; }

__device__ __forceinline__ int inproj_src_col(int vc) {
    if (vc < 512 || vc >= 1536) return vc;
    const int q = (vc - 512) >> 8, r = (vc - 512) & 255;
    return r < 128 ? 512 + q * 128 + r : 1024 + q * 128 + (r - 128);
}
__device__ __forceinline__ void transpose_item(const float* W, int ldw, int srck0, int srcn0, const float* gain, float gscale, bf16_t* WT, int ldt, int dn0, int dk0, LAS float* scr, int lane) {
#pragma unroll 8
    for (int i = 0; i < 32; ++i) { const int kk = 2 * i + (lane >> 5); float v = ((const GAS float*)W)[(size_t)(srck0 + kk) * ldw + srcn0 + (lane & 31)];
        const float gsc = gain ? ((const GAS float*)gain)[kk] * gscale : gscale; scr[kk * 33 + (lane & 31)] = v * gsc; }
    LDS_WAIT();
    const int c = lane & 7;
#pragma unroll
    for (int j = 0; j < 4; ++j) { const int n = (lane >> 3) + 8 * j; const LAS float* s = scr + (8 * c) * 33 + n;
        u32x4 o; o.x = cvt_pk_bf16(s[0 * 33], s[1 * 33]); o.y = cvt_pk_bf16(s[2 * 33], s[3 * 33]); o.z = cvt_pk_bf16(s[4 * 33], s[5 * 33]); o.w = cvt_pk_bf16(s[6 * 33], s[7 * 33]);
        *(GAS u32x4*)(WT + (size_t)(dn0 + n) * ldt + dk0 + 8 * c) = o; }
    LDS_WAIT();
}
__device__ __forceinline__ float convert_row(const float* src, bf16_t* dst, int lane) {
    const GAS f32x4* xr = (const GAS f32x4*)src + lane; f32x4 v[4]; float s = 0.f;
#pragma unroll
    for (int j = 0; j < 4; ++j) { v[j] = xr[64 * j]; s += (v[j][0] * v[j][0] + v[j][1] * v[j][1]) + (v[j][2] * v[j][2] + v[j][3] * v[j][3]); }
    GAS u32x2* o = (GAS u32x2*)dst + lane;
#pragma unroll
    for (int j = 0; j < 4; ++j) { u32x2 w; w.x = cvt_pk_bf16(v[j][0], v[j][1]); w.y = cvt_pk_bf16(v[j][2], v[j][3]); o[64 * j] = w; }
    return wave_sum(s);
}
constexpr int PI_IN = 1024, PI_GLU = 128, PI_SQ = 512, PI_UP = 2048, PI_CV = 2048;
constexpr int PI_LAYER = PI_IN + PI_GLU + 5 * PI_SQ + 2 * PI_UP + PI_CV;

__device__ __forceinline__ void prep_phase(unsigned char* ws, LAS unsigned char* lds, int gw, int NGW, int wave, int lane) {
    const KTab in = ktab();
    LAS float* scr = (LAS float*)(lds + wave * 8704);
    for (int it = gw; it < DEPTH * PI_LAYER; it += NGW) {
        const int l = it / PI_LAYER; int r = it - l * PI_LAYER;
        unsigned char* wl = ws + WS_W + (size_t)l * W_LAYER;
        if (r < PI_IN) { const int kb = r >> 6, nb = r & 63;
            transpose_item(as_global(in[I_WIN]) + (size_t)l * D * 2048, 2048, 64 * kb, inproj_src_col(32 * nb), as_global(in[I_GMIX]) + l * D + 64 * kb, 1.0f, (bf16_t*)(wl + W_IN), D, 32 * nb, 64 * kb, scr, lane); continue; }
        r -= PI_IN;
        if (r < PI_GLU) { const int kb = r >> 4, nb = r & 15;
            transpose_item(as_global(in[I_WGLU]) + (size_t)l * CH * CH, CH, 64 * kb, 32 * nb, nullptr, 1.0f, (bf16_t*)(wl + W_GLU), CH, 32 * nb, 64 * kb, scr, lane); continue; }
        r -= PI_GLU;
        if (r < PI_SQ) { const int kb = r >> 5, nb = r & 31, dk0 = 64 * kb;
            const float* gn = dk0 < 512 ? as_global(in[I_GB]) + l * CH + dk0 : as_global(in[I_GA]) + l * CH + dk0 - 512;
            transpose_item(as_global(in[I_WOUT]) + (size_t)l * D * D, D, (dk0 + 512) & 1023, 32 * nb, gn, 1.0f, (bf16_t*)(wl + W_OUT), D, 32 * nb, dk0, scr, lane); continue; }
        r -= PI_SQ;
        if (r < PI_SQ) { const int kb = r >> 5, nb = r & 31;
            transpose_item(as_global(in[I_WQ]) + (size_t)l * D * D, D, 64 * kb, 32 * nb, as_global(in[I_GX]) + l * D + 64 * kb, 0.0625f, (bf16_t*)(wl + W_Q), D, 32 * nb, 64 * kb, scr, lane); continue; }
        r -= PI_SQ;
        if (r < PI_SQ) { const int kb = r >> 5, nb = r & 31;
            transpose_item(as_global(in[I_WK]) + (size_t)l * D * D, D, 64 * kb, 32 * nb, as_global(in[I_GMEM]) + l * D + 64 * kb, 1.0f, (bf16_t*)(wl + W_KV), D, 32 * nb, 64 * kb, scr, lane); continue; }
        r -= PI_SQ;
        if (r < PI_SQ) { const int kb = r >> 5, nb = r & 31;
            transpose_item(as_global(in[I_WV]) + (size_t)l * D * D, D, 64 * kb, 32 * nb, as_global(in[I_GMEM]) + l * D + 64 * kb, 1.0f, (bf16_t*)(wl + W_KV), D, 1024 + 32 * nb, 64 * kb, scr, lane); continue; }
        r -= PI_SQ;
        if (r < PI_SQ) { const int kb = r >> 5, nb = r & 31;
            transpose_item(as_global(in[I_WO]) + (size_t)l * D * D, D, 64 * kb, 32 * nb, nullptr, 1.0f, (bf16_t*)(wl + W_O), D, 32 * nb, 64 * kb, scr, lane); continue; }
        r -= PI_SQ;
        if (r < PI_UP) { const int kb = r >> 7, nb = r & 127;
            transpose_item(as_global(in[I_WUP]) + (size_t)l * D * DFF, DFF, 64 * kb, 32 * nb, as_global(in[I_GMLP]) + l * D + 64 * kb, 1.0f, (bf16_t*)(wl + W_UP), D, 32 * nb, 64 * kb, scr, lane); continue; }
        r -= PI_UP;
        if (r < PI_UP) { const int kb = r >> 5, nb = r & 31;
            transpose_item(as_global(in[I_WDOWN]) + (size_t)l * DFF * D, D, 64 * kb, 32 * nb, nullptr, 1.0f, (bf16_t*)(wl + W_DOWN), DFF, 32 * nb, 64 * kb, scr, lane); continue; }
        r -= PI_UP;
        { const int kb = r >> 5, nb = r & 31;
            transpose_item(as_global(in[I_CV]) + (size_t)l * TMS * D, D, 64 * kb, 32 * nb, nullptr, 1.0f, (bf16_t*)(ws + WS_VTC) + (size_t)l * D * TMS, TMS, 32 * nb, 64 * kb, scr, lane); }
    }
    float* ss0 = ss_arr(ws, 0); float* invm = invmem_arr(ws);
    for (int m0 = gw * 2; m0 < T; m0 += NGW * 2) {
        const float* src = m0 < TP ? as_global(in[I_XP]) + (size_t)m0 * D : as_global(in[I_XS]) + (size_t)(m0 - TP) * D;
        const GAS f32x4* xr = (const GAS f32x4*)src + lane; f32x4 v[8]; float s0 = 0.f, s1 = 0.f;
#pragma unroll
        for (int j = 0; j < 8; ++j) v[j] = __builtin_nontemporal_load(xr + 64 * j);
#pragma unroll
        for (int j = 0; j < 4; ++j) { s0 += (v[j][0] * v[j][0] + v[j][1] * v[j][1]) + (v[j][2] * v[j][2] + v[j][3] * v[j][3]);
            s1 += (v[4 + j][0] * v[4 + j][0] + v[4 + j][1] * v[4 + j][1]) + (v[4 + j][2] * v[4 + j][2] + v[4 + j][3] * v[4 + j][3]); }
        GAS u32x2* o = (GAS u32x2*)((bf16_t*)(ws + WS_XB) + (size_t)m0 * D) + lane;
#pragma unroll
        for (int j = 0; j < 8; ++j) { u32x2 w; w.x = cvt_pk_bf16(v[j][0], v[j][1]); w.y = cvt_pk_bf16(v[j][2], v[j][3]); o[64 * j] = w; }
        s0 = wave_sum(s0); s1 = wave_sum(s1);
        if (lane == 0) { ((GAS float*)ss0)[m0] = s0; ((GAS float*)ss0)[m0 + 1] = s1; }
    }
    for (int m = T + gw; m < T + TM + 2 * TMS; m += NGW) {
        if (m < T) { const float* src = m < TP ? as_global(in[I_XP]) + (size_t)m * D : as_global(in[I_XS]) + (size_t)(m - TP) * D;
            const float s = convert_row(src, (bf16_t*)(ws + WS_XB) + (size_t)m * D, lane); if (lane == 0) ((GAS float*)ss0)[m] = s; }
        else if (m < T + TM) { const int mm = m - T; const float s = convert_row(as_global(in[I_MEM]) + (size_t)mm * D, (bf16_t*)(ws + WS_MNB) + (size_t)mm * D, lane);
            if (lane == 0) ((GAS float*)invm)[mm] = rsqrtf(s * (1.0f / D) + EPS); }
        else { const int mm = m - T - TM; (void)convert_row(as_global(in[I_CK]) + (size_t)mm * D, (bf16_t*)(ws + WS_KC) + (size_t)mm * D, lane); }
    }
    {
        float* sm = (float*)(ws + WS_SMALL); const int gt = gw * 64 + lane, NT = NGW * 64;
#define SMCOPY(off, idx, n) for (int i = gt; i < (n); i += NT) ((GAS float*)sm)[(off) + i] = ((const GAS float*)in[idx])[i]
        SMCOPY(SM_ARE, I_ARE, 4096); SMCOPY(SM_AIM, I_AIM, 4096); SMCOPY(SM_LOGDT, I_LOGDT, 64); SMCOPY(SM_BRE, I_BRE, 65536); SMCOPY(SM_BIM, I_BIM, 65536);
        SMCOPY(SM_CRE, I_CRE, 65536); SMCOPY(SM_CIM, I_CIM, 65536); SMCOPY(SM_SD, I_SD, 1024); SMCOPY(SM_CONVW, I_CONVW, 3072); SMCOPY(SM_SCONV, I_SCONV, 32768);
        SMCOPY(SM_SRE, I_SRE, 65536); SMCOPY(SM_SIM, I_SIM, 65536); SMCOPY(SM_GFIN, I_GFIN, 1024);
#undef SMCOPY
    }
    { float* z = ss_arr(ws, 1); const size_t n = (size_t)8 * T; for (size_t i = (size_t)gw * 64 + lane; i < n; i += (size_t)NGW * 64) ((GAS float*)z)[i] = 0.f; }
}

__device__ __forceinline__ float gelu_tanh(float x) {
    const float u = 0.7978845608f * (x + 0.044715f * x * x * x);
    const float e = __expf(2.0f * u);
    const float th = 1.0f - 2.0f * __builtin_amdgcn_rcpf(e + 1.0f);
    return 0.5f * x * (1.0f + th);
}
__device__ __forceinline__ void sincos_small(float x, float& s, float& c) {
    const float q = rintf(x * 0.63661977236f);
    float r = fmaf(-q, 1.57079637050628662109375f, x); r = fmaf(-q, -4.37113900018624283e-8f, r);
    const float r2 = r * r;
    const float sp = r + r * r2 * (-1.0f / 6 + r2 * (1.0f / 120 + r2 * (-1.0f / 5040 + r2 * (1.0f / 362880))));
    const float cp = 1.0f + r2 * (-0.5f + r2 * (1.0f / 24 + r2 * (-1.0f / 720 + r2 * (1.0f / 40320 + r2 * (-1.0f / 3628800)))));
    const int qi = (int)q & 3;
    s = (qi == 0) ? sp : (qi == 1) ? cp : (qi == 2) ? -sp : -cp;
    c = (qi == 0) ? cp : (qi == 1) ? -sp : (qi == 2) ? -cp : sp;
}
constexpr int BU_STRIDE = 528, H_STRIDE = 272, SCAN_LDS_WAVE = 16 * BU_STRIDE + 16 * H_STRIDE;

__device__ __forceinline__ void scan_item(unsigned char* ws, float* out, int l, int item, LAS unsigned char* wl, int lane_in) {
    int lane = lane_in; asm volatile("" : "+v"(lane));
    const GAS float* sm = (const GAS float*)(ws + WS_SMALL);
    int b, g, row0, nblk; const bool prompt = item < NB * 32;
    if (prompt) { b = item >> 5; g = item & 31; row0 = b * SEQ; nblk = SEQ / 16; }
    else { const int i2 = item - NB * 32; b = i2 >> 5; g = i2 & 31; row0 = TP + b * DSEQ; nblk = DSEQ / 16; }
    const bf16_t* U = (const bf16_t*)(ws + WS_U); bf16_t* YG = (bf16_t*)(ws + WS_YG);
    const int lg = l * 32 + g, p = lane, t16 = lane & 15, q = lane >> 4;
    const float are = fminf(sm[SM_ARE + lg * 64 + p], -1e-4f), aim = sm[SM_AIM + lg * 64 + p];
    const float dt = expf(sm[SM_LOGDT + lg]);
    float sn, cs; sincos_small(aim * dt, sn, cs);
    const float mag = expf(are * dt), abr = mag * cs, abi = mag * sn;
    const float nr = abr - 1.0f, ni = abi, den = 1.0f / (are * are + aim * aim);
    const float c0 = (nr * are + ni * aim) * den, c1 = (ni * are - nr * aim) * den;
    bf16x8 af[8];
#pragma unroll
    for (int f = 0; f < 8; ++f) {
        const int i = 16 * f + t16, ps = i >> 1, cc = i & 1;
        const float k0 = __shfl(c0, ps), k1 = __shfl(c1, ps);
        u32x4 w = (u32x4){0u, 0u, 0u, 0u};
        if (q < 2) {
            const GAS f32x4* br = (const GAS f32x4*)(sm + SM_BRE + ((size_t)lg * 64 + ps) * 16 + 8 * q); const GAS f32x4* bi = (const GAS f32x4*)(sm + SM_BIM + ((size_t)lg * 64 + ps) * 16 + 8 * q);
            const f32x4 r0 = br[0], r1 = br[1], i0 = bi[0], i1 = bi[1];
            f32x4 v0, v1;
            if (cc == 0) { v0 = k0 * r0 - k1 * i0; v1 = k0 * r1 - k1 * i1; } else { v0 = k0 * i0 + k1 * r0; v1 = k0 * i1 + k1 * r1; }
            w.x = cvt_pk_bf16(v0[0], v0[1]); w.y = cvt_pk_bf16(v0[2], v0[3]); w.z = cvt_pk_bf16(v1[0], v1[1]); w.w = cvt_pk_bf16(v1[2], v1[3]);
        }
        af[f] = __builtin_bit_cast(bf16x8, w);
    }
    bf16x8 cf[4];
#pragma unroll
    for (int s = 0; s < 4; ++s) {
        const int p0 = 16 * s + 4 * q;
        const f32x4 cr = *(const GAS f32x4*)(sm + SM_CRE + ((size_t)lg * 16 + t16) * 64 + p0), ci = *(const GAS f32x4*)(sm + SM_CIM + ((size_t)lg * 16 + t16) * 64 + p0);
        u32x4 w; w.x = cvt_pk_bf16(cr[0], -ci[0]); w.y = cvt_pk_bf16(cr[1], -ci[1]); w.z = cvt_pk_bf16(cr[2], -ci[2]); w.w = cvt_pk_bf16(cr[3], -ci[3]);
        cf[s] = __builtin_bit_cast(bf16x8, w);
    }
    const f32x4 dsk = *(const GAS f32x4*)(sm + SM_SD + l * CH + g * 16 + 4 * q);
    float hre = 0.f, him = 0.f;
    if (!prompt) { hre = sm[SM_SRE + (((size_t)l * NDB + b) * 32 + g) * 64 + p]; him = sm[SM_SIM + (((size_t)l * NDB + b) * 32 + g) * 64 + p]; }
    LAS unsigned char* BU = wl; LAS unsigned char* HB = wl + 16 * BU_STRIDE;
    const char* ubase = (const char*)U + (size_t)row0 * CH * 2; char* ybase = (char*)YG + (size_t)row0 * CH * 2;
    const unsigned lo8 = (unsigned)((t16 * CH + g * 16 + 8 * (q & 1)) * 2), lo4 = (unsigned)((t16 * CH + g * 16 + 4 * q) * 2);
    constexpr size_t BSTEP = (size_t)16 * CH * 2;
    constexpr int PD = 4;
    u32x4 ubuf[PD]; u32x2 ebuf[PD];
    const bool lowq = q < 2;
#pragma unroll
    for (int j = 0; j < PD; ++j) { const char* un = ubase + (size_t)j * BSTEP; ubuf[j] = *(const GAS u32x4*)(un + lo8); ebuf[j] = *(const GAS u32x2*)(un + lo4); }
#define U_BFRAG(v) __builtin_bit_cast(bf16x8, (u32x4){lowq ? (v).x : 0u, lowq ? (v).y : 0u, lowq ? (v).z : 0u, lowq ? (v).w : 0u})
    f32x2 buv[16];
    {
        const bf16x8 bfrag = U_BFRAG(ubuf[0]);
#pragma unroll
        for (int f = 0; f < 8; ++f) {
            const f32x4 r = __builtin_amdgcn_mfma_f32_16x16x32_bf16(af[f], bfrag, (f32x4){0.f, 0.f, 0.f, 0.f}, 0, 0, 0);
            *(LAS f32x4*)(BU + t16 * BU_STRIDE + (16 * f + 4 * q) * 4) = r;
        }
        LDS_WAIT();
#pragma unroll
        for (int t = 0; t < 16; ++t) buv[t] = *(const LAS f32x2*)(BU + t * BU_STRIDE + p * 8);
    }
    if (prompt) {
        for (int tb0 = 0; tb0 < nblk; tb0 += 32) {
#pragma unroll
        for (int j = 0; j < 32; ++j) {
            const int tb = tb0 + j;
            const u32x2 uec = ebuf[j % PD];
            const u32x4 ubn = ubuf[(j + 1) % PD];
            { const int tbn = (tb + PD < nblk) ? tb + PD : nblk - 1; const char* un = ubase + (size_t)tbn * BSTEP; ubuf[j % PD] = *(const GAS u32x4*)(un + lo8); ebuf[j % PD] = *(const GAS u32x2*)(un + lo4); }
            f32x4 rn[8];
            { const bf16x8 bfrag = U_BFRAG(ubn);
#pragma unroll
              for (int f = 0; f < 8; ++f) rn[f] = __builtin_amdgcn_mfma_f32_16x16x32_bf16(af[f], bfrag, (f32x4){0.f, 0.f, 0.f, 0.f}, 0, 0, 0); }
#pragma unroll
            for (int t = 0; t < 16; ++t) {
                const float nre = fmaf(abr, hre, fmaf(-abi, him, buv[t][0])), nim = fmaf(abr, him, fmaf(abi, hre, buv[t][1]));
                hre = nre; him = nim;
                *(LAS unsigned*)(HB + t * H_STRIDE + p * 4) = cvt_pk_bf16(hre, him);
            }
#pragma unroll
            for (int f = 0; f < 8; ++f) *(LAS f32x4*)(BU + t16 * BU_STRIDE + (16 * f + 4 * q) * 4) = rn[f];
            LDS_WAIT();
            bf16x8 hf[4];
#pragma unroll
            for (int s2 = 0; s2 < 4; ++s2) hf[s2] = *(const LAS bf16x8*)(HB + t16 * H_STRIDE + (32 * s2 + 8 * q) * 2);
#pragma unroll
            for (int t = 0; t < 16; ++t) buv[t] = *(const LAS f32x2*)(BU + t * BU_STRIDE + p * 8);
            f32x4 y = (f32x4){0.f, 0.f, 0.f, 0.f};
#pragma unroll
            for (int s2 = 0; s2 < 4; ++s2) y = __builtin_amdgcn_mfma_f32_16x16x32_bf16(cf[s2], hf[s2], y, 0, 0, 0);
            const float u0 = bf_lo(uec.x), u1 = bf_hi(uec.x), u2 = bf_lo(uec.y), u3 = bf_hi(uec.y);
            const float g0 = gelu_tanh(y[0] + dsk[0] * u0), g1 = gelu_tanh(y[1] + dsk[1] * u1), g2 = gelu_tanh(y[2] + dsk[2] * u2), g3 = gelu_tanh(y[3] + dsk[3] * u3);
            u32x2 w; w.x = cvt_pk_bf16(g0, g1); w.y = cvt_pk_bf16(g2, g3);
            *(GAS u32x2*)(ybase + (size_t)tb * BSTEP + lo4) = w;
        }
        }
    } else {
        for (int tb0 = 0; tb0 < nblk; tb0 += 4) {
#pragma unroll
        for (int j = 0; j < 4; ++j) {
            const int tb = tb0 + j;
            const u32x2 uec = ebuf[j % PD];
            const u32x4 ubn = ubuf[(j + 1) % PD];
            { const int tbn = (tb + PD < nblk) ? tb + PD : nblk - 1; const char* un = ubase + (size_t)tbn * BSTEP; ubuf[j % PD] = *(const GAS u32x4*)(un + lo8); ebuf[j % PD] = *(const GAS u32x2*)(un + lo4); }
            f32x4 rn[8];
            { const bf16x8 bfrag = U_BFRAG(ubn);
#pragma unroll
              for (int f = 0; f < 8; ++f) rn[f] = __builtin_amdgcn_mfma_f32_16x16x32_bf16(af[f], bfrag, (f32x4){0.f, 0.f, 0.f, 0.f}, 0, 0, 0); }
#pragma unroll
            for (int t = 0; t < 16; ++t) {
                const float nre = fmaf(abr, hre, fmaf(-abi, him, buv[t][0])), nim = fmaf(abr, him, fmaf(abi, hre, buv[t][1]));
                hre = nre; him = nim;
                *(LAS unsigned*)(HB + t * H_STRIDE + p * 4) = cvt_pk_bf16(hre, him);
            }
#pragma unroll
            for (int f = 0; f < 8; ++f) *(LAS f32x4*)(BU + t16 * BU_STRIDE + (16 * f + 4 * q) * 4) = rn[f];
            LDS_WAIT();
            bf16x8 hf[4];
#pragma unroll
            for (int s2 = 0; s2 < 4; ++s2) hf[s2] = *(const LAS bf16x8*)(HB + t16 * H_STRIDE + (32 * s2 + 8 * q) * 2);
#pragma unroll
            for (int t = 0; t < 16; ++t) buv[t] = *(const LAS f32x2*)(BU + t * BU_STRIDE + p * 8);
            f32x4 y = (f32x4){0.f, 0.f, 0.f, 0.f};
#pragma unroll
            for (int s2 = 0; s2 < 4; ++s2) y = __builtin_amdgcn_mfma_f32_16x16x32_bf16(cf[s2], hf[s2], y, 0, 0, 0);
            const float u0 = bf_lo(uec.x), u1 = bf_hi(uec.x), u2 = bf_lo(uec.y), u3 = bf_hi(uec.y);
            const float g0 = gelu_tanh(y[0] + dsk[0] * u0), g1 = gelu_tanh(y[1] + dsk[1] * u1), g2 = gelu_tanh(y[2] + dsk[2] * u2), g3 = gelu_tanh(y[3] + dsk[3] * u3);
            u32x2 w; w.x = cvt_pk_bf16(g0, g1); w.y = cvt_pk_bf16(g2, g3);
            *(GAS u32x2*)(ybase + (size_t)tb * BSTEP + lo4) = w;
        }
        }
    }
#undef U_BFRAG
    GAS float* outg = (GAS float*)out;
    if (prompt) { outg[O_REP + (((size_t)l * NB + b) * 32 + g) * 64 + p] = hre; outg[O_IMP + (((size_t)l * NB + b) * 32 + g) * 64 + p] = him; }
    else { outg[O_RES + (((size_t)l * NDB + b) * 32 + g) * 64 + p] = hre; outg[O_IMS + (((size_t)l * NDB + b) * 32 + g) * 64 + p] = him; }
}
__device__ __forceinline__ void conv_run(unsigned char* ws, int l, int run, int lane_in) {
    int lane = lane_in; asm volatile("" : "+v"(lane));
    const GAS float* sm = (const GAS float*)(ws + WS_SMALL);
    const bf16_t* XIN = (const bf16_t*)(ws + WS_XIN); const bf16_t* BG = (const bf16_t*)(ws + WS_BG); bf16_t* YCAT = (bf16_t*)(ws + WS_YCAT);
    const int row0 = run * 64, c0 = lane * 8;
    f32x4 w0a, w0b, w1a, w1b, w2a, w2b;
    { const GAS float* cw = sm + SM_CONVW + (size_t)l * 3 * CH + c0; w0a = *(const GAS f32x4*)cw; w0b = *(const GAS f32x4*)(cw + 4); w1a = *(const GAS f32x4*)(cw + CH); w1b = *(const GAS f32x4*)(cw + CH + 4);
      w2a = *(const GAS f32x4*)(cw + 2 * CH); w2b = *(const GAS f32x4*)(cw + 2 * CH + 4); }
    f32x4 p2a, p2b, p1a, p1b;
    const bool seq_start = row0 < TP ? ((row0 & (SEQ - 1)) == 0) : true;
    if (!seq_start) { unpack8(*(const GAS u32x4*)(XIN + (size_t)(row0 - 2) * CH + c0), p2a, p2b); unpack8(*(const GAS u32x4*)(XIN + (size_t)(row0 - 1) * CH + c0), p1a, p1b); }
    else if (row0 < TP) { p2a = p2b = p1a = p1b = (f32x4){0.f, 0.f, 0.f, 0.f}; }
    else { const int b = (row0 - TP) >> 6; const GAS float* st = sm + SM_SCONV + ((size_t)(l * NDB + b) * 2) * CH + c0;
        p2a = *(const GAS f32x4*)st; p2b = *(const GAS f32x4*)(st + 4); p1a = *(const GAS f32x4*)(st + CH); p1b = *(const GAS f32x4*)(st + CH + 4); }
    for (int tb = 0; tb < 64; tb += 8) {
        u32x4 xr[8], br[8];
#pragma unroll
        for (int j = 0; j < 8; ++j) { const size_t o = (size_t)(row0 + tb + j) * CH + c0; xr[j] = *(const GAS u32x4*)(XIN + o); br[j] = *(const GAS u32x4*)(BG + o); }
#pragma unroll
        for (int j = 0; j < 8; ++j) {
            f32x4 xa, xb, ba, bb; unpack8(xr[j], xa, xb); unpack8(br[j], ba, bb);
            f32x4 ya = ba * (w0a * p2a + w1a * p1a + w2a * xa), yb = bb * (w0b * p2b + w1b * p1b + w2b * xb);
            float s = 0.f;
#pragma unroll
            for (int e = 0; e < 4; ++e) s += ya[e] * ya[e] + yb[e] * yb[e];
            s = wave_sum(s);
            const float inv = rsqrtf(s * (1.0f / CH) + EPS);
            store8_bf16(YCAT + (size_t)(row0 + tb + j) * D + 512 + c0, ya * inv, yb * inv);
            p2a = p1a; p2b = p1b; p1a = xa; p1b = xb;
        }
    }
}

constexpr int KST = 528, VST = 520;
__device__ __forceinline__ const bf16_t* attn_kptr(unsigned char* ws, int l, int u) {
    if (u < NB * 32) { const int b = u >> 5, h = (u >> 3) & 3; return (const bf16_t*)(ws + WS_KB) + (size_t)l * TM * D + (size_t)(b * NMEM) * D + h * 256; }
    const int i = u - NB * 32, b = i >> 2, h = i & 3; return (const bf16_t*)(ws + WS_KC) + (size_t)l * TMS * D + (size_t)(b * NMEM) * D + h * 256;
}
__device__ __forceinline__ void attn_phase(unsigned char* ws, int l, LAS unsigned char* lds, int G, int bid) {
    int tid = threadIdx.x; asm volatile("" : "+v"(tid));
    const int wave = __builtin_amdgcn_readfirstlane(tid >> 6);
    const bf16_t* Q = (const bf16_t*)(ws + WS_Q); bf16_t* O = (bf16_t*)(ws + WS_O);
    const int NU = NB * 4 * 8 + NDB * 4;
    u32x4 kpre[16]; bool have = false;
#pragma unroll
    for (int i = 0; i < 16; ++i) kpre[i] = (u32x4){0u, 0u, 0u, 0u};
    for (int u = bid; u < NU; u += G) {
        int qrow0, nq, ldv; const bf16_t* Kp; const bf16_t* Vp; int h;
        if (u < NB * 32) { const int b = u >> 5; h = (u >> 3) & 3; const int qt = u & 7; qrow0 = b * SEQ + qt * 256; nq = 256;
            Kp = (const bf16_t*)(ws + WS_KB) + (size_t)l * TM * D + (size_t)(b * NMEM) * D + h * 256; Vp = (const bf16_t*)(ws + WS_VT) + (size_t)l * D * TM + (size_t)(h * 256) * TM + b * NMEM; ldv = TM; }
        else { const int i = u - NB * 32, b = i >> 2; h = i & 3; qrow0 = TP + b * DSEQ; nq = DSEQ;
            Kp = (const bf16_t*)(ws + WS_KC) + (size_t)l * TMS * D + (size_t)(b * NMEM) * D + h * 256; Vp = (const bf16_t*)(ws + WS_VTC) + (size_t)l * D * TMS + (size_t)(h * 256) * TMS + b * NMEM; ldv = TMS; }
        const bool active = wave * 32 < nq;
        __syncthreads();
        int t2 = tid; asm volatile("" : "+v"(t2));
        {
            const int c = t2 & 31, rr = t2 >> 5; const unsigned off = (unsigned)((rr * D + c * 8) * 2); const char* kb = (const char*)Kp;
            if (!have) {
#pragma unroll
                for (int i = 0; i < 16; ++i) kpre[i] = *(const GAS u32x4*)(kb + (size_t)(16 * i) * D * 2 + off);
            }
            LAS unsigned char* ld0 = lds + rr * KST + c * 16;
#pragma unroll
            for (int i = 0; i < 16; ++i) *(LAS u32x4*)(ld0 + 16 * i * KST) = kpre[i];
        }
        bf16x8 qf[16];
        const int r32 = t2 & 31, hh = (t2 >> 5) & 1;
        const int qrow = qrow0 + wave * 32 + r32;
        if (active) {
#pragma unroll
            for (int ks = 0; ks < 16; ++ks) qf[ks] = *(const GAS bf16x8*)(Q + (size_t)qrow * D + h * 256 + 16 * ks + 8 * hh);
        } else {
#pragma unroll
            for (int ks = 0; ks < 16; ++ks) qf[ks] = (bf16x8){0, 0, 0, 0, 0, 0, 0, 0};
        }
        __syncthreads();
        constexpr int NQ = 4, MTQ = 8 / NQ;
        bf16x8 pf[16]; float qmax[NQ], qsum[NQ];
#pragma unroll
        for (int qi = 0; qi < NQ; ++qi) { qmax[qi] = 0.f; qsum[qi] = 1.f; }
        if (active) {
#pragma unroll
            for (int qi = 0; qi < NQ; ++qi) {
                f32x16 sc[MTQ];
#pragma unroll
                for (int mq = 0; mq < MTQ; ++mq)
#pragma unroll
                    for (int e = 0; e < 16; ++e) sc[mq][e] = 0.f;
#pragma unroll
                for (int ks = 0; ks < 16; ++ks)
#pragma unroll
                    for (int mq = 0; mq < MTQ; ++mq) {
                        const bf16x8 kf = *(const LAS bf16x8*)(lds + (32 * (qi * MTQ + mq) + r32) * KST + (16 * ks + 8 * hh) * 2);
                        sc[mq] = __builtin_amdgcn_mfma_f32_32x32x16_bf16(kf, qf[ks], sc[mq], 0, 0, 0);
                    }
                float mx = -3.0e38f;
#pragma unroll
                for (int mq = 0; mq < MTQ; ++mq)
#pragma unroll
                    for (int e = 0; e < 16; ++e) mx = fmaxf(mx, sc[mq][e]);
                mx = fmaxf(mx, __shfl_xor(mx, 32));
                float sum = 0.f;
#pragma unroll
                for (int mq = 0; mq < MTQ; ++mq) {
#pragma unroll
                    for (int e = 0; e < 16; ++e) { const float pe = __builtin_amdgcn_exp2f((sc[mq][e] - mx) * 1.44269504089f); sc[mq][e] = pe; sum += pe; }
#pragma unroll
                    for (int s2 = 0; s2 < 2; ++s2) {
                        u32x4 w; w.x = cvt_pk_bf16(sc[mq][8 * s2 + 0], sc[mq][8 * s2 + 1]); w.y = cvt_pk_bf16(sc[mq][8 * s2 + 2], sc[mq][8 * s2 + 3]);
                        w.z = cvt_pk_bf16(sc[mq][8 * s2 + 4], sc[mq][8 * s2 + 5]); w.w = cvt_pk_bf16(sc[mq][8 * s2 + 6], sc[mq][8 * s2 + 7]);
                        pf[2 * (qi * MTQ + mq) + s2] = __builtin_bit_cast(bf16x8, w);
                    }
                }
                sum += __shfl_xor(sum, 32);
                qmax[qi] = mx; qsum[qi] = sum;
                __builtin_amdgcn_sched_barrier(0);
            }
        } else {
#pragma unroll
            for (int i = 0; i < 16; ++i) pf[i] = (bf16x8){0, 0, 0, 0, 0, 0, 0, 0};
        }
        float fq_[NQ]; float rinv;
        { float M = qmax[0];
#pragma unroll
          for (int qi = 1; qi < NQ; ++qi) M = fmaxf(M, qmax[qi]);
          float tot = 0.f;
#pragma unroll
          for (int qi = 0; qi < NQ; ++qi) { fq_[qi] = __builtin_amdgcn_exp2f((qmax[qi] - M) * 1.44269504089f); tot += fq_[qi] * qsum[qi]; }
          rinv = 1.0f / tot;
#pragma unroll
          for (int qi = 0; qi < NQ; ++qi) fq_[qi] *= rinv; }
        __builtin_amdgcn_sched_barrier(0);
        u32x4 vpre[16];
        const int vc = t2 & 31, vr = t2 >> 5;
        { const unsigned off = (unsigned)((vr * ldv + vc * 8) * 2); const char* vb = (const char*)Vp;
#pragma unroll
          for (int i = 0; i < 16; ++i) vpre[i] = *(const GAS u32x4*)(vb + (size_t)(16 * i) * ldv * 2 + off); }
        __syncthreads();
        {
            LAS unsigned char* ld0 = lds + vr * VST + vc * 16;
#pragma unroll
            for (int i = 0; i < 16; ++i) { LAS u32x2* d = (LAS u32x2*)(ld0 + 16 * i * VST); d[0] = (u32x2){vpre[i].x, vpre[i].y}; d[1] = (u32x2){vpre[i].z, vpre[i].w}; }
        }
        __syncthreads();
        {
            const int un = u + G; have = un < NU;
            if (have) { const char* kb = (const char*)attn_kptr(ws, l, un); const unsigned off = (unsigned)((vr * D + vc * 8) * 2);
#pragma unroll
                for (int i = 0; i < 16; ++i) kpre[i] = *(const GAS u32x4*)(kb + (size_t)(16 * i) * D * 2 + off); }
            else {
#pragma unroll
                for (int i = 0; i < 16; ++i) kpre[i] = (u32x4){0u, 0u, 0u, 0u}; }
            __builtin_amdgcn_sched_barrier(0);
        }
        if (active) {
#pragma unroll
            for (int dt = 0; dt < 8; ++dt) {
                f32x16 acc[NQ];
#pragma unroll
                for (int qi = 0; qi < NQ; ++qi)
#pragma unroll
                    for (int e = 0; e < 16; ++e) acc[qi][e] = 0.f;
#pragma unroll
                for (int mi = 0; mi < 16 / NQ; ++mi)
#pragma unroll
                    for (int qi = 0; qi < NQ; ++qi) {
                        const int ms = qi * (16 / NQ) + mi;
                        const LAS unsigned char* vp = lds + (32 * dt + r32) * VST + (16 * ms + 4 * hh) * 2;
                        const u32x2 lo = *(const LAS u32x2*)vp, hi = *(const LAS u32x2*)(vp + 16);
                        const u32x4 w = (u32x4){lo.x, lo.y, hi.x, hi.y};
                        acc[qi] = __builtin_amdgcn_mfma_f32_32x32x16_bf16(__builtin_bit_cast(bf16x8, w), pf[ms], acc[qi], 0, 0, 0);
                    }
#pragma unroll
                for (int g4 = 0; g4 < 4; ++g4) {
                    float o4[4];
#pragma unroll
                    for (int e = 0; e < 4; ++e) { float v = 0.f;
#pragma unroll
                        for (int qi = 0; qi < NQ; ++qi) v = fmaf(acc[qi][4 * g4 + e], fq_[qi], v);
                        o4[e] = v; }
                    u32x2 w; w.x = cvt_pk_bf16(o4[0], o4[1]); w.y = cvt_pk_bf16(o4[2], o4[3]);
                    *(GAS u32x2*)(O + (size_t)qrow * D + h * 256 + 32 * dt + 8 * g4 + 4 * hh) = w;
                }
                __builtin_amdgcn_sched_barrier(0);
            }
        }
    }
    __syncthreads();
}

#define XB_TMO      128
#define XB_XCNT(j)  (256  + 64 * (j))
#define XB_XSUB(j)  (1280 + 64 * (j))
#define XB_XGEN(j)  (2304 + 64 * (j))
#define XB_TOP      3328
#define XB_TOPGEN   3392
#define XCD_BAR_WORDS 3456
#define XB_SPIN_CAP (1u << 18)

__device__ __forceinline__ unsigned xb_ld(unsigned* p)              { return __hip_atomic_load(p, __ATOMIC_RELAXED, __HIP_MEMORY_SCOPE_AGENT); }
__device__ __forceinline__ unsigned xb_add(unsigned* p, unsigned v) { return __hip_atomic_fetch_add(p, v, __ATOMIC_RELAXED, __HIP_MEMORY_SCOPE_AGENT); }
__device__ __forceinline__ unsigned xb_xcc_id() { return (unsigned)__builtin_amdgcn_s_getreg((3 << 11) | 20) & 0xFu; }
#define XB_SPIN(cond, bar) do { unsigned _sp = 0; while (cond) { __builtin_amdgcn_s_sleep(1); \
    if ((++_sp & 255u) == 0u) { if (xb_ld(&(bar)[XB_TMO])) break; if (_sp > XB_SPIN_CAP) { atomicAdd(&(bar)[XB_TMO], 1u); break; } } } } while (0)

struct XcdBarrier {
    unsigned* bar; unsigned x;
    volatile LAS unsigned* st;
};

__device__ __forceinline__ XcdBarrier xcd_barrier_post(unsigned* bar, volatile LAS unsigned* st) {
    XcdBarrier b; b.bar = bar; b.x = xb_xcc_id(); b.st = st;
    if (threadIdx.x == 0) (void)xb_add(&bar[XB_XCNT(b.x)], 1u);
    return b;
}
__device__ __forceinline__ void xcd_barrier_complete(unsigned* bar, unsigned x, unsigned& nloc, unsigned& nx) {
    const unsigned G = gridDim.x * gridDim.y * gridDim.z;
    unsigned sum, cnt, mine, sp = 0u;
    for (;;) {
        sum = 0u; cnt = 0u; mine = 0u;
#pragma unroll
        for (unsigned j = 0; j < 16; ++j) { const unsigned c = xb_ld(&bar[XB_XCNT(j)]); sum += c; cnt += (c > 0u) ? 1u : 0u; mine = (j == x) ? c : mine; }
        if (sum == G) break;
        __builtin_amdgcn_s_sleep(1);
        if ((++sp & 255u) == 0u) { if (xb_ld(&bar[XB_TMO])) break; if (sp > XB_SPIN_CAP) { atomicAdd(&bar[XB_TMO], 1u); break; } }
    }
    nloc = mine > 0u ? mine : 1u; nx = cnt > 0u ? cnt : 1u;
}

__device__ __forceinline__ void xcd_barrier(const XcdBarrier& b) {
    asm volatile("s_waitcnt vmcnt(0)" ::: "memory");
    __syncthreads();
    if (threadIdx.x == 0) {
        unsigned* bar = b.bar;
        __builtin_amdgcn_s_waitcnt(0);
        unsigned nloc = b.st[0], nx = b.st[1];
        if (nloc == 0u) { xcd_barrier_complete(bar, b.x, nloc, nx); b.st[0] = nloc; b.st[1] = nx; }
        const unsigned old = xb_add(&bar[XB_XSUB(b.x)], 1u);
        const unsigned gen = old / nloc;
        if (old + 1u == (gen + 1u) * nloc) {
            __builtin_amdgcn_fence(__ATOMIC_RELEASE, "agent");
            asm volatile("s_waitcnt vmcnt(0)" ::: "memory");
            const unsigned og = xb_add(&bar[XB_TOP], 1u);
            const unsigned tg = og / nx;
            if (og + 1u == (tg + 1u) * nx) xb_add(&bar[XB_TOPGEN], 1u);
            else XB_SPIN(xb_ld(&bar[XB_TOPGEN]) == tg, bar);
            __builtin_amdgcn_fence(__ATOMIC_ACQUIRE, "agent");
            xb_add(&bar[XB_XGEN(b.x)], 1u);
            asm volatile("s_waitcnt vmcnt(0)" ::: "memory");
        } else {
            XB_SPIN(xb_ld(&bar[XB_XGEN(b.x)]) == gen, bar);
            __builtin_amdgcn_fence(__ATOMIC_ACQUIRE, "agent");
            asm volatile("s_waitcnt vmcnt(0)" ::: "memory");
        }
    }
    __syncthreads();
}

constexpr bool USE_SP2 = true;
__global__ void __launch_bounds__(512, 2) hybrid_fwd(Args a) {
    extern __shared__ __attribute__((aligned(16))) unsigned char lds_raw[];
    LAS unsigned char* lds = (LAS unsigned char*)lds_raw;
    cg::grid_group grid = cg::this_grid();
    volatile LAS unsigned* bst = (volatile LAS unsigned*)(lds + LDS_BYTES - 64);
    if (threadIdx.x < 16) bst[threadIdx.x] = 0u;
    __syncthreads();
    const XcdBarrier xbar = xcd_barrier_post((unsigned*)(a.ws + WS_BAR), bst);
    const int tid = threadIdx.x, lane = tid & 63, wave = __builtin_amdgcn_readfirstlane(tid >> 6);
    const int G = gridDim.x, bid = blockIdx.x;
    unsigned char* ws = as_global(a.ws);
    const int NGW = G * 8;

#ifndef NO_PREP
    for (int rep = 0; rep < REP_PREP; ++rep) { prep_phase(ws, lds, bid * 8 + wave, NGW, wave, lane); __syncthreads(); }
#endif
#define XBAR() do { XcdBarrier xb_ = xbar; asm volatile("" : "+s"(xb_.x)); xcd_barrier(xb_); } while (0)
    if (a.ws == nullptr) grid.sync();
    XBAR();

#define FRESH() unsigned char* wsp = ws; int ll = l, bb = bid, gg = G; asm volatile("" : "+s"(wsp), "+s"(ll), "+s"(bb), "+s"(gg)); wsp = as_global(wsp); float* outp = as_global(a.out); (void)outp; unsigned char* wl = wsp + WS_W + (size_t)ll * W_LAYER; (void)wl
#define SSA(k) ss_arr(wsp, 1 + 4 * ll + (k))
#pragma unroll 1
    for (int l = 0; l < DEPTH; ++l) {
        {
            FRESH();
            pg8::Gemm g{(const bf16_t*)(wsp + WS_XB), (const bf16_t*)(wl + W_IN), T, 2048, D, D, D}; pg8::StaticOrder S; S.init(T, 2048, gg, bb);
            EpiInProj E{(bf16_t*)(wsp + WS_BG), (bf16_t*)(wsp + WS_XIN), (bf16_t*)(wsp + WS_U), ll == 0 ? ss_arr(wsp, 0) : ss_arr(wsp, 4), outp + O_CONVP + (size_t)ll * NB * 2 * CH, outp + O_CONVS + (size_t)ll * NDB * 2 * CH};
#ifndef NO_GEMM
            pg8::gemm_phase<EpiInProj, USE_SP2, pg8::StaticOrder>(lds, g, S, E);
#endif
#ifndef NO_SMALL
            small_gemm(g.A, g.Bt, 2048, D, E, bb >= (gg >> 1) ? bb - (gg >> 1) : -1, gg >> 1);
#endif
        }
        {
            FRESH();
            pg8::Gemm g{(const bf16_t*)(wl + W_KV) + (size_t)D * D, (const bf16_t*)(wsp + WS_MNB), D, TM, D, D, D}; pg8::StaticOrder S; S.init(D, TM, gg, (bb + gg - (32 % gg)) % gg);
            EpiVT E{(bf16_t*)(wsp + WS_VT) + (size_t)ll * D * TM, invmem_arr(wsp)};
#ifndef NO_GEMM
            pg8::gemm_phase<EpiVT, USE_SP2, pg8::StaticOrder>(lds, g, S, E);
#endif
        }
        XBAR();
        {
            FRESH();
            int tid2 = threadIdx.x; asm volatile("" : "+v"(tid2)); const int lane2 = tid2 & 63;
            const int w = wave * gg + bb; const int NGW2 = gg * 8;
            for (int rep = 0; rep < REP_SCAN; ++rep) {
#ifndef NO_SCAN
            for (int it = w; it < NB * 32 + NDB * 32; it += NGW2) scan_item(wsp, outp, ll, it, lds + wave * SCAN_LDS_WAVE, lane2);
#endif
#ifndef NO_CONV
            for (int run = NGW2 - 1 - w; run < T / 64; run += NGW2) conv_run(wsp, ll, run, lane2);
#endif
            }
        }
        XBAR();
        {
            FRESH();
            pg8::Gemm g{(const bf16_t*)(wsp + WS_YG), (const bf16_t*)(wl + W_GLU), T, CH, CH, CH, CH}; pg8::StaticOrder S; S.init(T, CH, gg, bb);
            EpiGLU E{(const bf16_t*)(wsp + WS_YG), (bf16_t*)(wsp + WS_YCAT), SSA(0)};
#ifndef NO_GEMM
            pg8::gemm_phase<EpiGLU, USE_SP2, pg8::StaticOrder>(lds, g, S, E);
#endif
#ifndef NO_SMALL
            small_gemm(g.A, g.Bt, CH, CH, E, bb, gg);
#endif
        }
        XBAR();
        {
            FRESH();
            pg8::Gemm g{(const bf16_t*)(wsp + WS_YCAT), (const bf16_t*)(wl + W_OUT), T, D, D, D, D}; pg8::StaticOrder S; S.init(T, D, gg, bb);
            EpiRes<true> E{(bf16_t*)(wsp + WS_XB), SSA(1), SSA(0)};
#ifndef NO_GEMM
            pg8::gemm_phase<EpiRes<true>, USE_SP2, pg8::StaticOrder>(lds, g, S, E);
#endif
#ifndef NO_SMALL
            small_gemm(g.A, g.Bt, D, D, E, bb, gg);
#endif
        }
        {
            FRESH();
            pg8::Gemm g{(const bf16_t*)(wsp + WS_MNB), (const bf16_t*)(wl + W_KV), TM, D, D, D, D}; pg8::StaticOrder S; S.init(TM, D, gg, (bb + gg - (16 % gg)) % gg);
            EpiKV<false> E{outp + O_MKP + (size_t)ll * TM * D, outp + O_MVP + (size_t)ll * TM * D, (bf16_t*)(wsp + WS_KB) + (size_t)ll * TM * D, invmem_arr(wsp)};
#if !defined(NO_GEMM)
            pg8::gemm_phase<EpiKV<false>, USE_SP2, pg8::StaticOrder>(lds, g, S, E);
#endif
        }
        XBAR();
        {
            FRESH();
            pg8::Gemm g{(const bf16_t*)(wsp + WS_XB), (const bf16_t*)(wl + W_Q), T, D, D, D, D}; pg8::StaticOrder S; S.init(T, D, gg, bb);
            EpiScale<0> E{(bf16_t*)(wsp + WS_Q), D, SSA(1)};
#ifndef NO_GEMM
            pg8::gemm_phase<EpiScale<0>, USE_SP2, pg8::StaticOrder>(lds, g, S, E);
#endif
#ifndef NO_SMALL
            small_gemm(g.A, g.Bt, D, D, E, bb, gg);
#endif
        }
        {
            FRESH();
            pg8::Gemm g{(const bf16_t*)(wsp + WS_MNB), (const bf16_t*)(wl + W_KV) + (size_t)D * D, TM, D, D, D, D}; pg8::StaticOrder S; S.init(TM, D, gg, (bb + gg - (16 % gg)) % gg);
            EpiKV<true> E{outp + O_MKP + (size_t)ll * TM * D, outp + O_MVP + (size_t)ll * TM * D, (bf16_t*)(wsp + WS_KB) + (size_t)ll * TM * D, invmem_arr(wsp)};
#if !defined(NO_GEMM)
            pg8::gemm_phase<EpiKV<true>, USE_SP2, pg8::StaticOrder>(lds, g, S, E);
#endif
        }
        XBAR();
        {
            FRESH();
#ifndef NO_ATTN
            for (int rep = 0; rep < REP_ATTN; ++rep) attn_phase(wsp, ll, lds, gg, bb);
#endif
        }
        XBAR();
        {
            FRESH();
            pg8::Gemm g{(const bf16_t*)(wsp + WS_O), (const bf16_t*)(wl + W_O), T, D, D, D, D}; pg8::StaticOrder S; S.init(T, D, gg, bb);
            EpiRes<false> E{(bf16_t*)(wsp + WS_XB), SSA(2), nullptr};
#ifndef NO_GEMM
            pg8::gemm_phase<EpiRes<false>, USE_SP2, pg8::StaticOrder>(lds, g, S, E);
#endif
#ifndef NO_SMALL
            small_gemm(g.A, g.Bt, D, D, E, bb, gg);
#endif
        }
        XBAR();
        {
            FRESH();
            pg8::Gemm g{(const bf16_t*)(wsp + WS_XB), (const bf16_t*)(wl + W_UP), T, DFF, D, D, D}; pg8::StaticOrder S; S.init(T, DFF, gg, bb);
            EpiScale<1> E{(bf16_t*)(wsp + WS_HDN), DFF, SSA(2)};
#ifndef NO_GEMM
            for (int rep = 0; rep < REP_UP; ++rep) pg8::gemm_phase<EpiScale<1>, USE_SP2, pg8::StaticOrder>(lds, g, S, E);
#endif
#ifndef NO_SMALL
            small_gemm(g.A, g.Bt, DFF, D, E, bb, gg);
#endif
        }
        XBAR();
        {
            FRESH();
            pg8::Gemm g{(const bf16_t*)(wsp + WS_HDN), (const bf16_t*)(wl + W_DOWN), TP, D, DFF, DFF, DFF}; pg8::StaticOrder S; S.init(TP, D, gg, bb);
            EpiRes<false> E{(bf16_t*)(wsp + WS_XB), SSA(3), nullptr};
#if !defined(NO_GEMM)
            pg8::gemm_phase<EpiRes<false>, USE_SP2, pg8::StaticOrder>(lds, g, S, E);
#endif
        }
        {
            FRESH();
            pg8::Gemm g{(const bf16_t*)(wsp + WS_HDN) + (size_t)TP * DFF, (const bf16_t*)(wl + W_DOWN), TS, D, D, DFF, DFF}; pg8::KSplitOrder S; S.init(TS, D, 4, D, gg, bb);
            EpiAtomic E{(float*)(wsp + WS_SCR)};
#if !defined(NO_GEMM)
            pg8::gemm_phase<EpiAtomic, USE_SP2, pg8::KSplitOrder>(lds, g, S, E);
#endif
        }
        XBAR();
        {
            FRESH();
            int tid4 = threadIdx.x; asm volatile("" : "+v"(tid4)); const int lane4 = tid4 & 63;
            GAS float* scr = (GAS float*)(wsp + WS_SCR); GAS float* ss3 = (GAS float*)SSA(3);
            for (int r = bb * 8 + wave; r < TS; r += gg * 8) {
                GAS f32x4* sp = (GAS f32x4*)(scr + (size_t)r * D) + lane4; GAS u32x2* xp = (GAS u32x2*)((bf16_t*)(wsp + WS_XB) + (size_t)(TP + r) * D) + lane4;
                float ssum = 0.f;
#pragma unroll
                for (int j = 0; j < 4; ++j) { const f32x4 d = (sp[64 * j] + sp[64 * j + (size_t)TS * D / 4]) + (sp[64 * j + 2 * ((size_t)TS * D / 4)] + sp[64 * j + 3 * ((size_t)TS * D / 4)]); const u32x2 w = xp[64 * j];
                    const f32x4 x = (f32x4){bf_lo(w.x), bf_hi(w.x), bf_lo(w.y), bf_hi(w.y)} + d;
                    ssum += (x[0] * x[0] + x[1] * x[1]) + (x[2] * x[2] + x[3] * x[3]);
                    u32x2 o; o.x = cvt_pk_bf16(x[0], x[1]); o.y = cvt_pk_bf16(x[2], x[3]); xp[64 * j] = o; }
                ssum = wave_sum(ssum);
                if (lane4 == 0) ss3[TP + r] = ssum;
            }
        }
        XBAR();
    }
    {
        int tid3 = threadIdx.x; asm volatile("" : "+v"(tid3)); const int lane = tid3 & 63;
        const bf16_t* XB = (const bf16_t*)(ws + WS_XB); const float* ssf = ss_arr(ws, 1 + 4 + 3); const GAS float* gf = (const GAS float*)(ws + WS_SMALL) + SM_GFIN;
        f32x4 gv[4];
#pragma unroll
        for (int j = 0; j < 4; ++j) gv[j] = *(const GAS f32x4*)(gf + 256 * j + 4 * lane);
        for (int m0 = (bid * 8 + wave) * 4; m0 < T; m0 += NGW * 4) {
            u32x2 wv[4][4]; float inv[4];
#pragma unroll
            for (int r = 0; r < 4; ++r) { const GAS u32x2* xr = (const GAS u32x2*)(XB + (size_t)(m0 + r) * D) + lane;
#pragma unroll
                for (int j = 0; j < 4; ++j) wv[r][j] = xr[64 * j];
                inv[r] = rsqrtf(((const GAS float*)ssf)[m0 + r] * (1.0f / D) + EPS); }
#pragma unroll
            for (int r = 0; r < 4; ++r) { GAS f32x4* o = (GAS f32x4*)(a.out + (size_t)(m0 + r) * D) + lane;
#pragma unroll
                for (int j = 0; j < 4; ++j) { const u32x2 w = wv[r][j]; o[64 * j] = (f32x4){bf_lo(w.x), bf_hi(w.x), bf_lo(w.y), bf_hi(w.y)} * inv[r] * gv[j]; } }
        }
    }
}

extern "C" void kernel_launch(void* const* d_in, const int* in_sizes, int n_in, void* d_out, int out_size, void* d_ws, size_t ws_size, hipStream_t stream) {
    static int grid = 0;
    if (grid == 0) {
        if (n_in != 33 || (size_t)out_size != O_END || ws_size < WS_END) { fprintf(stderr, "kernel_launch: unexpected sizes n_in %d out %d ws %zu (need %zu)\n", n_in, out_size, ws_size, (size_t)WS_END); grid = -1; return; }
        int dev = 0, cus = 0, per_cu = 0;
        (void)hipGetDevice(&dev); (void)hipDeviceGetAttribute(&cus, hipDeviceAttributeMultiprocessorCount, dev);
        if (hipFuncSetAttribute((const void*)hybrid_fwd, hipFuncAttributeMaxDynamicSharedMemorySize, LDS_BYTES) != hipSuccess) { fprintf(stderr, "kernel_launch: hipFuncSetAttribute failed\n"); grid = -1; return; }
        if (hipOccupancyMaxActiveBlocksPerMultiprocessor(&per_cu, (const void*)hybrid_fwd, 512, LDS_BYTES) != hipSuccess || per_cu < 1) { fprintf(stderr, "kernel_launch: occupancy query says %d\n", per_cu); per_cu = 1; }
        (void)hipGetLastError();
        grid = cus > 0 ? cus : 256;
    }
    if (grid < 0) return;
    if (hipMemsetAsync((char*)d_ws + WS_BAR, 0, BAR_BYTES, stream) != hipSuccess) { fprintf(stderr, "kernel_launch: hipMemsetAsync failed\n"); return; }
    Args a{};
    for (int i = 0; i < 33; ++i) a.in[i] = (const float*)d_in[i];
    a.out = (float*)d_out; a.ws = (unsigned char*)d_ws;
    void* args[] = {&a};
    hipError_t e = hipLaunchCooperativeKernel((const void*)hybrid_fwd, dim3(grid), dim3(512), args, LDS_BYTES, stream);
    if (e != hipSuccess) fprintf(stderr, "kernel_launch: cooperative launch failed: %s (grid %d)\n", hipGetErrorString(e), grid);
}
```

```cpp
#include <hip/hip_runtime.h>
#include <hip/hip_cooperative_groups.h>
#include <cstdio>
#include <cstdint>
namespace cg = cooperative_groups;
#define NO_SMALL 1
#ifndef REP_PREP
#define REP_PREP 1
#endif
#ifndef REP_SCAN
#define REP_SCAN 1
#endif
#ifndef REP_ATTN
#define REP_ATTN 1
#endif
#ifndef REP_UP
#define REP_UP 1
#endif

#define LAS __attribute__((address_space(3)))
#define GAS __attribute__((address_space(1)))
typedef unsigned short bf16_t;
typedef short bf16x8 __attribute__((ext_vector_type(8)));
typedef short bf16x4 __attribute__((ext_vector_type(4)));
typedef float f32x2 __attribute__((ext_vector_type(2)));
typedef float f32x4 __attribute__((ext_vector_type(4)));
typedef float f32x16 __attribute__((ext_vector_type(16)));
typedef unsigned u32x4 __attribute__((ext_vector_type(4)));
typedef unsigned u32x2 __attribute__((ext_vector_type(2)));

constexpr int D = 1024, NB = 32, SEQ = 2048, NDB = 16, DSEQ = 64, DEPTH = 2;
constexpr int TP = NB * SEQ, TS = NDB * DSEQ, T = TP + TS;
constexpr int NMEM = 256, TM = NB * NMEM, TMS = NDB * NMEM;
constexpr int DFF = 4096, CH = 512;
constexpr float EPS = 1e-6f;
constexpr size_t O_YP = 0, O_YS = O_YP + (size_t)TP * D, O_CONVP = O_YS + (size_t)TS * D, O_REP = O_CONVP + (size_t)DEPTH * NB * 2 * CH,
                 O_IMP = O_REP + (size_t)DEPTH * NB * 32 * 64, O_MKP = O_IMP + (size_t)DEPTH * NB * 32 * 64, O_MVP = O_MKP + (size_t)DEPTH * TM * D,
                 O_CONVS = O_MVP + (size_t)DEPTH * TM * D, O_RES = O_CONVS + (size_t)DEPTH * NDB * 2 * CH, O_IMS = O_RES + (size_t)DEPTH * NDB * 32 * 64,
                 O_END = O_IMS + (size_t)DEPTH * NDB * 32 * 64;
constexpr size_t MiB = 1u << 20;
constexpr size_t WS_SS = 0;
constexpr size_t WS_BAR = 3 * MiB + MiB / 2, BAR_BYTES = 16384;
constexpr size_t WS_W = 4 * MiB, W_LAYER = 31 * MiB;
constexpr size_t W_IN = 0, W_GLU = 4 * MiB, W_OUT = 4 * MiB + MiB / 2, W_Q = 6 * MiB + MiB / 2, W_KV = 8 * MiB + MiB / 2, W_O = 12 * MiB + MiB / 2,
                 W_UP = 14 * MiB + MiB / 2, W_DOWN = 22 * MiB + MiB / 2;
constexpr size_t WS_XB = 66 * MiB;
constexpr size_t WS_MNB = 196 * MiB;
constexpr size_t WS_KB = 212 * MiB;
constexpr size_t WS_VT = 244 * MiB;
constexpr size_t WS_KC = 276 * MiB;
constexpr size_t WS_VTC = 292 * MiB;
constexpr size_t WS_BIG = 308 * MiB;
constexpr size_t SZ_T512 = (size_t)T * 512 * 2;
constexpr size_t WS_BG = WS_BIG, WS_XIN = WS_BG + SZ_T512, WS_U = WS_XIN + SZ_T512, WS_YG = WS_U + SZ_T512, WS_YCAT = WS_YG + SZ_T512;
constexpr size_t WS_Q = WS_BG, WS_O = WS_U, WS_HDN = WS_BIG;
constexpr size_t WS_SMALL = WS_BIG + (size_t)T * DFF * 2;
constexpr size_t WS_SCR = WS_SMALL + 4 * MiB;
constexpr size_t WS_END = WS_SCR + 16 * MiB;
constexpr int SM_ARE = 0, SM_AIM = 4096, SM_LOGDT = 8192, SM_BRE = 8256, SM_BIM = SM_BRE + 65536, SM_CRE = SM_BIM + 65536, SM_CIM = SM_CRE + 65536, SM_SD = SM_CIM + 65536,
              SM_CONVW = SM_SD + 1024, SM_SCONV = SM_CONVW + 3072, SM_SRE = SM_SCONV + 32768, SM_SIM = SM_SRE + 65536, SM_GFIN = SM_SIM + 65536, SM_END = SM_GFIN + 1024;
static_assert(WS_YCAT + 2 * SZ_T512 <= WS_END, "ws map");

constexpr int LDS_BYTES = 256 * 528 + 1024;

template <class Tp> __device__ __forceinline__ Tp* as_global(Tp* p) {
#if defined(__HIP_DEVICE_COMPILE__)
    __builtin_assume(!__builtin_amdgcn_is_shared((const __attribute__((address_space(0))) void*)p) && !__builtin_amdgcn_is_private((const __attribute__((address_space(0))) void*)p));
#endif
    return p;
}
__device__ __forceinline__ unsigned cvt_pk_bf16(float lo, float hi) { unsigned r; asm volatile("v_cvt_pk_bf16_f32 %0, %1, %2" : "=v"(r) : "v"(lo), "v"(hi)); return r; }
__device__ __forceinline__ float bf_lo(unsigned w) { return __uint_as_float(w << 16); }
__device__ __forceinline__ float bf_hi(unsigned w) { return __uint_as_float(w & 0xffff0000u); }
__device__ __forceinline__ float wave_sum(float v) {
#pragma unroll
    for (int o = 1; o < 64; o <<= 1) v += __shfl_xor(v, o);
    return v;
}
#define LDS_WAIT() asm volatile("s_waitcnt lgkmcnt(0)" ::: "memory")

namespace pg8 {
constexpr int BM = 256, BK = 64, HALF = 128, HTB = HALF * BK * 2, STAGE_BYTES = 8 * HTB, NXCD = 8, WGM = 8;
__host__ __device__ __forceinline__ int lds_byte(int r, int c) { const int st = (r >> 4) * 2 + (c >> 5), rr = r & 15, cc = c & 31, ob = rr * 64 + cc * 2; return st * 1024 + (ob ^ (((ob >> 9) & 1) << 5)); }
__host__ __device__ __forceinline__ void stage_rc(int b, int& R, int& C) { const int st = b / 1024, sb = b % 1024, swz = sb ^ (((sb >> 9) & 1) << 5); R = (st >> 1) * 16 + swz / 64; C = (st & 1) * 32 + (swz % 64) / 2; }
__host__ __device__ __forceinline__ int perm32(int rho) { const int n = rho >> 4, i = rho & 15; return 8 * (i >> 2) + 4 * n + (i & 3); }

struct Unit { int pm, pn, ko; };
struct Gemm { const bf16_t* A; const bf16_t* Bt; int M, N, K, lda, ldb; };

struct StaticOrder {
    int nM, nN, nwg, G, c;
    __device__ void init(int M, int N, int G_, int c_) { nM = M / BM; nN = N / BM; nwg = nM * nN; G = G_; c = c_; }
    __device__ bool next(int i, Unit& u) const {
        const long L = (long)i * G + c; if (L >= nwg) return false;
        int wgid = (int)L; { const int q = nwg / NXCD, r = nwg % NXCD, xcd = wgid % NXCD, off = wgid / NXCD; wgid = (xcd < r ? xcd * (q + 1) : r * (q + 1) + (xcd - r) * q) + off; }
        const int nig = WGM * nN, gid = wgid / nig, fm = gid * WGM, gsz = (nM - fm) < WGM ? (nM - fm) : WGM;
        u.pm = fm + ((wgid % nig) % gsz); u.pn = (wgid % nig) / gsz; u.ko = 0; return true;
    }
};
struct KSplitOrder {
    int nN, nS, nwg, G, c, kslice_bytes;
    __device__ void init(int M, int N, int nS_, int kslice, int G_, int c_) { nN = N / BM; nS = nS_; nwg = (M / BM) * nN * nS; G = G_; c = c_; kslice_bytes = kslice * 2; }
    __device__ bool next(int i, Unit& u) const {
        const long L = (long)i * G + c; if (L >= nwg) return false;
        const int l = (int)L, sidx = l % nS, t = l / nS; u.pn = t % nN; u.pm = t / nN; u.ko = sidx * kslice_bytes; return true;
    }
};

template <class Epi, bool SP2, class Sched>
__device__ __forceinline__ void gemm_phase(LAS unsigned char* lds, const Gemm g, const Sched& S, const Epi& E) {
    int tid = threadIdx.x; asm volatile("" : "+v"(tid));
    const int wid = __builtin_amdgcn_readfirstlane(tid >> 6), lane = tid & 63, wr = wid >> 2, wc = wid & 3, fr = lane & 15, fq = lane >> 4;
    const int K = g.K, nt = K / BK;
    unsigned voffA[2], voffB[2];
#pragma unroll
    for (int i = 0; i < 2; ++i) { int R, C; stage_rc(tid * 16 + i * 8192, R, C); const int Rb = Epi::PERM ? ((R & ~31) + perm32(R & 31)) : R;
        voffA[i] = (unsigned)(R * g.lda + C) * 2u; voffB[i] = (unsigned)(Rb * g.ldb + C) * 2u; }
    const size_t kstep = (size_t)(BK * 2);
    const size_t hstep = (size_t)HALF * g.lda * 2, hstepB = (size_t)HALF * g.ldb * 2;
    const size_t tstep = 2 * hstep, tstepB = 2 * hstepB;
    const unsigned ldsw = (unsigned)wid * 1024u;
    const int aoff = lds_byte(wr * 64 + fr, fq * 8), boff = lds_byte(wc * 32 + fr, fq * 8);
#define PG8_SA(b, h) (((b) * 2 + (h)) * HTB)
#define PG8_SB(b, h) ((4 + (b) * 2 + (h)) * HTB)
#define PG8_STAGE(bufoff, gbase, voff) do { _Pragma("unroll") for (int _i = 0; _i < 2; ++_i) \
        __builtin_amdgcn_global_load_lds((const unsigned*)((const char*)(gbase) + (voff)[_i]), (LAS unsigned*)(lds + (bufoff) + ldsw + _i * 8192), 16, 0, 0); } while (0)
#define PG8_LDA(dst, b, h) do { _Pragma("unroll") for (int m = 0; m < 4; ++m) _Pragma("unroll") for (int k = 0; k < 2; ++k) dst[m][k] = *(const LAS bf16x8*)(lds + PG8_SA(b, h) + aoff + m * 2048 + k * 1024); } while (0)
#define PG8_LDB(dst, b, h) do { _Pragma("unroll") for (int n = 0; n < 2; ++n) _Pragma("unroll") for (int k = 0; k < 2; ++k) dst[n][k] = *(const LAS bf16x8*)(lds + PG8_SB(b, h) + boff + n * 2048 + k * 1024); } while (0)
#define PG8_MMA(ai, bj, At, Bt) do { __builtin_amdgcn_s_setprio(1); _Pragma("unroll") for (int m = 0; m < 4; ++m) _Pragma("unroll") for (int n = 0; n < 2; ++n) _Pragma("unroll") for (int k = 0; k < 2; ++k) \
        acc[ai][bj][m][n] = __builtin_amdgcn_mfma_f32_16x16x32_bf16(Bt[n][k], At[m][k], acc[ai][bj][m][n], 0, 0, 0); __builtin_amdgcn_s_setprio(0); } while (0)
#define PG8_WAIT_V(n) asm volatile("s_waitcnt vmcnt(" #n ")" ::: "memory")
#define PG8_WAIT_L(n) asm volatile("s_waitcnt lgkmcnt(" #n ")" ::: "memory")
#define PG8_BAR __builtin_amdgcn_s_barrier()
#define PG8_SCHED __builtin_amdgcn_sched_barrier(0)
    Unit cur, nxt; int ui = 0;
    if (!S.next(0, cur)) return;
    f32x4 acc[2][2][4][2];
#pragma unroll
    for (int a = 0; a < 2; ++a)
#pragma unroll
        for (int b = 0; b < 2; ++b)
#pragma unroll
            for (int m = 0; m < 4; ++m)
#pragma unroll
                for (int n = 0; n < 2; ++n) acc[a][b][m][n] = (f32x4){0.f, 0.f, 0.f, 0.f};
    bf16x8 At[4][2], B0[2][2], B1[2][2];
    const char* cA = (const char*)g.A + (size_t)cur.pm * tstep + cur.ko; const char* cB = (const char*)g.Bt + (size_t)cur.pn * tstepB + cur.ko;
    if constexpr (SP2) {
        PG8_STAGE(PG8_SB(0, 0), cB, voffB); PG8_STAGE(PG8_SB(0, 1), cB + hstepB, voffB); PG8_STAGE(PG8_SA(0, 0), cA, voffA); PG8_STAGE(PG8_SA(0, 1), cA + hstep, voffA);
        if (wr == 1) PG8_BAR;
        PG8_WAIT_V(2); PG8_BAR;
        PG8_STAGE(PG8_SB(1, 0), cB + kstep, voffB); PG8_STAGE(PG8_SA(1, 0), cA + kstep, voffA); PG8_STAGE(PG8_SB(1, 1), cB + hstepB + kstep, voffB);
        PG8_WAIT_V(6); PG8_BAR;
    } else {
        PG8_STAGE(PG8_SB(0, 0), cB, voffB); PG8_STAGE(PG8_SA(0, 0), cA, voffA); PG8_STAGE(PG8_SB(0, 1), cB + hstepB, voffB); PG8_STAGE(PG8_SA(0, 1), cA + hstep, voffA);
        if (wr == 1) PG8_BAR;
        PG8_WAIT_V(4); PG8_BAR;
        PG8_STAGE(PG8_SB(1, 0), cB + kstep, voffB); PG8_STAGE(PG8_SA(1, 0), cA + kstep, voffA); PG8_STAGE(PG8_SB(1, 1), cB + hstepB + kstep, voffB);
        PG8_WAIT_V(6); PG8_BAR;
    }
    for (;;) {
        const bool has_next = S.next(ui + 1, nxt);
        const char* nA = has_next ? (const char*)g.A + (size_t)nxt.pm * tstep + nxt.ko : cA; const char* nB = has_next ? (const char*)g.Bt + (size_t)nxt.pn * tstepB + nxt.ko : cB;
        for (int t = 0; t < nt; t += 2) {
            const bool last = (t == nt - 2);
            const char* a1 = cA + (size_t)(t + 1) * kstep;
            const char* a2 = last ? nA : cA + (size_t)(t + 2) * kstep; const char* b2 = last ? nB : cB + (size_t)(t + 2) * kstep;
            const char* a3 = a2 + kstep; const char* b3 = b2 + kstep;
            if constexpr (Epi::MID) { if (t == (nt >> 1)) E.mid(acc, cur, wr, fr); }
            if constexpr (SP2) {
            PG8_LDB(B0, 0, 0); PG8_LDB(B1, 0, 1); PG8_SCHED; PG8_LDA(At, 0, 0); PG8_STAGE(PG8_SA(1, 1), a1 + hstep, voffA);
            PG8_WAIT_V(8); PG8_WAIT_L(0); PG8_BAR; PG8_MMA(0, 0, At, B0); PG8_MMA(0, 1, At, B1); PG8_BAR; PG8_SCHED;
            PG8_LDA(At, 0, 1); PG8_STAGE(PG8_SB(0, 0), b2, voffB); PG8_STAGE(PG8_SB(0, 1), b2 + hstepB, voffB); PG8_STAGE(PG8_SA(0, 0), a2, voffA);
            PG8_WAIT_V(8); PG8_WAIT_L(0); PG8_BAR; PG8_MMA(1, 0, At, B0); PG8_MMA(1, 1, At, B1); PG8_BAR; PG8_SCHED;
            PG8_LDB(B0, 1, 0); PG8_LDB(B1, 1, 1); PG8_SCHED; PG8_LDA(At, 1, 0); PG8_STAGE(PG8_SA(0, 1), a2 + hstep, voffA);
            PG8_WAIT_V(8); PG8_WAIT_L(0); PG8_BAR; PG8_MMA(0, 0, At, B0); PG8_MMA(0, 1, At, B1); PG8_BAR; PG8_SCHED;
            PG8_LDA(At, 1, 1); PG8_STAGE(PG8_SB(1, 0), b3, voffB); PG8_STAGE(PG8_SB(1, 1), b3 + hstepB, voffB); PG8_STAGE(PG8_SA(1, 0), a3, voffA);
            PG8_WAIT_V(8); PG8_WAIT_L(0); PG8_BAR; PG8_MMA(1, 0, At, B0); PG8_MMA(1, 1, At, B1); PG8_BAR; PG8_SCHED;
            } else {
            PG8_LDB(B0, 0, 0); PG8_SCHED; PG8_LDA(At, 0, 0); PG8_STAGE(PG8_SA(1, 1), a1 + hstep, voffA);
            PG8_WAIT_L(8); PG8_BAR; PG8_WAIT_L(0); PG8_MMA(0, 0, At, B0); PG8_BAR; PG8_SCHED;
            PG8_LDB(B1, 0, 1); PG8_STAGE(PG8_SB(0, 0), b2, voffB);
            PG8_BAR; PG8_WAIT_L(0); PG8_MMA(0, 1, At, B1); PG8_BAR;
            PG8_LDA(At, 0, 1); PG8_STAGE(PG8_SA(0, 0), a2, voffA);
            PG8_BAR; PG8_WAIT_L(0); PG8_MMA(1, 0, At, B0); PG8_BAR; PG8_SCHED;
            PG8_STAGE(PG8_SB(0, 1), b2 + hstepB, voffB);
            PG8_WAIT_V(6); PG8_BAR; PG8_MMA(1, 1, At, B1); PG8_BAR;
            PG8_LDB(B0, 1, 0); PG8_SCHED; PG8_LDA(At, 1, 0); PG8_STAGE(PG8_SA(0, 1), a2 + hstep, voffA);
            PG8_WAIT_L(8); PG8_BAR; PG8_WAIT_L(0); PG8_MMA(0, 0, At, B0); PG8_BAR; PG8_SCHED;
            PG8_LDB(B1, 1, 1); PG8_STAGE(PG8_SB(1, 0), b3, voffB);
            PG8_BAR; PG8_WAIT_L(0); PG8_MMA(0, 1, At, B1); PG8_BAR;
            PG8_LDA(At, 1, 1); PG8_STAGE(PG8_SA(1, 0), a3, voffA);
            PG8_BAR; PG8_WAIT_L(0); PG8_MMA(1, 0, At, B0); PG8_BAR; PG8_SCHED;
            PG8_STAGE(PG8_SB(1, 1), b3 + hstepB, voffB);
            PG8_WAIT_V(6); PG8_BAR; PG8_MMA(1, 1, At, B1); PG8_BAR;
            }
        }
        if (wr == 0) PG8_BAR;
        E(acc, cur, wr, wc, fr, fq);
        if (!has_next) break;
#pragma unroll
        for (int a = 0; a < 2; ++a)
#pragma unroll
            for (int b = 0; b < 2; ++b)
#pragma unroll
                for (int m = 0; m < 4; ++m)
#pragma unroll
                    for (int n = 0; n < 2; ++n) acc[a][b][m][n] = (f32x4){0.f, 0.f, 0.f, 0.f};
        cur = nxt; cA = nA; cB = nB; ++ui;
        if (wr == 1) PG8_BAR;
    }
    PG8_WAIT_V(0);
    PG8_BAR;
#undef PG8_SA
#undef PG8_SB
#undef PG8_STAGE
#undef PG8_LDA
#undef PG8_LDB
#undef PG8_MMA
#undef PG8_WAIT_V
#undef PG8_WAIT_L
#undef PG8_BAR
#undef PG8_SCHED
}
}
using pg8::Unit;
typedef f32x4 Acc[2][2][4][2];

__device__ __forceinline__ void store8_bf16(bf16_t* p, const f32x4& a, const f32x4& b) {
    u32x4 w; w.x = cvt_pk_bf16(a[0], a[1]); w.y = cvt_pk_bf16(a[2], a[3]); w.z = cvt_pk_bf16(b[0], b[1]); w.w = cvt_pk_bf16(b[2], b[3]);
    *(GAS u32x4*)p = w;
}
__device__ __forceinline__ void unpack8(const u32x4 w, f32x4& a, f32x4& b) {
    a = (f32x4){bf_lo(w.x), bf_hi(w.x), bf_lo(w.y), bf_hi(w.y)}; b = (f32x4){bf_lo(w.z), bf_hi(w.z), bf_lo(w.w), bf_hi(w.w)};
}

struct EpiInProj {
    static constexpr bool PERM = true, MID = false;
    bf16_t* BG; bf16_t* XIN; bf16_t* U; const float* ss; float* convp; float* convs;
    __device__ __forceinline__ int brow(int cb, int f) const {
        const int cg = cb >> 5;
        if (cg < 16) return cb + 16 * f;
        if (cg >= 48) return 1536 + 32 * (cg - 48) + 16 * f;
        const int c = 16 * (cg - 16), q = c >> 7, r = c & 127;
        return 512 + 256 * q + 128 * f + r;
    }
    __device__ __forceinline__ void small(const f32x4 (&acc)[2][2], int r0, int cb, int fr, int fq) const {
        const int cg = cb >> 5;
#pragma unroll
        for (int m = 0; m < 2; ++m) {
            const int r = r0 + 16 * m + fr; const float inv = rsqrtf(((const GAS float*)ss)[r] * (1.0f / D) + EPS);
            if (cg < 16 || cg >= 48) {
                bf16_t* dst = (cg < 16 ? BG + (size_t)r * CH + cb : U + (size_t)r * CH + (cb - 1536)) + 4 * fq;
#pragma unroll
                for (int f = 0; f < 2; ++f) { const f32x4 v = acc[m][f] * inv; u32x2 w; w.x = cvt_pk_bf16(v[0], v[1]); w.y = cvt_pk_bf16(v[2], v[3]); *(GAS u32x2*)(dst + 16 * f) = w; }
            } else {
                const int c0 = 16 * (cg - 16) + 4 * fq;
                const f32x4 x = (acc[m][0] * inv) * (acc[m][1] * inv);
                u32x2 w; w.x = cvt_pk_bf16(x[0], x[1]); w.y = cvt_pk_bf16(x[2], x[3]); *(GAS u32x2*)(XIN + (size_t)r * CH + c0) = w;
                const int rs = r - TP, t = rs & (DSEQ - 1);
                if (t >= DSEQ - 2) *(GAS f32x4*)(convs + ((size_t)(rs >> 6) * 2 + (t - (DSEQ - 2))) * CH + c0) = x;
            }
        }
    }
    __device__ __forceinline__ void operator()(const Acc& acc, const Unit& u, int wr, int wc, int fr, int fq) const {
        const int row0 = u.pm * 256 + wr * 64 + fr, cb = wc * 32 + 8 * fq;
#pragma unroll
        for (int ai = 0; ai < 2; ++ai)
#pragma unroll
            for (int m = 0; m < 4; ++m) {
                const int r = row0 + ai * 128 + m * 16;
                const float inv = rsqrtf(((const GAS float*)ss)[r] * (1.0f / D) + EPS);
                if (u.pn < 2 || u.pn >= 6) {
                    bf16_t* dst = (u.pn < 2 ? BG : U) + (size_t)r * CH + (u.pn & 1) * 256 + cb;
#pragma unroll
                    for (int bj = 0; bj < 2; ++bj) store8_bf16(dst + bj * 128, acc[ai][bj][m][0] * inv, acc[ai][bj][m][1] * inv);
                } else {
                    const int c0 = (u.pn - 2) * 128 + cb;
                    const f32x4 x0 = (acc[ai][0][m][0] * inv) * (acc[ai][1][m][0] * inv), x1 = (acc[ai][0][m][1] * inv) * (acc[ai][1][m][1] * inv);
                    store8_bf16(XIN + (size_t)r * CH + c0, x0, x1);
                    float* cd = nullptr;
                    if (r < TP) { const int t = r & (SEQ - 1); if (t >= SEQ - 2) cd = convp + ((size_t)(r >> 11) * 2 + (t - (SEQ - 2))) * CH + c0; }
                    else { const int rs = r - TP, t = rs & (DSEQ - 1); if (t >= DSEQ - 2) cd = convs + ((size_t)(rs >> 6) * 2 + (t - (DSEQ - 2))) * CH + c0; }
                    if (cd) { *(GAS f32x4*)cd = x0; *(GAS f32x4*)(cd + 4) = x1; }
                }
            }
    }
};
template <bool VPART> struct EpiKV {
    static constexpr bool PERM = false, MID = false;
    float* outK; float* outV; bf16_t* KB; const float* invm;
    __device__ __forceinline__ void operator()(const Acc& acc, const Unit& u, int wr, int wc, int fr, int fq) const {
        const int row0 = u.pm * 256 + wr * 64 + fr, col0 = (u.pn & 3) * 256 + wc * 32 + 4 * fq;
        float* outp = VPART ? outV : outK;
#pragma unroll
        for (int ai = 0; ai < 2; ++ai)
#pragma unroll
            for (int m = 0; m < 4; ++m) {
                const int r = row0 + ai * 128 + m * 16; const float inv = ((const GAS float*)invm)[r];
#pragma unroll
                for (int bj = 0; bj < 2; ++bj)
#pragma unroll
                    for (int n = 0; n < 2; ++n) {
                        const f32x4 v = acc[ai][bj][m][n] * inv; const size_t o = (size_t)r * D + col0 + bj * 128 + n * 16;
                        *(GAS f32x4*)(outp + o) = v;
                        if (!VPART) { u32x2 w; w.x = cvt_pk_bf16(v[0], v[1]); w.y = cvt_pk_bf16(v[2], v[3]); *(GAS u32x2*)(KB + o) = w; }
                    }
            }
    }
};
struct EpiVT {
    static constexpr bool PERM = true, MID = false;
    bf16_t* VT; const float* invm;
    __device__ __forceinline__ void operator()(const Acc& acc, const Unit& u, int wr, int wc, int fr, int fq) const {
        const int row0 = u.pm * 256 + wr * 64 + fr, col0 = u.pn * 256 + wc * 32 + 8 * fq;
        f32x4 s[2][2];
#pragma unroll
        for (int bj = 0; bj < 2; ++bj) { s[bj][0] = *(const GAS f32x4*)(invm + col0 + bj * 128); s[bj][1] = *(const GAS f32x4*)(invm + col0 + bj * 128 + 4); }
#pragma unroll
        for (int ai = 0; ai < 2; ++ai)
#pragma unroll
            for (int m = 0; m < 4; ++m) {
                const int r = row0 + ai * 128 + m * 16;
#pragma unroll
                for (int bj = 0; bj < 2; ++bj) store8_bf16(VT + (size_t)r * TM + col0 + bj * 128, acc[ai][bj][m][0] * s[bj][0], acc[ai][bj][m][1] * s[bj][1]);
            }
    }
};
struct EpiGLU {
    static constexpr bool PERM = true, MID = false;
    const bf16_t* YG; bf16_t* YCAT; float* ssb;
    __device__ __forceinline__ int brow(int cb, int f) const { return cb + 16 * f; }
    __device__ __forceinline__ void small(const f32x4 (&acc)[2][2], int r0, int cb, int fr, int fq) const {
#pragma unroll
        for (int m = 0; m < 2; ++m) {
            const int r = r0 + 16 * m + fr; float ssum = 0.f;
#pragma unroll
            for (int f = 0; f < 2; ++f) {
                const int c = cb + 16 * f + 4 * fq; const u32x2 yw = *(const GAS u32x2*)(YG + (size_t)r * CH + c);
                f32x4 y = (f32x4){bf_lo(yw.x), bf_hi(yw.x), bf_lo(yw.y), bf_hi(yw.y)};
#pragma unroll
                for (int e = 0; e < 4; ++e) { y[e] = y[e] * __builtin_amdgcn_rcpf(1.0f + __expf(-acc[m][f][e])); ssum += y[e] * y[e]; }
                u32x2 w; w.x = cvt_pk_bf16(y[0], y[1]); w.y = cvt_pk_bf16(y[2], y[3]); *(GAS u32x2*)(YCAT + (size_t)r * D + c) = w;
            }
            ssum += __shfl_xor(ssum, 16); ssum += __shfl_xor(ssum, 32);
            if (fq == 0) atomicAdd(ssb + r, ssum);
        }
    }
    __device__ __forceinline__ void operator()(const Acc& acc, const Unit& u, int wr, int wc, int fr, int fq) const {
        const int row0 = u.pm * 256 + wr * 64 + fr, col0 = u.pn * 256 + wc * 32 + 8 * fq;
#pragma unroll
        for (int ai = 0; ai < 2; ++ai)
#pragma unroll
            for (int m = 0; m < 4; ++m) {
                const int r = row0 + ai * 128 + m * 16; float ssum = 0.f;
#pragma unroll
                for (int bj = 0; bj < 2; ++bj) {
                    f32x4 y0, y1; unpack8(*(const GAS u32x4*)(YG + (size_t)r * CH + col0 + bj * 128), y0, y1);
                    f32x4 z0 = acc[ai][bj][m][0], z1 = acc[ai][bj][m][1];
#pragma unroll
                    for (int e = 0; e < 4; ++e) { y0[e] = y0[e] * __builtin_amdgcn_rcpf(1.0f + __expf(-z0[e])); y1[e] = y1[e] * __builtin_amdgcn_rcpf(1.0f + __expf(-z1[e]));
                        ssum += y0[e] * y0[e] + y1[e] * y1[e]; }
                    store8_bf16(YCAT + (size_t)r * D + col0 + bj * 128, y0, y1);
                }
                ssum += __shfl_xor(ssum, 16); ssum += __shfl_xor(ssum, 32);
                if (fq == 0) atomicAdd(ssb + r, ssum);
            }
    }
};
template <bool MIDS> struct EpiRes {
    static constexpr bool PERM = true, MID = MIDS;
    bf16_t* XB; float* ssout; const float* ssb;
    __device__ __forceinline__ int brow(int cb, int f) const { return cb + 16 * f; }
    __device__ __forceinline__ void mid_small(f32x4 (&acc)[2][2], int r0, int fr) const {
#pragma unroll
        for (int m = 0; m < 2; ++m) { const float sc = rsqrtf(((const GAS float*)ssb)[r0 + 16 * m + fr] * (1.0f / CH) + EPS); acc[m][0] *= sc; acc[m][1] *= sc; }
    }
    __device__ __forceinline__ void small(const f32x4 (&acc)[2][2], int r0, int cb, int fr, int fq) const {
#pragma unroll
        for (int m = 0; m < 2; ++m) {
            const int r = r0 + 16 * m + fr; float ssum = 0.f;
#pragma unroll
            for (int f = 0; f < 2; ++f) {
                bf16_t* p = XB + (size_t)r * D + cb + 16 * f + 4 * fq; const u32x2 xw = *(const GAS u32x2*)p;
                f32x4 x = (f32x4){bf_lo(xw.x), bf_hi(xw.x), bf_lo(xw.y), bf_hi(xw.y)} + acc[m][f];
#pragma unroll
                for (int e = 0; e < 4; ++e) ssum += x[e] * x[e];
                u32x2 w; w.x = cvt_pk_bf16(x[0], x[1]); w.y = cvt_pk_bf16(x[2], x[3]); *(GAS u32x2*)p = w;
            }
            ssum += __shfl_xor(ssum, 16); ssum += __shfl_xor(ssum, 32);
            if (fq == 0) atomicAdd(ssout + r, ssum);
        }
    }
    __device__ __forceinline__ void mid(Acc& acc, const Unit& u, int wr, int fr) const {
        const int row0 = u.pm * 256 + wr * 64 + fr;
#pragma unroll
        for (int ai = 0; ai < 2; ++ai)
#pragma unroll
            for (int m = 0; m < 4; ++m) {
                const float s = rsqrtf(((const GAS float*)ssb)[row0 + ai * 128 + m * 16] * (1.0f / CH) + EPS);
#pragma unroll
                for (int bj = 0; bj < 2; ++bj)
#pragma unroll
                    for (int n = 0; n < 2; ++n) acc[ai][bj][m][n] *= s;
            }
    }
    __device__ __forceinline__ void operator()(const Acc& acc, const Unit& u, int wr, int wc, int fr, int fq) const {
        const int row0 = u.pm * 256 + wr * 64 + fr, col0 = u.pn * 256 + wc * 32 + 8 * fq;
#pragma unroll
        for (int ai = 0; ai < 2; ++ai)
#pragma unroll
            for (int m = 0; m < 4; ++m) {
                const int r = row0 + ai * 128 + m * 16; float ssum = 0.f;
#pragma unroll
                for (int bj = 0; bj < 2; ++bj) {
                    bf16_t* p = XB + (size_t)r * D + col0 + bj * 128;
                    f32x4 x0, x1; unpack8(*(const GAS u32x4*)p, x0, x1);
                    x0 += acc[ai][bj][m][0]; x1 += acc[ai][bj][m][1];
#pragma unroll
                    for (int e = 0; e < 4; ++e) ssum += x0[e] * x0[e] + x1[e] * x1[e];
                    store8_bf16(p, x0, x1);
                }
                ssum += __shfl_xor(ssum, 16); ssum += __shfl_xor(ssum, 32);
                if (fq == 0) atomicAdd(ssout + r, ssum);
            }
    }
};
template <int ACT> struct EpiScale {
    static constexpr bool PERM = true, MID = false;
    bf16_t* OUT; int ldc; const float* ss;
    __device__ __forceinline__ int brow(int cb, int f) const { return cb + 16 * f; }
    __device__ __forceinline__ void small(const f32x4 (&acc)[2][2], int r0, int cb, int fr, int fq) const {
#pragma unroll
        for (int m = 0; m < 2; ++m) {
            const int r = r0 + 16 * m + fr; const float inv = rsqrtf(((const GAS float*)ss)[r] * (1.0f / D) + EPS);
#pragma unroll
            for (int f = 0; f < 2; ++f) {
                f32x4 v = acc[m][f] * inv;
                if (ACT == 1) {
#pragma unroll
                    for (int e = 0; e < 4; ++e) { const float a = fmaxf(v[e], 0.f); v[e] = a * a; }
                }
                u32x2 w; w.x = cvt_pk_bf16(v[0], v[1]); w.y = cvt_pk_bf16(v[2], v[3]); *(GAS u32x2*)(OUT + (size_t)r * ldc + cb + 16 * f + 4 * fq) = w;
            }
        }
    }
    __device__ __forceinline__ void operator()(const Acc& acc, const Unit& u, int wr, int wc, int fr, int fq) const {
        const int row0 = u.pm * 256 + wr * 64 + fr, col0 = u.pn * 256 + wc * 32 + 8 * fq;
#pragma unroll
        for (int ai = 0; ai < 2; ++ai)
#pragma unroll
            for (int m = 0; m < 4; ++m) {
                const int r = row0 + ai * 128 + m * 16; const float inv = rsqrtf(((const GAS float*)ss)[r] * (1.0f / D) + EPS);
#pragma unroll
                for (int bj = 0; bj < 2; ++bj) {
                    f32x4 v0 = acc[ai][bj][m][0] * inv, v1 = acc[ai][bj][m][1] * inv;
                    if (ACT == 1) {
#pragma unroll
                        for (int e = 0; e < 4; ++e) { const float a = fmaxf(v0[e], 0.f), b = fmaxf(v1[e], 0.f); v0[e] = a * a; v1[e] = b * b; }
                    }
                    if (ACT == 1) {
                        u32x4 w; w.x = cvt_pk_bf16(v0[0], v0[1]); w.y = cvt_pk_bf16(v0[2], v0[3]); w.z = cvt_pk_bf16(v1[0], v1[1]); w.w = cvt_pk_bf16(v1[2], v1[3]);
                        __builtin_nontemporal_store(w, (GAS u32x4*)(OUT + (size_t)r * ldc + col0 + bj * 128));
                    } else store8_bf16(OUT + (size_t)r * ldc + col0 + bj * 128, v0, v1);
                }
            }
    }
};

template <class Epi>
__device__ __forceinline__ void small_gemm(const bf16_t* A, const bf16_t* Bt, int N, int K, const Epi& E, int c, int stride) {
    int tid = threadIdx.x; asm volatile("" : "+v"(tid));
    const int wave = __builtin_amdgcn_readfirstlane(tid >> 6), lane = tid & 63, fr = lane & 15, fq = lane >> 4;
    const int ntn = N >> 7, ntiles = (TS / 64) * ntn;
    if (c < 0) return;
    for (int tile = c; tile < ntiles; tile += stride) {
        const int tm = tile / ntn, tn = tile - tm * ntn;
        const int r0 = TP + tm * 64 + (wave >> 2) * 32, cb = tn * 128 + (wave & 3) * 32;
        const char* pa = (const char*)A + ((size_t)(r0 + fr) * K + 8 * fq) * 2;
        const char* pb0 = (const char*)Bt + ((size_t)(E.brow(cb, 0) + fr) * K + 8 * fq) * 2;
        const char* pb1 = (const char*)Bt + ((size_t)(E.brow(cb, 1) + fr) * K + 8 * fq) * 2;
        const size_t a16 = (size_t)16 * K * 2;
        f32x4 acc[2][2];
#pragma unroll
        for (int m = 0; m < 2; ++m)
#pragma unroll
            for (int f = 0; f < 2; ++f) acc[m][f] = (f32x4){0.f, 0.f, 0.f, 0.f};
        const int ng = K >> 7;
        bf16x8 A0[4], A1[4], B0[4], B1[4], C0[4], C1[4], D0[4], D1[4];
#define SG_LOAD(a0, a1, b0, b1, g) do { _Pragma("unroll") for (int j = 0; j < 4; ++j) { const size_t ko = (size_t)((g) * 4 + j) * 64; \
            a0[j] = *(const GAS bf16x8*)(pa + ko); a1[j] = *(const GAS bf16x8*)(pa + a16 + ko); b0[j] = *(const GAS bf16x8*)(pb0 + ko); b1[j] = *(const GAS bf16x8*)(pb1 + ko); } } while (0)
#define SG_MMA(a0, a1, b0, b1) do { _Pragma("unroll") for (int j = 0; j < 4; ++j) { \
            acc[0][0] = __builtin_amdgcn_mfma_f32_16x16x32_bf16(b0[j], a0[j], acc[0][0], 0, 0, 0); acc[0][1] = __builtin_amdgcn_mfma_f32_16x16x32_bf16(b1[j], a0[j], acc[0][1], 0, 0, 0); \
            acc[1][0] = __builtin_amdgcn_mfma_f32_16x16x32_bf16(b0[j], a1[j], acc[1][0], 0, 0, 0); acc[1][1] = __builtin_amdgcn_mfma_f32_16x16x32_bf16(b1[j], a1[j], acc[1][1], 0, 0, 0); } } while (0)
        SG_LOAD(A0, A1, B0, B1, 0);
        for (int g = 0; g < ng; g += 2) {
            if constexpr (Epi::MID) { if (g == (ng >> 1)) E.mid_small(acc, r0, fr); }
            SG_LOAD(C0, C1, D0, D1, g + 1);
            SG_MMA(A0, A1, B0, B1);
            if (g + 2 < ng) SG_LOAD(A0, A1, B0, B1, g + 2);
            SG_MMA(C0, C1, D0, D1);
        }
#undef SG_LOAD
#undef SG_MMA
        E.small(acc, r0, cb, fr, fq);
    }
}

struct EpiAtomic {
    static constexpr bool PERM = false, MID = false;
    float* SCR;
    __device__ __forceinline__ void operator()(const Acc& acc, const Unit& u, int wr, int wc, int fr, int fq) const {
        const int row0 = u.pm * 256 + wr * 64 + fr, col0 = u.pn * 256 + wc * 32 + 4 * fq;
        float* slab = SCR + (size_t)(u.ko >> 11) * TS * D;
#pragma unroll
        for (int ai = 0; ai < 2; ++ai)
#pragma unroll
            for (int m = 0; m < 4; ++m) {
                float* rp = slab + (size_t)(row0 + ai * 128 + m * 16) * D + col0;
#pragma unroll
                for (int bj = 0; bj < 2; ++bj)
#pragma unroll
                    for (int n = 0; n < 2; ++n) *(GAS f32x4*)(rp + bj * 128 + n * 16) = acc[ai][bj][m][n];
            }
    }
};
struct Args { const float* in[33]; float* out; unsigned char* ws; };
enum { I_XP = 0, I_XS, I_MEM, I_SCONV, I_SRE, I_SIM, I_CK, I_CV, I_GMIX, I_WIN, I_CONVW, I_ARE, I_AIM, I_LOGDT, I_BRE, I_BIM, I_CRE, I_CIM, I_SD, I_WGLU,
       I_GA, I_GB, I_WOUT, I_GX, I_GMEM, I_WQ, I_WK, I_WV, I_WO, I_GMLP, I_WUP, I_WDOWN, I_GFIN };

typedef const float* const __attribute__((address_space(4)))* KTab;
__device__ __forceinline__ KTab ktab() { unsigned long long p = (unsigned long long)__builtin_amdgcn_kernarg_segment_ptr(); asm volatile("" : "+s"(p)); return (KTab)p; }
__device__ __forceinline__ float* ss_arr(unsigned char* ws, int idx) { return (float*)(ws + WS_SS) + (size_t)idx * T; }
__device__ __forceinline__ float* invmem_arr(unsigned char* ws) { return (float*)(ws + WS_SS) + (size_t)9 * T; }

__device__ __forceinline__ int inproj_src_col(int vc) {
    if (vc < 512 || vc >= 1536) return vc;
    const int q = (vc - 512) >> 8, r = (vc - 512) & 255;
    return r < 128 ? 512 + q * 128 + r : 1024 + q * 128 + (r - 128);
}
__device__ __forceinline__ void transpose_item(const float* W, int ldw, int srck0, int srcn0, const float* gain, float gscale, bf16_t* WT, int ldt, int dn0, int dk0, LAS float* scr, int lane) {
#pragma unroll 8
    for (int i = 0; i < 32; ++i) { const int kk = 2 * i + (lane >> 5); float v = __builtin_nontemporal_load((const GAS float*)W + (size_t)(srck0 + kk) * ldw + srcn0 + (lane & 31));
        const float gsc = gain ? ((const GAS float*)gain)[kk] * gscale : gscale; scr[kk * 33 + (lane & 31)] = v * gsc; }
    LDS_WAIT();
    const int c = lane & 7;
#pragma unroll
    for (int j = 0; j < 4; ++j) { const int n = (lane >> 3) + 8 * j; const LAS float* s = scr + (8 * c) * 33 + n;
        u32x4 o; o.x = cvt_pk_bf16(s[0 * 33], s[1 * 33]); o.y = cvt_pk_bf16(s[2 * 33], s[3 * 33]); o.z = cvt_pk_bf16(s[4 * 33], s[5 * 33]); o.w = cvt_pk_bf16(s[6 * 33], s[7 * 33]);
        *(GAS u32x4*)(WT + (size_t)(dn0 + n) * ldt + dk0 + 8 * c) = o; }
    LDS_WAIT();
}
__device__ __forceinline__ float convert_row(const float* src, bf16_t* dst, int lane) {
    const GAS f32x4* xr = (const GAS f32x4*)src + lane; f32x4 v[4]; float s = 0.f;
#pragma unroll
    for (int j = 0; j < 4; ++j) { v[j] = __builtin_nontemporal_load(xr + 64 * j); s += (v[j][0] * v[j][0] + v[j][1] * v[j][1]) + (v[j][2] * v[j][2] + v[j][3] * v[j][3]); }
    GAS u32x2* o = (GAS u32x2*)dst + lane;
#pragma unroll
    for (int j = 0; j < 4; ++j) { u32x2 w; w.x = cvt_pk_bf16(v[j][0], v[j][1]); w.y = cvt_pk_bf16(v[j][2], v[j][3]); o[64 * j] = w; }
    return wave_sum(s);
}
constexpr int PI_IN = 1024, PI_GLU = 128, PI_SQ = 512, PI_UP = 2048, PI_CV = 2048;
constexpr int PI_LAYER = PI_IN + PI_GLU + 5 * PI_SQ + 2 * PI_UP + PI_CV;

__device__ __forceinline__ void prep_phase(unsigned char* ws, LAS unsigned char* lds, int gw, int NGW, int wave, int lane) {
    const KTab in = ktab();
    LAS float* scr = (LAS float*)(lds + wave * 8704);
    for (int it = gw; it < DEPTH * PI_LAYER; it += NGW) {
        const int l = it / PI_LAYER; int r = it - l * PI_LAYER;
        unsigned char* wl = ws + WS_W + (size_t)l * W_LAYER;
        if (r < PI_IN) { const int kb = r >> 6, nb = r & 63;
            transpose_item(as_global(in[I_WIN]) + (size_t)l * D * 2048, 2048, 64 * kb, inproj_src_col(32 * nb), as_global(in[I_GMIX]) + l * D + 64 * kb, 1.0f, (bf16_t*)(wl + W_IN), D, 32 * nb, 64 * kb, scr, lane); continue; }
        r -= PI_IN;
        if (r < PI_GLU) { const int kb = r >> 4, nb = r & 15;
            transpose_item(as_global(in[I_WGLU]) + (size_t)l * CH * CH, CH, 64 * kb, 32 * nb, nullptr, 1.0f, (bf16_t*)(wl + W_GLU), CH, 32 * nb, 64 * kb, scr, lane); continue; }
        r -= PI_GLU;
        if (r < PI_SQ) { const int kb = r >> 5, nb = r & 31, dk0 = 64 * kb;
            const float* gn = dk0 < 512 ? as_global(in[I_GB]) + l * CH + dk0 : as_global(in[I_GA]) + l * CH + dk0 - 512;
            transpose_item(as_global(in[I_WOUT]) + (size_t)l * D * D, D, (dk0 + 512) & 1023, 32 * nb, gn, 1.0f, (bf16_t*)(wl + W_OUT), D, 32 * nb, dk0, scr, lane); continue; }
        r -= PI_SQ;
        if (r < PI_SQ) { const int kb = r >> 5, nb = r & 31;
            transpose_item(as_global(in[I_WQ]) + (size_t)l * D * D, D, 64 * kb, 32 * nb, as_global(in[I_GX]) + l * D + 64 * kb, 0.0625f, (bf16_t*)(wl + W_Q), D, 32 * nb, 64 * kb, scr, lane); continue; }
        r -= PI_SQ;
        if (r < PI_SQ) { const int kb = r >> 5, nb = r & 31;
            transpose_item(as_global(in[I_WK]) + (size_t)l * D * D, D, 64 * kb, 32 * nb, as_global(in[I_GMEM]) + l * D + 64 * kb, 1.0f, (bf16_t*)(wl + W_KV), D, 32 * nb, 64 * kb, scr, lane); continue; }
        r -= PI_SQ;
        if (r < PI_SQ) { const int kb = r >> 5, nb = r & 31;
            transpose_item(as_global(in[I_WV]) + (size_t)l * D * D, D, 64 * kb, 32 * nb, as_global(in[I_GMEM]) + l * D + 64 * kb, 1.0f, (bf16_t*)(wl + W_KV), D, 1024 + 32 * nb, 64 * kb, scr, lane); continue; }
        r -= PI_SQ;
        if (r < PI_SQ) { const int kb = r >> 5, nb = r & 31;
            transpose_item(as_global(in[I_WO]) + (size_t)l * D * D, D, 64 * kb, 32 * nb, nullptr, 1.0f, (bf16_t*)(wl + W_O), D, 32 * nb, 64 * kb, scr, lane); continue; }
        r -= PI_SQ;
        if (r < PI_UP) { const int kb = r >> 7, nb = r & 127;
            transpose_item(as_global(in[I_WUP]) + (size_t)l * D * DFF, DFF, 64 * kb, 32 * nb, as_global(in[I_GMLP]) + l * D + 64 * kb, 1.0f, (bf16_t*)(wl + W_UP), D, 32 * nb, 64 * kb, scr, lane); continue; }
        r -= PI_UP;
        if (r < PI_UP) { const int kb = r >> 5, nb = r & 31;
            transpose_item(as_global(in[I_WDOWN]) + (size_t)l * DFF * D, D, 64 * kb, 32 * nb, nullptr, 1.0f, (bf16_t*)(wl + W_DOWN), DFF, 32 * nb, 64 * kb, scr, lane); continue; }
        r -= PI_UP;
        { const int kb = r >> 5, nb = r & 31;
            transpose_item(as_global(in[I_CV]) + (size_t)l * TMS * D, D, 64 * kb, 32 * nb, nullptr, 1.0f, (bf16_t*)(ws + WS_VTC) + (size_t)l * D * TMS, TMS, 32 * nb, 64 * kb, scr, lane); }
    }
    float* ss0 = ss_arr(ws, 0); float* invm = invmem_arr(ws);
    for (int m0 = gw * 2; m0 < T; m0 += NGW * 2) {
        const float* src = m0 < TP ? as_global(in[I_XP]) + (size_t)m0 * D : as_global(in[I_XS]) + (size_t)(m0 - TP) * D;
        const GAS f32x4* xr = (const GAS f32x4*)src + lane; f32x4 v[8]; float s0 = 0.f, s1 = 0.f;
#pragma unroll
        for (int j = 0; j < 8; ++j) v[j] = __builtin_nontemporal_load(xr + 64 * j);
#pragma unroll
        for (int j = 0; j < 4; ++j) { s0 += (v[j][0] * v[j][0] + v[j][1] * v[j][1]) + (v[j][2] * v[j][2] + v[j][3] * v[j][3]);
            s1 += (v[4 + j][0] * v[4 + j][0] + v[4 + j][1] * v[4 + j][1]) + (v[4 + j][2] * v[4 + j][2] + v[4 + j][3] * v[4 + j][3]); }
        GAS u32x2* o = (GAS u32x2*)((bf16_t*)(ws + WS_XB) + (size_t)m0 * D) + lane;
#pragma unroll
        for (int j = 0; j < 8; ++j) { u32x2 w; w.x = cvt_pk_bf16(v[j][0], v[j][1]); w.y = cvt_pk_bf16(v[j][2], v[j][3]); o[64 * j] = w; }
        s0 = wave_sum(s0); s1 = wave_sum(s1);
        if (lane == 0) { ((GAS float*)ss0)[m0] = s0; ((GAS float*)ss0)[m0 + 1] = s1; }
    }
    for (int m = T + gw; m < T + TM + 2 * TMS; m += NGW) {
        if (m < T) { const float* src = m < TP ? as_global(in[I_XP]) + (size_t)m * D : as_global(in[I_XS]) + (size_t)(m - TP) * D;
            const float s = convert_row(src, (bf16_t*)(ws + WS_XB) + (size_t)m * D, lane); if (lane == 0) ((GAS float*)ss0)[m] = s; }
        else if (m < T + TM) { const int mm = m - T; const float s = convert_row(as_global(in[I_MEM]) + (size_t)mm * D, (bf16_t*)(ws + WS_MNB) + (size_t)mm * D, lane);
            if (lane == 0) ((GAS float*)invm)[mm] = rsqrtf(s * (1.0f / D) + EPS); }
        else { const int mm = m - T - TM; (void)convert_row(as_global(in[I_CK]) + (size_t)mm * D, (bf16_t*)(ws + WS_KC) + (size_t)mm * D, lane); }
    }
    {
        float* sm = (float*)(ws + WS_SMALL); const int gt = gw * 64 + lane, NT = NGW * 64;
#define SMCOPY(off, idx, n) for (int i = gt; i < (n); i += NT) ((GAS float*)sm)[(off) + i] = ((const GAS float*)in[idx])[i]
        SMCOPY(SM_ARE, I_ARE, 4096); SMCOPY(SM_AIM, I_AIM, 4096); SMCOPY(SM_LOGDT, I_LOGDT, 64); SMCOPY(SM_BRE, I_BRE, 65536); SMCOPY(SM_BIM, I_BIM, 65536);
        SMCOPY(SM_CRE, I_CRE, 65536); SMCOPY(SM_CIM, I_CIM, 65536); SMCOPY(SM_SD, I_SD, 1024); SMCOPY(SM_CONVW, I_CONVW, 3072); SMCOPY(SM_SCONV, I_SCONV, 32768);
        SMCOPY(SM_SRE, I_SRE, 65536); SMCOPY(SM_SIM, I_SIM, 65536); SMCOPY(SM_GFIN, I_GFIN, 1024);
#undef SMCOPY
    }
    { float* z = ss_arr(ws, 1); const size_t n = (size_t)8 * T; for (size_t i = (size_t)gw * 64 + lane; i < n; i += (size_t)NGW * 64) ((GAS float*)z)[i] = 0.f; }
}

__device__ __forceinline__ float gelu_tanh(float x) {
    const float u = 0.7978845608f * (x + 0.044715f * x * x * x);
    const float e = __expf(2.0f * u);
    const float th = 1.0f - 2.0f * __builtin_amdgcn_rcpf(e + 1.0f);
    return 0.5f * x * (1.0f + th);
}
__device__ __forceinline__ void sincos_small(float x, float& s, float& c) {
    const float q = rintf(x * 0.63661977236f);
    float r = fmaf(-q, 1.57079637050628662109375f, x); r = fmaf(-q, -4.37113900018624283e-8f, r);
    const float r2 = r * r;
    const float sp = r + r * r2 * (-1.0f / 6 + r2 * (1.0f / 120 + r2 * (-1.0f / 5040 + r2 * (1.0f / 362880))));
    const float cp = 1.0f + r2 * (-0.5f + r2 * (1.0f / 24 + r2 * (-1.0f / 720 + r2 * (1.0f / 40320 + r2 * (-1.0f / 3628800)))));
    const int qi = (int)q & 3;
    s = (qi == 0) ? sp : (qi == 1) ? cp : (qi == 2) ? -sp : -cp;
    c = (qi == 0) ? cp : (qi == 1) ? -sp : (qi == 2) ? -cp : sp;
}
constexpr int BU_STRIDE = 528, H_STRIDE = 272, SCAN_LDS_WAVE = 16 * BU_STRIDE + 16 * H_STRIDE;

__device__ __forceinline__ void scan_item(unsigned char* ws, float* out, int l, int item, LAS unsigned char* wl, int lane_in) {
    int lane = lane_in; asm volatile("" : "+v"(lane));
    const GAS float* sm = (const GAS float*)(ws + WS_SMALL);
    int b, g, row0, nblk; const bool prompt = item < NB * 32;
    if (prompt) { b = item >> 5; g = item & 31; row0 = b * SEQ; nblk = SEQ / 16; }
    else { const int i2 = item - NB * 32; b = i2 >> 5; g = i2 & 31; row0 = TP + b * DSEQ; nblk = DSEQ / 16; }
    const bf16_t* U = (const bf16_t*)(ws + WS_U); bf16_t* YG = (bf16_t*)(ws + WS_YG);
    const int lg = l * 32 + g, p = lane, t16 = lane & 15, q = lane >> 4;
    const float are = fminf(sm[SM_ARE + lg * 64 + p], -1e-4f), aim = sm[SM_AIM + lg * 64 + p];
    const float dt = expf(sm[SM_LOGDT + lg]);
    float sn, cs; sincos_small(aim * dt, sn, cs);
    const float mag = expf(are * dt), abr = mag * cs, abi = mag * sn;
    const float nr = abr - 1.0f, ni = abi, den = 1.0f / (are * are + aim * aim);
    const float c0 = (nr * are + ni * aim) * den, c1 = (ni * are - nr * aim) * den;
    bf16x8 af[8];
#pragma unroll
    for (int f = 0; f < 8; ++f) {
        const int i = 16 * f + t16, ps = i >> 1, cc = i & 1;
        const float k0 = __shfl(c0, ps), k1 = __shfl(c1, ps);
        u32x4 w = (u32x4){0u, 0u, 0u, 0u};
        if (q < 2) {
            const GAS f32x4* br = (const GAS f32x4*)(sm + SM_BRE + ((size_t)lg * 64 + ps) * 16 + 8 * q); const GAS f32x4* bi = (const GAS f32x4*)(sm + SM_BIM + ((size_t)lg * 64 + ps) * 16 + 8 * q);
            const f32x4 r0 = br[0], r1 = br[1], i0 = bi[0], i1 = bi[1];
            f32x4 v0, v1;
            if (cc == 0) { v0 = k0 * r0 - k1 * i0; v1 = k0 * r1 - k1 * i1; } else { v0 = k0 * i0 + k1 * r0; v1 = k0 * i1 + k1 * r1; }
            w.x = cvt_pk_bf16(v0[0], v0[1]); w.y = cvt_pk_bf16(v0[2], v0[3]); w.z = cvt_pk_bf16(v1[0], v1[1]); w.w = cvt_pk_bf16(v1[2], v1[3]);
        }
        af[f] = __builtin_bit_cast(bf16x8, w);
    }
    bf16x8 cf[4];
#pragma unroll
    for (int s = 0; s < 4; ++s) {
        const int p0 = 16 * s + 4 * q;
        const f32x4 cr = *(const GAS f32x4*)(sm + SM_CRE + ((size_t)lg * 16 + t16) * 64 + p0), ci = *(const GAS f32x4*)(sm + SM_CIM + ((size_t)lg * 16 + t16) * 64 + p0);
        u32x4 w; w.x = cvt_pk_bf16(cr[0], -ci[0]); w.y = cvt_pk_bf16(cr[1], -ci[1]); w.z = cvt_pk_bf16(cr[2], -ci[2]); w.w = cvt_pk_bf16(cr[3], -ci[3]);
        cf[s] = __builtin_bit_cast(bf16x8, w);
    }
    const f32x4 dsk = *(const GAS f32x4*)(sm + SM_SD + l * CH + g * 16 + 4 * q);
    float hre = 0.f, him = 0.f;
    if (!prompt) { hre = sm[SM_SRE + (((size_t)l * NDB + b) * 32 + g) * 64 + p]; him = sm[SM_SIM + (((size_t)l * NDB + b) * 32 + g) * 64 + p]; }
    LAS unsigned char* BU = wl; LAS unsigned char* HB = wl + 16 * BU_STRIDE;
    const char* ubase = (const char*)U + (size_t)row0 * CH * 2; char* ybase = (char*)YG + (size_t)row0 * CH * 2;
    const unsigned lo8 = (unsigned)((t16 * CH + g * 16 + 8 * (q & 1)) * 2), lo4 = (unsigned)((t16 * CH + g * 16 + 4 * q) * 2);
    constexpr size_t BSTEP = (size_t)16 * CH * 2;
    constexpr int PD = 4;
    u32x4 ubuf[PD]; u32x2 ebuf[PD];
    const bool lowq = q < 2;
#pragma unroll
    for (int j = 0; j < PD; ++j) { const char* un = ubase + (size_t)j * BSTEP; ubuf[j] = *(const GAS u32x4*)(un + lo8); ebuf[j] = *(const GAS u32x2*)(un + lo4); }
#define U_BFRAG(v) __builtin_bit_cast(bf16x8, (u32x4){lowq ? (v).x : 0u, lowq ? (v).y : 0u, lowq ? (v).z : 0u, lowq ? (v).w : 0u})
    f32x2 buv[16];
    {
        const bf16x8 bfrag = U_BFRAG(ubuf[0]);
#pragma unroll
        for (int f = 0; f < 8; ++f) {
            const f32x4 r = __builtin_amdgcn_mfma_f32_16x16x32_bf16(af[f], bfrag, (f32x4){0.f, 0.f, 0.f, 0.f}, 0, 0, 0);
            *(LAS f32x4*)(BU + t16 * BU_STRIDE + (16 * f + 4 * q) * 4) = r;
        }
        LDS_WAIT();
#pragma unroll
        for (int t = 0; t < 16; ++t) buv[t] = *(const LAS f32x2*)(BU + t * BU_STRIDE + p * 8);
    }
    if (prompt) {
        for (int tb0 = 0; tb0 < nblk; tb0 += 32) {
#pragma unroll
        for (int j = 0; j < 32; ++j) {
            const int tb = tb0 + j;
            const u32x2 uec = ebuf[j % PD];
            const u32x4 ubn = ubuf[(j + 1) % PD];
            { const int tbn = (tb + PD < nblk) ? tb + PD : nblk - 1; const char* un = ubase + (size_t)tbn * BSTEP; ubuf[j % PD] = *(const GAS u32x4*)(un + lo8); ebuf[j % PD] = *(const GAS u32x2*)(un + lo4); }
            f32x4 rn[8];
            { const bf16x8 bfrag = U_BFRAG(ubn);
#pragma unroll
              for (int f = 0; f < 8; ++f) rn[f] = __builtin_amdgcn_mfma_f32_16x16x32_bf16(af[f], bfrag, (f32x4){0.f, 0.f, 0.f, 0.f}, 0, 0, 0); }
#pragma unroll
            for (int t = 0; t < 16; ++t) {
                const float nre = fmaf(abr, hre, fmaf(-abi, him, buv[t][0])), nim = fmaf(abr, him, fmaf(abi, hre, buv[t][1]));
                hre = nre; him = nim;
                *(LAS unsigned*)(HB + t * H_STRIDE + p * 4) = cvt_pk_bf16(hre, him);
            }
#pragma unroll
            for (int f = 0; f < 8; ++f) *(LAS f32x4*)(BU + t16 * BU_STRIDE + (16 * f + 4 * q) * 4) = rn[f];
            LDS_WAIT();
            bf16x8 hf[4];
#pragma unroll
            for (int s2 = 0; s2 < 4; ++s2) hf[s2] = *(const LAS bf16x8*)(HB + t16 * H_STRIDE + (32 * s2 + 8 * q) * 2);
#pragma unroll
            for (int t = 0; t < 16; ++t) buv[t] = *(const LAS f32x2*)(BU + t * BU_STRIDE + p * 8);
            f32x4 y = (f32x4){0.f, 0.f, 0.f, 0.f};
#pragma unroll
            for (int s2 = 0; s2 < 4; ++s2) y = __builtin_amdgcn_mfma_f32_16x16x32_bf16(cf[s2], hf[s2], y, 0, 0, 0);
            const float u0 = bf_lo(uec.x), u1 = bf_hi(uec.x), u2 = bf_lo(uec.y), u3 = bf_hi(uec.y);
            const float g0 = gelu_tanh(y[0] + dsk[0] * u0), g1 = gelu_tanh(y[1] + dsk[1] * u1), g2 = gelu_tanh(y[2] + dsk[2] * u2), g3 = gelu_tanh(y[3] + dsk[3] * u3);
            u32x2 w; w.x = cvt_pk_bf16(g0, g1); w.y = cvt_pk_bf16(g2, g3);
            *(GAS u32x2*)(ybase + (size_t)tb * BSTEP + lo4) = w;
        }
        }
    } else {
        for (int tb0 = 0; tb0 < nblk; tb0 += 4) {
#pragma unroll
        for (int j = 0; j < 4; ++j) {
            const int tb = tb0 + j;
            const u32x2 uec = ebuf[j % PD];
            const u32x4 ubn = ubuf[(j + 1) % PD];
            { const int tbn = (tb + PD < nblk) ? tb + PD : nblk - 1; const char* un = ubase + (size_t)tbn * BSTEP; ubuf[j % PD] = *(const GAS u32x4*)(un + lo8); ebuf[j % PD] = *(const GAS u32x2*)(un + lo4); }
            f32x4 rn[8];
            { const bf16x8 bfrag = U_BFRAG(ubn);
#pragma unroll
              for (int f = 0; f < 8; ++f) rn[f] = __builtin_amdgcn_mfma_f32_16x16x32_bf16(af[f], bfrag, (f32x4){0.f, 0.f, 0.f, 0.f}, 0, 0, 0); }
#pragma unroll
            for (int t = 0; t < 16; ++t) {
                const float nre = fmaf(abr, hre, fmaf(-abi, him, buv[t][0])), nim = fmaf(abr, him, fmaf(abi, hre, buv[t][1]));
                hre = nre; him = nim;
                *(LAS unsigned*)(HB + t * H_STRIDE + p * 4) = cvt_pk_bf16(hre, him);
            }
#pragma unroll
            for (int f = 0; f < 8; ++f) *(LAS f32x4*)(BU + t16 * BU_STRIDE + (16 * f + 4 * q) * 4) = rn[f];
            LDS_WAIT();
            bf16x8 hf[4];
#pragma unroll
            for (int s2 = 0; s2 < 4; ++s2) hf[s2] = *(const LAS bf16x8*)(HB + t16 * H_STRIDE + (32 * s2 + 8 * q) * 2);
#pragma unroll
            for (int t = 0; t < 16; ++t) buv[t] = *(const LAS f32x2*)(BU + t * BU_STRIDE + p * 8);
            f32x4 y = (f32x4){0.f, 0.f, 0.f, 0.f};
#pragma unroll
            for (int s2 = 0; s2 < 4; ++s2) y = __builtin_amdgcn_mfma_f32_16x16x32_bf16(cf[s2], hf[s2], y, 0, 0, 0);
            const float u0 = bf_lo(uec.x), u1 = bf_hi(uec.x), u2 = bf_lo(uec.y), u3 = bf_hi(uec.y);
            const float g0 = gelu_tanh(y[0] + dsk[0] * u0), g1 = gelu_tanh(y[1] + dsk[1] * u1), g2 = gelu_tanh(y[2] + dsk[2] * u2), g3 = gelu_tanh(y[3] + dsk[3] * u3);
            u32x2 w; w.x = cvt_pk_bf16(g0, g1); w.y = cvt_pk_bf16(g2, g3);
            *(GAS u32x2*)(ybase + (size_t)tb * BSTEP + lo4) = w;
        }
        }
    }
#undef U_BFRAG
    GAS float* outg = (GAS float*)out;
    if (prompt) { outg[O_REP + (((size_t)l * NB + b) * 32 + g) * 64 + p] = hre; outg[O_IMP + (((size_t)l * NB + b) * 32 + g) * 64 + p] = him; }
    else { outg[O_RES + (((size_t)l * NDB + b) * 32 + g) * 64 + p] = hre; outg[O_IMS + (((size_t)l * NDB + b) * 32 + g) * 64 + p] = him; }
}
__device__ __forceinline__ void conv_run(unsigned char* ws, int l, int run, int lane_in) {
    int lane = lane_in; asm volatile("" : "+v"(lane));
    const GAS float* sm = (const GAS float*)(ws + WS_SMALL);
    const bf16_t* XIN = (const bf16_t*)(ws + WS_XIN); const bf16_t* BG = (const bf16_t*)(ws + WS_BG); bf16_t* YCAT = (bf16_t*)(ws + WS_YCAT);
    const int row0 = run * 64, c0 = lane * 8;
    f32x4 w0a, w0b, w1a, w1b, w2a, w2b;
    { const GAS float* cw = sm + SM_CONVW + (size_t)l * 3 * CH + c0; w0a = *(const GAS f32x4*)cw; w0b = *(const GAS f32x4*)(cw + 4); w1a = *(const GAS f32x4*)(cw + CH); w1b = *(const GAS f32x4*)(cw + CH + 4);
      w2a = *(const GAS f32x4*)(cw + 2 * CH); w2b = *(const GAS f32x4*)(cw + 2 * CH + 4); }
    f32x4 p2a, p2b, p1a, p1b;
    const bool seq_start = row0 < TP ? ((row0 & (SEQ - 1)) == 0) : true;
    if (!seq_start) { unpack8(*(const GAS u32x4*)(XIN + (size_t)(row0 - 2) * CH + c0), p2a, p2b); unpack8(*(const GAS u32x4*)(XIN + (size_t)(row0 - 1) * CH + c0), p1a, p1b); }
    else if (row0 < TP) { p2a = p2b = p1a = p1b = (f32x4){0.f, 0.f, 0.f, 0.f}; }
    else { const int b = (row0 - TP) >> 6; const GAS float* st = sm + SM_SCONV + ((size_t)(l * NDB + b) * 2) * CH + c0;
        p2a = *(const GAS f32x4*)st; p2b = *(const GAS f32x4*)(st + 4); p1a = *(const GAS f32x4*)(st + CH); p1b = *(const GAS f32x4*)(st + CH + 4); }
    for (int tb = 0; tb < 64; tb += 8) {
        u32x4 xr[8], br[8];
#pragma unroll
        for (int j = 0; j < 8; ++j) { const size_t o = (size_t)(row0 + tb + j) * CH + c0; xr[j] = *(const GAS u32x4*)(XIN + o); br[j] = *(const GAS u32x4*)(BG + o); }
#pragma unroll
        for (int j = 0; j < 8; ++j) {
            f32x4 xa, xb, ba, bb; unpack8(xr[j], xa, xb); unpack8(br[j], ba, bb);
            f32x4 ya = ba * (w0a * p2a + w1a * p1a + w2a * xa), yb = bb * (w0b * p2b + w1b * p1b + w2b * xb);
            float s = 0.f;
#pragma unroll
            for (int e = 0; e < 4; ++e) s += ya[e] * ya[e] + yb[e] * yb[e];
            s = wave_sum(s);
            const float inv = rsqrtf(s * (1.0f / CH) + EPS);
            store8_bf16(YCAT + (size_t)(row0 + tb + j) * D + 512 + c0, ya * inv, yb * inv);
            p2a = p1a; p2b = p1b; p1a = xa; p1b = xb;
        }
    }
}

constexpr int KST = 528, VST = 520;
__device__ __forceinline__ const bf16_t* attn_kptr(unsigned char* ws, int l, int u) {
    if (u < NB * 32) { const int b = u >> 5, h = (u >> 3) & 3; return (const bf16_t*)(ws + WS_KB) + (size_t)l * TM * D + (size_t)(b * NMEM) * D + h * 256; }
    const int i = u - NB * 32, b = i >> 2, h = i & 3; return (const bf16_t*)(ws + WS_KC) + (size_t)l * TMS * D + (size_t)(b * NMEM) * D + h * 256;
}
__device__ __forceinline__ void attn_phase(unsigned char* ws, int l, LAS unsigned char* lds, int G, int bid) {
    int tid = threadIdx.x; asm volatile("" : "+v"(tid));
    const int wave = __builtin_amdgcn_readfirstlane(tid >> 6);
    const bf16_t* Q = (const bf16_t*)(ws + WS_Q); bf16_t* O = (bf16_t*)(ws + WS_O);
    const int NU = NB * 4 * 8 + NDB * 4;
    u32x4 kpre[16]; bool have = false;
#pragma unroll
    for (int i = 0; i < 16; ++i) kpre[i] = (u32x4){0u, 0u, 0u, 0u};
    for (int u = bid; u < NU; u += G) {
        int qrow0, nq, ldv; const bf16_t* Kp; const bf16_t* Vp; int h;
        if (u < NB * 32) { const int b = u >> 5; h = (u >> 3) & 3; const int qt = u & 7; qrow0 = b * SEQ + qt * 256; nq = 256;
            Kp = (const bf16_t*)(ws + WS_KB) + (size_t)l * TM * D + (size_t)(b * NMEM) * D + h * 256; Vp = (const bf16_t*)(ws + WS_VT) + (size_t)l * D * TM + (size_t)(h * 256) * TM + b * NMEM; ldv = TM; }
        else { const int i = u - NB * 32, b = i >> 2; h = i & 3; qrow0 = TP + b * DSEQ; nq = DSEQ;
            Kp = (const bf16_t*)(ws + WS_KC) + (size_t)l * TMS * D + (size_t)(b * NMEM) * D + h * 256; Vp = (const bf16_t*)(ws + WS_VTC) + (size_t)l * D * TMS + (size_t)(h * 256) * TMS + b * NMEM; ldv = TMS; }
        const bool active = wave * 32 < nq;
        __syncthreads();
        int t2 = tid; asm volatile("" : "+v"(t2));
        {
            const int c = t2 & 31, rr = t2 >> 5; const unsigned off = (unsigned)((rr * D + c * 8) * 2); const char* kb = (const char*)Kp;
            if (!have) {
#pragma unroll
                for (int i = 0; i < 16; ++i) kpre[i] = *(const GAS u32x4*)(kb + (size_t)(16 * i) * D * 2 + off);
            }
            LAS unsigned char* ld0 = lds + rr * KST + c * 16;
#pragma unroll
            for (int i = 0; i < 16; ++i) *(LAS u32x4*)(ld0 + 16 * i * KST) = kpre[i];
        }
        bf16x8 qf[16];
        const int r32 = t2 & 31, hh = (t2 >> 5) & 1;
        const int qrow = qrow0 + wave * 32 + r32;
        if (active) {
#pragma unroll
            for (int ks = 0; ks < 16; ++ks) qf[ks] = *(const GAS bf16x8*)(Q + (size_t)qrow * D + h * 256 + 16 * ks + 8 * hh);
        } else {
#pragma unroll
            for (int ks = 0; ks < 16; ++ks) qf[ks] = (bf16x8){0, 0, 0, 0, 0, 0, 0, 0};
        }
        __syncthreads();
        constexpr int NQ = 4, MTQ = 8 / NQ;
        bf16x8 pf[16]; float qmax[NQ], qsum[NQ];
#pragma unroll
        for (int qi = 0; qi < NQ; ++qi) { qmax[qi] = 0.f; qsum[qi] = 1.f; }
        if (active) {
#pragma unroll
            for (int qi = 0; qi < NQ; ++qi) {
                f32x16 sc[MTQ];
#pragma unroll
                for (int mq = 0; mq < MTQ; ++mq)
#pragma unroll
                    for (int e = 0; e < 16; ++e) sc[mq][e] = 0.f;
#pragma unroll
                for (int ks = 0; ks < 16; ++ks)
#pragma unroll
                    for (int mq = 0; mq < MTQ; ++mq) {
                        const bf16x8 kf = *(const LAS bf16x8*)(lds + (32 * (qi * MTQ + mq) + r32) * KST + (16 * ks + 8 * hh) * 2);
                        sc[mq] = __builtin_amdgcn_mfma_f32_32x32x16_bf16(kf, qf[ks], sc[mq], 0, 0, 0);
                    }
                float mx = -3.0e38f;
#pragma unroll
                for (int mq = 0; mq < MTQ; ++mq)
#pragma unroll
                    for (int e = 0; e < 16; ++e) mx = fmaxf(mx, sc[mq][e]);
                mx = fmaxf(mx, __shfl_xor(mx, 32));
                float sum = 0.f;
#pragma unroll
                for (int mq = 0; mq < MTQ; ++mq) {
#pragma unroll
                    for (int e = 0; e < 16; ++e) { const float pe = __builtin_amdgcn_exp2f((sc[mq][e] - mx) * 1.44269504089f); sc[mq][e] = pe; sum += pe; }
#pragma unroll
                    for (int s2 = 0; s2 < 2; ++s2) {
                        u32x4 w; w.x = cvt_pk_bf16(sc[mq][8 * s2 + 0], sc[mq][8 * s2 + 1]); w.y = cvt_pk_bf16(sc[mq][8 * s2 + 2], sc[mq][8 * s2 + 3]);
                        w.z = cvt_pk_bf16(sc[mq][8 * s2 + 4], sc[mq][8 * s2 + 5]); w.w = cvt_pk_bf16(sc[mq][8 * s2 + 6], sc[mq][8 * s2 + 7]);
                        pf[2 * (qi * MTQ + mq) + s2] = __builtin_bit_cast(bf16x8, w);
                    }
                }
                sum += __shfl_xor(sum, 32);
                qmax[qi] = mx; qsum[qi] = sum;
                __builtin_amdgcn_sched_barrier(0);
            }
        } else {
#pragma unroll
            for (int i = 0; i < 16; ++i) pf[i] = (bf16x8){0, 0, 0, 0, 0, 0, 0, 0};
        }
        float fq_[NQ]; float rinv;
        { float M = qmax[0];
#pragma unroll
          for (int qi = 1; qi < NQ; ++qi) M = fmaxf(M, qmax[qi]);
          float tot = 0.f;
#pragma unroll
          for (int qi = 0; qi < NQ; ++qi) { fq_[qi] = __builtin_amdgcn_exp2f((qmax[qi] - M) * 1.44269504089f); tot += fq_[qi] * qsum[qi]; }
          rinv = 1.0f / tot;
#pragma unroll
          for (int qi = 0; qi < NQ; ++qi) fq_[qi] *= rinv; }
        __builtin_amdgcn_sched_barrier(0);
        u32x4 vpre[16];
        const int vc = t2 & 31, vr = t2 >> 5;
        { const unsigned off = (unsigned)((vr * ldv + vc * 8) * 2); const char* vb = (const char*)Vp;
#pragma unroll
          for (int i = 0; i < 16; ++i) vpre[i] = *(const GAS u32x4*)(vb + (size_t)(16 * i) * ldv * 2 + off); }
        __syncthreads();
        {
            LAS unsigned char* ld0 = lds + vr * VST + vc * 16;
#pragma unroll
            for (int i = 0; i < 16; ++i) { LAS u32x2* d = (LAS u32x2*)(ld0 + 16 * i * VST); d[0] = (u32x2){vpre[i].x, vpre[i].y}; d[1] = (u32x2){vpre[i].z, vpre[i].w}; }
        }
        __syncthreads();
        {
            const int un = u + G; have = un < NU;
            if (have) { const char* kb = (const char*)attn_kptr(ws, l, un); const unsigned off = (unsigned)((vr * D + vc * 8) * 2);
#pragma unroll
                for (int i = 0; i < 16; ++i) kpre[i] = *(const GAS u32x4*)(kb + (size_t)(16 * i) * D * 2 + off); }
            else {
#pragma unroll
                for (int i = 0; i < 16; ++i) kpre[i] = (u32x4){0u, 0u, 0u, 0u}; }
            __builtin_amdgcn_sched_barrier(0);
        }
        if (active) {
#pragma unroll
            for (int dt = 0; dt < 8; ++dt) {
                f32x16 acc[NQ];
#pragma unroll
                for (int qi = 0; qi < NQ; ++qi)
#pragma unroll
                    for (int e = 0; e < 16; ++e) acc[qi][e] = 0.f;
#pragma unroll
                for (int mi = 0; mi < 16 / NQ; ++mi)
#pragma unroll
                    for (int qi = 0; qi < NQ; ++qi) {
                        const int ms = qi * (16 / NQ) + mi;
                        const LAS unsigned char* vp = lds + (32 * dt + r32) * VST + (16 * ms + 4 * hh) * 2;
                        const u32x2 lo = *(const LAS u32x2*)vp, hi = *(const LAS u32x2*)(vp + 16);
                        const u32x4 w = (u32x4){lo.x, lo.y, hi.x, hi.y};
                        acc[qi] = __builtin_amdgcn_mfma_f32_32x32x16_bf16(__builtin_bit_cast(bf16x8, w), pf[ms], acc[qi], 0, 0, 0);
                    }
#pragma unroll
                for (int g4 = 0; g4 < 4; ++g4) {
                    float o4[4];
#pragma unroll
                    for (int e = 0; e < 4; ++e) { float v = 0.f;
#pragma unroll
                        for (int qi = 0; qi < NQ; ++qi) v = fmaf(acc[qi][4 * g4 + e], fq_[qi], v);
                        o4[e] = v; }
                    u32x2 w; w.x = cvt_pk_bf16(o4[0], o4[1]); w.y = cvt_pk_bf16(o4[2], o4[3]);
                    *(GAS u32x2*)(O + (size_t)qrow * D + h * 256 + 32 * dt + 8 * g4 + 4 * hh) = w;
                }
                __builtin_amdgcn_sched_barrier(0);
            }
        }
    }
    __syncthreads();
}

#define XB_TMO      128
#define XB_XCNT(j)  (256  + 64 * (j))
#define XB_XSUB(j)  (1280 + 64 * (j))
#define XB_XGEN(j)  (2304 + 64 * (j))
#define XB_TOP      3328
#define XB_TOPGEN   3392
#define XCD_BAR_WORDS 3456
#define XB_SPIN_CAP (1u << 18)

__device__ __forceinline__ unsigned xb_ld(unsigned* p)              { return __hip_atomic_load(p, __ATOMIC_RELAXED, __HIP_MEMORY_SCOPE_AGENT); }
__device__ __forceinline__ unsigned xb_add(unsigned* p, unsigned v) { return __hip_atomic_fetch_add(p, v, __ATOMIC_RELAXED, __HIP_MEMORY_SCOPE_AGENT); }
__device__ __forceinline__ unsigned xb_xcc_id() { return (unsigned)__builtin_amdgcn_s_getreg((3 << 11) | 20) & 0xFu; }
#define XB_SPIN(cond, bar) do { unsigned _sp = 0; while (cond) { __builtin_amdgcn_s_sleep(1); \
    if ((++_sp & 255u) == 0u) { if (xb_ld(&(bar)[XB_TMO])) break; if (_sp > XB_SPIN_CAP) { atomicAdd(&(bar)[XB_TMO], 1u); break; } } } } while (0)

struct XcdBarrier {
    unsigned* bar; unsigned x;
    volatile LAS unsigned* st;
};

__device__ __forceinline__ XcdBarrier xcd_barrier_post(unsigned* bar, volatile LAS unsigned* st) {
    XcdBarrier b; b.bar = bar; b.x = xb_xcc_id(); b.st = st;
    if (threadIdx.x == 0) (void)xb_add(&bar[XB_XCNT(b.x)], 1u);
    return b;
}
__device__ __forceinline__ void xcd_barrier_complete(unsigned* bar, unsigned x, unsigned& nloc, unsigned& nx) {
    const unsigned G = gridDim.x * gridDim.y * gridDim.z;
    unsigned sum, cnt, mine, sp = 0u;
    for (;;) {
        sum = 0u; cnt = 0u; mine = 0u;
#pragma unroll
        for (unsigned j = 0; j < 16; ++j) { const unsigned c = xb_ld(&bar[XB_XCNT(j)]); sum += c; cnt += (c > 0u) ? 1u : 0u; mine = (j == x) ? c : mine; }
        if (sum == G) break;
        __builtin_amdgcn_s_sleep(1);
        if ((++sp & 255u) == 0u) { if (xb_ld(&bar[XB_TMO])) break; if (sp > XB_SPIN_CAP) { atomicAdd(&bar[XB_TMO], 1u); break; } }
    }
    nloc = mine > 0u ? mine : 1u; nx = cnt > 0u ? cnt : 1u;
}

__device__ __forceinline__ void xcd_barrier(const XcdBarrier& b) {
    asm volatile("s_waitcnt vmcnt(0)" ::: "memory");
    __syncthreads();
    if (threadIdx.x == 0) {
        unsigned* bar = b.bar;
        __builtin_amdgcn_s_waitcnt(0);
        unsigned nloc = b.st[0], nx = b.st[1];
        if (nloc == 0u) { xcd_barrier_complete(bar, b.x, nloc, nx); b.st[0] = nloc; b.st[1] = nx; }
        const unsigned old = xb_add(&bar[XB_XSUB(b.x)], 1u);
        const unsigned gen = old / nloc;
        if (old + 1u == (gen + 1u) * nloc) {
            __builtin_amdgcn_fence(__ATOMIC_RELEASE, "agent");
            asm volatile("s_waitcnt vmcnt(0)" ::: "memory");
            const unsigned og = xb_add(&bar[XB_TOP], 1u);
            const unsigned tg = og / nx;
            if (og + 1u == (tg + 1u) * nx) xb_add(&bar[XB_TOPGEN], 1u);
            else XB_SPIN(xb_ld(&bar[XB_TOPGEN]) == tg, bar);
            __builtin_amdgcn_fence(__ATOMIC_ACQUIRE, "agent");
            xb_add(&bar[XB_XGEN(b.x)], 1u);
            asm volatile("s_waitcnt vmcnt(0)" ::: "memory");
        } else {
            XB_SPIN(xb_ld(&bar[XB_XGEN(b.x)]) == gen, bar);
            __builtin_amdgcn_fence(__ATOMIC_ACQUIRE, "agent");
            asm volatile("s_waitcnt vmcnt(0)" ::: "memory");
        }
    }
    __syncthreads();
}

constexpr bool USE_SP2 = true;
__global__ void __launch_bounds__(512, 2) hybrid_fwd(Args a) {
    extern __shared__ __attribute__((aligned(16))) unsigned char lds_raw[];
    LAS unsigned char* lds = (LAS unsigned char*)lds_raw;
    cg::grid_group grid = cg::this_grid();
    volatile LAS unsigned* bst = (volatile LAS unsigned*)(lds + LDS_BYTES - 64);
    if (threadIdx.x < 16) bst[threadIdx.x] = 0u;
    __syncthreads();
    const XcdBarrier xbar = xcd_barrier_post((unsigned*)(a.ws + WS_BAR), bst);
    const int tid = threadIdx.x, lane = tid & 63, wave = __builtin_amdgcn_readfirstlane(tid >> 6);
    const int G = gridDim.x, bid = blockIdx.x;
    unsigned char* ws = as_global(a.ws);
    const int NGW = G * 8;

#ifndef NO_PREP
    for (int rep = 0; rep < REP_PREP; ++rep) { prep_phase(ws, lds, bid * 8 + wave, NGW, wave, lane); __syncthreads(); }
#endif
#define XBAR() do { XcdBarrier xb_ = xbar; asm volatile("" : "+s"(xb_.x)); xcd_barrier(xb_); } while (0)
    if (a.ws == nullptr) grid.sync();
    XBAR();

#define FRESH() unsigned char* wsp = ws; int ll = l, bb = bid, gg = G; asm volatile("" : "+s"(wsp), "+s"(ll), "+s"(bb), "+s"(gg)); wsp = as_global(wsp); float* outp = as_global(a.out); (void)outp; unsigned char* wl = wsp + WS_W + (size_t)ll * W_LAYER; (void)wl
#define SSA(k) ss_arr(wsp, 1 + 4 * ll + (k))
#pragma unroll 1
    for (int l = 0; l < DEPTH; ++l) {
        {
            FRESH();
            pg8::Gemm g{(const bf16_t*)(wsp + WS_XB), (const bf16_t*)(wl + W_IN), T, 2048, D, D, D}; pg8::StaticOrder S; S.init(T, 2048, gg, bb);
            EpiInProj E{(bf16_t*)(wsp + WS_BG), (bf16_t*)(wsp + WS_XIN), (bf16_t*)(wsp + WS_U), ll == 0 ? ss_arr(wsp, 0) : ss_arr(wsp, 4), outp + O_CONVP + (size_t)ll * NB * 2 * CH, outp + O_CONVS + (size_t)ll * NDB * 2 * CH};
#ifndef NO_GEMM
            pg8::gemm_phase<EpiInProj, USE_SP2, pg8::StaticOrder>(lds, g, S, E);
#endif
#ifndef NO_SMALL
            small_gemm(g.A, g.Bt, 2048, D, E, bb >= (gg >> 1) ? bb - (gg >> 1) : -1, gg >> 1);
#endif
        }
        {
            FRESH();
            pg8::Gemm g{(const bf16_t*)(wl + W_KV) + (size_t)D * D, (const bf16_t*)(wsp + WS_MNB), D, TM, D, D, D}; pg8::StaticOrder S; S.init(D, TM, gg, (bb + gg - (32 % gg)) % gg);
            EpiVT E{(bf16_t*)(wsp + WS_VT) + (size_t)ll * D * TM, invmem_arr(wsp)};
#ifndef NO_GEMM
            pg8::gemm_phase<EpiVT, USE_SP2, pg8::StaticOrder>(lds, g, S, E);
#endif
        }
        XBAR();
        {
            FRESH();
            int tid2 = threadIdx.x; asm volatile("" : "+v"(tid2)); const int lane2 = tid2 & 63;
            const int w = wave * gg + bb; const int NGW2 = gg * 8;
            for (int rep = 0; rep < REP_SCAN; ++rep) {
#ifndef NO_SCAN
            for (int it = w; it < NB * 32 + NDB * 32; it += NGW2) scan_item(wsp, outp, ll, it, lds + wave * SCAN_LDS_WAVE, lane2);
#endif
#ifndef NO_CONV
            for (int run = NGW2 - 1 - w; run < T / 64; run += NGW2) conv_run(wsp, ll, run, lane2);
#endif
            }
        }
        XBAR();
        {
            FRESH();
            pg8::Gemm g{(const bf16_t*)(wsp + WS_YG), (const bf16_t*)(wl + W_GLU), T, CH, CH, CH, CH}; pg8::StaticOrder S; S.init(T, CH, gg, bb);
            EpiGLU E{(const bf16_t*)(wsp + WS_YG), (bf16_t*)(wsp + WS_YCAT), SSA(0)};
#ifndef NO_GEMM
            pg8::gemm_phase<EpiGLU, USE_SP2, pg8::StaticOrder>(lds, g, S, E);
#endif
#ifndef NO_SMALL
            small_gemm(g.A, g.Bt, CH, CH, E, bb, gg);
#endif
        }
        XBAR();
        {
            FRESH();
            pg8::Gemm g{(const bf16_t*)(wsp + WS_YCAT), (const bf16_t*)(wl + W_OUT), T, D, D, D, D}; pg8::StaticOrder S; S.init(T, D, gg, bb);
            EpiRes<true> E{(bf16_t*)(wsp + WS_XB), SSA(1), SSA(0)};
#ifndef NO_GEMM
            pg8::gemm_phase<EpiRes<true>, USE_SP2, pg8::StaticOrder>(lds, g, S, E);
#endif
#ifndef NO_SMALL
            small_gemm(g.A, g.Bt, D, D, E, bb, gg);
#endif
        }
        {
            FRESH();
            pg8::Gemm g{(const bf16_t*)(wsp + WS_MNB), (const bf16_t*)(wl + W_KV), TM, D, D, D, D}; pg8::StaticOrder S; S.init(TM, D, gg, (bb + gg - (16 % gg)) % gg);
            EpiKV<false> E{outp + O_MKP + (size_t)ll * TM * D, outp + O_MVP + (size_t)ll * TM * D, (bf16_t*)(wsp + WS_KB) + (size_t)ll * TM * D, invmem_arr(wsp)};
#if !defined(NO_GEMM)
            pg8::gemm_phase<EpiKV<false>, USE_SP2, pg8::StaticOrder>(lds, g, S, E);
#endif
        }
        XBAR();
        {
            FRESH();
            pg8::Gemm g{(const bf16_t*)(wsp + WS_XB), (const bf16_t*)(wl + W_Q), T, D, D, D, D}; pg8::StaticOrder S; S.init(T, D, gg, bb);
            EpiScale<0> E{(bf16_t*)(wsp + WS_Q), D, SSA(1)};
#ifndef NO_GEMM
            pg8::gemm_phase<EpiScale<0>, USE_SP2, pg8::StaticOrder>(lds, g, S, E);
#endif
#ifndef NO_SMALL
            small_gemm(g.A, g.Bt, D, D, E, bb, gg);
#endif
        }
        {
            FRESH();
            pg8::Gemm g{(const bf16_t*)(wsp + WS_MNB), (const bf16_t*)(wl + W_KV) + (size_t)D * D, TM, D, D, D, D}; pg8::StaticOrder S; S.init(TM, D, gg, (bb + gg - (16 % gg)) % gg);
            EpiKV<true> E{outp + O_MKP + (size_t)ll * TM * D, outp + O_MVP + (size_t)ll * TM * D, (bf16_t*)(wsp + WS_KB) + (size_t)ll * TM * D, invmem_arr(wsp)};
#if !defined(NO_GEMM)
            pg8::gemm_phase<EpiKV<true>, USE_SP2, pg8::StaticOrder>(lds, g, S, E);
#endif
        }
        XBAR();
        {
            FRESH();
#ifndef NO_ATTN
            for (int rep = 0; rep < REP_ATTN; ++rep) attn_phase(wsp, ll, lds, gg, bb);
#endif
        }
        XBAR();
        {
            FRESH();
            pg8::Gemm g{(const bf16_t*)(wsp + WS_O), (const bf16_t*)(wl + W_O), T, D, D, D, D}; pg8::StaticOrder S; S.init(T, D, gg, bb);
            EpiRes<false> E{(bf16_t*)(wsp + WS_XB), SSA(2), nullptr};
#ifndef NO_GEMM
            pg8::gemm_phase<EpiRes<false>, USE_SP2, pg8::StaticOrder>(lds, g, S, E);
#endif
#ifndef NO_SMALL
            small_gemm(g.A, g.Bt, D, D, E, bb, gg);
#endif
        }
        XBAR();
        {
            FRESH();
            pg8::Gemm g{(const bf16_t*)(wsp + WS_XB), (const bf16_t*)(wl + W_UP), T, DFF, D, D, D}; pg8::StaticOrder S; S.init(T, DFF, gg, bb);
            EpiScale<1> E{(bf16_t*)(wsp + WS_HDN), DFF, SSA(2)};
#ifndef NO_GEMM
            for (int rep = 0; rep < REP_UP; ++rep) pg8::gemm_phase<EpiScale<1>, USE_SP2, pg8::StaticOrder>(lds, g, S, E);
#endif
#ifndef NO_SMALL
            small_gemm(g.A, g.Bt, DFF, D, E, bb, gg);
#endif
        }
        XBAR();
        {
            FRESH();
            pg8::Gemm g{(const bf16_t*)(wsp + WS_HDN), (const bf16_t*)(wl + W_DOWN), TP, D, DFF, DFF, DFF}; pg8::StaticOrder S; S.init(TP, D, gg, bb);
            EpiRes<false> E{(bf16_t*)(wsp + WS_XB), SSA(3), nullptr};
#if !defined(NO_GEMM)
            pg8::gemm_phase<EpiRes<false>, USE_SP2, pg8::StaticOrder>(lds, g, S, E);
#endif
        }
        {
            FRESH();
            pg8::Gemm g{(const bf16_t*)(wsp + WS_HDN) + (size_t)TP * DFF, (const bf16_t*)(wl + W_DOWN), TS, D, D, DFF, DFF}; pg8::KSplitOrder S; S.init(TS, D, 4, D, gg, bb);
            EpiAtomic E{(float*)(wsp + WS_SCR)};
#if !defined(NO_GEMM)
            pg8::gemm_phase<EpiAtomic, USE_SP2, pg8::KSplitOrder>(lds, g, S, E);
#endif
        }
        XBAR();
        {
            FRESH();
            int tid4 = threadIdx.x; asm volatile("" : "+v"(tid4)); const int lane4 = tid4 & 63;
            GAS float* scr = (GAS float*)(wsp + WS_SCR); GAS float* ss3 = (GAS float*)SSA(3);
            for (int r = bb * 8 + wave; r < TS; r += gg * 8) {
                GAS f32x4* sp = (GAS f32x4*)(scr + (size_t)r * D) + lane4; GAS u32x2* xp = (GAS u32x2*)((bf16_t*)(wsp + WS_XB) + (size_t)(TP + r) * D) + lane4;
                float ssum = 0.f;
#pragma unroll
                for (int j = 0; j < 4; ++j) { const f32x4 d = (sp[64 * j] + sp[64 * j + (size_t)TS * D / 4]) + (sp[64 * j + 2 * ((size_t)TS * D / 4)] + sp[64 * j + 3 * ((size_t)TS * D / 4)]); const u32x2 w = xp[64 * j];
                    const f32x4 x = (f32x4){bf_lo(w.x), bf_hi(w.x), bf_lo(w.y), bf_hi(w.y)} + d;
                    ssum += (x[0] * x[0] + x[1] * x[1]) + (x[2] * x[2] + x[3] * x[3]);
                    u32x2 o; o.x = cvt_pk_bf16(x[0], x[1]); o.y = cvt_pk_bf16(x[2], x[3]); xp[64 * j] = o; }
                ssum = wave_sum(ssum);
                if (lane4 == 0) ss3[TP + r] = ssum;
            }
        }
        XBAR();
    }
    {
        int tid3 = threadIdx.x; asm volatile("" : "+v"(tid3)); const int lane = tid3 & 63;
        const bf16_t* XB = (const bf16_t*)(ws + WS_XB); const float* ssf = ss_arr(ws, 1 + 4 + 3); const GAS float* gf = (const GAS float*)(ws + WS_SMALL) + SM_GFIN;
        f32x4 gv[4];
#pragma unroll
        for (int j = 0; j < 4; ++j) gv[j] = *(const GAS f32x4*)(gf + 256 * j + 4 * lane);
        for (int m0 = (bid * 8 + wave) * 4; m0 < T; m0 += NGW * 4) {
            u32x2 wv[4][4]; float inv[4];
#pragma unroll
            for (int r = 0; r < 4; ++r) { const GAS u32x2* xr = (const GAS u32x2*)(XB + (size_t)(m0 + r) * D) + lane;
#pragma unroll
                for (int j = 0; j < 4; ++j) wv[r][j] = xr[64 * j];
                inv[r] = rsqrtf(((const GAS float*)ssf)[m0 + r] * (1.0f / D) + EPS); }
#pragma unroll
            for (int r = 0; r < 4; ++r) { GAS f32x4* o = (GAS f32x4*)(a.out + (size_t)(m0 + r) * D) + lane;
#pragma unroll
                for (int j = 0; j < 4; ++j) { const u32x2 w = wv[r][j]; o[64 * j] = (f32x4){bf_lo(w.x), bf_hi(w.x), bf_lo(w.y), bf_hi(w.y)} * inv[r] * gv[j]; } }
        }
    }
}

extern "C" void kernel_launch(void* const* d_in, const int* in_sizes, int n_in, void* d_out, int out_size, void* d_ws, size_t ws_size, hipStream_t stream) {
    static int grid = 0;
    if (grid == 0) {
        if (n_in != 33 || (size_t)out_size != O_END || ws_size < WS_END) { fprintf(stderr, "kernel_launch: unexpected sizes n_in %d out %d ws %zu (need %zu)\n", n_in, out_size, ws_size, (size_t)WS_END); grid = -1; return; }
        int dev = 0, cus = 0, per_cu = 0;
        (void)hipGetDevice(&dev); (void)hipDeviceGetAttribute(&cus, hipDeviceAttributeMultiprocessorCount, dev);
        if (hipFuncSetAttribute((const void*)hybrid_fwd, hipFuncAttributeMaxDynamicSharedMemorySize, LDS_BYTES) != hipSuccess) { fprintf(stderr, "kernel_launch: hipFuncSetAttribute failed\n"); grid = -1; return; }
        if (hipOccupancyMaxActiveBlocksPerMultiprocessor(&per_cu, (const void*)hybrid_fwd, 512, LDS_BYTES) != hipSuccess || per_cu < 1) { fprintf(stderr, "kernel_launch: occupancy query says %d\n", per_cu); per_cu = 1; }
        (void)hipGetLastError();
        grid = cus > 0 ? cus : 256;
    }
    if (grid < 0) return;
    if (hipMemsetAsync((char*)d_ws + WS_BAR, 0, BAR_BYTES, stream) != hipSuccess) { fprintf(stderr, "kernel_launch: hipMemsetAsync failed\n"); return; }
    Args a{};
    for (int i = 0; i < 33; ++i) a.in[i] = (const float*)d_in[i];
    a.out = (float*)d_out; a.ws = (unsigned char*)d_ws;
    void* args[] = {&a};
    hipError_t e = hipLaunchCooperativeKernel((const void*)hybrid_fwd, dim3(grid), dim3(512), args, LDS_BYTES, stream);
    if (e != hipSuccess) fprintf(stderr, "kernel_launch: cooperative launch failed: %s (grid %d)\n", hipGetErrorString(e), grid);
}
```
